# Optimizing an MI355X kernel written in HIP

```python
import math
import jax, jax.numpy as jnp
from jax import lax
import numpy as np

D_MODEL = 1024
BATCH = 4
SEQ = 8192
DEPTH = 1

CHUNK = 64
D_MIX = 2 * D_MODEL
D_MLSTM = D_MIX // 2
D_RGLRU = D_MIX - D_MLSTM
MLSTM_HEADS = 4
MLSTM_HEAD_DIM = D_MLSTM // MLSTM_HEADS
QKV_BLOCK = 4
RGLRU_BLOCKS = 4
RGLRU_BLOCK_W = D_RGLRU // RGLRU_BLOCKS
CONV_W = 4
RGLRU_C = 8.0
D_FF = 2816
EPS = 1e-6
M_INIT = -1e30

kernel_name = "hymba_mlstm_rglru_macaron_block"


def rmsnorm(x, g):
    xf = x.astype(jnp.float32)
    y = xf * lax.rsqrt(jnp.mean(xf * xf, axis=-1, keepdims=True) + EPS) * g.astype(jnp.float32)
    return y.astype(x.dtype)


def swiglu(x, wg, wu, wd):
    return (jax.nn.silu(x @ wg) * (x @ wu)) @ wd


def causal_dwconv(x, w, b):
    s = x.shape[1]
    xp = jnp.pad(x, ((0, 0), (CONV_W - 1, 0), (0, 0)))
    y = b
    for tap in range(CONV_W):
        y = y + w[tap] * xp[:, tap:tap + s]
    return y


def blockdiag(x, w):
    bsz, s, _ = x.shape
    nb, bi, bo = w.shape
    y = jnp.einsum('bsni,nio->bsno', x.reshape(bsz, s, nb, bi), w)
    return y.reshape(bsz, s, nb * bo)


def _mlstm_chunk_step(carry, inp):
    c_mem, n_mem, m_prev = carry
    q, k, v, ig, lf = inp
    L = q.shape[2]
    b = jnp.cumsum(lf, axis=-1)
    g = b[..., -1]
    causal = jnp.tril(jnp.ones((L, L), dtype=bool))
    dlog = b[..., :, None] - b[..., None, :] + ig[..., None, :]
    dlog = jnp.where(causal, dlog, -jnp.inf)
    inter = b + m_prev[..., None]
    m_row = jnp.maximum(inter, jnp.max(dlog, axis=-1))
    s = jnp.einsum('bhid,bhjd->bhij', q, k) * jnp.exp(dlog - m_row[..., None])
    inter_w = jnp.exp(inter - m_row)
    num = (jnp.einsum('bhij,bhjd->bhid', s, v)
           + inter_w[..., None] * jnp.einsum('bhvk,bhik->bhiv', c_mem, q))
    den = jnp.sum(s, axis=-1) + inter_w * jnp.einsum('bhk,bhik->bhi', n_mem, q)
    h = num / jnp.maximum(jnp.abs(den), jnp.exp(-m_row))[..., None]
    w = g[..., None] - b + ig
    m_new = jnp.maximum(g + m_prev, jnp.max(w, axis=-1))
    decay = jnp.exp(g + m_prev - m_new)
    wk = jnp.exp(w - m_new[..., None])
    c_new = decay[..., None, None] * c_mem + jnp.einsum('bhjv,bhjk->bhvk', v * wk[..., None], k)
    n_new = decay[..., None] * n_mem + jnp.einsum('bhj,bhjk->bhk', wk, k)
    return (c_new, n_new, m_new), h


def mlstm_group(x_m, z_m, conv_w, conv_b, wq, wk, wv, w_gates, b_gates, ln_w, skip):
    bsz, s, _ = x_m.shape
    H, dh = MLSTM_HEADS, MLSTM_HEAD_DIM
    nc = s // CHUNK
    xc = jax.nn.silu(causal_dwconv(x_m, conv_w, conv_b))
    q = blockdiag(xc, wq)
    k = blockdiag(xc, wk)
    v = blockdiag(x_m, wv)
    gates = (jnp.concatenate([q, k, v], axis=-1) @ w_gates + b_gates).astype(jnp.float32)
    ig = gates[..., :H]
    lf = jax.nn.log_sigmoid(gates[..., H:])

    def to_chunks(t):
        return t.astype(jnp.float32).reshape(bsz, nc, CHUNK, H, dh).transpose(1, 0, 3, 2, 4)

    def gate_chunks(t):
        return t.reshape(bsz, nc, CHUNK, H).transpose(1, 0, 3, 2)

    xs = (to_chunks(q), to_chunks(k) * (dh ** -0.5), to_chunks(v), gate_chunks(ig), gate_chunks(lf))
    carry0 = (jnp.zeros((bsz, H, dh, dh), jnp.float32),
              jnp.zeros((bsz, H, dh), jnp.float32),
              jnp.full((bsz, H), M_INIT, jnp.float32))
    _, hs = lax.scan(_mlstm_chunk_step, carry0, xs)
    h = hs.transpose(1, 0, 3, 2, 4).reshape(bsz, s, H, dh)
    mu = jnp.mean(h, axis=-1, keepdims=True)
    var = jnp.mean(jnp.square(h - mu), axis=-1, keepdims=True)
    hn = (h - mu) * lax.rsqrt(var + EPS) * ln_w.astype(jnp.float32).reshape(H, dh)
    hn = hn.reshape(bsz, s, D_MLSTM).astype(x_m.dtype)
    return (hn + skip * xc) * jax.nn.silu(z_m)


def _lin_combine(left, right):
    a_l, b_l = left
    a_r, b_r = right
    return a_l * a_r, a_r * b_l + b_r


def rglru_group(x_r, y_r, conv_w, conv_b, w_a, b_a, w_x, b_x, lam):
    xc = causal_dwconv(x_r, conv_w, conv_b)
    r = jax.nn.sigmoid((blockdiag(xc, w_a) + b_a).astype(jnp.float32))
    i = jax.nn.sigmoid((blockdiag(xc, w_x) + b_x).astype(jnp.float32))
    log_a = RGLRU_C * r * jax.nn.log_sigmoid(lam.astype(jnp.float32))
    a = jnp.exp(log_a)
    u = jnp.sqrt(-jnp.expm1(2.0 * log_a)) * (i * xc.astype(jnp.float32))
    _, h = lax.associative_scan(_lin_combine, (a, u), axis=1)
    return h.astype(x_r.dtype) * jax.nn.gelu(y_r)


def setup_inputs(seed: int = 0) -> dict:
    key = jax.random.key(seed)
    ks = iter(jax.random.split(key, 48))
    Ly = DEPTH
    H = MLSTM_HEADS

    def nrm(shape, scale):
        return jax.random.normal(next(ks), shape, jnp.float32) * scale

    def gain(shape):
        return 1.0 + nrm(shape, 0.02)

    x = nrm((BATCH, SEQ, D_MODEL), 1.0)
    norm_ffn1 = gain((Ly, D_MODEL))
    ffn1_wg = nrm((Ly, D_MODEL, D_FF), D_MODEL ** -0.5)
    ffn1_wu = nrm((Ly, D_MODEL, D_FF), D_MODEL ** -0.5)
    ffn1_wd = nrm((Ly, D_FF, D_MODEL), D_FF ** -0.5)
    norm_mix = gain((Ly, D_MODEL))
    w_in = nrm((Ly, D_MODEL, 2 * D_MLSTM + 2 * D_RGLRU), D_MODEL ** -0.5)
    m_conv_w = nrm((Ly, CONV_W, D_MLSTM), CONV_W ** -0.5)
    m_conv_b = nrm((Ly, D_MLSTM), 0.02)
    nqb = D_MLSTM // QKV_BLOCK
    m_wq = nrm((Ly, nqb, QKV_BLOCK, QKV_BLOCK), QKV_BLOCK ** -0.5)
    m_wk = nrm((Ly, nqb, QKV_BLOCK, QKV_BLOCK), QKV_BLOCK ** -0.5)
    m_wv = nrm((Ly, nqb, QKV_BLOCK, QKV_BLOCK), QKV_BLOCK ** -0.5)
    m_w_gates = nrm((Ly, 3 * D_MLSTM, 2 * H), (3 * D_MLSTM) ** -0.5)
    i_bias = nrm((Ly, H), 0.1)
    f_bias = jnp.linspace(3.0, 6.0, H, dtype=jnp.float32) + nrm((Ly, H), 0.1)
    m_b_gates = jnp.concatenate([i_bias, f_bias], axis=-1)
    m_ln_w = gain((Ly, D_MLSTM))
    m_skip = gain((Ly, D_MLSTM))
    r_conv_w = nrm((Ly, CONV_W, D_RGLRU), CONV_W ** -0.5)
    r_conv_b = nrm((Ly, D_RGLRU), 0.02)
    r_w_a = nrm((Ly, RGLRU_BLOCKS, RGLRU_BLOCK_W, RGLRU_BLOCK_W), RGLRU_BLOCK_W ** -0.5)
    r_b_a = nrm((Ly, D_RGLRU), 0.02)
    r_w_x = nrm((Ly, RGLRU_BLOCKS, RGLRU_BLOCK_W, RGLRU_BLOCK_W), RGLRU_BLOCK_W ** -0.5)
    r_b_x = nrm((Ly, D_RGLRU), 0.02)
    a0 = jax.random.uniform(next(ks), (Ly, D_RGLRU), jnp.float32, minval=0.9, maxval=0.999)
    sa = a0 ** (1.0 / RGLRU_C)
    r_lam = jnp.log(sa) - jnp.log1p(-sa)
    out_norm_m = gain((Ly, D_MLSTM))
    out_norm_r = gain((Ly, D_RGLRU))
    w_out = nrm((Ly, D_MIX, D_MODEL), D_MIX ** -0.5)
    norm_ffn2 = gain((Ly, D_MODEL))
    ffn2_wg = nrm((Ly, D_MODEL, D_FF), D_MODEL ** -0.5)
    ffn2_wu = nrm((Ly, D_MODEL, D_FF), D_MODEL ** -0.5)
    ffn2_wd = nrm((Ly, D_FF, D_MODEL), D_FF ** -0.5)
    norm_final = gain((D_MODEL,))
    return {"x": x, "norm_ffn1": norm_ffn1, "ffn1_wg": ffn1_wg, "ffn1_wu": ffn1_wu,
            "ffn1_wd": ffn1_wd, "norm_mix": norm_mix, "w_in": w_in,
            "m_conv_w": m_conv_w, "m_conv_b": m_conv_b, "m_wq": m_wq, "m_wk": m_wk,
            "m_wv": m_wv, "m_w_gates": m_w_gates, "m_b_gates": m_b_gates,
            "m_ln_w": m_ln_w, "m_skip": m_skip, "r_conv_w": r_conv_w,
            "r_conv_b": r_conv_b, "r_w_a": r_w_a, "r_b_a": r_b_a, "r_w_x": r_w_x,
            "r_b_x": r_b_x, "r_lam": r_lam, "out_norm_m": out_norm_m,
            "out_norm_r": out_norm_r, "w_out": w_out, "norm_ffn2": norm_ffn2,
            "ffn2_wg": ffn2_wg, "ffn2_wu": ffn2_wu, "ffn2_wd": ffn2_wd,
            "norm_final": norm_final}


def reference(x, norm_ffn1, ffn1_wg, ffn1_wu, ffn1_wd, norm_mix, w_in, m_conv_w, m_conv_b,
              m_wq, m_wk, m_wv, m_w_gates, m_b_gates, m_ln_w, m_skip, r_conv_w, r_conv_b,
              r_w_a, r_b_a, r_w_x, r_b_x, r_lam, out_norm_m, out_norm_r, w_out, norm_ffn2,
              ffn2_wg, ffn2_wu, ffn2_wd, norm_final):
    split_at = [D_MLSTM, 2 * D_MLSTM, 2 * D_MLSTM + D_RGLRU]
    for l in range(DEPTH):
        x = x + 0.5 * swiglu(rmsnorm(x, norm_ffn1[l]), ffn1_wg[l], ffn1_wu[l], ffn1_wd[l])
        h = rmsnorm(x, norm_mix[l])
        proj = h @ w_in[l]
        x_m, z_m, x_r, y_r = jnp.split(proj, split_at, axis=-1)
        out_m = mlstm_group(x_m, z_m, m_conv_w[l], m_conv_b[l], m_wq[l], m_wk[l], m_wv[l],
                            m_w_gates[l], m_b_gates[l], m_ln_w[l], m_skip[l]).astype(x.dtype)
        out_r = rglru_group(x_r, y_r, r_conv_w[l], r_conv_b[l], r_w_a[l], r_b_a[l],
                            r_w_x[l], r_b_x[l], r_lam[l]).astype(x.dtype)
        mixed = jnp.concatenate([rmsnorm(out_m, out_norm_m[l]),
                                 rmsnorm(out_r, out_norm_r[l])], axis=-1)
        x = x + mixed @ w_out[l]
        x = x + 0.5 * swiglu(rmsnorm(x, norm_ffn2[l]), ffn2_wg[l], ffn2_wu[l], ffn2_wd[l])
    return rmsnorm(x, norm_final)
```

```cpp
#include <hip/hip_runtime.h>
#include <hip/hip_cooperative_groups.h>
#include <cstdio>
#include <cstdint>
namespace cg = cooperative_groups;

#define LAS __attribute__((address_space(3)))
typedef unsigned short bf16_t;
typedef short bf16x8 __attribute__((ext_vector_type(8)));
typedef float f32x4 __attribute__((ext_vector_type(4)));
typedef unsigned u32x4 __attribute__((ext_vector_type(4)));
typedef unsigned u32x2 __attribute__((ext_vector_type(2)));

constexpr int T = 32768, D = 1024, FF = 2816, SEQ = 8192, NB = 4;
constexpr float EPS = 1e-6f;
constexpr size_t MiB = 1u << 20;
constexpr size_t WS_SSA = 0, WS_SSB = 2 * MiB, WS_SSC = 4 * MiB, WS_SSD = 6 * MiB;
constexpr size_t WS_GATES = 8 * MiB;
constexpr size_t WS_AGG = 9 * MiB;
constexpr size_t WS_BAR = 14 * MiB;
constexpr size_t WS_C8 = 12 * MiB;
constexpr size_t WS_WG8 = 11 * MiB;
constexpr size_t WS_WGU1 = 16 * MiB;
constexpr size_t WS_WD1 = WS_WGU1 + 11 * MiB;
constexpr size_t WS_WIN = WS_WD1 + 11 * MiB / 2;
constexpr size_t WS_WRG = WS_WIN + 8 * MiB;
constexpr size_t WS_WOUT = WS_WRG + 1 * MiB;
constexpr size_t WS_WGU2 = WS_WOUT + 4 * MiB;
constexpr size_t WS_WD2 = WS_WGU2 + 11 * MiB;
constexpr size_t WS_XB = 64 * MiB;
constexpr size_t WS_R1 = 128 * MiB;
constexpr size_t WS_XM = WS_R1, WS_ZM = WS_R1 + 64 * MiB, WS_XR = WS_R1 + 128 * MiB, WS_YR = WS_R1 + 192 * MiB;
constexpr size_t WS_XC = 384 * MiB;
constexpr size_t WS_U = 448 * MiB;
constexpr size_t WS_END = 512 * MiB;
constexpr int LDS_BYTES = 147456;

typedef float f32x2_t __attribute__((ext_vector_type(2)));
typedef __bf16 bf16x2_t __attribute__((ext_vector_type(2)));
__device__ __forceinline__ unsigned pk2(float lo, float hi) { const f32x2_t v = {lo, hi}; const bf16x2_t b = __builtin_convertvector(v, bf16x2_t); return __builtin_bit_cast(unsigned, b); }
__device__ __forceinline__ float bflo(unsigned u) { return __uint_as_float(u << 16); }
__device__ __forceinline__ float bfhi(unsigned u) { return __uint_as_float(u & 0xffff0000u); }
__device__ __forceinline__ float bf1(bf16_t u) { return __uint_as_float(((unsigned)u) << 16); }
__device__ __forceinline__ void unpack8(const u32x4 v, float* x) { x[0] = bflo(v.x); x[1] = bfhi(v.x); x[2] = bflo(v.y); x[3] = bfhi(v.y); x[4] = bflo(v.z); x[5] = bfhi(v.z); x[6] = bflo(v.w); x[7] = bfhi(v.w); }
__device__ __forceinline__ u32x4 pack8(const float* x) { u32x4 o; o.x = pk2(x[0], x[1]); o.y = pk2(x[2], x[3]); o.z = pk2(x[4], x[5]); o.w = pk2(x[6], x[7]); return o; }
__device__ __forceinline__ float sigmoidf_(float x) { return __builtin_amdgcn_rcpf(1.0f + __expf(-x)); }
__device__ __forceinline__ float siluf_(float x) { return x * __builtin_amdgcn_rcpf(1.0f + __expf(-x)); }
__device__ __forceinline__ float logsigf_(float x) { return fminf(x, 0.f) - __logf(1.0f + __expf(-fabsf(x))); }
__device__ __forceinline__ float logsig_acc_(float x) { return fminf(x, 0.f) - log1pf(expf(-fabsf(x))); }
__device__ __forceinline__ float geluf_(float x) { const float u = 0.7978845608028654f * (x + 0.044715f * x * x * x); const float t = 1.0f - 2.0f * __builtin_amdgcn_rcpf(1.0f + __expf(2.0f * u)); return 0.5f * x * (1.0f + t); }
__device__ __forceinline__ int opaque_tid() { int t = threadIdx.x; asm volatile("" : "+v"(t)); return t; }
__device__ __forceinline__ float wave_sum(float v) {
#pragma unroll
    for (int o = 1; o < 64; o <<= 1) v += __shfl_xor(v, o);
    return v;
}

namespace pg8 {
constexpr int BM = 256, BK = 64, HALF = 128, HTB = HALF * BK * 2, STAGE_BYTES = 8 * HTB, NXCD = 8, WGM = 8;
__host__ __device__ __forceinline__ int lds_byte(int r, int c) { const int st = (r >> 4) * 2 + (c >> 5), rr = r & 15, cc = c & 31, ob = rr * 64 + cc * 2; return st * 1024 + (ob ^ (((ob >> 9) & 1) << 5)); }
__host__ __device__ __forceinline__ void stage_rc(int b, int& R, int& C) { const int st = b / 1024, sb = b % 1024, swz = sb ^ (((sb >> 9) & 1) << 5); R = (st >> 1) * 16 + swz / 64; C = (st & 1) * 32 + (swz % 64) / 2; }
__host__ __device__ __forceinline__ int perm32(int rho) { const int n = rho >> 4, i = rho & 15; return 8 * (i >> 2) + 4 * n + (i & 3); }

struct Unit { int pm, pn; };
struct Gemm { const bf16_t* A; const bf16_t* Bt; int K; int lda; int ksplit; long kdelta; int a_pn_shift; int a_pn_bytes; };

struct StaticOrder {
    int nM, nN, nwg, G, c;
    __device__ void init(int M, int N, int G_, int c_) { nM = M / BM; nN = N / BM; nwg = nM * nN; G = G_; c = c_; }
    __device__ bool next(int i, Unit& u) const {
        const long L = (long)i * G + c; if (L >= nwg) return false;
        int wgid = (int)L; { const int q = nwg / NXCD, r = nwg % NXCD, xcd = wgid % NXCD, off = wgid / NXCD; wgid = (xcd < r ? xcd * (q + 1) : r * (q + 1) + (xcd - r) * q) + off; }
        const int nig = WGM * nN, gid = wgid / nig, fm = gid * WGM, gsz = (nM - fm) < WGM ? (nM - fm) : WGM;
        u.pm = fm + ((wgid % nig) % gsz); u.pn = (wgid % nig) / gsz; return true;
    }
};
struct ListOrder {
    int first, cnt, nshift;
    __device__ bool next(int i, Unit& u) const { if (i >= cnt) return false; const int L = first + i; u.pm = L >> nshift; u.pn = L & ((1 << nshift) - 1); return true; }
};

__device__ __forceinline__ float row_scale(const float* SS, int r) {
    const f32x4* p = (const f32x4*)(SS + (size_t)r * 16);
    const f32x4 a = p[0], b = p[1], c = p[2], d = p[3];
    const float s = ((a[0] + a[1]) + (a[2] + a[3])) + ((b[0] + b[1]) + (b[2] + b[3])) + ((c[0] + c[1]) + (c[2] + c[3])) + ((d[0] + d[1]) + (d[2] + d[3]));
    return rsqrtf(s * (1.0f / 1024.0f) + EPS);
}

__device__ __forceinline__ void row_scales8(const float* SS, int row0, int fq, float (&rs)[8]) {
    f32x4 v[8];
#pragma unroll
    for (int q = 0; q < 8; ++q) v[q] = *(const f32x4*)(SS + (size_t)(row0 + (q >> 2) * HALF + (q & 3) * 16) * 16 + fq * 4);
#pragma unroll
    for (int q = 0; q < 8; ++q) { float s = (v[q][0] + v[q][1]) + (v[q][2] + v[q][3]); s += __shfl_xor(s, 16); s += __shfl_xor(s, 32); rs[q] = rsqrtf(s * (1.0f / 1024.0f) + EPS); }
}
struct EpiSwiGLU {
    bf16_t* O; const float* SS;
    __device__ __forceinline__ void operator()(const f32x4 (&acc)[2][2][4][2], const Unit& u, int wr, int wc, int fr, int fq) const {
        const int row0 = u.pm * BM + wr * 64 + fr, col0 = u.pn * HALF + wc * 32 + 8 * fq;
        float rs8[8]; row_scales8(SS, row0, fq, rs8);
#pragma unroll
        for (int ai = 0; ai < 2; ++ai)
#pragma unroll
            for (int m = 0; m < 4; ++m) {
                const int r = row0 + ai * HALF + m * 16; const float rs = rs8[ai * 4 + m];
                float o[8];
#pragma unroll
                for (int n = 0; n < 2; ++n)
#pragma unroll
                    for (int j = 0; j < 4; ++j) { const float g = acc[ai][0][m][n][j] * rs, up = acc[ai][1][m][n][j] * rs; o[n * 4 + j] = siluf_(g) * up; }
                *(u32x4*)(O + (size_t)r * FF + col0) = pack8(o);
            }
    }
};
struct EpiResid {
    const float* Xin; float* Xout; bf16_t* XBo; float* SSo; float alpha;
    __device__ __forceinline__ void operator()(const f32x4 (&acc)[2][2][4][2], const Unit& u, int wr, int wc, int fr, int fq) const {
        const int row0 = u.pm * BM + wr * 64 + fr, col0 = u.pn * BM + wc * 32 + 8 * fq;
#pragma unroll
        for (int ai = 0; ai < 2; ++ai)
#pragma unroll
            for (int m = 0; m < 4; ++m) {
                const int r = row0 + ai * HALF + m * 16; float ss = 0.f;
#pragma unroll
                for (int bj = 0; bj < 2; ++bj) {
                    const size_t off = (size_t)r * D + col0 + bj * HALF;
                    const f32x4 x0 = *(const f32x4*)(Xin + off), x1 = *(const f32x4*)(Xin + off + 4);
                    const f32x4 v0 = x0 + acc[ai][bj][m][0] * alpha, v1 = x1 + acc[ai][bj][m][1] * alpha;
                    *(f32x4*)(Xout + off) = v0; *(f32x4*)(Xout + off + 4) = v1;
                    ss += (v0[0] * v0[0] + v0[1] * v0[1]) + (v0[2] * v0[2] + v0[3] * v0[3]) + (v1[0] * v1[0] + v1[1] * v1[1]) + (v1[2] * v1[2] + v1[3] * v1[3]);
                    if (XBo) { u32x4 w; w.x = pk2(v0[0], v0[1]); w.y = pk2(v0[2], v0[3]); w.z = pk2(v1[0], v1[1]); w.w = pk2(v1[2], v1[3]); *(u32x4*)(XBo + off) = w; }
                }
                ss += __shfl_xor(ss, 16); ss += __shfl_xor(ss, 32);
                if (fq == 0) SSo[(size_t)r * 16 + u.pn * 4 + wc] = ss;
            }
    }
};
struct EpiProj {
    bf16_t* O; const float* SS;
    __device__ __forceinline__ void operator()(const f32x4 (&acc)[2][2][4][2], const Unit& u, int wr, int wc, int fr, int fq) const {
        bf16_t* base = O + (size_t)(u.pn >> 2) * ((size_t)T * D);
        const int row0 = u.pm * BM + wr * 64 + fr, col0 = (u.pn & 3) * BM + wc * 32 + 8 * fq;
        float rs8[8]; row_scales8(SS, row0, fq, rs8);
#pragma unroll
        for (int ai = 0; ai < 2; ++ai)
#pragma unroll
            for (int m = 0; m < 4; ++m) {
                const int r = row0 + ai * HALF + m * 16; const float rs = rs8[ai * 4 + m];
#pragma unroll
                for (int bj = 0; bj < 2; ++bj) {
                    const f32x4 v0 = acc[ai][bj][m][0] * rs, v1 = acc[ai][bj][m][1] * rs;
                    u32x4 w; w.x = pk2(v0[0], v0[1]); w.y = pk2(v0[2], v0[3]); w.z = pk2(v1[0], v1[1]); w.w = pk2(v1[2], v1[3]);
                    *(u32x4*)(base + (size_t)r * D + col0 + bj * HALF) = w;
                }
            }
    }
};
__device__ __forceinline__ float neg_expm1_(float x) {
    const float p = -x * (1.0f + x * (0.5f + x * (0.16666667f + x * (0.041666668f + x * 0.0083333338f))));
    const float e = 1.0f - __expf(x);
    return (x > -0.3f) ? p : e;
}
struct EpiRg {
    const bf16_t* XCR; const float* ba; const float* bx; const float* c8t; bf16_t* LOGA; bf16_t* U;
    __device__ __forceinline__ void operator()(const f32x4 (&acc)[2][2][4][2], const Unit& u, int wr, int wc, int fr, int fq) const {
        const int row0 = u.pm * BM + wr * 64 + fr, ch0 = (u.pn >> 1) * 256 + (u.pn & 1) * HALF + wc * 32 + 8 * fq;
#pragma unroll
        for (int n = 0; n < 2; ++n) {
            const int ch = ch0 + 4 * n;
            const f32x4 b_a = *(const f32x4*)(ba + ch), b_x = *(const f32x4*)(bx + ch), c8 = *(const f32x4*)(c8t + ch);
#pragma unroll
            for (int ai = 0; ai < 2; ++ai)
#pragma unroll
                for (int m = 0; m < 4; ++m) {
                    const int r = row0 + ai * HALF + m * 16;
                    const u32x2 xv = *(const u32x2*)(XCR + (size_t)r * D + ch);
                    const float xc[4] = {bflo(xv.x), bfhi(xv.x), bflo(xv.y), bfhi(xv.y)};
                    float la[4], uu[4];
#pragma unroll
                    for (int j = 0; j < 4; ++j) {
                        const float rg = sigmoidf_(acc[ai][0][m][n][j] + b_a[j]), ig = sigmoidf_(acc[ai][1][m][n][j] + b_x[j]);
                        la[j] = c8[j] * rg;
                        uu[j] = __builtin_amdgcn_sqrtf(fmaxf(neg_expm1_(2.0f * la[j]), 0.f)) * (ig * xc[j]);
                    }
                    u32x2 w0, w1; w0.x = pk2(la[0], la[1]); w0.y = pk2(la[2], la[3]); w1.x = pk2(uu[0], uu[1]); w1.y = pk2(uu[2], uu[3]);
                    *(u32x2*)(LOGA + (size_t)r * D + ch) = w0; *(u32x2*)(U + (size_t)r * D + ch) = w1;
                    __builtin_amdgcn_sched_barrier(0);
                }
        }
    }
};
struct EpiGates {
    float* G; const float* bg;
    __device__ __forceinline__ void operator()(const f32x4 (&acc)[2][2][4][2], const Unit& u, int wr, int wc, int fr, int fq) const {
        if (wc != 0 || fq != 0) return;
        const int row0 = u.pm * BM + wr * 64 + fr;
        const f32x4 b0 = *(const f32x4*)(bg), b1 = *(const f32x4*)(bg + 4);
#pragma unroll
        for (int ai = 0; ai < 2; ++ai)
#pragma unroll
            for (int m = 0; m < 4; ++m) {
                const int r = row0 + ai * HALF + m * 16;
                f32x4 v0 = acc[ai][0][m][0] + b0, v1 = acc[ai][0][m][1] + b1;
                for (int j = 0; j < 4; ++j) v1[j] = logsigf_(v1[j]);
                *(f32x4*)(G + (size_t)r * 8) = v0; *(f32x4*)(G + (size_t)r * 8 + 4) = v1;
            }
    }
};

template <class Epi, class Sched>
__device__ __forceinline__ void gemm_phase(LAS unsigned char* lds, const Gemm g, const Sched& S, const Epi& E) {
    const int tid = opaque_tid(), wid = __builtin_amdgcn_readfirstlane(tid >> 6), lane = tid & 63, wr = wid >> 2, wc = wid & 3, fr = lane & 15, fq = lane >> 4;
    const int K = g.K, nt = K / BK, lda = g.lda;
    unsigned voffA[2], voffB[2];
#pragma unroll
    for (int i = 0; i < 2; ++i) { int R, C; stage_rc(tid * 16 + i * 8192, R, C); const int Rb = (R & ~31) + perm32(R & 31);
        voffA[i] = (unsigned)(R * lda + C) * 2u; voffB[i] = (unsigned)(Rb * K + C) * 2u; }
    const size_t kstep = (size_t)(BK * 2);
    const size_t hstepA = (size_t)HALF * lda * 2, tstepA = 2 * hstepA;
    const size_t hstepB = (size_t)HALF * K * 2, tstepB = 2 * hstepB;
    const unsigned ldsw = (unsigned)wid * 1024u;
    const int aoff = lds_byte(wr * 64 + fr, fq * 8), boff = lds_byte(wc * 32 + fr, fq * 8);
    const int ksplit = g.ksplit; const long kdelta = g.kdelta;
#define PG8_AK(t) ((long)(t) * (long)kstep + (((t) >= ksplit) ? kdelta : 0l))
#define PG8_SA(b, h) (((b) * 2 + (h)) * HTB)
#define PG8_SB(b, h) ((4 + (b) * 2 + (h)) * HTB)
#define PG8_STAGE(bufoff, gbase, voff) do { _Pragma("unroll") for (int _i = 0; _i < 2; ++_i) \
        __builtin_amdgcn_global_load_lds((const unsigned*)((const char*)(gbase) + (voff)[_i]), (LAS unsigned*)(lds + (bufoff) + ldsw + _i * 8192), 16, 0, 0); } while (0)
#define PG8_LDA(dst, b, h) do { _Pragma("unroll") for (int m = 0; m < 4; ++m) _Pragma("unroll") for (int k = 0; k < 2; ++k) dst[m][k] = *(const LAS bf16x8*)(lds + PG8_SA(b, h) + aoff + m * 2048 + k * 1024); } while (0)
#define PG8_LDB(dst, b, h) do { _Pragma("unroll") for (int n = 0; n < 2; ++n) _Pragma("unroll") for (int k = 0; k < 2; ++k) dst[n][k] = *(const LAS bf16x8*)(lds + PG8_SB(b, h) + boff + n * 2048 + k * 1024); } while (0)
#define PG8_MMA(ai, bj, At, Bt) do { __builtin_amdgcn_s_setprio(1); _Pragma("unroll") for (int m = 0; m < 4; ++m) _Pragma("unroll") for (int n = 0; n < 2; ++n) _Pragma("unroll") for (int k = 0; k < 2; ++k) \
        acc[ai][bj][m][n] = __builtin_amdgcn_mfma_f32_16x16x32_bf16(Bt[n][k], At[m][k], acc[ai][bj][m][n], 0, 0, 0); __builtin_amdgcn_s_setprio(0); } while (0)
#define PG8_WAIT_V(n) asm volatile("s_waitcnt vmcnt(" #n ")" ::: "memory")
#define PG8_WAIT_L(n) asm volatile("s_waitcnt lgkmcnt(" #n ")" ::: "memory")
#define PG8_BAR __builtin_amdgcn_s_barrier()
#define PG8_SCHED __builtin_amdgcn_sched_barrier(0)
    Unit cur, nxt; int ui = 0;
    if (!S.next(0, cur)) return;
    f32x4 acc[2][2][4][2];
#pragma unroll
    for (int a = 0; a < 2; ++a)
#pragma unroll
        for (int b = 0; b < 2; ++b)
#pragma unroll
            for (int m = 0; m < 4; ++m)
#pragma unroll
                for (int n = 0; n < 2; ++n) acc[a][b][m][n] = (f32x4){0.f, 0.f, 0.f, 0.f};
    bf16x8 At[4][2], B0[2][2], B1[2][2];
    const char* cA = (const char*)g.A + (size_t)cur.pm * tstepA + (size_t)(cur.pn >> g.a_pn_shift) * g.a_pn_bytes;
    const char* cB = (const char*)g.Bt + (size_t)cur.pn * tstepB;
    {
        PG8_STAGE(PG8_SB(0, 0), cB, voffB); PG8_STAGE(PG8_SB(0, 1), cB + hstepB, voffB); PG8_STAGE(PG8_SA(0, 0), cA, voffA); PG8_STAGE(PG8_SA(0, 1), cA + hstepA, voffA);
        if (wr == 1) PG8_BAR;
        PG8_WAIT_V(2); PG8_BAR;
        PG8_STAGE(PG8_SB(1, 0), cB + kstep, voffB); PG8_STAGE(PG8_SA(1, 0), cA + PG8_AK(1), voffA); PG8_STAGE(PG8_SB(1, 1), cB + hstepB + kstep, voffB);
        PG8_WAIT_V(6); PG8_BAR;
    }
    for (;;) {
        const bool has_next = S.next(ui + 1, nxt);
        const char* nA = has_next ? (const char*)g.A + (size_t)nxt.pm * tstepA + (size_t)(nxt.pn >> g.a_pn_shift) * g.a_pn_bytes : cA;
        const char* nB = has_next ? (const char*)g.Bt + (size_t)nxt.pn * tstepB : cB;
#pragma nounroll
        for (int t = 0; t < nt; t += 2) {
            const bool last = (t == nt - 2);
            const char* a1 = cA + PG8_AK(t + 1);
            const char* a2 = last ? nA : cA + PG8_AK(t + 2); const char* b2 = last ? nB : cB + (size_t)(t + 2) * kstep;
            const char* a3 = last ? nA + PG8_AK(1) : cA + PG8_AK(t + 3); const char* b3 = b2 + kstep;
            PG8_LDB(B0, 0, 0); PG8_LDB(B1, 0, 1); PG8_SCHED; PG8_LDA(At, 0, 0); PG8_STAGE(PG8_SA(1, 1), a1 + hstepA, voffA);
            PG8_WAIT_V(8); PG8_WAIT_L(0); PG8_BAR; PG8_MMA(0, 0, At, B0); PG8_MMA(0, 1, At, B1); PG8_BAR; PG8_SCHED;
            PG8_LDA(At, 0, 1); PG8_STAGE(PG8_SB(0, 0), b2, voffB); PG8_STAGE(PG8_SB(0, 1), b2 + hstepB, voffB); PG8_STAGE(PG8_SA(0, 0), a2, voffA);
            PG8_WAIT_V(8); PG8_WAIT_L(0); PG8_BAR; PG8_MMA(1, 0, At, B0); PG8_MMA(1, 1, At, B1); PG8_BAR; PG8_SCHED;
            PG8_LDB(B0, 1, 0); PG8_LDB(B1, 1, 1); PG8_SCHED; PG8_LDA(At, 1, 0); PG8_STAGE(PG8_SA(0, 1), a2 + hstepA, voffA);
            PG8_WAIT_V(8); PG8_WAIT_L(0); PG8_BAR; PG8_MMA(0, 0, At, B0); PG8_MMA(0, 1, At, B1); PG8_BAR; PG8_SCHED;
            PG8_LDA(At, 1, 1); PG8_STAGE(PG8_SB(1, 0), b3, voffB); PG8_STAGE(PG8_SB(1, 1), b3 + hstepB, voffB); PG8_STAGE(PG8_SA(1, 0), a3, voffA);
            PG8_WAIT_V(8); PG8_WAIT_L(0); PG8_BAR; PG8_MMA(1, 0, At, B0); PG8_MMA(1, 1, At, B1); PG8_BAR; PG8_SCHED;
        }
        if (wr == 0) PG8_BAR;
        E(acc, cur, wr, wc, fr, fq);
        if (!has_next) break;
#pragma unroll
        for (int a = 0; a < 2; ++a)
#pragma unroll
            for (int b = 0; b < 2; ++b)
#pragma unroll
                for (int m = 0; m < 4; ++m)
#pragma unroll
                    for (int n = 0; n < 2; ++n) acc[a][b][m][n] = (f32x4){0.f, 0.f, 0.f, 0.f};
        cur = nxt; cA = nA; cB = nB; ++ui;
        if (wr == 1) PG8_BAR;
    }
    PG8_WAIT_V(0);
    PG8_BAR;
#undef PG8_AK
#undef PG8_SA
#undef PG8_SB
#undef PG8_STAGE
#undef PG8_LDA
#undef PG8_LDB
#undef PG8_MMA
#undef PG8_WAIT_V
#undef PG8_WAIT_L
#undef PG8_BAR
#undef PG8_SCHED
}
}

struct Args { const float* in[31]; float* out; unsigned char* ws; };
enum { I_X = 0, I_NF1, I_WG1, I_WU1, I_WD1, I_NMIX, I_WIN, I_MCW, I_MCB, I_WQ, I_WK, I_WV, I_WGATES, I_BGATES, I_LNW, I_SKIP, I_RCW, I_RCB, I_RWA, I_RBA, I_RWX, I_RBX, I_LAM,
       I_ONM, I_ONR, I_WOUT, I_NF2, I_WG2, I_WU2, I_WD2, I_NFIN };

template <class F> __device__ __forceinline__ void tr_item(F src, int K, bf16_t* WT, float* scr, int item, int nblk, int lane) {
    const int kb = item / nblk, nb = item % nblk, k0 = 64 * kb, n0 = 32 * nb;
#pragma unroll 8
    for (int i = 0; i < 32; ++i) { const int kk = 2 * i + (lane >> 5); scr[kk * 33 + (lane & 31)] = src(k0 + kk, n0 + (lane & 31)); }
    __builtin_amdgcn_wave_barrier();
    const int c = lane & 7;
#pragma unroll
    for (int j = 0; j < 4; ++j) { const int n = (lane >> 3) + 8 * j; const float* s = scr + (8 * c) * 33 + n;
        u32x4 o; o.x = pk2(s[0 * 33], s[1 * 33]); o.y = pk2(s[2 * 33], s[3 * 33]); o.z = pk2(s[4 * 33], s[5 * 33]); o.w = pk2(s[6 * 33], s[7 * 33]);
        *(u32x4*)(WT + (size_t)(n0 + n) * K + k0 + 8 * c) = o; }
    __builtin_amdgcn_wave_barrier();
}

__device__ __forceinline__ void p0_prologue(const Args& a, unsigned char* lds) {
    const int tid = opaque_tid(), lane = tid & 63, wave = tid >> 6;
    const int gw = blockIdx.x * 8 + wave, NGW = gridDim.x * 8;
    float* scr = (float*)(lds + wave * 16384);
    unsigned char* ws = a.ws;
    constexpr int I1 = 16 * 176, I2 = 44 * 32, I3 = 16 * 128, I4 = 4 * 64, I5 = 32 * 32;
    constexpr int NIT = I1 + I2 + I3 + I4 + I5 + I1 + I2;
    for (int it = gw; it < NIT; it += NGW) {
        int r = it;
        if (r < I1) { const float* wg = a.in[I_WG1]; const float* wu = a.in[I_WU1]; const float* gn = a.in[I_NF1];
            tr_item([=](int k, int n) { const int c = (n >> 8) * 128 + (n & 127); return (((n >> 7) & 1) ? wu : wg)[(size_t)k * FF + c] * gn[k]; }, 1024, (bf16_t*)(ws + WS_WGU1), scr, r, 176, lane); continue; } r -= I1;
        if (r < I2) { const float* wd = a.in[I_WD1];
            tr_item([=](int k, int n) { return wd[(size_t)k * D + n]; }, FF, (bf16_t*)(ws + WS_WD1), scr, r, 32, lane); continue; } r -= I2;
        if (r < I3) { const float* w = a.in[I_WIN]; const float* gn = a.in[I_NMIX];
            tr_item([=](int k, int n) { return w[(size_t)k * 4096 + n] * gn[k]; }, 1024, (bf16_t*)(ws + WS_WIN), scr, r, 128, lane); continue; } r -= I3;
        if (r < I4) { const float* wa = a.in[I_RWA]; const float* wx = a.in[I_RWX];
            tr_item([=](int k, int n) { const int pn = n >> 8, blk = pn >> 1, hh = pn & 1, sel = (n >> 7) & 1, c = hh * 128 + (n & 127); return (sel ? wx : wa)[(size_t)blk * 65536 + (size_t)k * 256 + c]; }, 256, (bf16_t*)(ws + WS_WRG), scr, r, 64, lane); continue; } r -= I4;
        if (r < I5) { const float* w = a.in[I_WOUT]; const float* gm = a.in[I_ONM]; const float* gr = a.in[I_ONR];
            tr_item([=](int k, int n) { return w[(size_t)k * D + n] * (k < 1024 ? gm[k] : gr[k - 1024]); }, 2048, (bf16_t*)(ws + WS_WOUT), scr, r, 32, lane); continue; } r -= I5;
        if (r < I1) { const float* wg = a.in[I_WG2]; const float* wu = a.in[I_WU2]; const float* gn = a.in[I_NF2];
            tr_item([=](int k, int n) { const int c = (n >> 8) * 128 + (n & 127); return (((n >> 7) & 1) ? wu : wg)[(size_t)k * FF + c] * gn[k]; }, 1024, (bf16_t*)(ws + WS_WGU2), scr, r, 176, lane); continue; } r -= I1;
        { const float* wd = a.in[I_WD2];
            tr_item([=](int k, int n) { return wd[(size_t)k * D + n]; }, FF, (bf16_t*)(ws + WS_WD2), scr, r, 32, lane); }
    }
    {
        bf16_t* WG8 = (bf16_t*)(ws + WS_WG8);
        const float* wq = a.in[I_WQ]; const float* wk = a.in[I_WK]; const float* wv = a.in[I_WV]; const float* Wg = a.in[I_WGATES];
        const int gt = blockIdx.x * 512 + tid, NT = gridDim.x * 512;
        for (int e = gt; e < 256 * 2048 / 8; e += NT) {
            const int g = e / 256, k0 = (e % 256) * 8;
            float o[8];
#pragma unroll
            for (int j = 0; j < 8; ++j) {
                float v = 0.f;
                if (g < 8) { const int k = k0 + j, c = k & 1023, n = c >> 2, i = c & 3;
                    if (k < 1024) { for (int oo = 0; oo < 4; ++oo) v += wq[n * 16 + i * 4 + oo] * Wg[(size_t)(4 * n + oo) * 8 + g] + wk[n * 16 + i * 4 + oo] * Wg[(size_t)(1024 + 4 * n + oo) * 8 + g]; }
                    else { for (int oo = 0; oo < 4; ++oo) v += wv[n * 16 + i * 4 + oo] * Wg[(size_t)(2048 + 4 * n + oo) * 8 + g]; } }
                o[j] = v;
            }
            *(u32x4*)(WG8 + (size_t)g * 2048 + k0) = pack8(o);
        }
    }
    if (blockIdx.x == 0) { float* C8 = (float*)(ws + WS_C8); const float* lam = a.in[I_LAM]; for (int e = tid; e < 1024; e += 512) C8[e] = 8.0f * logsig_acc_(lam[e]); }
    {
        const float* x = a.in[I_X]; bf16_t* XB = (bf16_t*)(ws + WS_XB); float* SS = (float*)(ws + WS_SSA);
        for (int m = gw; m < T; m += NGW) {
            const f32x4* xr = (const f32x4*)(x + (size_t)m * D) + lane;
            f32x4 v[4]; float s = 0.f;
#pragma unroll
            for (int j = 0; j < 4; ++j) { v[j] = xr[64 * j]; s += (v[j][0] * v[j][0] + v[j][1] * v[j][1]) + (v[j][2] * v[j][2] + v[j][3] * v[j][3]); }
            s = wave_sum(s);
            u32x2* o8 = (u32x2*)(XB + (size_t)m * D) + lane;
#pragma unroll
            for (int j = 0; j < 4; ++j) { u32x2 w; w.x = pk2(v[j][0], v[j][1]); w.y = pk2(v[j][2], v[j][3]); o8[64 * j] = w; }
            if (lane < 16) SS[(size_t)m * 16 + lane] = (lane == 0) ? s : 0.f;
        }
    }
}

template <bool SILU> __device__ __forceinline__ void conv_part(const bf16_t* in, bf16_t* out, const float* cw, const float* cb, int t0, int c0) {
    float w[4][8], b[8];
#pragma unroll
    for (int tap = 0; tap < 4; ++tap) { const f32x4 p = *(const f32x4*)(cw + tap * D + c0), q = *(const f32x4*)(cw + tap * D + c0 + 4); for (int j = 0; j < 4; ++j) { w[tap][j] = p[j]; w[tap][4 + j] = q[j]; } }
    { const f32x4 p = *(const f32x4*)(cb + c0), q = *(const f32x4*)(cb + c0 + 4); for (int j = 0; j < 4; ++j) { b[j] = p[j]; b[4 + j] = q[j]; } }
    float h0[8], h1[8], h2[8];
    const bool first = (t0 % SEQ) == 0;
    if (first) { for (int j = 0; j < 8; ++j) { h0[j] = 0.f; h1[j] = 0.f; h2[j] = 0.f; } }
    else {
        unpack8(*(const u32x4*)(in + (size_t)(t0 - 3) * D + c0), h0); unpack8(*(const u32x4*)(in + (size_t)(t0 - 2) * D + c0), h1); unpack8(*(const u32x4*)(in + (size_t)(t0 - 1) * D + c0), h2);
    }
    u32x4 cur[8];
#pragma unroll
    for (int i = 0; i < 8; ++i) cur[i] = *(const u32x4*)(in + (size_t)(t0 + i) * D + c0);
#pragma unroll
    for (int i = 0; i < 8; ++i) {
        float x[8], y[8]; unpack8(cur[i], x);
#pragma unroll
        for (int j = 0; j < 8; ++j) { float v = b[j] + w[0][j] * h0[j] + w[1][j] * h1[j] + w[2][j] * h2[j] + w[3][j] * x[j]; y[j] = SILU ? siluf_(v) : v; h0[j] = h1[j]; h1[j] = h2[j]; h2[j] = x[j]; }
        *(u32x4*)(out + (size_t)(t0 + i) * D + c0) = pack8(y);
    }
}
__device__ __forceinline__ void p4_conv(const Args& a) {
    unsigned char* ws = a.ws; const int tid = opaque_tid(), cgp = tid & 127, ts = tid >> 7;
    for (int u = blockIdx.x; u < T / 32; u += gridDim.x) {
        const int t0 = u * 32 + ts * 8, c0 = cgp * 8;
        conv_part<true>((const bf16_t*)(ws + WS_XM), (bf16_t*)(ws + WS_XC), a.in[I_MCW], a.in[I_MCB], t0, c0);
        conv_part<false>((const bf16_t*)(ws + WS_XR), (bf16_t*)(ws + WS_XB), a.in[I_RCW], a.in[I_RCB], t0, c0);
    }
}

__device__ __forceinline__ void p6_rg_agg(const Args& a) {
    unsigned char* ws = a.ws; const int tid = opaque_tid();
    const unsigned* LOGA = (const unsigned*)(ws + WS_XR); const unsigned* U = (const unsigned*)(ws + WS_U); float* AGG = (float*)(ws + WS_AGG);
    for (int tile = blockIdx.x; tile < 256; tile += gridDim.x) {
        const size_t row0 = (size_t)tile * 128;
        float sl0 = 0.f, sl1 = 0.f, h0 = 0.f, h1 = 0.f;
        for (int i0 = 0; i0 < 128; i0 += 16) {
            unsigned la[16], uu[16];
#pragma unroll
            for (int i = 0; i < 16; ++i) { la[i] = LOGA[(row0 + i0 + i) * 512 + tid]; uu[i] = U[(row0 + i0 + i) * 512 + tid]; }
#pragma unroll
            for (int i = 0; i < 16; ++i) { const float l0 = bflo(la[i]), l1 = bfhi(la[i]); sl0 += l0; sl1 += l1; h0 = __expf(l0) * h0 + bflo(uu[i]); h1 = __expf(l1) * h1 + bfhi(uu[i]); }
        }
        f32x4 o = {sl0, h0, sl1, h1};
        *(f32x4*)(AGG + ((size_t)tile * 1024 + 2 * tid) * 2) = o;
    }
}

namespace ml {
constexpr int QP = 264, SP = 72;
constexpr int O_QS = 0, O_KS = 33792, O_SS = 67584, O_VT = 76800, O_VW = 81408, O_CS = 86016, O_OSM = 102912, O_TAB = 111360, O_WTS = 113920, O_END = 126208;
}
__device__ __forceinline__ void p6_mlstm(const Args& a, unsigned char* lds) {
    using namespace ml;
    unsigned char* ws = a.ws;
    const int tid = opaque_tid(), lane = tid & 63, w = __builtin_amdgcn_readfirstlane(tid >> 6), fr = lane & 15, fq = lane >> 4;
    bf16_t* Qs = (bf16_t*)(lds + O_QS); bf16_t* Ks = (bf16_t*)(lds + O_KS); bf16_t* Ss = (bf16_t*)(lds + O_SS);
    bf16_t* Vt = (bf16_t*)(lds + O_VT); bf16_t* Vw = (bf16_t*)(lds + O_VW); bf16_t* Cs = (bf16_t*)(lds + O_CS);
    float* Osm = (float*)(lds + O_OSM); float* TAB = (float*)(lds + O_TAB); float* WTS = (float*)(lds + O_WTS);
    const bf16_t* XC = (const bf16_t*)(ws + WS_XC); const bf16_t* XM = (const bf16_t*)(ws + WS_XM); const float* GATES = (const float*)(ws + WS_GATES);
    bf16_t* HM = (bf16_t*)(ws + WS_XB);
    for (int unit = blockIdx.x; unit < 256; unit += gridDim.x) {
        const int xcd = unit & 7, idx = unit >> 3, bh = xcd * 2 + (idx >> 4), vs = idx & 15, b = bh >> 2, h = bh & 3;
        __syncthreads();
        for (int e = tid; e < 64 * SP / 2; e += 512) ((unsigned*)Ss)[e] = 0u;
        for (int e = tid; e < 32 * SP / 2; e += 512) { const int row = e / (SP / 2); ((unsigned*)Vt)[e] = (row == 16) ? 0x3F803F80u : 0u; ((unsigned*)Vw)[e] = 0u; }
        for (int e = tid; e < 32 * QP / 2; e += 512) ((unsigned*)Cs)[e] = 0u;
        for (int e = tid; e < 1024; e += 512) { const int g = e >> 4, bb = (e >> 2) & 3, aa = e & 3; const float* wq = a.in[I_WQ] + (h * 64 + g) * 16; const float* wk = a.in[I_WK] + (h * 64 + g) * 16;
            float v = 0.f; for (int o = 0; o < 4; ++o) v += wq[bb * 4 + o] * wk[aa * 4 + o]; WTS[e] = v * 0.0625f; }
        for (int e = tid; e < 1024; e += 512) WTS[2048 + e] = a.in[I_WV][h * 1024 + e];
        f32x4 Cacc[2][2];
#pragma unroll
        for (int i = 0; i < 2; ++i)
#pragma unroll
            for (int j = 0; j < 2; ++j) Cacc[i][j] = (f32x4){0.f, 0.f, 0.f, 0.f};
        const int srow = tid >> 5, scol = (tid & 31) * 8;
        const int vrow = tid >> 1, vhalf = tid & 1;
        const size_t tbase = (size_t)b * SEQ;
        u32x4 xr[4], xmr = (u32x4){0u, 0u, 0u, 0u}; float gi, gf;
        {
            const size_t t0 = tbase;
#pragma unroll
            for (int i = 0; i < 4; ++i) xr[i] = *(const u32x4*)(XC + (t0 + srow + 16 * i) * D + h * 256 + scol);
            if (tid < 128) xmr = *(const u32x4*)(XM + (t0 + vrow) * D + h * 256 + vs * 16 + vhalf * 8);
            gi = GATES[(t0 + lane) * 8 + h]; gf = GATES[(t0 + lane) * 8 + 4 + h];
        }
        __syncthreads();
        float vreg[8], decay = 0.f, m_cur = -1e30f;
#pragma unroll
        for (int e = 0; e < 8; ++e) vreg[e] = 0.f;
        constexpr int NC = SEQ / 64;
        for (int c = -1; c < NC; ++c) {
            float* tab = TAB + (c & 1) * 320;
            if (c >= 0) {
            __syncthreads();
            {
                for (int li = w; li < 10; li += 8) {
                    int it, jt;
                    if (li < 4) { it = 3; jt = li; } else if (li < 7) { it = 2; jt = li - 4; } else if (li < 9) { it = 1; jt = li - 7; } else { it = 0; jt = 0; }
                    f32x4 s = (f32x4){0.f, 0.f, 0.f, 0.f};
#pragma unroll
                    for (int ks = 0; ks < 8; ++ks) {
                        const bf16x8 ka = *(const bf16x8*)(Ks + (jt * 16 + fr) * QP + ks * 32 + fq * 8);
                        const bf16x8 qb = *(const bf16x8*)(Qs + (it * 16 + fr) * QP + ks * 32 + fq * 8);
                        s = __builtin_amdgcn_mfma_f32_16x16x32_bf16(ka, qb, s, 0, 0, 0);
                    }
                    const int i = it * 16 + fr, j0 = jt * 16 + fq * 4; const float rf = tab[i];
                    float o[4];
#pragma unroll
                    for (int e = 0; e < 4; ++e) { const int j = j0 + e; o[e] = (j <= i) ? s[e] * __expf(rf + tab[64 + j]) : 0.f; }
                    u32x2 wv; wv.x = pk2(o[0], o[1]); wv.y = pk2(o[2], o[3]);
                    *(u32x2*)(Ss + i * SP + j0) = wv;
                }
                if (tid < 128) {
                    const float wk = tab[256 + vrow];
#pragma unroll
                    for (int e = 0; e < 8; ++e) Vw[(vhalf * 8 + e) * SP + vrow] = (bf16_t)(pk2(vreg[e] * wk, 0.f) & 0xffffu);
                } else if (tid < 192) { Vw[16 * SP + (tid - 128)] = (bf16_t)(pk2(tab[256 + tid - 128], 0.f) & 0xffffu); }
            }
            __syncthreads();
            {
                const int rt = w & 3, vt = w >> 2;
                f32x4 a1 = (f32x4){0.f, 0.f, 0.f, 0.f}, a2 = (f32x4){0.f, 0.f, 0.f, 0.f};
#pragma unroll
                for (int ks = 0; ks < 2; ++ks) {
                    const bf16x8 sa_ = *(const bf16x8*)(Ss + (rt * 16 + fr) * SP + ks * 32 + fq * 8);
                    const bf16x8 vb = *(const bf16x8*)(Vt + (vt * 16 + fr) * SP + ks * 32 + fq * 8);
                    a1 = __builtin_amdgcn_mfma_f32_16x16x32_bf16(sa_, vb, a1, 0, 0, 0);
                }
#pragma unroll
                for (int ks = 0; ks < 8; ++ks) {
                    const bf16x8 qa = *(const bf16x8*)(Qs + (rt * 16 + fr) * QP + ks * 32 + fq * 8);
                    const bf16x8 cb = *(const bf16x8*)(Cs + (vt * 16 + fr) * QP + ks * 32 + fq * 8);
                    a2 = __builtin_amdgcn_mfma_f32_16x16x32_bf16(qa, cb, a2, 0, 0, 0);
                }
#pragma unroll
                for (int e = 0; e < 4; ++e) { const int i = rt * 16 + fq * 4 + e; Osm[i * 33 + vt * 16 + fr] = a1[e] + tab[128 + i] * a2[e]; }
            }
            {
#pragma unroll
                for (int kl = 0; kl < 2; ++kl)
#pragma unroll
                    for (int vt = 0; vt < 2; ++vt) Cacc[kl][vt] = Cacc[kl][vt] * decay;
#pragma unroll
                for (int kl = 0; kl < 2; ++kl) {
                    const int kcol = (2 * w + kl) * 16 + fr;
#pragma unroll
                    for (int ks = 0; ks < 2; ++ks) {
                        bf16x8 ka;
#pragma unroll
                        for (int e = 0; e < 8; ++e) ka[e] = (short)Ks[(ks * 32 + fq * 8 + e) * QP + kcol];
#pragma unroll
                        for (int vt = 0; vt < 2; ++vt) {
                            const bf16x8 vb = *(const bf16x8*)(Vw + (vt * 16 + fr) * SP + ks * 32 + fq * 8);
                            Cacc[kl][vt] = __builtin_amdgcn_mfma_f32_16x16x32_bf16(ka, vb, Cacc[kl][vt], 0, 0, 0);
                        }
                    }
                }
            }
            }
            u32x4 qpk[4]; float vnx[8], decay_n = 0.f, m_nx = m_cur;
            if (c + 1 < NC) {
                const int lg0 = (tid & 31) * 2;
                f32x4 Wq[2][4];
#pragma unroll
                for (int g2 = 0; g2 < 2; ++g2)
#pragma unroll
                    for (int i = 0; i < 4; ++i) Wq[g2][i] = *(const f32x4*)(WTS + (lg0 + g2) * 16 + i * 4);
#pragma unroll
                for (int i = 0; i < 4; ++i) {
                    float x[8]; unpack8(xr[i], x);
                    float q[8];
#pragma unroll
                    for (int g2 = 0; g2 < 2; ++g2) {
                        const f32x4 qq = Wq[g2][0] * x[4 * g2] + Wq[g2][1] * x[4 * g2 + 1] + Wq[g2][2] * x[4 * g2 + 2] + Wq[g2][3] * x[4 * g2 + 3];
                        for (int j = 0; j < 4; ++j) q[4 * g2 + j] = qq[j];
                    }
                    qpk[i] = pack8(q);
                }
                if (tid < 128) {
                    float x[8]; unpack8(xmr, x);
                    const int lgv = vs * 4 + vhalf * 2;
#pragma unroll
                    for (int g2 = 0; g2 < 2; ++g2) {
                        const float* Wv = WTS + 2048 + (lgv + g2) * 16;
#pragma unroll
                        for (int o = 0; o < 4; ++o) vnx[4 * g2 + o] = Wv[0 * 4 + o] * x[4 * g2] + Wv[1 * 4 + o] * x[4 * g2 + 1] + Wv[2 * 4 + o] * x[4 * g2 + 2] + Wv[3 * 4 + o] * x[4 * g2 + 3];
                    }
                }
                float sa = gf, sc = gi;
#pragma unroll
                for (int d = 1; d < 64; d <<= 1) { const float ao = __shfl_up(sa, d), co = __shfl_up(sc, d); if (lane >= d) { sc = fmaxf(co + sa, sc); sa = ao + sa; } }
                const float Mi = fmaxf(m_cur + sa, sc);
                const float gtot = __shfl(sa, 63); m_nx = __shfl(Mi, 63);
                decay_n = __expf(gtot + m_cur - m_nx);
                if (w == 0) {
                    float* tn = TAB + ((c + 1) & 1) * 320;
                    tn[lane] = sa - Mi; tn[64 + lane] = gi - sa; tn[128 + lane] = __expf(sa + m_cur - Mi); tn[192 + lane] = __expf(-Mi); tn[256 + lane] = __expf(gtot - sa + gi - m_nx);
                }
            }
            if (c >= 0) {
            __syncthreads();
            {
#pragma unroll
                for (int kl = 0; kl < 2; ++kl)
#pragma unroll
                    for (int vt = 0; vt < 2; ++vt) {
                        u32x2 wv; wv.x = pk2(Cacc[kl][vt][0], Cacc[kl][vt][1]); wv.y = pk2(Cacc[kl][vt][2], Cacc[kl][vt][3]);
                        *(u32x2*)(Cs + (vt * 16 + fr) * QP + (2 * w + kl) * 16 + fq * 4) = wv;
                    }
                const int i = tid >> 3, vp = (tid & 7) * 2;
                const float den = Osm[i * 33 + 16], dn = fmaxf(fabsf(den), tab[192 + i]);
                const float rdn = __builtin_amdgcn_rcpf(dn); const float h0 = Osm[i * 33 + vp] * rdn, h1 = Osm[i * 33 + vp + 1] * rdn;
                *(unsigned*)(HM + ((size_t)(bh * 16 + vs) * SEQ + (size_t)c * 64 + i) * 16 + vp) = pk2(h0, h1);
            }
            }
            if (c + 1 < NC) {
#pragma unroll
                for (int i = 0; i < 4; ++i) { const int r = srow + 16 * i; *(u32x4*)(Qs + r * QP + scol) = qpk[i]; *(u32x4*)(Ks + r * QP + scol) = xr[i]; }
                if (tid < 128) {
#pragma unroll
                    for (int e = 0; e < 8; ++e) { Vt[(vhalf * 8 + e) * SP + vrow] = (bf16_t)(pk2(vnx[e], 0.f) & 0xffffu); vreg[e] = vnx[e]; }
                }
                decay = decay_n; m_cur = m_nx;
                if (c + 2 < NC) {
                    const size_t t2 = tbase + (size_t)(c + 2) * 64;
#pragma unroll
                    for (int i = 0; i < 4; ++i) xr[i] = *(const u32x4*)(XC + (t2 + srow + 16 * i) * D + h * 256 + scol);
                    if (tid < 128) xmr = *(const u32x4*)(XM + (t2 + vrow) * D + h * 256 + vs * 16 + vhalf * 8);
                    gi = GATES[(t2 + lane) * 8 + h]; gf = GATES[(t2 + lane) * 8 + 4 + h];
                }
            }
        }
    }
}

__device__ __forceinline__ void p6_mlstm_tok(const Args& a, unsigned char* lds) {
    using namespace ml;
    unsigned char* ws = a.ws;
    const int tid = opaque_tid(), lane = tid & 63, w = __builtin_amdgcn_readfirstlane(tid >> 6), fr = lane & 15, fq = lane >> 4;
    bf16_t* Qs = (bf16_t*)(lds + O_QS); bf16_t* Ks = (bf16_t*)(lds + O_KS); bf16_t* Ss = (bf16_t*)(lds + O_SS);
    bf16_t* Vt = (bf16_t*)(lds + O_VT); bf16_t* Vw = (bf16_t*)(lds + O_VW); bf16_t* Cs = (bf16_t*)(lds + O_CS);
    float* Osm = (float*)(lds + O_OSM); float* TAB = (float*)(lds + O_TAB); float* WTS = (float*)(lds + O_WTS);
    const bf16_t* XC = (const bf16_t*)(ws + WS_XC); const bf16_t* XM = (const bf16_t*)(ws + WS_XM); const float* GATES = (const float*)(ws + WS_GATES);
    bf16_t* HM = (bf16_t*)(ws + WS_XB);
    for (int unit = blockIdx.x; unit < 256; unit += gridDim.x) {
        const int xcd = unit & 7, idx = unit >> 3, bh = xcd * 2 + (idx >> 4), vs = idx & 15, b = bh >> 2, h = bh & 3;
        __syncthreads();
        for (int e = tid; e < 64 * SP / 2; e += 512) ((unsigned*)Ss)[e] = 0u;
        for (int e = tid; e < 32 * SP / 2; e += 512) { const int row = e / (SP / 2); ((unsigned*)Vt)[e] = (row == 16) ? 0x3F803F80u : 0u; ((unsigned*)Vw)[e] = 0u; }
        for (int e = tid; e < 32 * QP / 2; e += 512) ((unsigned*)Cs)[e] = 0u;
        for (int e = tid; e < 3 * 64 * 16; e += 512) { const int m = e / 1024, r = e % 1024; const float* src = (m == 0) ? a.in[I_WQ] : (m == 1 ? a.in[I_WK] : a.in[I_WV]); WTS[e] = src[h * 1024 + r] * (m == 1 ? 0.0625f : 1.0f); }
        f32x4 Cacc[2][2];
#pragma unroll
        for (int i = 0; i < 2; ++i)
#pragma unroll
            for (int j = 0; j < 2; ++j) Cacc[i][j] = (f32x4){0.f, 0.f, 0.f, 0.f};
        float m_prev = -1e30f;
        float Ct[8], Nt[8];
#pragma unroll
        for (int j = 0; j < 8; ++j) { Ct[j] = 0.f; Nt[j] = 0.f; }
        const int srow = tid >> 5, scol = (tid & 31) * 8;
        const int vrow = tid >> 1, vhalf = tid & 1;
        const size_t tbase = (size_t)b * SEQ;
        u32x4 xr[4], xmr = (u32x4){0u, 0u, 0u, 0u}; float gi, gf;
        {
            const size_t t0 = tbase;
#pragma unroll
            for (int i = 0; i < 4; ++i) xr[i] = *(const u32x4*)(XC + (t0 + srow + 16 * i) * D + h * 256 + scol);
            if (tid < 128) xmr = *(const u32x4*)(XM + (t0 + vrow) * D + h * 256 + vs * 16 + vhalf * 8);
            gi = GATES[(t0 + lane) * 8 + h]; gf = GATES[(t0 + lane) * 8 + 4 + h];
        }
        __syncthreads();
        for (int c = 0; c < SEQ / 64; ++c) {
            const size_t t0 = tbase + (size_t)c * 64;
            float* tab = TAB;
            float vreg[8];
            {
                const int lg0 = (tid & 31) * 2;
                f32x4 Wq[2][4], Wk[2][4];
#pragma unroll
                for (int g2 = 0; g2 < 2; ++g2)
#pragma unroll
                    for (int i = 0; i < 4; ++i) { Wq[g2][i] = *(const f32x4*)(WTS + (lg0 + g2) * 16 + i * 4); Wk[g2][i] = *(const f32x4*)(WTS + 1024 + (lg0 + g2) * 16 + i * 4); }
#pragma unroll
                for (int i = 0; i < 4; ++i) {
                    float x[8]; unpack8(xr[i], x);
                    float q[8], k[8];
#pragma unroll
                    for (int g2 = 0; g2 < 2; ++g2) {
                        const f32x4 qq = Wq[g2][0] * x[4 * g2] + Wq[g2][1] * x[4 * g2 + 1] + Wq[g2][2] * x[4 * g2 + 2] + Wq[g2][3] * x[4 * g2 + 3];
                        const f32x4 kk = Wk[g2][0] * x[4 * g2] + Wk[g2][1] * x[4 * g2 + 1] + Wk[g2][2] * x[4 * g2 + 2] + Wk[g2][3] * x[4 * g2 + 3];
                        for (int j = 0; j < 4; ++j) { q[4 * g2 + j] = qq[j]; k[4 * g2 + j] = kk[j]; }
                    }
                    const int r = srow + 16 * i;
                    *(u32x4*)(Qs + r * QP + scol) = pack8(q); *(u32x4*)(Ks + r * QP + scol) = pack8(k);
                }
                if (tid < 128) {
                    float x[8]; unpack8(xmr, x);
                    const int lgv = vs * 4 + vhalf * 2;
#pragma unroll
                    for (int g2 = 0; g2 < 2; ++g2) {
                        const float* Wv = WTS + 2048 + (lgv + g2) * 16;
#pragma unroll
                        for (int o = 0; o < 4; ++o) vreg[4 * g2 + o] = Wv[0 * 4 + o] * x[4 * g2] + Wv[1 * 4 + o] * x[4 * g2 + 1] + Wv[2 * 4 + o] * x[4 * g2 + 2] + Wv[3 * 4 + o] * x[4 * g2 + 3];
                    }
#pragma unroll
                    for (int e = 0; e < 8; ++e) Vt[(vhalf * 8 + e) * SP + vrow] = (bf16_t)(pk2(vreg[e], 0.f) & 0xffffu);
                }
            }
            float sa = gf, sc = gi;
#pragma unroll
            for (int d = 1; d < 64; d <<= 1) { const float ao = __shfl_up(sa, d), co = __shfl_up(sc, d); if (lane >= d) { sc = fmaxf(co + sa, sc); sa = ao + sa; } }
            const float Mi = fmaxf(m_prev + sa, sc);
            const float gtot = __shfl(sa, 63), m_new = __shfl(Mi, 63);
            const float decay = __expf(gtot + m_prev - m_new);
            {
                float Mp = __shfl_up(Mi, 1); if (lane == 0) Mp = m_prev;
                if (w == 0) { tab[lane] = __expf(gf + Mp - Mi); tab[64 + lane] = __expf(gi - Mi); tab[128 + lane] = __expf(-Mi); }
            }
            if (c + 1 < SEQ / 64) {
                const size_t t1 = t0 + 64;
#pragma unroll
                for (int i = 0; i < 4; ++i) xr[i] = *(const u32x4*)(XC + (t1 + srow + 16 * i) * D + h * 256 + scol);
                if (tid < 128) xmr = *(const u32x4*)(XM + (t1 + vrow) * D + h * 256 + vs * 16 + vhalf * 8);
                gi = GATES[(t1 + lane) * 8 + h]; gf = GATES[(t1 + lane) * 8 + 4 + h];
            }
            __syncthreads();
            {
                const int v = tid >> 5, kq = tid & 31, k0 = kq * 8;
                for (int tb = 0; tb < 64; tb += 8) {
                    float acc[8], dp[8];
#pragma unroll
                    for (int u = 0; u < 8; ++u) {
                        const int t = tb + u;
                        const float f = tab[t], ii = tab[64 + t];
                        const float vv = bf1(Vt[v * SP + t]) * ii;
                        float k8[8], q8[8];
                        unpack8(*(const u32x4*)(Ks + t * QP + k0), k8); unpack8(*(const u32x4*)(Qs + t * QP + k0), q8);
                        float a_ = 0.f, d_ = 0.f;
#pragma unroll
                        for (int j = 0; j < 8; ++j) { Ct[j] = f * Ct[j] + vv * k8[j]; a_ += Ct[j] * q8[j]; Nt[j] = f * Nt[j] + ii * k8[j]; d_ += Nt[j] * q8[j]; }
                        acc[u] = a_; dp[u] = d_;
                    }
#pragma unroll
                    for (int o = 1; o < 32; o <<= 1) {
#pragma unroll
                        for (int u = 0; u < 8; ++u) { acc[u] += __shfl_xor(acc[u], o); dp[u] += __shfl_xor(dp[u], o); }
                    }
                    float hv = 0.f;
#pragma unroll
                    for (int u = 0; u < 8; ++u) { const float h_ = acc[u] / fmaxf(fabsf(dp[u]), tab[128 + tb + u]); if (kq == u) hv = h_; }
                    if (kq < 8) HM[((size_t)(bh * 16 + vs) * SEQ + (size_t)c * 64 + tb + kq) * 16 + v] = (bf16_t)(pk2(hv, 0.f) & 0xffffu);
                }
            }
            __syncthreads();
            m_prev = m_new;
            __syncthreads();
        }
    }
}

__device__ __forceinline__ void p7_mlstm_fin(const Args& a) {
    unsigned char* ws = a.ws; const int tid = opaque_tid(), lane = tid & 63, wave = tid >> 6;
    const int gw = blockIdx.x * 8 + wave, NGW = gridDim.x * 8;
    const bf16_t* HM = (const bf16_t*)(ws + WS_XB); const bf16_t* XC = (const bf16_t*)(ws + WS_XC); bf16_t* ZM = (bf16_t*)(ws + WS_ZM);
    float lnw[16], skp[16];
#pragma unroll
    for (int j = 0; j < 4; ++j) { const f32x4 p = *(const f32x4*)(a.in[I_LNW] + lane * 16 + 4 * j), q = *(const f32x4*)(a.in[I_SKIP] + lane * 16 + 4 * j); for (int e = 0; e < 4; ++e) { lnw[4 * j + e] = p[e]; skp[4 * j + e] = q[e]; } }
    for (int m = gw; m < T; m += NGW) {
        const size_t off = (size_t)m * D + lane * 16;
        float hv[16], xc[16], z[16];
        { const size_t hoff = ((size_t)(((m / SEQ) * 4 + (lane >> 4)) * 16 + (lane & 15)) * SEQ + (size_t)(m % SEQ)) * 16;
          unpack8(*(const u32x4*)(HM + hoff), hv); unpack8(*(const u32x4*)(HM + hoff + 8), hv + 8); }
        unpack8(*(const u32x4*)(XC + off), xc); unpack8(*(const u32x4*)(XC + off + 8), xc + 8);
        unpack8(*(const u32x4*)(ZM + off), z); unpack8(*(const u32x4*)(ZM + off + 8), z + 8);
        float s = 0.f;
#pragma unroll
        for (int e = 0; e < 16; ++e) s += hv[e];
        s += __shfl_xor(s, 1); s += __shfl_xor(s, 2); s += __shfl_xor(s, 4); s += __shfl_xor(s, 8);
        const float mu = s * (1.0f / 256.0f); float q = 0.f;
#pragma unroll
        for (int e = 0; e < 16; ++e) { hv[e] -= mu; q += hv[e] * hv[e]; }
        q += __shfl_xor(q, 1); q += __shfl_xor(q, 2); q += __shfl_xor(q, 4); q += __shfl_xor(q, 8);
        const float rstd = rsqrtf(q * (1.0f / 256.0f) + EPS);
        float o[16], ss = 0.f;
#pragma unroll
        for (int e = 0; e < 16; ++e) { o[e] = (hv[e] * rstd * lnw[e] + skp[e] * xc[e]) * siluf_(z[e]); ss += o[e] * o[e]; }
        ss = wave_sum(ss);
        const float rs = rsqrtf(ss * (1.0f / 1024.0f) + EPS);
#pragma unroll
        for (int e = 0; e < 16; ++e) o[e] *= rs;
        *(u32x4*)(ZM + off) = pack8(o); *(u32x4*)(ZM + off + 8) = pack8(o + 8);
    }
}
__device__ __forceinline__ void p7_rg_fin(const Args& a, unsigned char* lds) {
    unsigned char* ws = a.ws; const int tid = opaque_tid();
    unsigned* LOGA = (unsigned*)(ws + WS_XR); const unsigned* U = (const unsigned*)(ws + WS_U); const unsigned* YR = (const unsigned*)(ws + WS_YR); const float* AGG = (const float*)(ws + WS_AGG);
    float* Ot = (float*)lds;
    constexpr int OP = 1028;
    for (int tile = blockIdx.x; tile < 256; tile += gridDim.x) {
        const int tc = tile & 63, tb = tile & ~63;
        float h0 = 0.f, h1 = 0.f;
        for (int p = 0; p < tc; ++p) { const f32x4 g = *(const f32x4*)(AGG + ((size_t)(tb + p) * 1024 + 2 * tid) * 2); h0 = __expf(g[0]) * h0 + g[1]; h1 = __expf(g[2]) * h1 + g[3]; }
        const size_t row0 = (size_t)tile * 128;
        for (int i0 = 0; i0 < 128; i0 += 16) {
            unsigned la[16], uu[16], yy[16];
#pragma unroll
            for (int i = 0; i < 16; ++i) { const size_t o = (row0 + i0 + i) * 512 + tid; la[i] = LOGA[o]; uu[i] = U[o]; yy[i] = YR[o]; }
            __syncthreads();
#pragma unroll
            for (int i = 0; i < 16; ++i) {
                h0 = __expf(bflo(la[i])) * h0 + bflo(uu[i]); h1 = __expf(bfhi(la[i])) * h1 + bfhi(uu[i]);
                Ot[i * OP + 2 * tid] = h0 * geluf_(bflo(yy[i])); Ot[i * OP + 2 * tid + 1] = h1 * geluf_(bfhi(yy[i]));
            }
            __syncthreads();
            {
                const int row = tid >> 5, sub = tid & 31;
                f32x4 v[4][2]; float ss = 0.f;
#pragma unroll
                for (int q = 0; q < 4; ++q)
#pragma unroll
                    for (int hh = 0; hh < 2; ++hh) { v[q][hh] = *(const f32x4*)(Ot + row * OP + q * 256 + sub * 8 + hh * 4); const f32x4 t = v[q][hh]; ss += (t[0] * t[0] + t[1] * t[1]) + (t[2] * t[2] + t[3] * t[3]); }
                ss += __shfl_xor(ss, 1); ss += __shfl_xor(ss, 2); ss += __shfl_xor(ss, 4); ss += __shfl_xor(ss, 8); ss += __shfl_xor(ss, 16);
                const float rs = rsqrtf(ss * (1.0f / 1024.0f) + EPS);
                bf16_t* orow = (bf16_t*)LOGA + (row0 + i0 + row) * D;
#pragma unroll
                for (int q = 0; q < 4; ++q) { const f32x4 p = v[q][0] * rs, r = v[q][1] * rs; u32x4 wv; wv.x = pk2(p[0], p[1]); wv.y = pk2(p[2], p[3]); wv.z = pk2(r[0], r[1]); wv.w = pk2(r[2], r[3]); *(u32x4*)(orow + q * 256 + sub * 8) = wv; }
            }
        }
        __syncthreads();
    }
}

__device__ __forceinline__ void p11_final(const Args& a) {
    const int tid = opaque_tid(), lane = tid & 63, wave = tid >> 6;
    const int gw = blockIdx.x * 8 + wave, NGW = gridDim.x * 8;
    const float* SS = (const float*)(a.ws + WS_SSD); const float* gn = a.in[I_NFIN];
    f32x4 g[4];
#pragma unroll
    for (int j = 0; j < 4; ++j) g[j] = *((const f32x4*)gn + lane + 64 * j);
    for (int m = gw; m < T; m += NGW) {
        const float rs = pg8::row_scale(SS, m);
        f32x4* xr = (f32x4*)(a.out + (size_t)m * D) + lane;
#pragma unroll
        for (int j = 0; j < 4; ++j) { f32x4 v = xr[64 * j]; v = v * rs * g[j]; xr[64 * j] = v; }
    }
}


#define XB_TMO      128
#define XB_XCNT(j)  (256  + 64 * (j))
#define XB_XSUB(j)  (1280 + 64 * (j))
#define XB_XGEN(j)  (2304 + 64 * (j))
#define XB_TOP      3328
#define XB_TOPGEN   3392
#define XCD_BAR_WORDS 3456
#define XB_SPIN_CAP (1u << 18)
__device__ __forceinline__ unsigned xb_ld(unsigned* p)              { return __hip_atomic_load(p, __ATOMIC_RELAXED, __HIP_MEMORY_SCOPE_AGENT); }
__device__ __forceinline__ unsigned xb_add(unsigned* p, unsigned v) { return __hip_atomic_fetch_add(p, v, __ATOMIC_RELAXED, __HIP_MEMORY_SCOPE_AGENT); }
__device__ __forceinline__ unsigned xb_xcc_id() { return (unsigned)__builtin_amdgcn_s_getreg((3 << 11) | 20) & 0xFu; }
#define XB_SPIN(cond, bar) do { unsigned _sp = 0; while (cond) { __builtin_amdgcn_s_sleep(1); \
    if ((++_sp & 255u) == 0u) { if (xb_ld(&(bar)[XB_TMO])) break; if (_sp > XB_SPIN_CAP) { atomicAdd(&(bar)[XB_TMO], 1u); break; } } } } while (0)
struct XcdBarrier { unsigned* bar; unsigned x; volatile LAS unsigned* st; };
__device__ __forceinline__ XcdBarrier xcd_barrier_post(unsigned* bar, volatile LAS unsigned* st) {
    XcdBarrier b; b.bar = bar; b.x = xb_xcc_id(); b.st = st;
    if (threadIdx.x == 0) (void)xb_add(&bar[XB_XCNT(b.x)], 1u);
    return b;
}
__device__ __forceinline__ void xcd_barrier_complete(unsigned* bar, unsigned x, unsigned& nloc, unsigned& nx) {
    const unsigned G = gridDim.x * gridDim.y * gridDim.z;
    unsigned sum, cnt, mine, sp = 0u;
    for (;;) {
        sum = 0u; cnt = 0u; mine = 0u;
#pragma unroll
        for (unsigned j = 0; j < 16; ++j) { const unsigned c = xb_ld(&bar[XB_XCNT(j)]); sum += c; cnt += (c > 0u) ? 1u : 0u; mine = (j == x) ? c : mine; }
        if (sum == G) break;
        __builtin_amdgcn_s_sleep(1);
        if ((++sp & 255u) == 0u) { if (xb_ld(&bar[XB_TMO])) break; if (sp > XB_SPIN_CAP) { atomicAdd(&bar[XB_TMO], 1u); break; } }
    }
    nloc = mine > 0u ? mine : 1u; nx = cnt > 0u ? cnt : 1u;
}
__device__ __forceinline__ void xcd_barrier(const XcdBarrier& b) {
    asm volatile("s_waitcnt vmcnt(0)" ::: "memory");
    __syncthreads();
    if (threadIdx.x == 0) {
        unsigned* bar = b.bar;
        __builtin_amdgcn_s_waitcnt(0);
        unsigned nloc = b.st[0], nx = b.st[1];
        if (nloc == 0u) { xcd_barrier_complete(bar, b.x, nloc, nx); b.st[0] = nloc; b.st[1] = nx; }
        const unsigned old = xb_add(&bar[XB_XSUB(b.x)], 1u);
        const unsigned gen = old / nloc;
        if (old + 1u == (gen + 1u) * nloc) {
            __builtin_amdgcn_fence(__ATOMIC_RELEASE, "agent");
            asm volatile("s_waitcnt vmcnt(0)" ::: "memory");
            const unsigned og = xb_add(&bar[XB_TOP], 1u);
            const unsigned tg = og / nx;
            if (og + 1u == (tg + 1u) * nx) xb_add(&bar[XB_TOPGEN], 1u);
            else XB_SPIN(xb_ld(&bar[XB_TOPGEN]) == tg, bar);
            __builtin_amdgcn_fence(__ATOMIC_ACQUIRE, "agent");
            xb_add(&bar[XB_XGEN(b.x)], 1u);
            asm volatile("s_waitcnt vmcnt(0)" ::: "memory");
        } else {
            XB_SPIN(xb_ld(&bar[XB_XGEN(b.x)]) == gen, bar);
            __builtin_amdgcn_fence(__ATOMIC_ACQUIRE, "agent");
            asm volatile("s_waitcnt vmcnt(0)" ::: "memory");
        }
    }
    __syncthreads();
}
#define GSYNC() xcd_barrier(xbar)
__global__ void __launch_bounds__(512, 2) mk_fwd(Args args) {
    extern __shared__ __attribute__((aligned(16))) unsigned char lds_raw[];
    cg::grid_group grid = cg::this_grid();
    LAS unsigned char* lds = (LAS unsigned char*)lds_raw;
    unsigned char* ws = args.ws;
    const int G = gridDim.x, bid = blockIdx.x;
    volatile LAS unsigned* xst = (volatile LAS unsigned*)(lds + (LDS_BYTES - 64));
    if (threadIdx.x == 0) { xst[0] = 0u; xst[1] = 0u; }
    __syncthreads();
    const XcdBarrier xbar = xcd_barrier_post((unsigned*)(ws + WS_BAR), xst);
    bf16_t* XB = (bf16_t*)(ws + WS_XB); bf16_t* ACT = (bf16_t*)(ws + WS_R1);
#ifndef NO_P0
    p0_prologue(args, lds_raw);
#endif
    asm volatile("s_waitcnt vmcnt(0)" ::: "memory"); __threadfence(); grid.sync();
#ifndef NO_P1
    { const pg8::Gemm gUp1{XB, (const bf16_t*)(ws + WS_WGU1), 1024, 1024, 1 << 30, 0, 0, 0}; pg8::StaticOrder S; S.init(T, 2 * FF, G, bid); pg8::EpiSwiGLU E{ACT, (const float*)(ws + WS_SSA)}; pg8::gemm_phase(lds, gUp1, S, E); }
#endif
    GSYNC();
#ifndef NO_P2
    { const pg8::Gemm gDn1{ACT, (const bf16_t*)(ws + WS_WD1), FF, FF, 1 << 30, 0, 0, 0}; pg8::StaticOrder S; S.init(T, D, G, bid); pg8::EpiResid E{args.in[I_X], args.out, XB, (float*)(ws + WS_SSB), 0.5f}; pg8::gemm_phase(lds, gDn1, S, E); }
#endif
    GSYNC();
#ifndef NO_P3
    { const pg8::Gemm gIn{XB, (const bf16_t*)(ws + WS_WIN), 1024, 1024, 1 << 30, 0, 0, 0}; pg8::StaticOrder S; S.init(T, 4096, G, bid); pg8::EpiProj E{(bf16_t*)(ws + WS_XM), (const float*)(ws + WS_SSB)}; pg8::gemm_phase(lds, gIn, S, E); }
#endif
    GSYNC();
#ifndef NO_P4
    p4_conv(args);
#endif
    GSYNC();
#ifndef NO_P5
    {
        const pg8::Gemm gRg{XB  , (const bf16_t*)(ws + WS_WRG), 256, 1024, 1 << 30, 0, 1, 512};
        const pg8::Gemm gGt{(const bf16_t*)(ws + WS_XC), (const bf16_t*)(ws + WS_WG8), 2048, 1024, 16, (long)WS_XM - (long)WS_XC - 16 * 128, 0, 0};
        pg8::EpiGates Eg{(float*)(ws + WS_GATES), args.in[I_BGATES]};
        pg8::EpiRg Er{XB, args.in[I_RBA], args.in[I_RBX], (const float*)(ws + WS_C8), (bf16_t*)(ws + WS_XR), (bf16_t*)(ws + WS_U)};
        if (G == 256) {
#ifndef NO_P5G
            if (bid < 128) { pg8::ListOrder S{bid, 1, 0}; pg8::gemm_phase(lds, gGt, S, Eg); }
#endif
#ifndef NO_P5R
            if (bid >= 128) { pg8::ListOrder S{(bid - 128) * 8, 8, 3}; pg8::gemm_phase(lds, gRg, S, Er); }
#endif
        } else {
#ifndef NO_P5G
            for (int u = bid; u < 128; u += G) { pg8::ListOrder S{u, 1, 0}; pg8::gemm_phase(lds, gGt, S, Eg); }
#endif
#ifndef NO_P5R
            for (int u = bid; u < 128; u += G) { pg8::ListOrder S{u * 8, 8, 3}; pg8::gemm_phase(lds, gRg, S, Er); }
#endif
        }
    }
#endif
    GSYNC();
#ifndef NO_P6A
    p6_rg_agg(args);
#endif
#ifndef NO_P6
    p6_mlstm(args, lds_raw);
#endif
    GSYNC();
#ifndef NO_P7A
    p7_mlstm_fin(args);
#endif
#ifndef NO_P7B
    p7_rg_fin(args, lds_raw);
#endif
    GSYNC();
#ifndef NO_P8
    { const pg8::Gemm gOut{(const bf16_t*)(ws + WS_ZM)  , (const bf16_t*)(ws + WS_WOUT), 2048, 1024, 16, (long)(64 * MiB) - 16 * 128, 0, 0}; pg8::StaticOrder S; S.init(T, D, G, bid); pg8::EpiResid E{args.out, args.out, XB, (float*)(ws + WS_SSC), 1.0f}; pg8::gemm_phase(lds, gOut, S, E); }
#endif
    GSYNC();
#ifndef NO_P9
    { const pg8::Gemm gUp2{XB, (const bf16_t*)(ws + WS_WGU2), 1024, 1024, 1 << 30, 0, 0, 0}; pg8::StaticOrder S; S.init(T, 2 * FF, G, bid); pg8::EpiSwiGLU E{ACT, (const float*)(ws + WS_SSC)}; pg8::gemm_phase(lds, gUp2, S, E); }
#endif
    GSYNC();
#ifndef NO_P10
    { const pg8::Gemm gDn2{ACT, (const bf16_t*)(ws + WS_WD2), FF, FF, 1 << 30, 0, 0, 0}; pg8::StaticOrder S; S.init(T, D, G, bid); pg8::EpiResid E{args.out, args.out, nullptr, (float*)(ws + WS_SSD), 0.5f}; pg8::gemm_phase(lds, gDn2, S, E); }
#endif
    GSYNC();
#ifndef NO_P11
    p11_final(args);
#endif
}

extern "C" void kernel_launch(void* const* d_in, const int* in_sizes, int n_in, void* d_out, int out_size, void* d_ws, size_t ws_size, hipStream_t stream) {
    static int grid = 0;
    if (grid == 0) {
        if (n_in != 31 || in_sizes[0] != T * D || out_size != T * D || ws_size < WS_END) { fprintf(stderr, "kernel_launch: unexpected shapes (n_in %d, in0 %d, out %d, ws %zu)\n", n_in, n_in > 0 ? in_sizes[0] : -1, out_size, ws_size); grid = -1; return; }
        int dev = 0, cus = 0, per_cu = 0;
        if (hipGetDevice(&dev) != hipSuccess || hipDeviceGetAttribute(&cus, hipDeviceAttributeMultiprocessorCount, dev) != hipSuccess) { grid = -1; return; }
        if (hipFuncSetAttribute((const void*)mk_fwd, hipFuncAttributeMaxDynamicSharedMemorySize, LDS_BYTES) != hipSuccess) { fprintf(stderr, "kernel_launch: hipFuncSetAttribute failed\n"); grid = -1; return; }
        if (hipOccupancyMaxActiveBlocksPerMultiprocessor(&per_cu, (const void*)mk_fwd, 512, LDS_BYTES) != hipSuccess || per_cu < 1) { fprintf(stderr, "kernel_launch: occupancy query says %d\n", per_cu); (void)hipGetLastError(); grid = -1; return; }
        grid = cus;
    }
    if (grid < 0) return;
    if (hipMemsetAsync((char*)d_ws + WS_BAR, 0, 16384, stream) != hipSuccess) { fprintf(stderr, "kernel_launch: memset of barrier words failed\n"); return; }
    Args a{};
    for (int i = 0; i < 31; ++i) a.in[i] = (const float*)d_in[i];
    a.out = (float*)d_out; a.ws = (unsigned char*)d_ws;
    void* kargs[] = {&a};
    hipError_t e = hipLaunchCooperativeKernel((const void*)mk_fwd, dim3(grid), dim3(512), kargs, LDS_BYTES, stream);
    if (e != hipSuccess) fprintf(stderr, "kernel_launch: cooperative launch failed: %s (grid %d)\n", hipGetErrorString(e), grid);
}
```

```cpp
#include <hip/hip_runtime.h>
#include <hip/hip_cooperative_groups.h>
#include <cstdio>
#include <cstdint>
namespace cg = cooperative_groups;

#define LAS __attribute__((address_space(3)))
typedef unsigned short bf16_t;
typedef short bf16x8 __attribute__((ext_vector_type(8)));
typedef float f32x4 __attribute__((ext_vector_type(4)));
typedef unsigned u32x4 __attribute__((ext_vector_type(4)));
typedef unsigned u32x2 __attribute__((ext_vector_type(2)));

constexpr int T = 32768, D = 1024, FF = 2816, SEQ = 8192, NB = 4;
constexpr float EPS = 1e-6f;
constexpr size_t MiB = 1u << 20;
constexpr size_t WS_SSA = 0, WS_SSB = 2 * MiB, WS_SSC = 4 * MiB, WS_SSD = 6 * MiB;
constexpr size_t WS_GATES = 8 * MiB;
constexpr size_t WS_AGG = 9 * MiB;
constexpr size_t WS_BAR = 14 * MiB;
constexpr size_t WS_C8 = 12 * MiB;
constexpr size_t WS_WG8 = 11 * MiB;
constexpr size_t WS_WGU1 = 16 * MiB;
constexpr size_t WS_WD1 = WS_WGU1 + 11 * MiB;
constexpr size_t WS_WIN = WS_WD1 + 11 * MiB / 2;
constexpr size_t WS_WRG = WS_WIN + 8 * MiB;
constexpr size_t WS_WOUT = WS_WRG + 1 * MiB;
constexpr size_t WS_WGU2 = WS_WOUT + 4 * MiB;
constexpr size_t WS_WD2 = WS_WGU2 + 11 * MiB;
constexpr size_t WS_XB = 64 * MiB;
constexpr size_t WS_R1 = 128 * MiB;
constexpr size_t WS_XM = WS_R1, WS_ZM = WS_R1 + 64 * MiB, WS_XR = WS_R1 + 128 * MiB, WS_YR = WS_R1 + 192 * MiB;
constexpr size_t WS_XC = 384 * MiB;
constexpr size_t WS_U = 448 * MiB;
constexpr size_t WS_END = 512 * MiB;
constexpr int LDS_BYTES = 147456;

typedef float f32x2_t __attribute__((ext_vector_type(2)));
typedef __bf16 bf16x2_t __attribute__((ext_vector_type(2)));
__device__ __forceinline__ unsigned pk2(float lo, float hi) { const f32x2_t v = {lo, hi}; const bf16x2_t b = __builtin_convertvector(v, bf16x2_t); return __builtin_bit_cast(unsigned, b); }
__device__ __forceinline__ float bflo(unsigned u) { return __uint_as_float(u << 16); }
__device__ __forceinline__ float bfhi(unsigned u) { return __uint_as_float(u & 0xffff0000u); }
__device__ __forceinline__ float bf1(bf16_t u) { return __uint_as_float(((unsigned)u) << 16); }
__device__ __forceinline__ void unpack8(const u32x4 v, float* x) { x[0] = bflo(v.x); x[1] = bfhi(v.x); x[2] = bflo(v.y); x[3] = bfhi(v.y); x[4] = bflo(v.z); x[5] = bfhi(v.z); x[6] = bflo(v.w); x[7] = bfhi(v.w); }
__device__ __forceinline__ u32x4 pack8(const float* x) { u32x4 o; o.x = pk2(x[0], x[1]); o.y = pk2(x[2], x[3]); o.z = pk2(x[4], x[5]); o.w = pk2(x[6], x[7]); return o; }
__device__ __forceinline__ float sigmoidf_(float x) { return __builtin_amdgcn_rcpf(1.0f + __expf(-x)); }
__device__ __forceinline__ float siluf_(float x) { return x * __builtin_amdgcn_rcpf(1.0f + __expf(-x)); }
__device__ __forceinline__ float logsigf_(float x) { return fminf(x, 0.f) - __logf(1.0f + __expf(-fabsf(x))); }
__device__ __forceinline__ float logsig_acc_(float x) { return fminf(x, 0.f) - log1pf(expf(-fabsf(x))); }
__device__ __forceinline__ float geluf_(float x) { const float u = 0.7978845608028654f * (x + 0.044715f * x * x * x); const float t = 1.0f - 2.0f * __builtin_amdgcn_rcpf(1.0f + __expf(2.0f * u)); return 0.5f * x * (1.0f + t); }
__device__ __forceinline__ int opaque_tid() { int t = threadIdx.x; asm volatile("" : "+v"(t)); return t; }
__device__ __forceinline__ float wave_sum(float v) {
#pragma unroll
    for (int o = 1; o < 64; o <<= 1) v += __shfl_xor(v, o);
    return v;
}

namespace pg8 {
constexpr int BM = 256, BK = 64, HALF = 128, HTB = HALF * BK * 2, STAGE_BYTES = 8 * HTB, NXCD = 8, WGM = 8;
__host__ __device__ __forceinline__ int lds_byte(int r, int c) { const int st = (r >> 4) * 2 + (c >> 5), rr = r & 15, cc = c & 31, ob = rr * 64 + cc * 2; return st * 1024 + (ob ^ (((ob >> 9) & 1) << 5)); }
__host__ __device__ __forceinline__ void stage_rc(int b, int& R, int& C) { const int st = b / 1024, sb = b % 1024, swz = sb ^ (((sb >> 9) & 1) << 5); R = (st >> 1) * 16 + swz / 64; C = (st & 1) * 32 + (swz % 64) / 2; }
__host__ __device__ __forceinline__ int perm32(int rho) { const int n = rho >> 4, i = rho & 15; return 8 * (i >> 2) + 4 * n + (i & 3); }

struct Unit { int pm, pn; };
struct Gemm { const bf16_t* A; const bf16_t* Bt; int K; int lda; int ksplit; long kdelta; int a_pn_shift; int a_pn_bytes; };

struct StaticOrder {
    int nM, nN, nwg, G, c;
    __device__ void init(int M, int N, int G_, int c_) { nM = M / BM; nN = N / BM; nwg = nM * nN; G = G_; c = c_; }
    __device__ bool next(int i, Unit& u) const {
        const long L = (long)i * G + c; if (L >= nwg) return false;
        int wgid = (int)L; { const int q = nwg / NXCD, r = nwg % NXCD, xcd = wgid % NXCD, off = wgid / NXCD; wgid = (xcd < r ? xcd * (q + 1) : r * (q + 1) + (xcd - r) * q) + off; }
        const int nig = WGM * nN, gid = wgid / nig, fm = gid * WGM, gsz = (nM - fm) < WGM ? (nM - fm) : WGM;
        u.pm = fm + ((wgid % nig) % gsz); u.pn = (wgid % nig) / gsz; return true;
    }
};
struct ListOrder {
    int first, cnt, nshift;
    __device__ bool next(int i, Unit& u) const { if (i >= cnt) return false; const int L = first + i; u.pm = L >> nshift; u.pn = L & ((1 << nshift) - 1); return true; }
};

__device__ __forceinline__ float row_scale(const float* SS, int r) {
    const f32x4* p = (const f32x4*)(SS + (size_t)r * 16);
    const f32x4 a = p[0], b = p[1], c = p[2], d = p[3];
    const float s = ((a[0] + a[1]) + (a[2] + a[3])) + ((b[0] + b[1]) + (b[2] + b[3])) + ((c[0] + c[1]) + (c[2] + c[3])) + ((d[0] + d[1]) + (d[2] + d[3]));
    return rsqrtf(s * (1.0f / 1024.0f) + EPS);
}

__device__ __forceinline__ void row_scales8(const float* SS, int row0, int fq, float (&rs)[8]) {
    f32x4 v[8];
#pragma unroll
    for (int q = 0; q < 8; ++q) v[q] = *(const f32x4*)(SS + (size_t)(row0 + (q >> 2) * HALF + (q & 3) * 16) * 16 + fq * 4);
#pragma unroll
    for (int q = 0; q < 8; ++q) { float s = (v[q][0] + v[q][1]) + (v[q][2] + v[q][3]); s += __shfl_xor(s, 16); s += __shfl_xor(s, 32); rs[q] = rsqrtf(s * (1.0f / 1024.0f) + EPS); }
}
struct EpiSwiGLU {
    bf16_t* O; const float* SS;
    __device__ __forceinline__ void operator()(const f32x4 (&acc)[2][2][4][2], const Unit& u, int wr, int wc, int fr, int fq) const {
        const int row0 = u.pm * BM + wr * 64 + fr, col0 = u.pn * HALF + wc * 32 + 8 * fq;
        float rs8[8]; row_scales8(SS, row0, fq, rs8);
#pragma unroll
        for (int ai = 0; ai < 2; ++ai)
#pragma unroll
            for (int m = 0; m < 4; ++m) {
                const int r = row0 + ai * HALF + m * 16; const float rs = rs8[ai * 4 + m];
                float o[8];
#pragma unroll
                for (int n = 0; n < 2; ++n)
#pragma unroll
                    for (int j = 0; j < 4; ++j) { const float g = acc[ai][0][m][n][j] * rs, up = acc[ai][1][m][n][j] * rs; o[n * 4 + j] = siluf_(g) * up; }
                *(u32x4*)(O + (size_t)r * FF + col0) = pack8(o);
            }
    }
};
struct EpiResid {
    const float* Xin; float* Xout; bf16_t* XBo; float* SSo; float alpha;
    __device__ __forceinline__ void operator()(const f32x4 (&acc)[2][2][4][2], const Unit& u, int wr, int wc, int fr, int fq) const {
        const int row0 = u.pm * BM + wr * 64 + fr, col0 = u.pn * BM + wc * 32 + 8 * fq;
#pragma unroll
        for (int ai = 0; ai < 2; ++ai)
#pragma unroll
            for (int m = 0; m < 4; ++m) {
                const int r = row0 + ai * HALF + m * 16; float ss = 0.f;
#pragma unroll
                for (int bj = 0; bj < 2; ++bj) {
                    const size_t off = (size_t)r * D + col0 + bj * HALF;
                    const f32x4 x0 = *(const f32x4*)(Xin + off), x1 = *(const f32x4*)(Xin + off + 4);
                    const f32x4 v0 = x0 + acc[ai][bj][m][0] * alpha, v1 = x1 + acc[ai][bj][m][1] * alpha;
                    *(f32x4*)(Xout + off) = v0; *(f32x4*)(Xout + off + 4) = v1;
                    ss += (v0[0] * v0[0] + v0[1] * v0[1]) + (v0[2] * v0[2] + v0[3] * v0[3]) + (v1[0] * v1[0] + v1[1] * v1[1]) + (v1[2] * v1[2] + v1[3] * v1[3]);
                    if (XBo) { u32x4 w; w.x = pk2(v0[0], v0[1]); w.y = pk2(v0[2], v0[3]); w.z = pk2(v1[0], v1[1]); w.w = pk2(v1[2], v1[3]); *(u32x4*)(XBo + off) = w; }
                }
                ss += __shfl_xor(ss, 16); ss += __shfl_xor(ss, 32);
                if (fq == 0) SSo[(size_t)r * 16 + u.pn * 4 + wc] = ss;
            }
    }
};
struct EpiProj {
    bf16_t* O; const float* SS;
    __device__ __forceinline__ void operator()(const f32x4 (&acc)[2][2][4][2], const Unit& u, int wr, int wc, int fr, int fq) const {
        bf16_t* base = O + (size_t)(u.pn >> 2) * ((size_t)T * D);
        const int row0 = u.pm * BM + wr * 64 + fr, col0 = (u.pn & 3) * BM + wc * 32 + 8 * fq;
        float rs8[8]; row_scales8(SS, row0, fq, rs8);
#pragma unroll
        for (int ai = 0; ai < 2; ++ai)
#pragma unroll
            for (int m = 0; m < 4; ++m) {
                const int r = row0 + ai * HALF + m * 16; const float rs = rs8[ai * 4 + m];
#pragma unroll
                for (int bj = 0; bj < 2; ++bj) {
                    const f32x4 v0 = acc[ai][bj][m][0] * rs, v1 = acc[ai][bj][m][1] * rs;
                    u32x4 w; w.x = pk2(v0[0], v0[1]); w.y = pk2(v0[2], v0[3]); w.z = pk2(v1[0], v1[1]); w.w = pk2(v1[2], v1[3]);
                    *(u32x4*)(base + (size_t)r * D + col0 + bj * HALF) = w;
                }
            }
    }
};
__device__ __forceinline__ float neg_expm1_(float x) {
    const float p = -x * (1.0f + x * (0.5f + x * (0.16666667f + x * (0.041666668f + x * 0.0083333338f))));
    const float e = 1.0f - __expf(x);
    return (x > -0.3f) ? p : e;
}
struct EpiRg {
    const bf16_t* XCR; const float* ba; const float* bx; const float* c8t; bf16_t* LOGA; bf16_t* U;
    __device__ __forceinline__ void operator()(const f32x4 (&acc)[2][2][4][2], const Unit& u, int wr, int wc, int fr, int fq) const {
        const int row0 = u.pm * BM + wr * 64 + fr, ch0 = (u.pn >> 1) * 256 + (u.pn & 1) * HALF + wc * 32 + 8 * fq;
#pragma unroll
        for (int n = 0; n < 2; ++n) {
            const int ch = ch0 + 4 * n;
            const f32x4 b_a = *(const f32x4*)(ba + ch), b_x = *(const f32x4*)(bx + ch), c8 = *(const f32x4*)(c8t + ch);
#pragma unroll
            for (int ai = 0; ai < 2; ++ai)
#pragma unroll
                for (int m = 0; m < 4; ++m) {
                    const int r = row0 + ai * HALF + m * 16;
                    const u32x2 xv = *(const u32x2*)(XCR + (size_t)r * D + ch);
                    const float xc[4] = {bflo(xv.x), bfhi(xv.x), bflo(xv.y), bfhi(xv.y)};
                    float la[4], uu[4];
#pragma unroll
                    for (int j = 0; j < 4; ++j) {
                        const float rg = sigmoidf_(acc[ai][0][m][n][j] + b_a[j]), ig = sigmoidf_(acc[ai][1][m][n][j] + b_x[j]);
                        la[j] = c8[j] * rg;
                        uu[j] = __builtin_amdgcn_sqrtf(fmaxf(neg_expm1_(2.0f * la[j]), 0.f)) * (ig * xc[j]);
                    }
                    u32x2 w0, w1; w0.x = pk2(la[0], la[1]); w0.y = pk2(la[2], la[3]); w1.x = pk2(uu[0], uu[1]); w1.y = pk2(uu[2], uu[3]);
                    *(u32x2*)(LOGA + (size_t)r * D + ch) = w0; *(u32x2*)(U + (size_t)r * D + ch) = w1;
                    __builtin_amdgcn_sched_barrier(0);
                }
        }
    }
};
struct EpiGates {
    float* G; const float* bg;
    __device__ __forceinline__ void operator()(const f32x4 (&acc)[2][2][4][2], const Unit& u, int wr, int wc, int fr, int fq) const {
        if (wc != 0 || fq != 0) return;
        const int row0 = u.pm * BM + wr * 64 + fr;
        const f32x4 b0 = *(const f32x4*)(bg), b1 = *(const f32x4*)(bg + 4);
#pragma unroll
        for (int ai = 0; ai < 2; ++ai)
#pragma unroll
            for (int m = 0; m < 4; ++m) {
                const int r = row0 + ai * HALF + m * 16;
                f32x4 v0 = acc[ai][0][m][0] + b0, v1 = acc[ai][0][m][1] + b1;
                for (int j = 0; j < 4; ++j) v1[j] = logsigf_(v1[j]);
                *(f32x4*)(G + (size_t)r * 8) = v0; *(f32x4*)(G + (size_t)r * 8 + 4) = v1;
            }
    }
};

template <class Epi, class Sched>
__device__ __forceinline__ void gemm_phase(LAS unsigned char* lds, const Gemm g, const Sched& S, const Epi& E) {
    const int tid = opaque_tid(), wid = __builtin_amdgcn_readfirstlane(tid >> 6), lane = tid & 63, wr = wid >> 2, wc = wid & 3, fr = lane & 15, fq = lane >> 4;
    const int K = g.K, nt = K / BK, lda = g.lda;
    unsigned voffA[2], voffB[2];
#pragma unroll
    for (int i = 0; i < 2; ++i) { int R, C; stage_rc(tid * 16 + i * 8192, R, C); const int Rb = (R & ~31) + perm32(R & 31);
        voffA[i] = (unsigned)(R * lda + C) * 2u; voffB[i] = (unsigned)(Rb * K + C) * 2u; }
    const size_t kstep = (size_t)(BK * 2);
    const size_t hstepA = (size_t)HALF * lda * 2, tstepA = 2 * hstepA;
    const size_t hstepB = (size_t)HALF * K * 2, tstepB = 2 * hstepB;
    const unsigned ldsw = (unsigned)wid * 1024u;
    const int aoff = lds_byte(wr * 64 + fr, fq * 8), boff = lds_byte(wc * 32 + fr, fq * 8);
    const int ksplit = g.ksplit; const long kdelta = g.kdelta;
#define PG8_AK(t) ((long)(t) * (long)kstep + (((t) >= ksplit) ? kdelta : 0l))
#define PG8_SA(b, h) (((b) * 2 + (h)) * HTB)
#define PG8_SB(b, h) ((4 + (b) * 2 + (h)) * HTB)
#define PG8_STAGE(bufoff, gbase, voff) do { _Pragma("unroll") for (int _i = 0; _i < 2; ++_i) \
        __builtin_amdgcn_global_load_lds((const unsigned*)((const char*)(gbase) + (voff)[_i]), (LAS unsigned*)(lds + (bufoff) + ldsw + _i * 8192), 16, 0, 0); } while (0)
#define PG8_LDA(dst, b, h) do { _Pragma("unroll") for (int m = 0; m < 4; ++m) _Pragma("unroll") for (int k = 0; k < 2; ++k) dst[m][k] = *(const LAS bf16x8*)(lds + PG8_SA(b, h) + aoff + m * 2048 + k * 1024); } while (0)
#define PG8_LDB(dst, b, h) do { _Pragma("unroll") for (int n = 0; n < 2; ++n) _Pragma("unroll") for (int k = 0; k < 2; ++k) dst[n][k] = *(const LAS bf16x8*)(lds + PG8_SB(b, h) + boff + n * 2048 + k * 1024); } while (0)
#define PG8_MMA(ai, bj, At, Bt) do { __builtin_amdgcn_s_setprio(1); _Pragma("unroll") for (int m = 0; m < 4; ++m) _Pragma("unroll") for (int n = 0; n < 2; ++n) _Pragma("unroll") for (int k = 0; k < 2; ++k) \
        acc[ai][bj][m][n] = __builtin_amdgcn_mfma_f32_16x16x32_bf16(Bt[n][k], At[m][k], acc[ai][bj][m][n], 0, 0, 0); __builtin_amdgcn_s_setprio(0); } while (0)
#define PG8_WAIT_V(n) asm volatile("s_waitcnt vmcnt(" #n ")" ::: "memory")
#define PG8_WAIT_L(n) asm volatile("s_waitcnt lgkmcnt(" #n ")" ::: "memory")
#define PG8_BAR __builtin_amdgcn_s_barrier()
#define PG8_SCHED __builtin_amdgcn_sched_barrier(0)
    Unit cur, nxt; int ui = 0;
    if (!S.next(0, cur)) return;
    f32x4 acc[2][2][4][2];
#pragma unroll
    for (int a = 0; a < 2; ++a)
#pragma unroll
        for (int b = 0; b < 2; ++b)
#pragma unroll
            for (int m = 0; m < 4; ++m)
#pragma unroll
                for (int n = 0; n < 2; ++n) acc[a][b][m][n] = (f32x4){0.f, 0.f, 0.f, 0.f};
    bf16x8 At[4][2], B0[2][2], B1[2][2];
    const char* cA = (const char*)g.A + (size_t)cur.pm * tstepA + (size_t)(cur.pn >> g.a_pn_shift) * g.a_pn_bytes;
    const char* cB = (const char*)g.Bt + (size_t)cur.pn * tstepB;
    {
        PG8_STAGE(PG8_SB(0, 0), cB, voffB); PG8_STAGE(PG8_SB(0, 1), cB + hstepB, voffB); PG8_STAGE(PG8_SA(0, 0), cA, voffA); PG8_STAGE(PG8_SA(0, 1), cA + hstepA, voffA);
        if (wr == 1) PG8_BAR;
        PG8_WAIT_V(2); PG8_BAR;
        PG8_STAGE(PG8_SB(1, 0), cB + kstep, voffB); PG8_STAGE(PG8_SA(1, 0), cA + PG8_AK(1), voffA); PG8_STAGE(PG8_SB(1, 1), cB + hstepB + kstep, voffB);
        PG8_WAIT_V(6); PG8_BAR;
    }
    for (;;) {
        const bool has_next = S.next(ui + 1, nxt);
        const char* nA = has_next ? (const char*)g.A + (size_t)nxt.pm * tstepA + (size_t)(nxt.pn >> g.a_pn_shift) * g.a_pn_bytes : cA;
        const char* nB = has_next ? (const char*)g.Bt + (size_t)nxt.pn * tstepB : cB;
#pragma nounroll
        for (int t = 0; t < nt; t += 2) {
            const bool last = (t == nt - 2);
            const char* a1 = cA + PG8_AK(t + 1);
            const char* a2 = last ? nA : cA + PG8_AK(t + 2); const char* b2 = last ? nB : cB + (size_t)(t + 2) * kstep;
            const char* a3 = last ? nA + PG8_AK(1) : cA + PG8_AK(t + 3); const char* b3 = b2 + kstep;
            PG8_LDB(B0, 0, 0); PG8_LDB(B1, 0, 1); PG8_SCHED; PG8_LDA(At, 0, 0); PG8_STAGE(PG8_SA(1, 1), a1 + hstepA, voffA);
            PG8_WAIT_V(8); PG8_WAIT_L(0); PG8_BAR; PG8_MMA(0, 0, At, B0); PG8_MMA(0, 1, At, B1); PG8_BAR; PG8_SCHED;
            PG8_LDA(At, 0, 1); PG8_STAGE(PG8_SB(0, 0), b2, voffB); PG8_STAGE(PG8_SB(0, 1), b2 + hstepB, voffB); PG8_STAGE(PG8_SA(0, 0), a2, voffA);
            PG8_WAIT_V(8); PG8_WAIT_L(0); PG8_BAR; PG8_MMA(1, 0, At, B0); PG8_MMA(1, 1, At, B1); PG8_BAR; PG8_SCHED;
            PG8_LDB(B0, 1, 0); PG8_LDB(B1, 1, 1); PG8_SCHED; PG8_LDA(At, 1, 0); PG8_STAGE(PG8_SA(0, 1), a2 + hstepA, voffA);
            PG8_WAIT_V(8); PG8_WAIT_L(0); PG8_BAR; PG8_MMA(0, 0, At, B0); PG8_MMA(0, 1, At, B1); PG8_BAR; PG8_SCHED;
            PG8_LDA(At, 1, 1); PG8_STAGE(PG8_SB(1, 0), b3, voffB); PG8_STAGE(PG8_SB(1, 1), b3 + hstepB, voffB); PG8_STAGE(PG8_SA(1, 0), a3, voffA);
            PG8_WAIT_V(8); PG8_WAIT_L(0); PG8_BAR; PG8_MMA(1, 0, At, B0); PG8_MMA(1, 1, At, B1); PG8_BAR; PG8_SCHED;
        }
        if (wr == 0) PG8_BAR;
        E(acc, cur, wr, wc, fr, fq);
        if (!has_next) break;
#pragma unroll
        for (int a = 0; a < 2; ++a)
#pragma unroll
            for (int b = 0; b < 2; ++b)
#pragma unroll
                for (int m = 0; m < 4; ++m)
#pragma unroll
                    for (int n = 0; n < 2; ++n) acc[a][b][m][n] = (f32x4){0.f, 0.f, 0.f, 0.f};
        cur = nxt; cA = nA; cB = nB; ++ui;
        if (wr == 1) PG8_BAR;
    }
    PG8_WAIT_V(0);
    PG8_BAR;
#undef PG8_AK
#undef PG8_SA
#undef PG8_SB
#undef PG8_STAGE
#undef PG8_LDA
#undef PG8_LDB
#undef PG8_MMA
#undef PG8_WAIT_V
#undef PG8_WAIT_L
#undef PG8_BAR
#undef PG8_SCHED
}
}

struct Args { const float* in[31]; float* out; unsigned char* ws; };
enum { I_X = 0, I_NF1, I_WG1, I_WU1, I_WD1, I_NMIX, I_WIN, I_MCW, I_MCB, I_WQ, I_WK, I_WV, I_WGATES, I_BGATES, I_LNW, I_SKIP, I_RCW, I_RCB, I_RWA, I_RBA, I_RWX, I_RBX, I_LAM,
       I_ONM, I_ONR, I_WOUT, I_NF2, I_WG2, I_WU2, I_WD2, I_NFIN };

template <class F> __device__ __forceinline__ void tr_item(F src, int K, bf16_t* WT, float* scr, int item, int nblk, int lane) {
    const int kb = item / nblk, nb = item % nblk, k0 = 64 * kb, n0 = 32 * nb;
#pragma unroll 8
    for (int i = 0; i < 32; ++i) { const int kk = 2 * i + (lane >> 5); scr[kk * 33 + (lane & 31)] = src(k0 + kk, n0 + (lane & 31)); }
    __builtin_amdgcn_wave_barrier();
    const int c = lane & 7;
#pragma unroll
    for (int j = 0; j < 4; ++j) { const int n = (lane >> 3) + 8 * j; const float* s = scr + (8 * c) * 33 + n;
        u32x4 o; o.x = pk2(s[0 * 33], s[1 * 33]); o.y = pk2(s[2 * 33], s[3 * 33]); o.z = pk2(s[4 * 33], s[5 * 33]); o.w = pk2(s[6 * 33], s[7 * 33]);
        *(u32x4*)(WT + (size_t)(n0 + n) * K + k0 + 8 * c) = o; }
    __builtin_amdgcn_wave_barrier();
}

__device__ __forceinline__ void p0_prologue(const Args& a, unsigned char* lds) {
    const int tid = opaque_tid(), lane = tid & 63, wave = tid >> 6;
    const int gw = blockIdx.x * 8 + wave, NGW = gridDim.x * 8;
    float* scr = (float*)(lds + wave * 16384);
    unsigned char* ws = a.ws;
    constexpr int I1 = 16 * 176, I2 = 44 * 32, I3 = 16 * 128, I4 = 4 * 64, I5 = 32 * 32;
    constexpr int NIT = I1 + I2 + I3 + I4 + I5 + I1 + I2;
    for (int it = gw; it < NIT; it += NGW) {
        int r = it;
        if (r < I1) { const float* wg = a.in[I_WG1]; const float* wu = a.in[I_WU1]; const float* gn = a.in[I_NF1];
            tr_item([=](int k, int n) { const int c = (n >> 8) * 128 + (n & 127); return (((n >> 7) & 1) ? wu : wg)[(size_t)k * FF + c] * gn[k]; }, 1024, (bf16_t*)(ws + WS_WGU1), scr, r, 176, lane); continue; } r -= I1;
        if (r < I2) { const float* wd = a.in[I_WD1];
            tr_item([=](int k, int n) { return wd[(size_t)k * D + n]; }, FF, (bf16_t*)(ws + WS_WD1), scr, r, 32, lane); continue; } r -= I2;
        if (r < I3) { const float* w = a.in[I_WIN]; const float* gn = a.in[I_NMIX];
            tr_item([=](int k, int n) { return w[(size_t)k * 4096 + n] * gn[k]; }, 1024, (bf16_t*)(ws + WS_WIN), scr, r, 128, lane); continue; } r -= I3;
        if (r < I4) { const float* wa = a.in[I_RWA]; const float* wx = a.in[I_RWX];
            tr_item([=](int k, int n) { const int pn = n >> 8, blk = pn >> 1, hh = pn & 1, sel = (n >> 7) & 1, c = hh * 128 + (n & 127); return (sel ? wx : wa)[(size_t)blk * 65536 + (size_t)k * 256 + c]; }, 256, (bf16_t*)(ws + WS_WRG), scr, r, 64, lane); continue; } r -= I4;
        if (r < I5) { const float* w = a.in[I_WOUT]; const float* gm = a.in[I_ONM]; const float* gr = a.in[I_ONR];
            tr_item([=](int k, int n) { return w[(size_t)k * D + n] * (k < 1024 ? gm[k] : gr[k - 1024]); }, 2048, (bf16_t*)(ws + WS_WOUT), scr, r, 32, lane); continue; } r -= I5;
        if (r < I1) { const float* wg = a.in[I_WG2]; const float* wu = a.in[I_WU2]; const float* gn = a.in[I_NF2];
            tr_item([=](int k, int n) { const int c = (n >> 8) * 128 + (n & 127); return (((n >> 7) & 1) ? wu : wg)[(size_t)k * FF + c] * gn[k]; }, 1024, (bf16_t*)(ws + WS_WGU2), scr, r, 176, lane); continue; } r -= I1;
        { const float* wd = a.in[I_WD2];
            tr_item([=](int k, int n) { return wd[(size_t)k * D + n]; }, FF, (bf16_t*)(ws + WS_WD2), scr, r, 32, lane); }
    }
    {
        bf16_t* WG8 = (bf16_t*)(ws + WS_WG8);
        const float* wq = a.in[I_WQ]; const float* wk = a.in[I_WK]; const float* wv = a.in[I_WV]; const float* Wg = a.in[I_WGATES];
        const int gt = blockIdx.x * 512 + tid, NT = gridDim.x * 512;
        for (int e = gt; e < 256 * 2048 / 8; e += NT) {
            const int g = e / 256, k0 = (e % 256) * 8;
            float o[8];
#pragma unroll
            for (int j = 0; j < 8; ++j) {
                float v = 0.f;
                if (g < 8) { const int k = k0 + j, c = k & 1023, n = c >> 2, i = c & 3;
                    if (k < 1024) { for (int oo = 0; oo < 4; ++oo) v += wq[n * 16 + i * 4 + oo] * Wg[(size_t)(4 * n + oo) * 8 + g] + wk[n * 16 + i * 4 + oo] * Wg[(size_t)(1024 + 4 * n + oo) * 8 + g]; }
                    else { for (int oo = 0; oo < 4; ++oo) v += wv[n * 16 + i * 4 + oo] * Wg[(size_t)(2048 + 4 * n + oo) * 8 + g]; } }
                o[j] = v;
            }
            *(u32x4*)(WG8 + (size_t)g * 2048 + k0) = pack8(o);
        }
    }
    if (blockIdx.x == 0) { float* C8 = (float*)(ws + WS_C8); const float* lam = a.in[I_LAM]; for (int e = tid; e < 1024; e += 512) C8[e] = 8.0f * logsig_acc_(lam[e]); }
    {
        const float* x = a.in[I_X]; bf16_t* XB = (bf16_t*)(ws + WS_XB); float* SS = (float*)(ws + WS_SSA);
        for (int m = gw; m < T; m += NGW) {
            const f32x4* xr = (const f32x4*)(x + (size_t)m * D) + lane;
            f32x4 v[4]; float s = 0.f;
#pragma unroll
            for (int j = 0; j < 4; ++j) { v[j] = xr[64 * j]; s += (v[j][0] * v[j][0] + v[j][1] * v[j][1]) + (v[j][2] * v[j][2] + v[j][3] * v[j][3]); }
            s = wave_sum(s);
            u32x2* o8 = (u32x2*)(XB + (size_t)m * D) + lane;
#pragma unroll
            for (int j = 0; j < 4; ++j) { u32x2 w; w.x = pk2(v[j][0], v[j][1]); w.y = pk2(v[j][2], v[j][3]); o8[64 * j] = w; }
            if (lane < 16) SS[(size_t)m * 16 + lane] = (lane == 0) ? s : 0.f;
        }
    }
}

template <bool SILU> __device__ __forceinline__ void conv_part(const bf16_t* in, bf16_t* out, const float* cw, const float* cb, int t0, int c0) {
    float w[4][8], b[8];
#pragma unroll
    for (int tap = 0; tap < 4; ++tap) { const f32x4 p = *(const f32x4*)(cw + tap * D + c0), q = *(const f32x4*)(cw + tap * D + c0 + 4); for (int j = 0; j < 4; ++j) { w[tap][j] = p[j]; w[tap][4 + j] = q[j]; } }
    { const f32x4 p = *(const f32x4*)(cb + c0), q = *(const f32x4*)(cb + c0 + 4); for (int j = 0; j < 4; ++j) { b[j] = p[j]; b[4 + j] = q[j]; } }
    float h0[8], h1[8], h2[8];
    const bool first = (t0 % SEQ) == 0;
    if (first) { for (int j = 0; j < 8; ++j) { h0[j] = 0.f; h1[j] = 0.f; h2[j] = 0.f; } }
    else {
        unpack8(*(const u32x4*)(in + (size_t)(t0 - 3) * D + c0), h0); unpack8(*(const u32x4*)(in + (size_t)(t0 - 2) * D + c0), h1); unpack8(*(const u32x4*)(in + (size_t)(t0 - 1) * D + c0), h2);
    }
    u32x4 cur[8];
#pragma unroll
    for (int i = 0; i < 8; ++i) cur[i] = *(const u32x4*)(in + (size_t)(t0 + i) * D + c0);
#pragma unroll
    for (int i = 0; i < 8; ++i) {
        float x[8], y[8]; unpack8(cur[i], x);
#pragma unroll
        for (int j = 0; j < 8; ++j) { float v = b[j] + w[0][j] * h0[j] + w[1][j] * h1[j] + w[2][j] * h2[j] + w[3][j] * x[j]; y[j] = SILU ? siluf_(v) : v; h0[j] = h1[j]; h1[j] = h2[j]; h2[j] = x[j]; }
        *(u32x4*)(out + (size_t)(t0 + i) * D + c0) = pack8(y);
    }
}
__device__ __forceinline__ void p4_conv(const Args& a) {
    unsigned char* ws = a.ws; const int tid = opaque_tid(), cgp = tid & 127, ts = tid >> 7;
    for (int u = blockIdx.x; u < T / 32; u += gridDim.x) {
        const int t0 = u * 32 + ts * 8, c0 = cgp * 8;
        conv_part<true>((const bf16_t*)(ws + WS_XM), (bf16_t*)(ws + WS_XC), a.in[I_MCW], a.in[I_MCB], t0, c0);
        conv_part<false>((const bf16_t*)(ws + WS_XR), (bf16_t*)(ws + WS_XB), a.in[I_RCW], a.in[I_RCB], t0, c0);
    }
}

__device__ __forceinline__ void p6_rg_agg(const Args& a) {
    unsigned char* ws = a.ws; const int tid = opaque_tid();
    const unsigned* LOGA = (const unsigned*)(ws + WS_XR); const unsigned* U = (const unsigned*)(ws + WS_U); float* AGG = (float*)(ws + WS_AGG);
    for (int tile = blockIdx.x; tile < 256; tile += gridDim.x) {
        const size_t row0 = (size_t)tile * 128;
        float sl0 = 0.f, sl1 = 0.f, h0 = 0.f, h1 = 0.f;
        for (int i0 = 0; i0 < 128; i0 += 16) {
            unsigned la[16], uu[16];
#pragma unroll
            for (int i = 0; i < 16; ++i) { la[i] = LOGA[(row0 + i0 + i) * 512 + tid]; uu[i] = U[(row0 + i0 + i) * 512 + tid]; }
#pragma unroll
            for (int i = 0; i < 16; ++i) { const float l0 = bflo(la[i]), l1 = bfhi(la[i]); sl0 += l0; sl1 += l1; h0 = __expf(l0) * h0 + bflo(uu[i]); h1 = __expf(l1) * h1 + bfhi(uu[i]); }
        }
        f32x4 o = {sl0, h0, sl1, h1};
        *(f32x4*)(AGG + ((size_t)tile * 1024 + 2 * tid) * 2) = o;
    }
}

template <int CTRL, int RMASK> __device__ __forceinline__ float dppf(float old, float src) {
    return __builtin_bit_cast(float, __builtin_amdgcn_update_dpp(__builtin_bit_cast(int, old), __builtin_bit_cast(int, src), CTRL, RMASK, 0xf, false));
}
__device__ __forceinline__ float readlane_f(float v, int l) { return __builtin_bit_cast(float, __builtin_amdgcn_readlane(__builtin_bit_cast(int, v), l)); }
namespace ml {
constexpr int QP = 264, SP = 72;
constexpr int O_QS = 0, O_KS = 33792, O_SS = 67584, O_VT = 76800, O_VW = 81408, O_CS = 86016, O_OSM = 102912, O_TAB = 111360, O_WTS = 113920, O_END = 126208;
}
__device__ __forceinline__ void p6_mlstm(const Args& a, unsigned char* lds) {
    using namespace ml;
    unsigned char* ws = a.ws;
    const int tid = opaque_tid(), lane = tid & 63, w = __builtin_amdgcn_readfirstlane(tid >> 6), fr = lane & 15, fq = lane >> 4;
    bf16_t* Qs = (bf16_t*)(lds + O_QS); bf16_t* Ks = (bf16_t*)(lds + O_KS); bf16_t* Ss = (bf16_t*)(lds + O_SS);
    bf16_t* Vt = (bf16_t*)(lds + O_VT); bf16_t* Vw = (bf16_t*)(lds + O_VW); bf16_t* Cs = (bf16_t*)(lds + O_CS);
    float* Osm = (float*)(lds + O_OSM); float* TAB = (float*)(lds + O_TAB); float* WTS = (float*)(lds + O_WTS);
    const bf16_t* XC = (const bf16_t*)(ws + WS_XC); const bf16_t* XM = (const bf16_t*)(ws + WS_XM); const float* GATES = (const float*)(ws + WS_GATES);
    bf16_t* HM = (bf16_t*)(ws + WS_XB);
    for (int unit = blockIdx.x; unit < 256; unit += gridDim.x) {
        const int xcd = unit & 7, idx = unit >> 3, bh = xcd * 2 + (idx >> 4), vs = idx & 15, b = bh >> 2, h = bh & 3;
        __syncthreads();
        for (int e = tid; e < 64 * SP / 2; e += 512) ((unsigned*)Ss)[e] = 0u;
        for (int e = tid; e < 32 * SP / 2; e += 512) { const int row = e / (SP / 2); ((unsigned*)Vt)[e] = (row == 16) ? 0x3F803F80u : 0u; ((unsigned*)Vw)[e] = 0u; }
        for (int e = tid; e < 32 * QP / 2; e += 512) ((unsigned*)Cs)[e] = 0u;
        for (int e = tid; e < 1024; e += 512) { const int g = e >> 4, bb = (e >> 2) & 3, aa = e & 3; const float* wq = a.in[I_WQ] + (h * 64 + g) * 16; const float* wk = a.in[I_WK] + (h * 64 + g) * 16;
            float v = 0.f; for (int o = 0; o < 4; ++o) v += wq[bb * 4 + o] * wk[aa * 4 + o]; WTS[e] = v * 0.0625f; }
        for (int e = tid; e < 1024; e += 512) WTS[2048 + e] = a.in[I_WV][h * 1024 + e];
        f32x4 Cacc[2][2];
#pragma unroll
        for (int i = 0; i < 2; ++i)
#pragma unroll
            for (int j = 0; j < 2; ++j) Cacc[i][j] = (f32x4){0.f, 0.f, 0.f, 0.f};
        const int srow = tid >> 5, scol = (tid & 31) * 8;
        const int vrow = tid >> 1, vhalf = tid & 1;
        const size_t tbase = (size_t)b * SEQ;
        u32x4 xr[4], xmr = (u32x4){0u, 0u, 0u, 0u}; float gi, gf;
        {
            const size_t t0 = tbase;
#pragma unroll
            for (int i = 0; i < 4; ++i) xr[i] = *(const u32x4*)(XC + (t0 + srow + 16 * i) * D + h * 256 + scol);
            if (tid < 128) xmr = *(const u32x4*)(XM + (t0 + vrow) * D + h * 256 + vs * 16 + vhalf * 8);
            gi = GATES[(t0 + lane) * 8 + h]; gf = GATES[(t0 + lane) * 8 + 4 + h];
        }
        __syncthreads();
        float vreg[8], decay = 0.f, m_cur = -1e30f;
#pragma unroll
        for (int e = 0; e < 8; ++e) vreg[e] = 0.f;
        constexpr int NC = SEQ / 64;
        for (int c = -1; c < NC; ++c) {
            float* tab = TAB + (c & 1) * 320;
            if (c >= 0) {
            __syncthreads();
            {
#define S_DECODE(li, it, jt) do { if ((li) < 4) { it = 3; jt = (li); } else if ((li) < 7) { it = 2; jt = (li) - 4; } else if ((li) < 9) { it = 1; jt = (li) - 7; } else { it = 0; jt = 0; } } while (0)
#define S_EPI(it, jt, sv) do { const int i_ = (it) * 16 + fr, j0_ = (jt) * 16 + fq * 4; const float rf_ = tab[i_]; float o_[4]; \
        _Pragma("unroll") for (int e = 0; e < 4; ++e) { const int j_ = j0_ + e; o_[e] = (j_ <= i_) ? sv[e] * __expf(rf_ + tab[64 + j_]) : 0.f; } \
        u32x2 wv_; wv_.x = pk2(o_[0], o_[1]); wv_.y = pk2(o_[2], o_[3]); *(u32x2*)(Ss + i_ * SP + j0_) = wv_; } while (0)
                {
                    int it0, jt0, it1 = 0, jt1 = 0; S_DECODE(w, it0, jt0);
                    const bool two = (w < 2); if (two) S_DECODE(w + 8, it1, jt1);
                    f32x4 sA = (f32x4){0.f, 0.f, 0.f, 0.f}, sB = sA, tA = sA, tB = sA;
                    const bf16_t* k0p = Ks + (jt0 * 16 + fr) * QP + fq * 8; const bf16_t* q0p = Qs + (it0 * 16 + fr) * QP + fq * 8;
                    const bf16_t* k1p = Ks + (jt1 * 16 + fr) * QP + fq * 8; const bf16_t* q1p = Qs + (it1 * 16 + fr) * QP + fq * 8;
#pragma unroll
                    for (int ks = 0; ks < 8; ks += 2) {
                        sA = __builtin_amdgcn_mfma_f32_16x16x32_bf16(*(const bf16x8*)(k0p + ks * 32), *(const bf16x8*)(q0p + ks * 32), sA, 0, 0, 0);
                        sB = __builtin_amdgcn_mfma_f32_16x16x32_bf16(*(const bf16x8*)(k0p + ks * 32 + 32), *(const bf16x8*)(q0p + ks * 32 + 32), sB, 0, 0, 0);
                        if (two) {
                            tA = __builtin_amdgcn_mfma_f32_16x16x32_bf16(*(const bf16x8*)(k1p + ks * 32), *(const bf16x8*)(q1p + ks * 32), tA, 0, 0, 0);
                            tB = __builtin_amdgcn_mfma_f32_16x16x32_bf16(*(const bf16x8*)(k1p + ks * 32 + 32), *(const bf16x8*)(q1p + ks * 32 + 32), tB, 0, 0, 0);
                        }
                    }
                    const f32x4 s0 = sA + sB; S_EPI(it0, jt0, s0);
                    if (two) { const f32x4 s1 = tA + tB; S_EPI(it1, jt1, s1); }
                }
#undef S_DECODE
#undef S_EPI
                if (tid < 128) {
                    const float wk = tab[256 + vrow];
#pragma unroll
                    for (int e = 0; e < 8; ++e) Vw[(vhalf * 8 + e) * SP + vrow] = (bf16_t)(pk2(vreg[e] * wk, 0.f) & 0xffffu);
                } else if (tid < 192) { Vw[16 * SP + (tid - 128)] = (bf16_t)(pk2(tab[256 + tid - 128], 0.f) & 0xffffu); }
            }
            __syncthreads();
            {
                const int rt = w & 3, vt = w >> 2;
                f32x4 a1 = (f32x4){0.f, 0.f, 0.f, 0.f}, a2 = (f32x4){0.f, 0.f, 0.f, 0.f};
#pragma unroll
                for (int ks = 0; ks < 2; ++ks) {
                    const bf16x8 sa_ = *(const bf16x8*)(Ss + (rt * 16 + fr) * SP + ks * 32 + fq * 8);
                    const bf16x8 vb = *(const bf16x8*)(Vt + (vt * 16 + fr) * SP + ks * 32 + fq * 8);
                    a1 = __builtin_amdgcn_mfma_f32_16x16x32_bf16(sa_, vb, a1, 0, 0, 0);
                }
#pragma unroll
                for (int ks = 0; ks < 8; ++ks) {
                    const bf16x8 qa = *(const bf16x8*)(Qs + (rt * 16 + fr) * QP + ks * 32 + fq * 8);
                    const bf16x8 cb = *(const bf16x8*)(Cs + (vt * 16 + fr) * QP + ks * 32 + fq * 8);
                    a2 = __builtin_amdgcn_mfma_f32_16x16x32_bf16(qa, cb, a2, 0, 0, 0);
                }
#pragma unroll
                for (int e = 0; e < 4; ++e) { const int i = rt * 16 + fq * 4 + e; Osm[i * 33 + vt * 16 + fr] = a1[e] + tab[128 + i] * a2[e]; }
            }
            {
#pragma unroll
                for (int kl = 0; kl < 2; ++kl)
#pragma unroll
                    for (int vt = 0; vt < 2; ++vt) Cacc[kl][vt] = Cacc[kl][vt] * decay;
#pragma unroll
                for (int kl = 0; kl < 2; ++kl) {
                    const int kcol = (2 * w + kl) * 16 + fr;
#pragma unroll
                    for (int ks = 0; ks < 2; ++ks) {
                        bf16x8 ka;
#pragma unroll
                        for (int e = 0; e < 8; ++e) ka[e] = (short)Ks[(ks * 32 + fq * 8 + e) * QP + kcol];
#pragma unroll
                        for (int vt = 0; vt < 2; ++vt) {
                            const bf16x8 vb = *(const bf16x8*)(Vw + (vt * 16 + fr) * SP + ks * 32 + fq * 8);
                            Cacc[kl][vt] = __builtin_amdgcn_mfma_f32_16x16x32_bf16(ka, vb, Cacc[kl][vt], 0, 0, 0);
                        }
                    }
                }
            }
            }
            u32x4 qpk[4]; float vnx[8], decay_n = 0.f, m_nx = m_cur;
            if (c + 1 < NC) {
                const int lg0 = (tid & 31) * 2;
                f32x4 Wq[2][4];
#pragma unroll
                for (int g2 = 0; g2 < 2; ++g2)
#pragma unroll
                    for (int i = 0; i < 4; ++i) Wq[g2][i] = *(const f32x4*)(WTS + (lg0 + g2) * 16 + i * 4);
#pragma unroll
                for (int i = 0; i < 4; ++i) {
                    float x[8]; unpack8(xr[i], x);
                    float q[8];
#pragma unroll
                    for (int g2 = 0; g2 < 2; ++g2) {
                        const f32x4 qq = Wq[g2][0] * x[4 * g2] + Wq[g2][1] * x[4 * g2 + 1] + Wq[g2][2] * x[4 * g2 + 2] + Wq[g2][3] * x[4 * g2 + 3];
                        for (int j = 0; j < 4; ++j) q[4 * g2 + j] = qq[j];
                    }
                    qpk[i] = pack8(q);
                }
                if (tid < 128) {
                    float x[8]; unpack8(xmr, x);
                    const int lgv = vs * 4 + vhalf * 2;
#pragma unroll
                    for (int g2 = 0; g2 < 2; ++g2) {
                        const float* Wv = WTS + 2048 + (lgv + g2) * 16;
#pragma unroll
                        for (int o = 0; o < 4; ++o) vnx[4 * g2 + o] = Wv[0 * 4 + o] * x[4 * g2] + Wv[1 * 4 + o] * x[4 * g2 + 1] + Wv[2 * 4 + o] * x[4 * g2 + 2] + Wv[3 * 4 + o] * x[4 * g2 + 3];
                    }
                }
                float sa = gf, sc = gi;
#define SCAN_STEP(CTRL, RM) do { const float ao = dppf<CTRL, RM>(0.f, sa), co = dppf<CTRL, RM>(-INFINITY, sc); sc = fmaxf(co + sa, sc); sa = ao + sa; } while (0)
                SCAN_STEP(0x111, 0xf); SCAN_STEP(0x112, 0xf); SCAN_STEP(0x114, 0xf); SCAN_STEP(0x118, 0xf);
                SCAN_STEP(0x142, 0xa);
                SCAN_STEP(0x143, 0xc);
#undef SCAN_STEP
                const float Mi = fmaxf(m_cur + sa, sc);
                const float gtot = readlane_f(sa, 63); m_nx = readlane_f(Mi, 63);
                decay_n = __expf(gtot + m_cur - m_nx);
                if (w == 0) {
                    float* tn = TAB + ((c + 1) & 1) * 320;
                    tn[lane] = sa - Mi; tn[64 + lane] = gi - sa; tn[128 + lane] = __expf(sa + m_cur - Mi); tn[192 + lane] = __expf(-Mi); tn[256 + lane] = __expf(gtot - sa + gi - m_nx);
                }
            }
            if (c >= 0) {
            __syncthreads();
            {
#pragma unroll
                for (int kl = 0; kl < 2; ++kl)
#pragma unroll
                    for (int vt = 0; vt < 2; ++vt) {
                        u32x2 wv; wv.x = pk2(Cacc[kl][vt][0], Cacc[kl][vt][1]); wv.y = pk2(Cacc[kl][vt][2], Cacc[kl][vt][3]);
                        *(u32x2*)(Cs + (vt * 16 + fr) * QP + (2 * w + kl) * 16 + fq * 4) = wv;
                    }
                const int i = tid >> 3, vp = (tid & 7) * 2;
                const float den = Osm[i * 33 + 16], dn = fmaxf(fabsf(den), tab[192 + i]);
                const float rdn = __builtin_amdgcn_rcpf(dn); const float h0 = Osm[i * 33 + vp] * rdn, h1 = Osm[i * 33 + vp + 1] * rdn;
                *(unsigned*)(HM + ((size_t)(bh * 16 + vs) * SEQ + (size_t)c * 64 + i) * 16 + vp) = pk2(h0, h1);
            }
            }
            if (c + 1 < NC) {
#pragma unroll
                for (int i = 0; i < 4; ++i) { const int r = srow + 16 * i; *(u32x4*)(Qs + r * QP + scol) = qpk[i]; *(u32x4*)(Ks + r * QP + scol) = xr[i]; }
                if (tid < 128) {
#pragma unroll
                    for (int e = 0; e < 8; ++e) { Vt[(vhalf * 8 + e) * SP + vrow] = (bf16_t)(pk2(vnx[e], 0.f) & 0xffffu); vreg[e] = vnx[e]; }
                }
                decay = decay_n; m_cur = m_nx;
                if (c + 2 < NC) {
                    const size_t t2 = tbase + (size_t)(c + 2) * 64;
#pragma unroll
                    for (int i = 0; i < 4; ++i) xr[i] = *(const u32x4*)(XC + (t2 + srow + 16 * i) * D + h * 256 + scol);
                    if (tid < 128) xmr = *(const u32x4*)(XM + (t2 + vrow) * D + h * 256 + vs * 16 + vhalf * 8);
                    gi = GATES[(t2 + lane) * 8 + h]; gf = GATES[(t2 + lane) * 8 + 4 + h];
                }
            }
        }
    }
}

__device__ __forceinline__ void p6_mlstm_tok(const Args& a, unsigned char* lds) {
    using namespace ml;
    unsigned char* ws = a.ws;
    const int tid = opaque_tid(), lane = tid & 63, w = __builtin_amdgcn_readfirstlane(tid >> 6), fr = lane & 15, fq = lane >> 4;
    bf16_t* Qs = (bf16_t*)(lds + O_QS); bf16_t* Ks = (bf16_t*)(lds + O_KS); bf16_t* Ss = (bf16_t*)(lds + O_SS);
    bf16_t* Vt = (bf16_t*)(lds + O_VT); bf16_t* Vw = (bf16_t*)(lds + O_VW); bf16_t* Cs = (bf16_t*)(lds + O_CS);
    float* Osm = (float*)(lds + O_OSM); float* TAB = (float*)(lds + O_TAB); float* WTS = (float*)(lds + O_WTS);
    const bf16_t* XC = (const bf16_t*)(ws + WS_XC); const bf16_t* XM = (const bf16_t*)(ws + WS_XM); const float* GATES = (const float*)(ws + WS_GATES);
    bf16_t* HM = (bf16_t*)(ws + WS_XB);
    for (int unit = blockIdx.x; unit < 256; unit += gridDim.x) {
        const int xcd = unit & 7, idx = unit >> 3, bh = xcd * 2 + (idx >> 4), vs = idx & 15, b = bh >> 2, h = bh & 3;
        __syncthreads();
        for (int e = tid; e < 64 * SP / 2; e += 512) ((unsigned*)Ss)[e] = 0u;
        for (int e = tid; e < 32 * SP / 2; e += 512) { const int row = e / (SP / 2); ((unsigned*)Vt)[e] = (row == 16) ? 0x3F803F80u : 0u; ((unsigned*)Vw)[e] = 0u; }
        for (int e = tid; e < 32 * QP / 2; e += 512) ((unsigned*)Cs)[e] = 0u;
        for (int e = tid; e < 3 * 64 * 16; e += 512) { const int m = e / 1024, r = e % 1024; const float* src = (m == 0) ? a.in[I_WQ] : (m == 1 ? a.in[I_WK] : a.in[I_WV]); WTS[e] = src[h * 1024 + r] * (m == 1 ? 0.0625f : 1.0f); }
        f32x4 Cacc[2][2];
#pragma unroll
        for (int i = 0; i < 2; ++i)
#pragma unroll
            for (int j = 0; j < 2; ++j) Cacc[i][j] = (f32x4){0.f, 0.f, 0.f, 0.f};
        float m_prev = -1e30f;
        float Ct[8], Nt[8];
#pragma unroll
        for (int j = 0; j < 8; ++j) { Ct[j] = 0.f; Nt[j] = 0.f; }
        const int srow = tid >> 5, scol = (tid & 31) * 8;
        const int vrow = tid >> 1, vhalf = tid & 1;
        const size_t tbase = (size_t)b * SEQ;
        u32x4 xr[4], xmr = (u32x4){0u, 0u, 0u, 0u}; float gi, gf;
        {
            const size_t t0 = tbase;
#pragma unroll
            for (int i = 0; i < 4; ++i) xr[i] = *(const u32x4*)(XC + (t0 + srow + 16 * i) * D + h * 256 + scol);
            if (tid < 128) xmr = *(const u32x4*)(XM + (t0 + vrow) * D + h * 256 + vs * 16 + vhalf * 8);
            gi = GATES[(t0 + lane) * 8 + h]; gf = GATES[(t0 + lane) * 8 + 4 + h];
        }
        __syncthreads();
        for (int c = 0; c < SEQ / 64; ++c) {
            const size_t t0 = tbase + (size_t)c * 64;
            float* tab = TAB;
            float vreg[8];
            {
                const int lg0 = (tid & 31) * 2;
                f32x4 Wq[2][4], Wk[2][4];
#pragma unroll
                for (int g2 = 0; g2 < 2; ++g2)
#pragma unroll
                    for (int i = 0; i < 4; ++i) { Wq[g2][i] = *(const f32x4*)(WTS + (lg0 + g2) * 16 + i * 4); Wk[g2][i] = *(const f32x4*)(WTS + 1024 + (lg0 + g2) * 16 + i * 4); }
#pragma unroll
                for (int i = 0; i < 4; ++i) {
                    float x[8]; unpack8(xr[i], x);
                    float q[8], k[8];
#pragma unroll
                    for (int g2 = 0; g2 < 2; ++g2) {
                        const f32x4 qq = Wq[g2][0] * x[4 * g2] + Wq[g2][1] * x[4 * g2 + 1] + Wq[g2][2] * x[4 * g2 + 2] + Wq[g2][3] * x[4 * g2 + 3];
                        const f32x4 kk = Wk[g2][0] * x[4 * g2] + Wk[g2][1] * x[4 * g2 + 1] + Wk[g2][2] * x[4 * g2 + 2] + Wk[g2][3] * x[4 * g2 + 3];
                        for (int j = 0; j < 4; ++j) { q[4 * g2 + j] = qq[j]; k[4 * g2 + j] = kk[j]; }
                    }
                    const int r = srow + 16 * i;
                    *(u32x4*)(Qs + r * QP + scol) = pack8(q); *(u32x4*)(Ks + r * QP + scol) = pack8(k);
                }
                if (tid < 128) {
                    float x[8]; unpack8(xmr, x);
                    const int lgv = vs * 4 + vhalf * 2;
#pragma unroll
                    for (int g2 = 0; g2 < 2; ++g2) {
                        const float* Wv = WTS + 2048 + (lgv + g2) * 16;
#pragma unroll
                        for (int o = 0; o < 4; ++o) vreg[4 * g2 + o] = Wv[0 * 4 + o] * x[4 * g2] + Wv[1 * 4 + o] * x[4 * g2 + 1] + Wv[2 * 4 + o] * x[4 * g2 + 2] + Wv[3 * 4 + o] * x[4 * g2 + 3];
                    }
#pragma unroll
                    for (int e = 0; e < 8; ++e) Vt[(vhalf * 8 + e) * SP + vrow] = (bf16_t)(pk2(vreg[e], 0.f) & 0xffffu);
                }
            }
            float sa = gf, sc = gi;
#pragma unroll
            for (int d = 1; d < 64; d <<= 1) { const float ao = __shfl_up(sa, d), co = __shfl_up(sc, d); if (lane >= d) { sc = fmaxf(co + sa, sc); sa = ao + sa; } }
            const float Mi = fmaxf(m_prev + sa, sc);
            const float gtot = __shfl(sa, 63), m_new = __shfl(Mi, 63);
            const float decay = __expf(gtot + m_prev - m_new);
            {
                float Mp = __shfl_up(Mi, 1); if (lane == 0) Mp = m_prev;
                if (w == 0) { tab[lane] = __expf(gf + Mp - Mi); tab[64 + lane] = __expf(gi - Mi); tab[128 + lane] = __expf(-Mi); }
            }
            if (c + 1 < SEQ / 64) {
                const size_t t1 = t0 + 64;
#pragma unroll
                for (int i = 0; i < 4; ++i) xr[i] = *(const u32x4*)(XC + (t1 + srow + 16 * i) * D + h * 256 + scol);
                if (tid < 128) xmr = *(const u32x4*)(XM + (t1 + vrow) * D + h * 256 + vs * 16 + vhalf * 8);
                gi = GATES[(t1 + lane) * 8 + h]; gf = GATES[(t1 + lane) * 8 + 4 + h];
            }
            __syncthreads();
            {
                const int v = tid >> 5, kq = tid & 31, k0 = kq * 8;
                for (int tb = 0; tb < 64; tb += 8) {
                    float acc[8], dp[8];
#pragma unroll
                    for (int u = 0; u < 8; ++u) {
                        const int t = tb + u;
                        const float f = tab[t], ii = tab[64 + t];
                        const float vv = bf1(Vt[v * SP + t]) * ii;
                        float k8[8], q8[8];
                        unpack8(*(const u32x4*)(Ks + t * QP + k0), k8); unpack8(*(const u32x4*)(Qs + t * QP + k0), q8);
                        float a_ = 0.f, d_ = 0.f;
#pragma unroll
                        for (int j = 0; j < 8; ++j) { Ct[j] = f * Ct[j] + vv * k8[j]; a_ += Ct[j] * q8[j]; Nt[j] = f * Nt[j] + ii * k8[j]; d_ += Nt[j] * q8[j]; }
                        acc[u] = a_; dp[u] = d_;
                    }
#pragma unroll
                    for (int o = 1; o < 32; o <<= 1) {
#pragma unroll
                        for (int u = 0; u < 8; ++u) { acc[u] += __shfl_xor(acc[u], o); dp[u] += __shfl_xor(dp[u], o); }
                    }
                    float hv = 0.f;
#pragma unroll
                    for (int u = 0; u < 8; ++u) { const float h_ = acc[u] / fmaxf(fabsf(dp[u]), tab[128 + tb + u]); if (kq == u) hv = h_; }
                    if (kq < 8) HM[((size_t)(bh * 16 + vs) * SEQ + (size_t)c * 64 + tb + kq) * 16 + v] = (bf16_t)(pk2(hv, 0.f) & 0xffffu);
                }
            }
            __syncthreads();
            m_prev = m_new;
            __syncthreads();
        }
    }
}

__device__ __forceinline__ void p7_mlstm_fin(const Args& a) {
    unsigned char* ws = a.ws; const int tid = opaque_tid(), lane = tid & 63, wave = tid >> 6;
    const int gw = blockIdx.x * 8 + wave, NGW = gridDim.x * 8;
    const bf16_t* HM = (const bf16_t*)(ws + WS_XB); const bf16_t* XC = (const bf16_t*)(ws + WS_XC); bf16_t* ZM = (bf16_t*)(ws + WS_ZM);
    float lnw[16], skp[16];
#pragma unroll
    for (int j = 0; j < 4; ++j) { const f32x4 p = *(const f32x4*)(a.in[I_LNW] + lane * 16 + 4 * j), q = *(const f32x4*)(a.in[I_SKIP] + lane * 16 + 4 * j); for (int e = 0; e < 4; ++e) { lnw[4 * j + e] = p[e]; skp[4 * j + e] = q[e]; } }
    for (int m = gw; m < T; m += NGW) {
        const size_t off = (size_t)m * D + lane * 16;
        float hv[16], xc[16], z[16];
        { const size_t hoff = ((size_t)(((m / SEQ) * 4 + (lane >> 4)) * 16 + (lane & 15)) * SEQ + (size_t)(m % SEQ)) * 16;
          unpack8(*(const u32x4*)(HM + hoff), hv); unpack8(*(const u32x4*)(HM + hoff + 8), hv + 8); }
        unpack8(*(const u32x4*)(XC + off), xc); unpack8(*(const u32x4*)(XC + off + 8), xc + 8);
        unpack8(*(const u32x4*)(ZM + off), z); unpack8(*(const u32x4*)(ZM + off + 8), z + 8);
        float s = 0.f;
#pragma unroll
        for (int e = 0; e < 16; ++e) s += hv[e];
        s += __shfl_xor(s, 1); s += __shfl_xor(s, 2); s += __shfl_xor(s, 4); s += __shfl_xor(s, 8);
        const float mu = s * (1.0f / 256.0f); float q = 0.f;
#pragma unroll
        for (int e = 0; e < 16; ++e) { hv[e] -= mu; q += hv[e] * hv[e]; }
        q += __shfl_xor(q, 1); q += __shfl_xor(q, 2); q += __shfl_xor(q, 4); q += __shfl_xor(q, 8);
        const float rstd = rsqrtf(q * (1.0f / 256.0f) + EPS);
        float o[16], ss = 0.f;
#pragma unroll
        for (int e = 0; e < 16; ++e) { o[e] = (hv[e] * rstd * lnw[e] + skp[e] * xc[e]) * siluf_(z[e]); ss += o[e] * o[e]; }
        ss = wave_sum(ss);
        const float rs = rsqrtf(ss * (1.0f / 1024.0f) + EPS);
#pragma unroll
        for (int e = 0; e < 16; ++e) o[e] *= rs;
        *(u32x4*)(ZM + off) = pack8(o); *(u32x4*)(ZM + off + 8) = pack8(o + 8);
    }
}
__device__ __forceinline__ void p7_rg_fin(const Args& a, unsigned char* lds) {
    unsigned char* ws = a.ws; const int tid = opaque_tid();
    unsigned* LOGA = (unsigned*)(ws + WS_XR); const unsigned* U = (const unsigned*)(ws + WS_U); const unsigned* YR = (const unsigned*)(ws + WS_YR); const float* AGG = (const float*)(ws + WS_AGG);
    float* Ot = (float*)lds;
    constexpr int OP = 1028;
    for (int tile = blockIdx.x; tile < 256; tile += gridDim.x) {
        const int tc = tile & 63, tb = tile & ~63;
        float h0 = 0.f, h1 = 0.f;
        for (int p = 0; p < tc; ++p) { const f32x4 g = *(const f32x4*)(AGG + ((size_t)(tb + p) * 1024 + 2 * tid) * 2); h0 = __expf(g[0]) * h0 + g[1]; h1 = __expf(g[2]) * h1 + g[3]; }
        const size_t row0 = (size_t)tile * 128;
        for (int i0 = 0; i0 < 128; i0 += 16) {
            unsigned la[16], uu[16], yy[16];
#pragma unroll
            for (int i = 0; i < 16; ++i) { const size_t o = (row0 + i0 + i) * 512 + tid; la[i] = LOGA[o]; uu[i] = U[o]; yy[i] = YR[o]; }
            __syncthreads();
#pragma unroll
            for (int i = 0; i < 16; ++i) {
                h0 = __expf(bflo(la[i])) * h0 + bflo(uu[i]); h1 = __expf(bfhi(la[i])) * h1 + bfhi(uu[i]);
                Ot[i * OP + 2 * tid] = h0 * geluf_(bflo(yy[i])); Ot[i * OP + 2 * tid + 1] = h1 * geluf_(bfhi(yy[i]));
            }
            __syncthreads();
            {
                const int row = tid >> 5, sub = tid & 31;
                f32x4 v[4][2]; float ss = 0.f;
#pragma unroll
                for (int q = 0; q < 4; ++q)
#pragma unroll
                    for (int hh = 0; hh < 2; ++hh) { v[q][hh] = *(const f32x4*)(Ot + row * OP + q * 256 + sub * 8 + hh * 4); const f32x4 t = v[q][hh]; ss += (t[0] * t[0] + t[1] * t[1]) + (t[2] * t[2] + t[3] * t[3]); }
                ss += __shfl_xor(ss, 1); ss += __shfl_xor(ss, 2); ss += __shfl_xor(ss, 4); ss += __shfl_xor(ss, 8); ss += __shfl_xor(ss, 16);
                const float rs = rsqrtf(ss * (1.0f / 1024.0f) + EPS);
                bf16_t* orow = (bf16_t*)LOGA + (row0 + i0 + row) * D;
#pragma unroll
                for (int q = 0; q < 4; ++q) { const f32x4 p = v[q][0] * rs, r = v[q][1] * rs; u32x4 wv; wv.x = pk2(p[0], p[1]); wv.y = pk2(p[2], p[3]); wv.z = pk2(r[0], r[1]); wv.w = pk2(r[2], r[3]); *(u32x4*)(orow + q * 256 + sub * 8) = wv; }
            }
        }
        __syncthreads();
    }
}

__device__ __forceinline__ void p11_final(const Args& a) {
    const int tid = opaque_tid(), lane = tid & 63, wave = tid >> 6;
    const int gw = blockIdx.x * 8 + wave, NGW = gridDim.x * 8;
    const float* SS = (const float*)(a.ws + WS_SSD); const float* gn = a.in[I_NFIN];
    f32x4 g[4];
#pragma unroll
    for (int j = 0; j < 4; ++j) g[j] = *((const f32x4*)gn + lane + 64 * j);
    for (int m = gw; m < T; m += NGW) {
        const float rs = pg8::row_scale(SS, m);
        f32x4* xr = (f32x4*)(a.out + (size_t)m * D) + lane;
#pragma unroll
        for (int j = 0; j < 4; ++j) { f32x4 v = xr[64 * j]; v = v * rs * g[j]; xr[64 * j] = v; }
    }
}


#define XB_TMO      128
#define XB_XCNT(j)  (256  + 64 * (j))
#define XB_XSUB(j)  (1280 + 64 * (j))
#define XB_XGEN(j)  (2304 + 64 * (j))
#define XB_TOP      3328
#define XB_TOPGEN   3392
#define XCD_BAR_WORDS 3456
#define XB_SPIN_CAP (1u << 18)
__device__ __forceinline__ unsigned xb_ld(unsigned* p)              { return __hip_atomic_load(p, __ATOMIC_RELAXED, __HIP_MEMORY_SCOPE_AGENT); }
__device__ __forceinline__ unsigned xb_add(unsigned* p, unsigned v) { return __hip_atomic_fetch_add(p, v, __ATOMIC_RELAXED, __HIP_MEMORY_SCOPE_AGENT); }
__device__ __forceinline__ unsigned xb_xcc_id() { return (unsigned)__builtin_amdgcn_s_getreg((3 << 11) | 20) & 0xFu; }
#define XB_SPIN(cond, bar) do { unsigned _sp = 0; while (cond) { __builtin_amdgcn_s_sleep(1); \
    if ((++_sp & 255u) == 0u) { if (xb_ld(&(bar)[XB_TMO])) break; if (_sp > XB_SPIN_CAP) { atomicAdd(&(bar)[XB_TMO], 1u); break; } } } } while (0)
struct XcdBarrier { unsigned* bar; unsigned x; volatile LAS unsigned* st; };
__device__ __forceinline__ XcdBarrier xcd_barrier_post(unsigned* bar, volatile LAS unsigned* st) {
    XcdBarrier b; b.bar = bar; b.x = xb_xcc_id(); b.st = st;
    if (threadIdx.x == 0) (void)xb_add(&bar[XB_XCNT(b.x)], 1u);
    return b;
}
__device__ __forceinline__ void xcd_barrier_complete(unsigned* bar, unsigned x, unsigned& nloc, unsigned& nx) {
    const unsigned G = gridDim.x * gridDim.y * gridDim.z;
    unsigned sum, cnt, mine, sp = 0u;
    for (;;) {
        sum = 0u; cnt = 0u; mine = 0u;
#pragma unroll
        for (unsigned j = 0; j < 16; ++j) { const unsigned c = xb_ld(&bar[XB_XCNT(j)]); sum += c; cnt += (c > 0u) ? 1u : 0u; mine = (j == x) ? c : mine; }
        if (sum == G) break;
        __builtin_amdgcn_s_sleep(1);
        if ((++sp & 255u) == 0u) { if (xb_ld(&bar[XB_TMO])) break; if (sp > XB_SPIN_CAP) { atomicAdd(&bar[XB_TMO], 1u); break; } }
    }
    nloc = mine > 0u ? mine : 1u; nx = cnt > 0u ? cnt : 1u;
}
__device__ __forceinline__ void xcd_barrier(const XcdBarrier& b) {
    asm volatile("s_waitcnt vmcnt(0)" ::: "memory");
    __syncthreads();
    if (threadIdx.x == 0) {
        unsigned* bar = b.bar;
        __builtin_amdgcn_s_waitcnt(0);
        unsigned nloc = b.st[0], nx = b.st[1];
        if (nloc == 0u) { xcd_barrier_complete(bar, b.x, nloc, nx); b.st[0] = nloc; b.st[1] = nx; }
        const unsigned old = xb_add(&bar[XB_XSUB(b.x)], 1u);
        const unsigned gen = old / nloc;
        if (old + 1u == (gen + 1u) * nloc) {
            __builtin_amdgcn_fence(__ATOMIC_RELEASE, "agent");
            asm volatile("s_waitcnt vmcnt(0)" ::: "memory");
            const unsigned og = xb_add(&bar[XB_TOP], 1u);
            const unsigned tg = og / nx;
            if (og + 1u == (tg + 1u) * nx) xb_add(&bar[XB_TOPGEN], 1u);
            else XB_SPIN(xb_ld(&bar[XB_TOPGEN]) == tg, bar);
            __builtin_amdgcn_fence(__ATOMIC_ACQUIRE, "agent");
            xb_add(&bar[XB_XGEN(b.x)], 1u);
            asm volatile("s_waitcnt vmcnt(0)" ::: "memory");
        } else {
            XB_SPIN(xb_ld(&bar[XB_XGEN(b.x)]) == gen, bar);
            __builtin_amdgcn_fence(__ATOMIC_ACQUIRE, "agent");
            asm volatile("s_waitcnt vmcnt(0)" ::: "memory");
        }
    }
    __syncthreads();
}
#define GSYNC() xcd_barrier(xbar)
__global__ void __launch_bounds__(512, 2) mk_fwd(Args args) {
    extern __shared__ __attribute__((aligned(16))) unsigned char lds_raw[];
    cg::grid_group grid = cg::this_grid();
    LAS unsigned char* lds = (LAS unsigned char*)lds_raw;
    unsigned char* ws = args.ws;
    const int G = gridDim.x, bid = blockIdx.x;
    volatile LAS unsigned* xst = (volatile LAS unsigned*)(lds + (LDS_BYTES - 64));
    if (threadIdx.x == 0) { xst[0] = 0u; xst[1] = 0u; }
    __syncthreads();
    const XcdBarrier xbar = xcd_barrier_post((unsigned*)(ws + WS_BAR), xst);
    bf16_t* XB = (bf16_t*)(ws + WS_XB); bf16_t* ACT = (bf16_t*)(ws + WS_R1);
#ifndef NO_P0
    p0_prologue(args, lds_raw);
#endif
    asm volatile("s_waitcnt vmcnt(0)" ::: "memory"); __threadfence(); grid.sync();
#ifndef NO_P1
    { const pg8::Gemm gUp1{XB, (const bf16_t*)(ws + WS_WGU1), 1024, 1024, 1 << 30, 0, 0, 0}; pg8::StaticOrder S; S.init(T, 2 * FF, G, bid); pg8::EpiSwiGLU E{ACT, (const float*)(ws + WS_SSA)}; pg8::gemm_phase(lds, gUp1, S, E); }
#endif
    GSYNC();
#ifndef NO_P2
    { const pg8::Gemm gDn1{ACT, (const bf16_t*)(ws + WS_WD1), FF, FF, 1 << 30, 0, 0, 0}; pg8::StaticOrder S; S.init(T, D, G, bid); pg8::EpiResid E{args.in[I_X], args.out, XB, (float*)(ws + WS_SSB), 0.5f}; pg8::gemm_phase(lds, gDn1, S, E); }
#endif
    GSYNC();
#ifndef NO_P3
    { const pg8::Gemm gIn{XB, (const bf16_t*)(ws + WS_WIN), 1024, 1024, 1 << 30, 0, 0, 0}; pg8::StaticOrder S; S.init(T, 4096, G, bid); pg8::EpiProj E{(bf16_t*)(ws + WS_XM), (const float*)(ws + WS_SSB)}; pg8::gemm_phase(lds, gIn, S, E); }
#endif
    GSYNC();
#ifndef NO_P4
    p4_conv(args);
#endif
    GSYNC();
#ifndef NO_P5
    {
        const pg8::Gemm gRg{XB  , (const bf16_t*)(ws + WS_WRG), 256, 1024, 1 << 30, 0, 1, 512};
        const pg8::Gemm gGt{(const bf16_t*)(ws + WS_XC), (const bf16_t*)(ws + WS_WG8), 2048, 1024, 16, (long)WS_XM - (long)WS_XC - 16 * 128, 0, 0};
        pg8::EpiGates Eg{(float*)(ws + WS_GATES), args.in[I_BGATES]};
        pg8::EpiRg Er{XB, args.in[I_RBA], args.in[I_RBX], (const float*)(ws + WS_C8), (bf16_t*)(ws + WS_XR), (bf16_t*)(ws + WS_U)};
        if (G == 256) {
#ifndef NO_P5G
            if (bid < 128) { pg8::ListOrder S{bid, 1, 0}; pg8::gemm_phase(lds, gGt, S, Eg); }
#endif
#ifndef NO_P5R
            if (bid >= 128) { pg8::ListOrder S{(bid - 128) * 8, 8, 3}; pg8::gemm_phase(lds, gRg, S, Er); }
#endif
        } else {
#ifndef NO_P5G
            for (int u = bid; u < 128; u += G) { pg8::ListOrder S{u, 1, 0}; pg8::gemm_phase(lds, gGt, S, Eg); }
#endif
#ifndef NO_P5R
            for (int u = bid; u < 128; u += G) { pg8::ListOrder S{u * 8, 8, 3}; pg8::gemm_phase(lds, gRg, S, Er); }
#endif
        }
    }
#endif
    GSYNC();
#ifndef NO_P6A
    p6_rg_agg(args);
#endif
#ifndef NO_P6
    p6_mlstm(args, lds_raw);
#endif
    GSYNC();
#ifndef NO_P7A
    p7_mlstm_fin(args);
#endif
#ifndef NO_P7B
    p7_rg_fin(args, lds_raw);
#endif
    GSYNC();
#ifndef NO_P8
    { const pg8::Gemm gOut{(const bf16_t*)(ws + WS_ZM)  , (const bf16_t*)(ws + WS_WOUT), 2048, 1024, 16, (long)(64 * MiB) - 16 * 128, 0, 0}; pg8::StaticOrder S; S.init(T, D, G, bid); pg8::EpiResid E{args.out, args.out, XB, (float*)(ws + WS_SSC), 1.0f}; pg8::gemm_phase(lds, gOut, S, E); }
#endif
    GSYNC();
#ifndef NO_P9
    { const pg8::Gemm gUp2{XB, (const bf16_t*)(ws + WS_WGU2), 1024, 1024, 1 << 30, 0, 0, 0}; pg8::StaticOrder S; S.init(T, 2 * FF, G, bid); pg8::EpiSwiGLU E{ACT, (const float*)(ws + WS_SSC)}; pg8::gemm_phase(lds, gUp2, S, E); }
#endif
    GSYNC();
#ifndef NO_P10
    { const pg8::Gemm gDn2{ACT, (const bf16_t*)(ws + WS_WD2), FF, FF, 1 << 30, 0, 0, 0}; pg8::StaticOrder S; S.init(T, D, G, bid); pg8::EpiResid E{args.out, args.out, nullptr, (float*)(ws + WS_SSD), 0.5f}; pg8::gemm_phase(lds, gDn2, S, E); }
#endif
    GSYNC();
#ifndef NO_P11
    p11_final(args);
#endif
}

extern "C" void kernel_launch(void* const* d_in, const int* in_sizes, int n_in, void* d_out, int out_size, void* d_ws, size_t ws_size, hipStream_t stream) {
    static int grid = 0;
    if (grid == 0) {
        if (n_in != 31 || in_sizes[0] != T * D || out_size != T * D || ws_size < WS_END) { fprintf(stderr, "kernel_launch: unexpected shapes (n_in %d, in0 %d, out %d, ws %zu)\n", n_in, n_in > 0 ? in_sizes[0] : -1, out_size, ws_size); grid = -1; return; }
        int dev = 0, cus = 0, per_cu = 0;
        if (hipGetDevice(&dev) != hipSuccess || hipDeviceGetAttribute(&cus, hipDeviceAttributeMultiprocessorCount, dev) != hipSuccess) { grid = -1; return; }
        if (hipFuncSetAttribute((const void*)mk_fwd, hipFuncAttributeMaxDynamicSharedMemorySize, LDS_BYTES) != hipSuccess) { fprintf(stderr, "kernel_launch: hipFuncSetAttribute failed\n"); grid = -1; return; }
        if (hipOccupancyMaxActiveBlocksPerMultiprocessor(&per_cu, (const void*)mk_fwd, 512, LDS_BYTES) != hipSuccess || per_cu < 1) { fprintf(stderr, "kernel_launch: occupancy query says %d\n", per_cu); (void)hipGetLastError(); grid = -1; return; }
        grid = cus;
    }
    if (grid < 0) return;
    if (hipMemsetAsync((char*)d_ws + WS_BAR, 0, 16384, stream) != hipSuccess) { fprintf(stderr, "kernel_launch: memset of barrier words failed\n"); return; }
    Args a{};
    for (int i = 0; i < 31; ++i) a.in[i] = (const float*)d_in[i];
    a.out = (float*)d_out; a.ws = (unsigned char*)d_ws;
    void* kargs[] = {&a};
    hipError_t e = hipLaunchCooperativeKernel((const void*)mk_fwd, dim3(grid), dim3(512), kargs, LDS_BYTES, stream);
    if (e != hipSuccess) fprintf(stderr, "kernel_launch: cooperative launch failed: %s (grid %d)\n", hipGetErrorString(e), grid);
}
```

```cpp
#include <hip/hip_runtime.h>
#include <hip/hip_cooperative_groups.h>
#include <cstdio>
#include <cstdint>
namespace cg = cooperative_groups;

#define LAS __attribute__((address_space(3)))
typedef unsigned short bf16_t;
typedef short bf16x8 __attribute__((ext_vector_type(8)));
typedef float f32x4 __attribute__((ext_vector_type(4)));
typedef unsigned u32x4 __attribute__((ext_vector_type(4)));
typedef unsigned u32x2 __attribute__((ext_vector_type(2)));

constexpr int T = 32768, D = 1024, FF = 2816, SEQ = 8192, NB = 4;
constexpr float EPS = 1e-6f;
constexpr size_t MiB = 1u << 20;
constexpr size_t WS_SSA = 0, WS_SSB = 2 * MiB, WS_SSC = 4 * MiB, WS_SSD = 6 * MiB;
constexpr size_t WS_GATES = 8 * MiB;
constexpr size_t WS_AGG = 9 * MiB;
constexpr size_t WS_BAR = 14 * MiB;
constexpr size_t WS_C8 = 12 * MiB;
constexpr size_t WS_WG8 = 11 * MiB;
constexpr size_t WS_WGU1 = 16 * MiB;
constexpr size_t WS_WD1 = WS_WGU1 + 11 * MiB;
constexpr size_t WS_WIN = WS_WD1 + 11 * MiB / 2;
constexpr size_t WS_WRG = WS_WIN + 8 * MiB;
constexpr size_t WS_WOUT = WS_WRG + 1 * MiB;
constexpr size_t WS_WGU2 = WS_WOUT + 4 * MiB;
constexpr size_t WS_WD2 = WS_WGU2 + 11 * MiB;
constexpr size_t WS_XB = 64 * MiB;
constexpr size_t WS_R1 = 128 * MiB;
constexpr size_t WS_XM = WS_R1, WS_ZM = WS_R1 + 64 * MiB, WS_XR = WS_R1 + 128 * MiB, WS_YR = WS_R1 + 192 * MiB;
constexpr size_t WS_XC = 384 * MiB;
constexpr size_t WS_U = 448 * MiB;
constexpr size_t WS_END = 512 * MiB;
constexpr int LDS_BYTES = 147456;

typedef float f32x2_t __attribute__((ext_vector_type(2)));
typedef __bf16 bf16x2_t __attribute__((ext_vector_type(2)));
__device__ __forceinline__ unsigned pk2(float lo, float hi) { const f32x2_t v = {lo, hi}; const bf16x2_t b = __builtin_convertvector(v, bf16x2_t); return __builtin_bit_cast(unsigned, b); }
__device__ __forceinline__ float bflo(unsigned u) { return __uint_as_float(u << 16); }
__device__ __forceinline__ float bfhi(unsigned u) { return __uint_as_float(u & 0xffff0000u); }
__device__ __forceinline__ float bf1(bf16_t u) { return __uint_as_float(((unsigned)u) << 16); }
__device__ __forceinline__ void unpack8(const u32x4 v, float* x) { x[0] = bflo(v.x); x[1] = bfhi(v.x); x[2] = bflo(v.y); x[3] = bfhi(v.y); x[4] = bflo(v.z); x[5] = bfhi(v.z); x[6] = bflo(v.w); x[7] = bfhi(v.w); }
__device__ __forceinline__ u32x4 pack8(const float* x) { u32x4 o; o.x = pk2(x[0], x[1]); o.y = pk2(x[2], x[3]); o.z = pk2(x[4], x[5]); o.w = pk2(x[6], x[7]); return o; }
__device__ __forceinline__ float sigmoidf_(float x) { return __builtin_amdgcn_rcpf(1.0f + __expf(-x)); }
__device__ __forceinline__ float siluf_(float x) { return x * __builtin_amdgcn_rcpf(1.0f + __expf(-x)); }
__device__ __forceinline__ float logsigf_(float x) { return fminf(x, 0.f) - __logf(1.0f + __expf(-fabsf(x))); }
__device__ __forceinline__ float logsig_acc_(float x) { return fminf(x, 0.f) - log1pf(expf(-fabsf(x))); }
__device__ __forceinline__ float geluf_(float x) { const float u = 0.7978845608028654f * (x + 0.044715f * x * x * x); const float t = 1.0f - 2.0f * __builtin_amdgcn_rcpf(1.0f + __expf(2.0f * u)); return 0.5f * x * (1.0f + t); }
__device__ __forceinline__ int opaque_tid() { int t = threadIdx.x; asm volatile("" : "+v"(t)); return t; }
__device__ __forceinline__ float wave_sum(float v) {
#pragma unroll
    for (int o = 1; o < 64; o <<= 1) v += __shfl_xor(v, o);
    return v;
}

namespace pg8 {
constexpr int BM = 256, BK = 64, HALF = 128, HTB = HALF * BK * 2, STAGE_BYTES = 8 * HTB, NXCD = 8, WGM = 8;
__host__ __device__ __forceinline__ int lds_byte(int r, int c) { const int st = (r >> 4) * 2 + (c >> 5), rr = r & 15, cc = c & 31, ob = rr * 64 + cc * 2; return st * 1024 + (ob ^ (((ob >> 9) & 1) << 5)); }
__host__ __device__ __forceinline__ void stage_rc(int b, int& R, int& C) { const int st = b / 1024, sb = b % 1024, swz = sb ^ (((sb >> 9) & 1) << 5); R = (st >> 1) * 16 + swz / 64; C = (st & 1) * 32 + (swz % 64) / 2; }
__host__ __device__ __forceinline__ int perm32(int rho) { const int n = rho >> 4, i = rho & 15; return 8 * (i >> 2) + 4 * n + (i & 3); }

struct Unit { int pm, pn; };
struct Gemm { const bf16_t* A; const bf16_t* Bt; int K; int lda; int ksplit; long kdelta; int a_pn_shift; int a_pn_bytes; };

struct StaticOrder {
    int nM, nN, nwg, G, c;
    __device__ void init(int M, int N, int G_, int c_) { nM = M / BM; nN = N / BM; nwg = nM * nN; G = G_; c = c_; }
    __device__ bool next(int i, Unit& u) const {
        const long L = (long)i * G + c; if (L >= nwg) return false;
        int wgid = (int)L; { const int q = nwg / NXCD, r = nwg % NXCD, xcd = wgid % NXCD, off = wgid / NXCD; wgid = (xcd < r ? xcd * (q + 1) : r * (q + 1) + (xcd - r) * q) + off; }
        const int nig = WGM * nN, gid = wgid / nig, fm = gid * WGM, gsz = (nM - fm) < WGM ? (nM - fm) : WGM;
        u.pm = fm + ((wgid % nig) % gsz); u.pn = (wgid % nig) / gsz; return true;
    }
};
struct ListOrder {
    int first, cnt, nshift;
    __device__ bool next(int i, Unit& u) const { if (i >= cnt) return false; const int L = first + i; u.pm = L >> nshift; u.pn = L & ((1 << nshift) - 1); return true; }
};

__device__ __forceinline__ float row_scale(const float* SS, int r) {
    const f32x4* p = (const f32x4*)(SS + (size_t)r * 16);
    const f32x4 a = p[0], b = p[1], c = p[2], d = p[3];
    const float s = ((a[0] + a[1]) + (a[2] + a[3])) + ((b[0] + b[1]) + (b[2] + b[3])) + ((c[0] + c[1]) + (c[2] + c[3])) + ((d[0] + d[1]) + (d[2] + d[3]));
    return rsqrtf(s * (1.0f / 1024.0f) + EPS);
}

__device__ __forceinline__ void row_scales8(const float* SS, int row0, int fq, float (&rs)[8]) {
    f32x4 v[8];
#pragma unroll
    for (int q = 0; q < 8; ++q) v[q] = *(const f32x4*)(SS + (size_t)(row0 + (q >> 2) * HALF + (q & 3) * 16) * 16 + fq * 4);
#pragma unroll
    for (int q = 0; q < 8; ++q) { float s = (v[q][0] + v[q][1]) + (v[q][2] + v[q][3]); s += __shfl_xor(s, 16); s += __shfl_xor(s, 32); rs[q] = rsqrtf(s * (1.0f / 1024.0f) + EPS); }
}
struct EpiSwiGLU {
    bf16_t* O; const float* SS;
    __device__ __forceinline__ void operator()(const f32x4 (&acc)[2][2][4][2], const Unit& u, int wr, int wc, int fr, int fq) const {
        const int row0 = u.pm * BM + wr * 64 + fr, col0 = u.pn * HALF + wc * 32 + 8 * fq;
        float rs8[8]; row_scales8(SS, row0, fq, rs8);
#pragma unroll
        for (int ai = 0; ai < 2; ++ai)
#pragma unroll
            for (int m = 0; m < 4; ++m) {
                const int r = row0 + ai * HALF + m * 16; const float rs = rs8[ai * 4 + m];
                float o[8];
#pragma unroll
                for (int n = 0; n < 2; ++n)
#pragma unroll
                    for (int j = 0; j < 4; ++j) { const float g = acc[ai][0][m][n][j] * rs, up = acc[ai][1][m][n][j] * rs; o[n * 4 + j] = siluf_(g) * up; }
                *(u32x4*)(O + (size_t)r * FF + col0) = pack8(o);
            }
    }
};
struct EpiResid {
    const float* Xin; float* Xout; bf16_t* XBo; float* SSo; float alpha;
    __device__ __forceinline__ void operator()(const f32x4 (&acc)[2][2][4][2], const Unit& u, int wr, int wc, int fr, int fq) const {
        const int row0 = u.pm * BM + wr * 64 + fr, col0 = u.pn * BM + wc * 32 + 8 * fq;
#pragma unroll
        for (int ai = 0; ai < 2; ++ai)
#pragma unroll
            for (int m = 0; m < 4; ++m) {
                const int r = row0 + ai * HALF + m * 16; float ss = 0.f;
#pragma unroll
                for (int bj = 0; bj < 2; ++bj) {
                    const size_t off = (size_t)r * D + col0 + bj * HALF;
                    const f32x4 x0 = *(const f32x4*)(Xin + off), x1 = *(const f32x4*)(Xin + off + 4);
                    const f32x4 v0 = x0 + acc[ai][bj][m][0] * alpha, v1 = x1 + acc[ai][bj][m][1] * alpha;
                    *(f32x4*)(Xout + off) = v0; *(f32x4*)(Xout + off + 4) = v1;
                    ss += (v0[0] * v0[0] + v0[1] * v0[1]) + (v0[2] * v0[2] + v0[3] * v0[3]) + (v1[0] * v1[0] + v1[1] * v1[1]) + (v1[2] * v1[2] + v1[3] * v1[3]);
                    if (XBo) { u32x4 w; w.x = pk2(v0[0], v0[1]); w.y = pk2(v0[2], v0[3]); w.z = pk2(v1[0], v1[1]); w.w = pk2(v1[2], v1[3]); *(u32x4*)(XBo + off) = w; }
                }
                ss += __shfl_xor(ss, 16); ss += __shfl_xor(ss, 32);
                if (fq == 0) SSo[(size_t)r * 16 + u.pn * 4 + wc] = ss;
            }
    }
};
struct EpiProj {
    bf16_t* O; const float* SS;
    __device__ __forceinline__ void operator()(const f32x4 (&acc)[2][2][4][2], const Unit& u, int wr, int wc, int fr, int fq) const {
        bf16_t* base = O + (size_t)(u.pn >> 2) * ((size_t)T * D);
        const int row0 = u.pm * BM + wr * 64 + fr, col0 = (u.pn & 3) * BM + wc * 32 + 8 * fq;
        float rs8[8]; row_scales8(SS, row0, fq, rs8);
#pragma unroll
        for (int ai = 0; ai < 2; ++ai)
#pragma unroll
            for (int m = 0; m < 4; ++m) {
                const int r = row0 + ai * HALF + m * 16; const float rs = rs8[ai * 4 + m];
#pragma unroll
                for (int bj = 0; bj < 2; ++bj) {
                    const f32x4 v0 = acc[ai][bj][m][0] * rs, v1 = acc[ai][bj][m][1] * rs;
                    u32x4 w; w.x = pk2(v0[0], v0[1]); w.y = pk2(v0[2], v0[3]); w.z = pk2(v1[0], v1[1]); w.w = pk2(v1[2], v1[3]);
                    *(u32x4*)(base + (size_t)r * D + col0 + bj * HALF) = w;
                }
            }
    }
};
__device__ __forceinline__ float neg_expm1_(float x) {
    const float p = -x * (1.0f + x * (0.5f + x * (0.16666667f + x * (0.041666668f + x * 0.0083333338f))));
    const float e = 1.0f - __expf(x);
    return (x > -0.3f) ? p : e;
}
struct EpiRg {
    const bf16_t* XCR; const float* ba; const float* bx; const float* c8t; bf16_t* LOGA; bf16_t* U;
    __device__ __forceinline__ void operator()(const f32x4 (&acc)[2][2][4][2], const Unit& u, int wr, int wc, int fr, int fq) const {
        const int row0 = u.pm * BM + wr * 64 + fr, ch0 = (u.pn >> 1) * 256 + (u.pn & 1) * HALF + wc * 32 + 8 * fq;
#pragma unroll
        for (int n = 0; n < 2; ++n) {
            const int ch = ch0 + 4 * n;
            const f32x4 b_a = *(const f32x4*)(ba + ch), b_x = *(const f32x4*)(bx + ch), c8 = *(const f32x4*)(c8t + ch);
#pragma unroll
            for (int ai = 0; ai < 2; ++ai)
#pragma unroll
                for (int m = 0; m < 4; ++m) {
                    const int r = row0 + ai * HALF + m * 16;
                    const u32x2 xv = *(const u32x2*)(XCR + (size_t)r * D + ch);
                    const float xc[4] = {bflo(xv.x), bfhi(xv.x), bflo(xv.y), bfhi(xv.y)};
                    float la[4], uu[4];
#pragma unroll
                    for (int j = 0; j < 4; ++j) {
                        const float rg = sigmoidf_(acc[ai][0][m][n][j] + b_a[j]), ig = sigmoidf_(acc[ai][1][m][n][j] + b_x[j]);
                        la[j] = c8[j] * rg;
                        uu[j] = __builtin_amdgcn_sqrtf(fmaxf(neg_expm1_(2.0f * la[j]), 0.f)) * (ig * xc[j]);
                    }
                    u32x2 w0, w1; w0.x = pk2(la[0], la[1]); w0.y = pk2(la[2], la[3]); w1.x = pk2(uu[0], uu[1]); w1.y = pk2(uu[2], uu[3]);
                    *(u32x2*)(LOGA + (size_t)r * D + ch) = w0; *(u32x2*)(U + (size_t)r * D + ch) = w1;
                    __builtin_amdgcn_sched_barrier(0);
                }
        }
    }
};
struct EpiGates {
    float* G; const float* bg;
    __device__ __forceinline__ void operator()(const f32x4 (&acc)[2][2][4][2], const Unit& u, int wr, int wc, int fr, int fq) const {
        if (wc != 0 || fq != 0) return;
        const int row0 = u.pm * BM + wr * 64 + fr;
        const f32x4 b0 = *(const f32x4*)(bg), b1 = *(const f32x4*)(bg + 4);
#pragma unroll
        for (int ai = 0; ai < 2; ++ai)
#pragma unroll
            for (int m = 0; m < 4; ++m) {
                const int r = row0 + ai * HALF + m * 16;
                f32x4 v0 = acc[ai][0][m][0] + b0, v1 = acc[ai][0][m][1] + b1;
                for (int j = 0; j < 4; ++j) v1[j] = logsigf_(v1[j]);
                *(f32x4*)(G + (size_t)r * 8) = v0; *(f32x4*)(G + (size_t)r * 8 + 4) = v1;
            }
    }
};

template <class Epi, class Sched>
__device__ __forceinline__ void gemm_phase(LAS unsigned char* lds, const Gemm g, const Sched& S, const Epi& E) {
    const int tid = opaque_tid(), wid = __builtin_amdgcn_readfirstlane(tid >> 6), lane = tid & 63, wr = wid >> 2, wc = wid & 3, fr = lane & 15, fq = lane >> 4;
    const int K = g.K, nt = K / BK, lda = g.lda;
    unsigned voffA[2], voffB[2];
#pragma unroll
    for (int i = 0; i < 2; ++i) { int R, C; stage_rc(tid * 16 + i * 8192, R, C); const int Rb = (R & ~31) + perm32(R & 31);
        voffA[i] = (unsigned)(R * lda + C) * 2u; voffB[i] = (unsigned)(Rb * K + C) * 2u; }
    const size_t kstep = (size_t)(BK * 2);
    const size_t hstepA = (size_t)HALF * lda * 2, tstepA = 2 * hstepA;
    const size_t hstepB = (size_t)HALF * K * 2, tstepB = 2 * hstepB;
    const unsigned ldsw = (unsigned)wid * 1024u;
    const int aoff = lds_byte(wr * 64 + fr, fq * 8), boff = lds_byte(wc * 32 + fr, fq * 8);
    const int ksplit = g.ksplit; const long kdelta = g.kdelta;
#define PG8_AK(t) ((long)(t) * (long)kstep + (((t) >= ksplit) ? kdelta : 0l))
#define PG8_SA(b, h) (((b) * 2 + (h)) * HTB)
#define PG8_SB(b, h) ((4 + (b) * 2 + (h)) * HTB)
#define PG8_STAGE(bufoff, gbase, voff) do { _Pragma("unroll") for (int _i = 0; _i < 2; ++_i) \
        __builtin_amdgcn_global_load_lds((const unsigned*)((const char*)(gbase) + (voff)[_i]), (LAS unsigned*)(lds + (bufoff) + ldsw + _i * 8192), 16, 0, 0); } while (0)
#define PG8_LDA(dst, b, h) do { _Pragma("unroll") for (int m = 0; m < 4; ++m) _Pragma("unroll") for (int k = 0; k < 2; ++k) dst[m][k] = *(const LAS bf16x8*)(lds + PG8_SA(b, h) + aoff + m * 2048 + k * 1024); } while (0)
#define PG8_LDB(dst, b, h) do { _Pragma("unroll") for (int n = 0; n < 2; ++n) _Pragma("unroll") for (int k = 0; k < 2; ++k) dst[n][k] = *(const LAS bf16x8*)(lds + PG8_SB(b, h) + boff + n * 2048 + k * 1024); } while (0)
#define PG8_MMA(ai, bj, At, Bt) do { __builtin_amdgcn_s_setprio(1); _Pragma("unroll") for (int m = 0; m < 4; ++m) _Pragma("unroll") for (int n = 0; n < 2; ++n) _Pragma("unroll") for (int k = 0; k < 2; ++k) \
        acc[ai][bj][m][n] = __builtin_amdgcn_mfma_f32_16x16x32_bf16(Bt[n][k], At[m][k], acc[ai][bj][m][n], 0, 0, 0); __builtin_amdgcn_s_setprio(0); } while (0)
#define PG8_WAIT_V(n) asm volatile("s_waitcnt vmcnt(" #n ")" ::: "memory")
#define PG8_WAIT_L(n) asm volatile("s_waitcnt lgkmcnt(" #n ")" ::: "memory")
#define PG8_BAR __builtin_amdgcn_s_barrier()
#define PG8_SCHED __builtin_amdgcn_sched_barrier(0)
    Unit cur, nxt; int ui = 0;
    if (!S.next(0, cur)) return;
    f32x4 acc[2][2][4][2];
#pragma unroll
    for (int a = 0; a < 2; ++a)
#pragma unroll
        for (int b = 0; b < 2; ++b)
#pragma unroll
            for (int m = 0; m < 4; ++m)
#pragma unroll
                for (int n = 0; n < 2; ++n) acc[a][b][m][n] = (f32x4){0.f, 0.f, 0.f, 0.f};
    bf16x8 At[4][2], B0[2][2], B1[2][2];
    const char* cA = (const char*)g.A + (size_t)cur.pm * tstepA + (size_t)(cur.pn >> g.a_pn_shift) * g.a_pn_bytes;
    const char* cB = (const char*)g.Bt + (size_t)cur.pn * tstepB;
    {
        PG8_STAGE(PG8_SB(0, 0), cB, voffB); PG8_STAGE(PG8_SB(0, 1), cB + hstepB, voffB); PG8_STAGE(PG8_SA(0, 0), cA, voffA); PG8_STAGE(PG8_SA(0, 1), cA + hstepA, voffA);
        if (wr == 1) PG8_BAR;
        PG8_WAIT_V(2); PG8_BAR;
        PG8_STAGE(PG8_SB(1, 0), cB + kstep, voffB); PG8_STAGE(PG8_SA(1, 0), cA + PG8_AK(1), voffA); PG8_STAGE(PG8_SB(1, 1), cB + hstepB + kstep, voffB);
        PG8_WAIT_V(6); PG8_BAR;
    }
    for (;;) {
        const bool has_next = S.next(ui + 1, nxt);
        const char* nA = has_next ? (const char*)g.A + (size_t)nxt.pm * tstepA + (size_t)(nxt.pn >> g.a_pn_shift) * g.a_pn_bytes : cA;
        const char* nB = has_next ? (const char*)g.Bt + (size_t)nxt.pn * tstepB : cB;
#pragma nounroll
        for (int t = 0; t < nt; t += 2) {
            const bool last = (t == nt - 2);
            const char* a1 = cA + PG8_AK(t + 1);
            const char* a2 = last ? nA : cA + PG8_AK(t + 2); const char* b2 = last ? nB : cB + (size_t)(t + 2) * kstep;
            const char* a3 = last ? nA + PG8_AK(1) : cA + PG8_AK(t + 3); const char* b3 = b2 + kstep;
            PG8_LDB(B0, 0, 0); PG8_LDB(B1, 0, 1); PG8_SCHED; PG8_LDA(At, 0, 0); PG8_STAGE(PG8_SA(1, 1), a1 + hstepA, voffA);
            PG8_WAIT_V(8); PG8_WAIT_L(0); PG8_BAR; PG8_MMA(0, 0, At, B0); PG8_MMA(0, 1, At, B1); PG8_BAR; PG8_SCHED;
            PG8_LDA(At, 0, 1); PG8_STAGE(PG8_SB(0, 0), b2, voffB); PG8_STAGE(PG8_SB(0, 1), b2 + hstepB, voffB); PG8_STAGE(PG8_SA(0, 0), a2, voffA);
            PG8_WAIT_V(8); PG8_WAIT_L(0); PG8_BAR; PG8_MMA(1, 0, At, B0); PG8_MMA(1, 1, At, B1); PG8_BAR; PG8_SCHED;
            PG8_LDB(B0, 1, 0); PG8_LDB(B1, 1, 1); PG8_SCHED; PG8_LDA(At, 1, 0); PG8_STAGE(PG8_SA(0, 1), a2 + hstepA, voffA);
            PG8_WAIT_V(8); PG8_WAIT_L(0); PG8_BAR; PG8_MMA(0, 0, At, B0); PG8_MMA(0, 1, At, B1); PG8_BAR; PG8_SCHED;
            PG8_LDA(At, 1, 1); PG8_STAGE(PG8_SB(1, 0), b3, voffB); PG8_STAGE(PG8_SB(1, 1), b3 + hstepB, voffB); PG8_STAGE(PG8_SA(1, 0), a3, voffA);
            PG8_WAIT_V(8); PG8_WAIT_L(0); PG8_BAR; PG8_MMA(1, 0, At, B0); PG8_MMA(1, 1, At, B1); PG8_BAR; PG8_SCHED;
        }
        if (wr == 0) PG8_BAR;
        E(acc, cur, wr, wc, fr, fq);
        if (!has_next) break;
#pragma unroll
        for (int a = 0; a < 2; ++a)
#pragma unroll
            for (int b = 0; b < 2; ++b)
#pragma unroll
                for (int m = 0; m < 4; ++m)
#pragma unroll
                    for (int n = 0; n < 2; ++n) acc[a][b][m][n] = (f32x4){0.f, 0.f, 0.f, 0.f};
        cur = nxt; cA = nA; cB = nB; ++ui;
        if (wr == 1) PG8_BAR;
    }
    PG8_WAIT_V(0);
    PG8_BAR;
#undef PG8_AK
#undef PG8_SA
#undef PG8_SB
#undef PG8_STAGE
#undef PG8_LDA
#undef PG8_LDB
#undef PG8_MMA
#undef PG8_WAIT_V
#undef PG8_WAIT_L
#undef PG8_BAR
#undef PG8_SCHED
}
}

struct Args { const float* in[31]; float* out; unsigned char* ws; };
enum { I_X = 0, I_NF1, I_WG1, I_WU1, I_WD1, I_NMIX, I_WIN, I_MCW, I_MCB, I_WQ, I_WK, I_WV, I_WGATES, I_BGATES, I_LNW, I_SKIP, I_RCW, I_RCB, I_RWA, I_RBA, I_RWX, I_RBX, I_LAM,
       I_ONM, I_ONR, I_WOUT, I_NF2, I_WG2, I_WU2, I_WD2, I_NFIN };

template <class F> __device__ __forceinline__ void tr_item(F src, int K, bf16_t* WT, float* scr, int item, int nblk, int lane) {
    const int kb = item / nblk, nb = item % nblk, k0 = 64 * kb, n0 = 32 * nb;
#pragma unroll 8
    for (int i = 0; i < 32; ++i) { const int kk = 2 * i + (lane >> 5); scr[kk * 33 + (lane & 31)] = src(k0 + kk, n0 + (lane & 31)); }
    __builtin_amdgcn_wave_barrier();
    const int c = lane & 7;
#pragma unroll
    for (int j = 0; j < 4; ++j) { const int n = (lane >> 3) + 8 * j; const float* s = scr + (8 * c) * 33 + n;
        u32x4 o; o.x = pk2(s[0 * 33], s[1 * 33]); o.y = pk2(s[2 * 33], s[3 * 33]); o.z = pk2(s[4 * 33], s[5 * 33]); o.w = pk2(s[6 * 33], s[7 * 33]);
        *(u32x4*)(WT + (size_t)(n0 + n) * K + k0 + 8 * c) = o; }
    __builtin_amdgcn_wave_barrier();
}

__device__ __forceinline__ void p0_prologue(const Args& a, unsigned char* lds) {
    const int tid = opaque_tid(), lane = tid & 63, wave = tid >> 6;
    const int gw = blockIdx.x * 8 + wave, NGW = gridDim.x * 8;
    float* scr = (float*)(lds + wave * 16384);
    unsigned char* ws = a.ws;
    constexpr int I1 = 16 * 176, I2 = 44 * 32, I3 = 16 * 128, I4 = 4 * 64, I5 = 32 * 32;
    constexpr int NIT = I1 + I2 + I3 + I4 + I5 + I1 + I2;
    for (int it = gw; it < NIT; it += NGW) {
        int r = it;
        if (r < I1) { const float* wg = a.in[I_WG1]; const float* wu = a.in[I_WU1]; const float* gn = a.in[I_NF1];
            tr_item([=](int k, int n) { const int c = (n >> 8) * 128 + (n & 127); return (((n >> 7) & 1) ? wu : wg)[(size_t)k * FF + c] * gn[k]; }, 1024, (bf16_t*)(ws + WS_WGU1), scr, r, 176, lane); continue; } r -= I1;
        if (r < I2) { const float* wd = a.in[I_WD1];
            tr_item([=](int k, int n) { return wd[(size_t)k * D + n]; }, FF, (bf16_t*)(ws + WS_WD1), scr, r, 32, lane); continue; } r -= I2;
        if (r < I3) { const float* w = a.in[I_WIN]; const float* gn = a.in[I_NMIX];
            tr_item([=](int k, int n) { return w[(size_t)k * 4096 + n] * gn[k]; }, 1024, (bf16_t*)(ws + WS_WIN), scr, r, 128, lane); continue; } r -= I3;
        if (r < I4) { const float* wa = a.in[I_RWA]; const float* wx = a.in[I_RWX];
            tr_item([=](int k, int n) { const int pn = n >> 8, blk = pn >> 1, hh = pn & 1, sel = (n >> 7) & 1, c = hh * 128 + (n & 127); return (sel ? wx : wa)[(size_t)blk * 65536 + (size_t)k * 256 + c]; }, 256, (bf16_t*)(ws + WS_WRG), scr, r, 64, lane); continue; } r -= I4;
        if (r < I5) { const float* w = a.in[I_WOUT]; const float* gm = a.in[I_ONM]; const float* gr = a.in[I_ONR];
            tr_item([=](int k, int n) { return w[(size_t)k * D + n] * (k < 1024 ? gm[k] : gr[k - 1024]); }, 2048, (bf16_t*)(ws + WS_WOUT), scr, r, 32, lane); continue; } r -= I5;
        if (r < I1) { const float* wg = a.in[I_WG2]; const float* wu = a.in[I_WU2]; const float* gn = a.in[I_NF2];
            tr_item([=](int k, int n) { const int c = (n >> 8) * 128 + (n & 127); return (((n >> 7) & 1) ? wu : wg)[(size_t)k * FF + c] * gn[k]; }, 1024, (bf16_t*)(ws + WS_WGU2), scr, r, 176, lane); continue; } r -= I1;
        { const float* wd = a.in[I_WD2];
            tr_item([=](int k, int n) { return wd[(size_t)k * D + n]; }, FF, (bf16_t*)(ws + WS_WD2), scr, r, 32, lane); }
    }
    {
        bf16_t* WG8 = (bf16_t*)(ws + WS_WG8);
        const float* wq = a.in[I_WQ]; const float* wk = a.in[I_WK]; const float* wv = a.in[I_WV]; const float* Wg = a.in[I_WGATES];
        const int gt = blockIdx.x * 512 + tid, NT = gridDim.x * 512;
        for (int e = gt; e < 256 * 2048 / 8; e += NT) {
            const int g = e / 256, k0 = (e % 256) * 8;
            float o[8];
#pragma unroll
            for (int j = 0; j < 8; ++j) {
                float v = 0.f;
                if (g < 8) { const int k = k0 + j, c = k & 1023, n = c >> 2, i = c & 3;
                    if (k < 1024) { for (int oo = 0; oo < 4; ++oo) v += wq[n * 16 + i * 4 + oo] * Wg[(size_t)(4 * n + oo) * 8 + g] + wk[n * 16 + i * 4 + oo] * Wg[(size_t)(1024 + 4 * n + oo) * 8 + g]; }
                    else { for (int oo = 0; oo < 4; ++oo) v += wv[n * 16 + i * 4 + oo] * Wg[(size_t)(2048 + 4 * n + oo) * 8 + g]; } }
                o[j] = v;
            }
            *(u32x4*)(WG8 + (size_t)g * 2048 + k0) = pack8(o);
        }
    }
    if (blockIdx.x == 0) { float* C8 = (float*)(ws + WS_C8); const float* lam = a.in[I_LAM]; for (int e = tid; e < 1024; e += 512) C8[e] = 8.0f * logsig_acc_(lam[e]); }
    {
        const float* x = a.in[I_X]; bf16_t* XB = (bf16_t*)(ws + WS_XB); float* SS = (float*)(ws + WS_SSA);
        for (int m = gw; m < T; m += NGW) {
            const f32x4* xr = (const f32x4*)(x + (size_t)m * D) + lane;
            f32x4 v[4]; float s = 0.f;
#pragma unroll
            for (int j = 0; j < 4; ++j) { v[j] = xr[64 * j]; s += (v[j][0] * v[j][0] + v[j][1] * v[j][1]) + (v[j][2] * v[j][2] + v[j][3] * v[j][3]); }
            s = wave_sum(s);
            u32x2* o8 = (u32x2*)(XB + (size_t)m * D) + lane;
#pragma unroll
            for (int j = 0; j < 4; ++j) { u32x2 w; w.x = pk2(v[j][0], v[j][1]); w.y = pk2(v[j][2], v[j][3]); o8[64 * j] = w; }
            if (lane < 16) SS[(size_t)m * 16 + lane] = (lane == 0) ? s : 0.f;
        }
    }
}

template <bool SILU> __device__ __forceinline__ void conv_part(const bf16_t* in, bf16_t* out, const float* cw, const float* cb, int t0, int c0) {
    float w[4][8], b[8];
#pragma unroll
    for (int tap = 0; tap < 4; ++tap) { const f32x4 p = *(const f32x4*)(cw + tap * D + c0), q = *(const f32x4*)(cw + tap * D + c0 + 4); for (int j = 0; j < 4; ++j) { w[tap][j] = p[j]; w[tap][4 + j] = q[j]; } }
    { const f32x4 p = *(const f32x4*)(cb + c0), q = *(const f32x4*)(cb + c0 + 4); for (int j = 0; j < 4; ++j) { b[j] = p[j]; b[4 + j] = q[j]; } }
    float h0[8], h1[8], h2[8];
    const bool first = (t0 % SEQ) == 0;
    if (first) { for (int j = 0; j < 8; ++j) { h0[j] = 0.f; h1[j] = 0.f; h2[j] = 0.f; } }
    else {
        unpack8(*(const u32x4*)(in + (size_t)(t0 - 3) * D + c0), h0); unpack8(*(const u32x4*)(in + (size_t)(t0 - 2) * D + c0), h1); unpack8(*(const u32x4*)(in + (size_t)(t0 - 1) * D + c0), h2);
    }
    u32x4 cur[8];
#pragma unroll
    for (int i = 0; i < 8; ++i) cur[i] = *(const u32x4*)(in + (size_t)(t0 + i) * D + c0);
#pragma unroll
    for (int i = 0; i < 8; ++i) {
        float x[8], y[8]; unpack8(cur[i], x);
#pragma unroll
        for (int j = 0; j < 8; ++j) { float v = b[j] + w[0][j] * h0[j] + w[1][j] * h1[j] + w[2][j] * h2[j] + w[3][j] * x[j]; y[j] = SILU ? siluf_(v) : v; h0[j] = h1[j]; h1[j] = h2[j]; h2[j] = x[j]; }
        *(u32x4*)(out + (size_t)(t0 + i) * D + c0) = pack8(y);
    }
}
__device__ __forceinline__ void p4_conv(const Args& a) {
    unsigned char* ws = a.ws; const int tid = opaque_tid(), cgp = tid & 127, ts = tid >> 7;
    for (int u = blockIdx.x; u < T / 32; u += gridDim.x) {
        const int t0 = u * 32 + ts * 8, c0 = cgp * 8;
        conv_part<true>((const bf16_t*)(ws + WS_XM), (bf16_t*)(ws + WS_XC), a.in[I_MCW], a.in[I_MCB], t0, c0);
        conv_part<false>((const bf16_t*)(ws + WS_XR), (bf16_t*)(ws + WS_XB), a.in[I_RCW], a.in[I_RCB], t0, c0);
    }
}

__device__ __forceinline__ void p6_rg_agg(const Args& a) {
    unsigned char* ws = a.ws; const int tid = opaque_tid();
    const unsigned* LOGA = (const unsigned*)(ws + WS_XR); const unsigned* U = (const unsigned*)(ws + WS_U); float* AGG = (float*)(ws + WS_AGG);
    for (int tile = blockIdx.x; tile < 256; tile += gridDim.x) {
        const size_t row0 = (size_t)tile * 128;
        float sl0 = 0.f, sl1 = 0.f, h0 = 0.f, h1 = 0.f;
        for (int i0 = 0; i0 < 128; i0 += 16) {
            unsigned la[16], uu[16];
#pragma unroll
            for (int i = 0; i < 16; ++i) { la[i] = LOGA[(row0 + i0 + i) * 512 + tid]; uu[i] = U[(row0 + i0 + i) * 512 + tid]; }
#pragma unroll
            for (int i = 0; i < 16; ++i) { const float l0 = bflo(la[i]), l1 = bfhi(la[i]); sl0 += l0; sl1 += l1; h0 = __expf(l0) * h0 + bflo(uu[i]); h1 = __expf(l1) * h1 + bfhi(uu[i]); }
        }
        f32x4 o = {sl0, h0, sl1, h1};
        *(f32x4*)(AGG + ((size_t)tile * 1024 + 2 * tid) * 2) = o;
    }
}

template <int CTRL, int RMASK> __device__ __forceinline__ float dppf(float old, float src) {
    return __builtin_bit_cast(float, __builtin_amdgcn_update_dpp(__builtin_bit_cast(int, old), __builtin_bit_cast(int, src), CTRL, RMASK, 0xf, false));
}
__device__ __forceinline__ float readlane_f(float v, int l) { return __builtin_bit_cast(float, __builtin_amdgcn_readlane(__builtin_bit_cast(int, v), l)); }

namespace ml {
constexpr int QP = 264, SP = 72;
constexpr int O_QS = 0, O_KS = 33792, O_SS = 67584, O_VT = 76800, O_VW = 81408, O_CS = 86016, O_OSM = 102912, O_TAB = 111360, O_WTS = 113920, O_END = 126208;
}
__device__ __forceinline__ unsigned char* sraw_ptr(unsigned char* ws, int u) {
    return u < 1600 ? ws + (size_t)u * 5120 : (u < 2000 ? ws + 62 * MiB + (size_t)(u - 1600) * 5120 : ws + 12 * MiB + 512 * 1024 + (size_t)(u - 2000) * 5120);
}
__device__ __forceinline__ void p5b_sraw(const Args& a, unsigned char* lds) {
    using namespace ml;
    unsigned char* ws = a.ws;
    const int tid = opaque_tid(), lane = tid & 63, w = __builtin_amdgcn_readfirstlane(tid >> 6), fr = lane & 15, fq = lane >> 4;
    bf16_t* Qs = (bf16_t*)(lds + O_QS); bf16_t* Ks = (bf16_t*)(lds + O_KS); float* WTS = (float*)(lds + O_WTS);
    const bf16_t* XC = (const bf16_t*)(ws + WS_XC);
    const int srow = tid >> 5, scol = (tid & 31) * 8;
    for (int g = blockIdx.x; g < 256; g += gridDim.x) {
        const int bh = g >> 4, c0 = (g & 15) * 8, b = bh >> 2, h = bh & 3;
        __syncthreads();
        for (int e = tid; e < 1024; e += 512) { const int gg = e >> 4, bb = (e >> 2) & 3, aa = e & 3; const float* wq = a.in[I_WQ] + (h * 64 + gg) * 16; const float* wk = a.in[I_WK] + (h * 64 + gg) * 16;
            float v = 0.f; for (int o = 0; o < 4; ++o) v += wq[bb * 4 + o] * wk[aa * 4 + o]; WTS[e] = v * 0.0625f; }
        __syncthreads();
        const int lg0 = (tid & 31) * 2;
        f32x4 Wq[2][4];
#pragma unroll
        for (int g2 = 0; g2 < 2; ++g2)
#pragma unroll
            for (int i = 0; i < 4; ++i) Wq[g2][i] = *(const f32x4*)(WTS + (lg0 + g2) * 16 + i * 4);
        for (int cc = 0; cc < 8; ++cc) {
            const int c = c0 + cc; const size_t t0 = (size_t)b * SEQ + (size_t)c * 64;
            u32x4 xr[4];
#pragma unroll
            for (int i = 0; i < 4; ++i) xr[i] = *(const u32x4*)(XC + (t0 + srow + 16 * i) * D + h * 256 + scol);
#pragma unroll
            for (int i = 0; i < 4; ++i) {
                float x[8]; unpack8(xr[i], x);
                float q[8];
#pragma unroll
                for (int g2 = 0; g2 < 2; ++g2) {
                    const f32x4 qq = Wq[g2][0] * x[4 * g2] + Wq[g2][1] * x[4 * g2 + 1] + Wq[g2][2] * x[4 * g2 + 2] + Wq[g2][3] * x[4 * g2 + 3];
                    for (int j = 0; j < 4; ++j) q[4 * g2 + j] = qq[j];
                }
                const int r = srow + 16 * i;
                *(u32x4*)(Qs + r * QP + scol) = pack8(q); *(u32x4*)(Ks + r * QP + scol) = xr[i];
            }
            __syncthreads();
            {
                unsigned char* sp = sraw_ptr(ws, bh * 128 + c);
#define S_DECODE(li, it, jt) do { if ((li) < 4) { it = 3; jt = (li); } else if ((li) < 7) { it = 2; jt = (li) - 4; } else if ((li) < 9) { it = 1; jt = (li) - 7; } else { it = 0; jt = 0; } } while (0)
#define S_EPI(li, sv) do { u32x2 wv_; wv_.x = pk2(sv[0], sv[1]); wv_.y = pk2(sv[2], sv[3]); *(u32x2*)(sp + (li) * 512 + lane * 8) = wv_; } while (0)
                int it0, jt0, it1 = 0, jt1 = 0; S_DECODE(w, it0, jt0);
                const bool two = (w < 2); if (two) S_DECODE(w + 8, it1, jt1);
                f32x4 sA = (f32x4){0.f, 0.f, 0.f, 0.f}, sB = sA, tA = sA, tB = sA;
                const bf16_t* k0p = Ks + (jt0 * 16 + fr) * QP + fq * 8; const bf16_t* q0p = Qs + (it0 * 16 + fr) * QP + fq * 8;
                const bf16_t* k1p = Ks + (jt1 * 16 + fr) * QP + fq * 8; const bf16_t* q1p = Qs + (it1 * 16 + fr) * QP + fq * 8;
#pragma unroll
                for (int ks = 0; ks < 8; ks += 2) {
                    sA = __builtin_amdgcn_mfma_f32_16x16x32_bf16(*(const bf16x8*)(k0p + ks * 32), *(const bf16x8*)(q0p + ks * 32), sA, 0, 0, 0);
                    sB = __builtin_amdgcn_mfma_f32_16x16x32_bf16(*(const bf16x8*)(k0p + ks * 32 + 32), *(const bf16x8*)(q0p + ks * 32 + 32), sB, 0, 0, 0);
                    if (two) {
                        tA = __builtin_amdgcn_mfma_f32_16x16x32_bf16(*(const bf16x8*)(k1p + ks * 32), *(const bf16x8*)(q1p + ks * 32), tA, 0, 0, 0);
                        tB = __builtin_amdgcn_mfma_f32_16x16x32_bf16(*(const bf16x8*)(k1p + ks * 32 + 32), *(const bf16x8*)(q1p + ks * 32 + 32), tB, 0, 0, 0);
                    }
                }
                const f32x4 s0 = sA + sB; S_EPI(w, s0);
                if (two) { const f32x4 s1 = tA + tB; S_EPI(w + 8, s1); }
#undef S_DECODE
#undef S_EPI
            }
            __syncthreads();
        }
    }
}

__device__ __forceinline__ void p6_mlstm(const Args& a, unsigned char* lds) {
    using namespace ml;
    unsigned char* ws = a.ws;
    const int tid = opaque_tid(), lane = tid & 63, w = __builtin_amdgcn_readfirstlane(tid >> 6), fr = lane & 15, fq = lane >> 4;
    bf16_t* Qs = (bf16_t*)(lds + O_QS); bf16_t* Ks = (bf16_t*)(lds + O_KS); bf16_t* Ss = (bf16_t*)(lds + O_SS);
    bf16_t* Vt = (bf16_t*)(lds + O_VT); bf16_t* Vw = (bf16_t*)(lds + O_VW); bf16_t* Cs = (bf16_t*)(lds + O_CS);
    float* Osm = (float*)(lds + O_OSM); float* TAB = (float*)(lds + O_TAB); float* WTS = (float*)(lds + O_WTS);
    const bf16_t* XC = (const bf16_t*)(ws + WS_XC); const bf16_t* XM = (const bf16_t*)(ws + WS_XM); const float* GATES = (const float*)(ws + WS_GATES);
    bf16_t* HM = (bf16_t*)(ws + WS_XB);
    for (int unit = blockIdx.x; unit < 256; unit += gridDim.x) {
        const int xcd = unit & 7, idx = unit >> 3, bh = xcd * 2 + (idx >> 4), vs = idx & 15, b = bh >> 2, h = bh & 3;
        __syncthreads();
        for (int e = tid; e < 64 * SP / 2; e += 512) ((unsigned*)Ss)[e] = 0u;
        for (int e = tid; e < 32 * SP / 2; e += 512) { const int row = e / (SP / 2); ((unsigned*)Vt)[e] = (row == 16) ? 0x3F803F80u : 0u; ((unsigned*)Vw)[e] = 0u; }
        for (int e = tid; e < 32 * QP / 2; e += 512) ((unsigned*)Cs)[e] = 0u;
        for (int e = tid; e < 1024; e += 512) { const int g = e >> 4, bb = (e >> 2) & 3, aa = e & 3; const float* wq = a.in[I_WQ] + (h * 64 + g) * 16; const float* wk = a.in[I_WK] + (h * 64 + g) * 16;
            float v = 0.f; for (int o = 0; o < 4; ++o) v += wq[bb * 4 + o] * wk[aa * 4 + o]; WTS[e] = v * 0.0625f; }
        for (int e = tid; e < 1024; e += 512) WTS[2048 + e] = a.in[I_WV][h * 1024 + e];
        f32x4 Cacc[2][2];
#pragma unroll
        for (int i = 0; i < 2; ++i)
#pragma unroll
            for (int j = 0; j < 2; ++j) Cacc[i][j] = (f32x4){0.f, 0.f, 0.f, 0.f};
        const int srow = tid >> 5, scol = (tid & 31) * 8;
        const int vrow = tid >> 1, vhalf = tid & 1;
        const size_t tbase = (size_t)b * SEQ;
        u32x4 xr[4], xmr = (u32x4){0u, 0u, 0u, 0u}; float gi, gf;
        u32x2 sr0 = (u32x2){0u, 0u}, sr1 = (u32x2){0u, 0u};
        {
            const size_t t0 = tbase;
#pragma unroll
            for (int i = 0; i < 4; ++i) xr[i] = *(const u32x4*)(XC + (t0 + srow + 16 * i) * D + h * 256 + scol);
            if (tid < 128) xmr = *(const u32x4*)(XM + (t0 + vrow) * D + h * 256 + vs * 16 + vhalf * 8);
            gi = GATES[(t0 + lane) * 8 + h]; gf = GATES[(t0 + lane) * 8 + 4 + h];
            const unsigned char* sp = sraw_ptr(ws, bh * 128);
            sr0 = *(const u32x2*)(sp + tid * 8); if (tid < 128) sr1 = *(const u32x2*)(sp + 4096 + tid * 8);
        }
        __syncthreads();
        float decay = 0.f, m_cur = -1e30f;
        constexpr int NC = SEQ / 64;
        for (int c = -1; c < NC; ++c) {
            float* tab = TAB + (c & 1) * 320;
            if (c >= 0) {
            __syncthreads();
            {
                const int rt = w & 3, vt = w >> 2;
                f32x4 a1 = (f32x4){0.f, 0.f, 0.f, 0.f}, a2 = (f32x4){0.f, 0.f, 0.f, 0.f};
#pragma unroll
                for (int ks = 0; ks < 2; ++ks) {
                    const bf16x8 sa_ = *(const bf16x8*)(Ss + (rt * 16 + fr) * SP + ks * 32 + fq * 8);
                    const bf16x8 vb = *(const bf16x8*)(Vt + (vt * 16 + fr) * SP + ks * 32 + fq * 8);
                    a1 = __builtin_amdgcn_mfma_f32_16x16x32_bf16(sa_, vb, a1, 0, 0, 0);
                }
#pragma unroll
                for (int ks = 0; ks < 8; ++ks) {
                    const bf16x8 qa = *(const bf16x8*)(Qs + (rt * 16 + fr) * QP + ks * 32 + fq * 8);
                    const bf16x8 cb = *(const bf16x8*)(Cs + (vt * 16 + fr) * QP + ks * 32 + fq * 8);
                    a2 = __builtin_amdgcn_mfma_f32_16x16x32_bf16(qa, cb, a2, 0, 0, 0);
                }
#pragma unroll
                for (int e = 0; e < 4; ++e) { const int i = rt * 16 + fq * 4 + e; Osm[i * 33 + vt * 16 + fr] = a1[e] + tab[128 + i] * a2[e]; }
            }
            {
#pragma unroll
                for (int kl = 0; kl < 2; ++kl)
#pragma unroll
                    for (int vt = 0; vt < 2; ++vt) Cacc[kl][vt] = Cacc[kl][vt] * decay;
#pragma unroll
                for (int kl = 0; kl < 2; ++kl) {
                    const int kcol = (2 * w + kl) * 16 + fr;
#pragma unroll
                    for (int ks = 0; ks < 2; ++ks) {
                        bf16x8 ka;
#pragma unroll
                        for (int e = 0; e < 8; ++e) ka[e] = (short)Ks[(ks * 32 + fq * 8 + e) * QP + kcol];
#pragma unroll
                        for (int vt = 0; vt < 2; ++vt) {
                            const bf16x8 vb = *(const bf16x8*)(Vw + (vt * 16 + fr) * SP + ks * 32 + fq * 8);
                            Cacc[kl][vt] = __builtin_amdgcn_mfma_f32_16x16x32_bf16(ka, vb, Cacc[kl][vt], 0, 0, 0);
                        }
                    }
                }
            }
            }
            u32x4 qpk[4]; float vnx[8], decay_n = 0.f, m_nx = m_cur;
            if (c + 1 < NC) {
                const int lg0 = (tid & 31) * 2;
                f32x4 Wq[2][4];
#pragma unroll
                for (int g2 = 0; g2 < 2; ++g2)
#pragma unroll
                    for (int i = 0; i < 4; ++i) Wq[g2][i] = *(const f32x4*)(WTS + (lg0 + g2) * 16 + i * 4);
#pragma unroll
                for (int i = 0; i < 4; ++i) {
                    float x[8]; unpack8(xr[i], x);
                    float q[8];
#pragma unroll
                    for (int g2 = 0; g2 < 2; ++g2) {
                        const f32x4 qq = Wq[g2][0] * x[4 * g2] + Wq[g2][1] * x[4 * g2 + 1] + Wq[g2][2] * x[4 * g2 + 2] + Wq[g2][3] * x[4 * g2 + 3];
                        for (int j = 0; j < 4; ++j) q[4 * g2 + j] = qq[j];
                    }
                    qpk[i] = pack8(q);
                }
                if (tid < 128) {
                    float x[8]; unpack8(xmr, x);
                    const int lgv = vs * 4 + vhalf * 2;
#pragma unroll
                    for (int g2 = 0; g2 < 2; ++g2) {
                        const float* Wv = WTS + 2048 + (lgv + g2) * 16;
#pragma unroll
                        for (int o = 0; o < 4; ++o) vnx[4 * g2 + o] = Wv[0 * 4 + o] * x[4 * g2] + Wv[1 * 4 + o] * x[4 * g2 + 1] + Wv[2 * 4 + o] * x[4 * g2 + 2] + Wv[3 * 4 + o] * x[4 * g2 + 3];
                    }
                }
                float sa = gf, sc = gi;
#define SCAN_STEP(CTRL, RM) do { const float ao = dppf<CTRL, RM>(0.f, sa), co = dppf<CTRL, RM>(-INFINITY, sc); sc = fmaxf(co + sa, sc); sa = ao + sa; } while (0)
                SCAN_STEP(0x111, 0xf); SCAN_STEP(0x112, 0xf); SCAN_STEP(0x114, 0xf); SCAN_STEP(0x118, 0xf);
                SCAN_STEP(0x142, 0xa);
                SCAN_STEP(0x143, 0xc);
#undef SCAN_STEP
                const float Mi = fmaxf(m_cur + sa, sc);
                const float gtot = readlane_f(sa, 63); m_nx = readlane_f(Mi, 63);
                decay_n = __expf(gtot + m_cur - m_nx);
                if (w == 0) {
                    float* tn = TAB + ((c + 1) & 1) * 320;
                    tn[lane] = sa - Mi; tn[64 + lane] = gi - sa; tn[128 + lane] = __expf(sa + m_cur - Mi); tn[192 + lane] = __expf(-Mi); tn[256 + lane] = __expf(gtot - sa + gi - m_nx);
                }
            }
            if (c >= 0) {
            __syncthreads();
            {
#pragma unroll
                for (int kl = 0; kl < 2; ++kl)
#pragma unroll
                    for (int vt = 0; vt < 2; ++vt) {
                        u32x2 wv; wv.x = pk2(Cacc[kl][vt][0], Cacc[kl][vt][1]); wv.y = pk2(Cacc[kl][vt][2], Cacc[kl][vt][3]);
                        *(u32x2*)(Cs + (vt * 16 + fr) * QP + (2 * w + kl) * 16 + fq * 4) = wv;
                    }
                const int i = tid >> 3, vp = (tid & 7) * 2;
                const float den = Osm[i * 33 + 16], dn = fmaxf(fabsf(den), tab[192 + i]);
                const float rdn = __builtin_amdgcn_rcpf(dn); const float h0 = Osm[i * 33 + vp] * rdn, h1 = Osm[i * 33 + vp + 1] * rdn;
                *(unsigned*)(HM + ((size_t)(bh * 16 + vs) * SEQ + (size_t)c * 64 + i) * 16 + vp) = pk2(h0, h1);
            }
            }
            if (c + 1 < NC) {
#pragma unroll
                for (int i = 0; i < 4; ++i) { const int r = srow + 16 * i; *(u32x4*)(Qs + r * QP + scol) = qpk[i]; *(u32x4*)(Ks + r * QP + scol) = xr[i]; }
                if (c < 0) __syncthreads();
                const float* tn = TAB + ((c + 1) & 1) * 320;
                if (tid < 128) {
                    const float wk = tn[256 + vrow];
#pragma unroll
                    for (int e = 0; e < 8; ++e) { Vt[(vhalf * 8 + e) * SP + vrow] = (bf16_t)(pk2(vnx[e], 0.f) & 0xffffu); Vw[(vhalf * 8 + e) * SP + vrow] = (bf16_t)(pk2(vnx[e] * wk, 0.f) & 0xffffu); }
                } else if (tid < 192) { Vw[16 * SP + (tid - 128)] = (bf16_t)(pk2(tn[256 + tid - 128], 0.f) & 0xffffu); }
#define SS_ITEM(li, sr) do { int it_, jt_; if ((li) < 4) { it_ = 3; jt_ = (li); } else if ((li) < 7) { it_ = 2; jt_ = (li) - 4; } else if ((li) < 9) { it_ = 1; jt_ = (li) - 7; } else { it_ = 0; jt_ = 0; } \
        const int i_ = it_ * 16 + fr, j0_ = jt_ * 16 + fq * 4; const float rf_ = tn[i_]; const f32x4 cf_ = *(const f32x4*)(tn + 64 + j0_); \
        const float sv_[4] = {bflo((sr).x), bfhi((sr).x), bflo((sr).y), bfhi((sr).y)}; float o_[4]; \
        _Pragma("unroll") for (int e = 0; e < 4; ++e) o_[e] = (j0_ + e <= i_) ? sv_[e] * __expf(rf_ + cf_[e]) : 0.f; \
        u32x2 wv_; wv_.x = pk2(o_[0], o_[1]); wv_.y = pk2(o_[2], o_[3]); *(u32x2*)(Ss + i_ * SP + j0_) = wv_; } while (0)
                SS_ITEM(w, sr0);
                if (w < 2) SS_ITEM(w + 8, sr1);
#undef SS_ITEM
                decay = decay_n; m_cur = m_nx;
                if (c + 2 < NC) {
                    const size_t t2 = tbase + (size_t)(c + 2) * 64;
#pragma unroll
                    for (int i = 0; i < 4; ++i) xr[i] = *(const u32x4*)(XC + (t2 + srow + 16 * i) * D + h * 256 + scol);
                    if (tid < 128) xmr = *(const u32x4*)(XM + (t2 + vrow) * D + h * 256 + vs * 16 + vhalf * 8);
                    gi = GATES[(t2 + lane) * 8 + h]; gf = GATES[(t2 + lane) * 8 + 4 + h];
                    const unsigned char* sp = sraw_ptr(ws, bh * 128 + c + 2);
                    sr0 = *(const u32x2*)(sp + tid * 8); if (tid < 128) sr1 = *(const u32x2*)(sp + 4096 + tid * 8);
                }
            }
        }
    }
}

__device__ __forceinline__ void p6_mlstm_tok(const Args& a, unsigned char* lds) {
    using namespace ml;
    unsigned char* ws = a.ws;
    const int tid = opaque_tid(), lane = tid & 63, w = __builtin_amdgcn_readfirstlane(tid >> 6), fr = lane & 15, fq = lane >> 4;
    bf16_t* Qs = (bf16_t*)(lds + O_QS); bf16_t* Ks = (bf16_t*)(lds + O_KS); bf16_t* Ss = (bf16_t*)(lds + O_SS);
    bf16_t* Vt = (bf16_t*)(lds + O_VT); bf16_t* Vw = (bf16_t*)(lds + O_VW); bf16_t* Cs = (bf16_t*)(lds + O_CS);
    float* Osm = (float*)(lds + O_OSM); float* TAB = (float*)(lds + O_TAB); float* WTS = (float*)(lds + O_WTS);
    const bf16_t* XC = (const bf16_t*)(ws + WS_XC); const bf16_t* XM = (const bf16_t*)(ws + WS_XM); const float* GATES = (const float*)(ws + WS_GATES);
    bf16_t* HM = (bf16_t*)(ws + WS_XB);
    for (int unit = blockIdx.x; unit < 256; unit += gridDim.x) {
        const int xcd = unit & 7, idx = unit >> 3, bh = xcd * 2 + (idx >> 4), vs = idx & 15, b = bh >> 2, h = bh & 3;
        __syncthreads();
        for (int e = tid; e < 64 * SP / 2; e += 512) ((unsigned*)Ss)[e] = 0u;
        for (int e = tid; e < 32 * SP / 2; e += 512) { const int row = e / (SP / 2); ((unsigned*)Vt)[e] = (row == 16) ? 0x3F803F80u : 0u; ((unsigned*)Vw)[e] = 0u; }
        for (int e = tid; e < 32 * QP / 2; e += 512) ((unsigned*)Cs)[e] = 0u;
        for (int e = tid; e < 3 * 64 * 16; e += 512) { const int m = e / 1024, r = e % 1024; const float* src = (m == 0) ? a.in[I_WQ] : (m == 1 ? a.in[I_WK] : a.in[I_WV]); WTS[e] = src[h * 1024 + r] * (m == 1 ? 0.0625f : 1.0f); }
        f32x4 Cacc[2][2];
#pragma unroll
        for (int i = 0; i < 2; ++i)
#pragma unroll
            for (int j = 0; j < 2; ++j) Cacc[i][j] = (f32x4){0.f, 0.f, 0.f, 0.f};
        float m_prev = -1e30f;
        float Ct[8], Nt[8];
#pragma unroll
        for (int j = 0; j < 8; ++j) { Ct[j] = 0.f; Nt[j] = 0.f; }
        const int srow = tid >> 5, scol = (tid & 31) * 8;
        const int vrow = tid >> 1, vhalf = tid & 1;
        const size_t tbase = (size_t)b * SEQ;
        u32x4 xr[4], xmr = (u32x4){0u, 0u, 0u, 0u}; float gi, gf;
        {
            const size_t t0 = tbase;
#pragma unroll
            for (int i = 0; i < 4; ++i) xr[i] = *(const u32x4*)(XC + (t0 + srow + 16 * i) * D + h * 256 + scol);
            if (tid < 128) xmr = *(const u32x4*)(XM + (t0 + vrow) * D + h * 256 + vs * 16 + vhalf * 8);
            gi = GATES[(t0 + lane) * 8 + h]; gf = GATES[(t0 + lane) * 8 + 4 + h];
        }
        __syncthreads();
        for (int c = 0; c < SEQ / 64; ++c) {
            const size_t t0 = tbase + (size_t)c * 64;
            float* tab = TAB;
            float vreg[8];
            {
                const int lg0 = (tid & 31) * 2;
                f32x4 Wq[2][4], Wk[2][4];
#pragma unroll
                for (int g2 = 0; g2 < 2; ++g2)
#pragma unroll
                    for (int i = 0; i < 4; ++i) { Wq[g2][i] = *(const f32x4*)(WTS + (lg0 + g2) * 16 + i * 4); Wk[g2][i] = *(const f32x4*)(WTS + 1024 + (lg0 + g2) * 16 + i * 4); }
#pragma unroll
                for (int i = 0; i < 4; ++i) {
                    float x[8]; unpack8(xr[i], x);
                    float q[8], k[8];
#pragma unroll
                    for (int g2 = 0; g2 < 2; ++g2) {
                        const f32x4 qq = Wq[g2][0] * x[4 * g2] + Wq[g2][1] * x[4 * g2 + 1] + Wq[g2][2] * x[4 * g2 + 2] + Wq[g2][3] * x[4 * g2 + 3];
                        const f32x4 kk = Wk[g2][0] * x[4 * g2] + Wk[g2][1] * x[4 * g2 + 1] + Wk[g2][2] * x[4 * g2 + 2] + Wk[g2][3] * x[4 * g2 + 3];
                        for (int j = 0; j < 4; ++j) { q[4 * g2 + j] = qq[j]; k[4 * g2 + j] = kk[j]; }
                    }
                    const int r = srow + 16 * i;
                    *(u32x4*)(Qs + r * QP + scol) = pack8(q); *(u32x4*)(Ks + r * QP + scol) = pack8(k);
                }
                if (tid < 128) {
                    float x[8]; unpack8(xmr, x);
                    const int lgv = vs * 4 + vhalf * 2;
#pragma unroll
                    for (int g2 = 0; g2 < 2; ++g2) {
                        const float* Wv = WTS + 2048 + (lgv + g2) * 16;
#pragma unroll
                        for (int o = 0; o < 4; ++o) vreg[4 * g2 + o] = Wv[0 * 4 + o] * x[4 * g2] + Wv[1 * 4 + o] * x[4 * g2 + 1] + Wv[2 * 4 + o] * x[4 * g2 + 2] + Wv[3 * 4 + o] * x[4 * g2 + 3];
                    }
#pragma unroll
                    for (int e = 0; e < 8; ++e) Vt[(vhalf * 8 + e) * SP + vrow] = (bf16_t)(pk2(vreg[e], 0.f) & 0xffffu);
                }
            }
            float sa = gf, sc = gi;
#pragma unroll
            for (int d = 1; d < 64; d <<= 1) { const float ao = __shfl_up(sa, d), co = __shfl_up(sc, d); if (lane >= d) { sc = fmaxf(co + sa, sc); sa = ao + sa; } }
            const float Mi = fmaxf(m_prev + sa, sc);
            const float gtot = __shfl(sa, 63), m_new = __shfl(Mi, 63);
            const float decay = __expf(gtot + m_prev - m_new);
            {
                float Mp = __shfl_up(Mi, 1); if (lane == 0) Mp = m_prev;
                if (w == 0) { tab[lane] = __expf(gf + Mp - Mi); tab[64 + lane] = __expf(gi - Mi); tab[128 + lane] = __expf(-Mi); }
            }
            if (c + 1 < SEQ / 64) {
                const size_t t1 = t0 + 64;
#pragma unroll
                for (int i = 0; i < 4; ++i) xr[i] = *(const u32x4*)(XC + (t1 + srow + 16 * i) * D + h * 256 + scol);
                if (tid < 128) xmr = *(const u32x4*)(XM + (t1 + vrow) * D + h * 256 + vs * 16 + vhalf * 8);
                gi = GATES[(t1 + lane) * 8 + h]; gf = GATES[(t1 + lane) * 8 + 4 + h];
            }
            __syncthreads();
            {
                const int v = tid >> 5, kq = tid & 31, k0 = kq * 8;
                for (int tb = 0; tb < 64; tb += 8) {
                    float acc[8], dp[8];
#pragma unroll
                    for (int u = 0; u < 8; ++u) {
                        const int t = tb + u;
                        const float f = tab[t], ii = tab[64 + t];
                        const float vv = bf1(Vt[v * SP + t]) * ii;
                        float k8[8], q8[8];
                        unpack8(*(const u32x4*)(Ks + t * QP + k0), k8); unpack8(*(const u32x4*)(Qs + t * QP + k0), q8);
                        float a_ = 0.f, d_ = 0.f;
#pragma unroll
                        for (int j = 0; j < 8; ++j) { Ct[j] = f * Ct[j] + vv * k8[j]; a_ += Ct[j] * q8[j]; Nt[j] = f * Nt[j] + ii * k8[j]; d_ += Nt[j] * q8[j]; }
                        acc[u] = a_; dp[u] = d_;
                    }
#pragma unroll
                    for (int o = 1; o < 32; o <<= 1) {
#pragma unroll
                        for (int u = 0; u < 8; ++u) { acc[u] += __shfl_xor(acc[u], o); dp[u] += __shfl_xor(dp[u], o); }
                    }
                    float hv = 0.f;
#pragma unroll
                    for (int u = 0; u < 8; ++u) { const float h_ = acc[u] / fmaxf(fabsf(dp[u]), tab[128 + tb + u]); if (kq == u) hv = h_; }
                    if (kq < 8) HM[((size_t)(bh * 16 + vs) * SEQ + (size_t)c * 64 + tb + kq) * 16 + v] = (bf16_t)(pk2(hv, 0.f) & 0xffffu);
                }
            }
            __syncthreads();
            m_prev = m_new;
            __syncthreads();
        }
    }
}

__device__ __forceinline__ void p7_mlstm_fin(const Args& a) {
    unsigned char* ws = a.ws; const int tid = opaque_tid(), lane = tid & 63, wave = tid >> 6;
    const int gw = blockIdx.x * 8 + wave, NGW = gridDim.x * 8;
    const bf16_t* HM = (const bf16_t*)(ws + WS_XB); const bf16_t* XC = (const bf16_t*)(ws + WS_XC); bf16_t* ZM = (bf16_t*)(ws + WS_ZM);
    float lnw[16], skp[16];
#pragma unroll
    for (int j = 0; j < 4; ++j) { const f32x4 p = *(const f32x4*)(a.in[I_LNW] + lane * 16 + 4 * j), q = *(const f32x4*)(a.in[I_SKIP] + lane * 16 + 4 * j); for (int e = 0; e < 4; ++e) { lnw[4 * j + e] = p[e]; skp[4 * j + e] = q[e]; } }
    for (int m = gw; m < T; m += NGW) {
        const size_t off = (size_t)m * D + lane * 16;
        float hv[16], xc[16], z[16];
        { const size_t hoff = ((size_t)(((m / SEQ) * 4 + (lane >> 4)) * 16 + (lane & 15)) * SEQ + (size_t)(m % SEQ)) * 16;
          unpack8(*(const u32x4*)(HM + hoff), hv); unpack8(*(const u32x4*)(HM + hoff + 8), hv + 8); }
        unpack8(*(const u32x4*)(XC + off), xc); unpack8(*(const u32x4*)(XC + off + 8), xc + 8);
        unpack8(*(const u32x4*)(ZM + off), z); unpack8(*(const u32x4*)(ZM + off + 8), z + 8);
        float s = 0.f;
#pragma unroll
        for (int e = 0; e < 16; ++e) s += hv[e];
        s += __shfl_xor(s, 1); s += __shfl_xor(s, 2); s += __shfl_xor(s, 4); s += __shfl_xor(s, 8);
        const float mu = s * (1.0f / 256.0f); float q = 0.f;
#pragma unroll
        for (int e = 0; e < 16; ++e) { hv[e] -= mu; q += hv[e] * hv[e]; }
        q += __shfl_xor(q, 1); q += __shfl_xor(q, 2); q += __shfl_xor(q, 4); q += __shfl_xor(q, 8);
        const float rstd = rsqrtf(q * (1.0f / 256.0f) + EPS);
        float o[16], ss = 0.f;
#pragma unroll
        for (int e = 0; e < 16; ++e) { o[e] = (hv[e] * rstd * lnw[e] + skp[e] * xc[e]) * siluf_(z[e]); ss += o[e] * o[e]; }
        ss = wave_sum(ss);
        const float rs = rsqrtf(ss * (1.0f / 1024.0f) + EPS);
#pragma unroll
        for (int e = 0; e < 16; ++e) o[e] *= rs;
        *(u32x4*)(ZM + off) = pack8(o); *(u32x4*)(ZM + off + 8) = pack8(o + 8);
    }
}
__device__ __forceinline__ void p7_rg_fin(const Args& a, unsigned char* lds) {
    unsigned char* ws = a.ws; const int tid = opaque_tid();
    unsigned* LOGA = (unsigned*)(ws + WS_XR); const unsigned* U = (const unsigned*)(ws + WS_U); const unsigned* YR = (const unsigned*)(ws + WS_YR); const float* AGG = (const float*)(ws + WS_AGG);
    float* Ot = (float*)lds;
    constexpr int OP = 1028;
    for (int tile = blockIdx.x; tile < 256; tile += gridDim.x) {
        const int tc = tile & 63, tb = tile & ~63;
        float h0 = 0.f, h1 = 0.f;
        for (int p = 0; p < tc; ++p) { const f32x4 g = *(const f32x4*)(AGG + ((size_t)(tb + p) * 1024 + 2 * tid) * 2); h0 = __expf(g[0]) * h0 + g[1]; h1 = __expf(g[2]) * h1 + g[3]; }
        const size_t row0 = (size_t)tile * 128;
        for (int i0 = 0; i0 < 128; i0 += 16) {
            unsigned la[16], uu[16], yy[16];
#pragma unroll
            for (int i = 0; i < 16; ++i) { const size_t o = (row0 + i0 + i) * 512 + tid; la[i] = LOGA[o]; uu[i] = U[o]; yy[i] = YR[o]; }
            __syncthreads();
#pragma unroll
            for (int i = 0; i < 16; ++i) {
                h0 = __expf(bflo(la[i])) * h0 + bflo(uu[i]); h1 = __expf(bfhi(la[i])) * h1 + bfhi(uu[i]);
                Ot[i * OP + 2 * tid] = h0 * geluf_(bflo(yy[i])); Ot[i * OP + 2 * tid + 1] = h1 * geluf_(bfhi(yy[i]));
            }
            __syncthreads();
            {
                const int row = tid >> 5, sub = tid & 31;
                f32x4 v[4][2]; float ss = 0.f;
#pragma unroll
                for (int q = 0; q < 4; ++q)
#pragma unroll
                    for (int hh = 0; hh < 2; ++hh) { v[q][hh] = *(const f32x4*)(Ot + row * OP + q * 256 + sub * 8 + hh * 4); const f32x4 t = v[q][hh]; ss += (t[0] * t[0] + t[1] * t[1]) + (t[2] * t[2] + t[3] * t[3]); }
                ss += __shfl_xor(ss, 1); ss += __shfl_xor(ss, 2); ss += __shfl_xor(ss, 4); ss += __shfl_xor(ss, 8); ss += __shfl_xor(ss, 16);
                const float rs = rsqrtf(ss * (1.0f / 1024.0f) + EPS);
                bf16_t* orow = (bf16_t*)LOGA + (row0 + i0 + row) * D;
#pragma unroll
                for (int q = 0; q < 4; ++q) { const f32x4 p = v[q][0] * rs, r = v[q][1] * rs; u32x4 wv; wv.x = pk2(p[0], p[1]); wv.y = pk2(p[2], p[3]); wv.z = pk2(r[0], r[1]); wv.w = pk2(r[2], r[3]); *(u32x4*)(orow + q * 256 + sub * 8) = wv; }
            }
        }
        __syncthreads();
    }
}

__device__ __forceinline__ void p11_final(const Args& a) {
    const int tid = opaque_tid(), lane = tid & 63, wave = tid >> 6;
    const int gw = blockIdx.x * 8 + wave, NGW = gridDim.x * 8;
    const float* SS = (const float*)(a.ws + WS_SSD); const float* gn = a.in[I_NFIN];
    f32x4 g[4];
#pragma unroll
    for (int j = 0; j < 4; ++j) g[j] = *((const f32x4*)gn + lane + 64 * j);
    for (int m = gw; m < T; m += NGW) {
        const float rs = pg8::row_scale(SS, m);
        f32x4* xr = (f32x4*)(a.out + (size_t)m * D) + lane;
#pragma unroll
        for (int j = 0; j < 4; ++j) { f32x4 v = xr[64 * j]; v = v * rs * g[j]; xr[64 * j] = v; }
    }
}


#define XB_TMO      128
#define XB_XCNT(j)  (256  + 64 * (j))
#define XB_XSUB(j)  (1280 + 64 * (j))
#define XB_XGEN(j)  (2304 + 64 * (j))
#define XB_TOP      3328
#define XB_TOPGEN   3392
#define XCD_BAR_WORDS 3456
#define XB_SPIN_CAP (1u << 18)
__device__ __forceinline__ unsigned xb_ld(unsigned* p)              { return __hip_atomic_load(p, __ATOMIC_RELAXED, __HIP_MEMORY_SCOPE_AGENT); }
__device__ __forceinline__ unsigned xb_add(unsigned* p, unsigned v) { return __hip_atomic_fetch_add(p, v, __ATOMIC_RELAXED, __HIP_MEMORY_SCOPE_AGENT); }
__device__ __forceinline__ unsigned xb_xcc_id() { return (unsigned)__builtin_amdgcn_s_getreg((3 << 11) | 20) & 0xFu; }
#define XB_SPIN(cond, bar) do { unsigned _sp = 0; while (cond) { __builtin_amdgcn_s_sleep(1); \
    if ((++_sp & 255u) == 0u) { if (xb_ld(&(bar)[XB_TMO])) break; if (_sp > XB_SPIN_CAP) { atomicAdd(&(bar)[XB_TMO], 1u); break; } } } } while (0)
struct XcdBarrier { unsigned* bar; unsigned x; volatile LAS unsigned* st; };
__device__ __forceinline__ XcdBarrier xcd_barrier_post(unsigned* bar, volatile LAS unsigned* st) {
    XcdBarrier b; b.bar = bar; b.x = xb_xcc_id(); b.st = st;
    if (threadIdx.x == 0) (void)xb_add(&bar[XB_XCNT(b.x)], 1u);
    return b;
}
__device__ __forceinline__ void xcd_barrier_complete(unsigned* bar, unsigned x, unsigned& nloc, unsigned& nx) {
    const unsigned G = gridDim.x * gridDim.y * gridDim.z;
    unsigned sum, cnt, mine, sp = 0u;
    for (;;) {
        sum = 0u; cnt = 0u; mine = 0u;
#pragma unroll
        for (unsigned j = 0; j < 16; ++j) { const unsigned c = xb_ld(&bar[XB_XCNT(j)]); sum += c; cnt += (c > 0u) ? 1u : 0u; mine = (j == x) ? c : mine; }
        if (sum == G) break;
        __builtin_amdgcn_s_sleep(1);
        if ((++sp & 255u) == 0u) { if (xb_ld(&bar[XB_TMO])) break; if (sp > XB_SPIN_CAP) { atomicAdd(&bar[XB_TMO], 1u); break; } }
    }
    nloc = mine > 0u ? mine : 1u; nx = cnt > 0u ? cnt : 1u;
}
__device__ __forceinline__ void xcd_barrier(const XcdBarrier& b) {
    asm volatile("s_waitcnt vmcnt(0)" ::: "memory");
    __syncthreads();
    if (threadIdx.x == 0) {
        unsigned* bar = b.bar;
        __builtin_amdgcn_s_waitcnt(0);
        unsigned nloc = b.st[0], nx = b.st[1];
        if (nloc == 0u) { xcd_barrier_complete(bar, b.x, nloc, nx); b.st[0] = nloc; b.st[1] = nx; }
        const unsigned old = xb_add(&bar[XB_XSUB(b.x)], 1u);
        const unsigned gen = old / nloc;
        if (old + 1u == (gen + 1u) * nloc) {
            __builtin_amdgcn_fence(__ATOMIC_RELEASE, "agent");
            asm volatile("s_waitcnt vmcnt(0)" ::: "memory");
            const unsigned og = xb_add(&bar[XB_TOP], 1u);
            const unsigned tg = og / nx;
            if (og + 1u == (tg + 1u) * nx) xb_add(&bar[XB_TOPGEN], 1u);
            else XB_SPIN(xb_ld(&bar[XB_TOPGEN]) == tg, bar);
            __builtin_amdgcn_fence(__ATOMIC_ACQUIRE, "agent");
            xb_add(&bar[XB_XGEN(b.x)], 1u);
            asm volatile("s_waitcnt vmcnt(0)" ::: "memory");
        } else {
            XB_SPIN(xb_ld(&bar[XB_XGEN(b.x)]) == gen, bar);
            __builtin_amdgcn_fence(__ATOMIC_ACQUIRE, "agent");
            asm volatile("s_waitcnt vmcnt(0)" ::: "memory");
        }
    }
    __syncthreads();
}
#define GSYNC() xcd_barrier(xbar)
__global__ void __launch_bounds__(512, 2) mk_fwd(Args args) {
    extern __shared__ __attribute__((aligned(16))) unsigned char lds_raw[];
    cg::grid_group grid = cg::this_grid();
    LAS unsigned char* lds = (LAS unsigned char*)lds_raw;
    unsigned char* ws = args.ws;
    const int G = gridDim.x, bid = blockIdx.x;
    volatile LAS unsigned* xst = (volatile LAS unsigned*)(lds + (LDS_BYTES - 64));
    if (threadIdx.x == 0) { xst[0] = 0u; xst[1] = 0u; }
    __syncthreads();
    const XcdBarrier xbar = xcd_barrier_post((unsigned*)(ws + WS_BAR), xst);
    bf16_t* XB = (bf16_t*)(ws + WS_XB); bf16_t* ACT = (bf16_t*)(ws + WS_R1);
#ifndef NO_P0
    p0_prologue(args, lds_raw);
#endif
    asm volatile("s_waitcnt vmcnt(0)" ::: "memory"); __threadfence(); grid.sync();
#ifndef NO_P1
    { const pg8::Gemm gUp1{XB, (const bf16_t*)(ws + WS_WGU1), 1024, 1024, 1 << 30, 0, 0, 0}; pg8::StaticOrder S; S.init(T, 2 * FF, G, bid); pg8::EpiSwiGLU E{ACT, (const float*)(ws + WS_SSA)}; pg8::gemm_phase(lds, gUp1, S, E); }
#endif
    GSYNC();
#ifndef NO_P2
    { const pg8::Gemm gDn1{ACT, (const bf16_t*)(ws + WS_WD1), FF, FF, 1 << 30, 0, 0, 0}; pg8::StaticOrder S; S.init(T, D, G, bid); pg8::EpiResid E{args.in[I_X], args.out, XB, (float*)(ws + WS_SSB), 0.5f}; pg8::gemm_phase(lds, gDn1, S, E); }
#endif
    GSYNC();
#ifndef NO_P3
    { const pg8::Gemm gIn{XB, (const bf16_t*)(ws + WS_WIN), 1024, 1024, 1 << 30, 0, 0, 0}; pg8::StaticOrder S; S.init(T, 4096, G, bid); pg8::EpiProj E{(bf16_t*)(ws + WS_XM), (const float*)(ws + WS_SSB)}; pg8::gemm_phase(lds, gIn, S, E); }
#endif
    GSYNC();
#ifndef NO_P4
    p4_conv(args);
#endif
    GSYNC();
#ifndef NO_P5
    {
        const pg8::Gemm gRg{XB  , (const bf16_t*)(ws + WS_WRG), 256, 1024, 1 << 30, 0, 1, 512};
        const pg8::Gemm gGt{(const bf16_t*)(ws + WS_XC), (const bf16_t*)(ws + WS_WG8), 2048, 1024, 16, (long)WS_XM - (long)WS_XC - 16 * 128, 0, 0};
        pg8::EpiGates Eg{(float*)(ws + WS_GATES), args.in[I_BGATES]};
        pg8::EpiRg Er{XB, args.in[I_RBA], args.in[I_RBX], (const float*)(ws + WS_C8), (bf16_t*)(ws + WS_XR), (bf16_t*)(ws + WS_U)};
        if (G == 256) {
#ifndef NO_P5G
            if (bid < 128) { pg8::ListOrder S{bid, 1, 0}; pg8::gemm_phase(lds, gGt, S, Eg); }
#endif
#ifndef NO_P5R
            if (bid >= 128) { pg8::ListOrder S{(bid - 128) * 8, 8, 3}; pg8::gemm_phase(lds, gRg, S, Er); }
#endif
        } else {
#ifndef NO_P5G
            for (int u = bid; u < 128; u += G) { pg8::ListOrder S{u, 1, 0}; pg8::gemm_phase(lds, gGt, S, Eg); }
#endif
#ifndef NO_P5R
            for (int u = bid; u < 128; u += G) { pg8::ListOrder S{u * 8, 8, 3}; pg8::gemm_phase(lds, gRg, S, Er); }
#endif
        }
    }
#endif
    GSYNC();
#ifndef NO_P6A
    p6_rg_agg(args);
#endif
    p5b_sraw(args, lds_raw);
    GSYNC();
#ifndef NO_P6
    p6_mlstm(args, lds_raw);
#endif
    GSYNC();
#ifndef NO_P7A
    p7_mlstm_fin(args);
#endif
#ifndef NO_P7B
    p7_rg_fin(args, lds_raw);
#endif
    GSYNC();
#ifndef NO_P8
    { const pg8::Gemm gOut{(const bf16_t*)(ws + WS_ZM)  , (const bf16_t*)(ws + WS_WOUT), 2048, 1024, 16, (long)(64 * MiB) - 16 * 128, 0, 0}; pg8::StaticOrder S; S.init(T, D, G, bid); pg8::EpiResid E{args.out, args.out, XB, (float*)(ws + WS_SSC), 1.0f}; pg8::gemm_phase(lds, gOut, S, E); }
#endif
    GSYNC();
#ifndef NO_P9
    { const pg8::Gemm gUp2{XB, (const bf16_t*)(ws + WS_WGU2), 1024, 1024, 1 << 30, 0, 0, 0}; pg8::StaticOrder S; S.init(T, 2 * FF, G, bid); pg8::EpiSwiGLU E{ACT, (const float*)(ws + WS_SSC)}; pg8::gemm_phase(lds, gUp2, S, E); }
#endif
    GSYNC();
#ifndef NO_P10
    { const pg8::Gemm gDn2{ACT, (const bf16_t*)(ws + WS_WD2), FF, FF, 1 << 30, 0, 0, 0}; pg8::StaticOrder S; S.init(T, D, G, bid); pg8::EpiResid E{args.out, args.out, nullptr, (float*)(ws + WS_SSD), 0.5f}; pg8::gemm_phase(lds, gDn2, S, E); }
#endif
    GSYNC();
#ifndef NO_P11
    p11_final(args);
#endif
}

extern "C" void kernel_launch(void* const* d_in, const int* in_sizes, int n_in, void* d_out, int out_size, void* d_ws, size_t ws_size, hipStream_t stream) {
    static int grid = 0;
    if (grid == 0) {
        if (n_in != 31 || in_sizes[0] != T * D || out_size != T * D || ws_size < WS_END) { fprintf(stderr, "kernel_launch: unexpected shapes (n_in %d, in0 %d, out %d, ws %zu)\n", n_in, n_in > 0 ? in_sizes[0] : -1, out_size, ws_size); grid = -1; return; }
        int dev = 0, cus = 0, per_cu = 0;
        if (hipGetDevice(&dev) != hipSuccess || hipDeviceGetAttribute(&cus, hipDeviceAttributeMultiprocessorCount, dev) != hipSuccess) { grid = -1; return; }
        if (hipFuncSetAttribute((const void*)mk_fwd, hipFuncAttributeMaxDynamicSharedMemorySize, LDS_BYTES) != hipSuccess) { fprintf(stderr, "kernel_launch: hipFuncSetAttribute failed\n"); grid = -1; return; }
        if (hipOccupancyMaxActiveBlocksPerMultiprocessor(&per_cu, (const void*)mk_fwd, 512, LDS_BYTES) != hipSuccess || per_cu < 1) { fprintf(stderr, "kernel_launch: occupancy query says %d\n", per_cu); (void)hipGetLastError(); grid = -1; return; }
        grid = cus;
    }
    if (grid < 0) return;
    if (hipMemsetAsync((char*)d_ws + WS_BAR, 0, 16384, stream) != hipSuccess) { fprintf(stderr, "kernel_launch: memset of barrier words failed\n"); return; }
    Args a{};
    for (int i = 0; i < 31; ++i) a.in[i] = (const float*)d_in[i];
    a.out = (float*)d_out; a.ws = (unsigned char*)d_ws;
    void* kargs[] = {&a};
    hipError_t e = hipLaunchCooperativeKernel((const void*)mk_fwd, dim3(grid), dim3(512), kargs, LDS_BYTES, stream);
    if (e != hipSuccess) fprintf(stderr, "kernel_launch: cooperative launch failed: %s (grid %d)\n", hipGetErrorString(e), grid);
}
```

```cpp
#include <hip/hip_runtime.h>
#include <hip/hip_cooperative_groups.h>
#include <cstdio>
#include <cstdint>
namespace cg = cooperative_groups;

#define LAS __attribute__((address_space(3)))
typedef unsigned short bf16_t;
typedef short bf16x8 __attribute__((ext_vector_type(8)));
typedef float f32x4 __attribute__((ext_vector_type(4)));
typedef unsigned u32x4 __attribute__((ext_vector_type(4)));
typedef unsigned u32x2 __attribute__((ext_vector_type(2)));

constexpr int T = 32768, D = 1024, FF = 2816, SEQ = 8192, NB = 4;
constexpr float EPS = 1e-6f;
constexpr size_t MiB = 1u << 20;
constexpr size_t WS_SSA = 0, WS_SSB = 2 * MiB, WS_SSC = 4 * MiB, WS_SSD = 6 * MiB;
constexpr size_t WS_GATES = 8 * MiB;
constexpr size_t WS_AGG = 9 * MiB;
constexpr size_t WS_BAR = 14 * MiB;
constexpr size_t WS_C8 = 12 * MiB;
constexpr size_t WS_WG8 = 11 * MiB;
constexpr size_t WS_WGU1 = 16 * MiB;
constexpr size_t WS_WD1 = WS_WGU1 + 11 * MiB;
constexpr size_t WS_WIN = WS_WD1 + 11 * MiB / 2;
constexpr size_t WS_WRG = WS_WIN + 8 * MiB;
constexpr size_t WS_WOUT = WS_WRG + 1 * MiB;
constexpr size_t WS_WGU2 = WS_WOUT + 4 * MiB;
constexpr size_t WS_WD2 = WS_WGU2 + 11 * MiB;
constexpr size_t WS_XB = 64 * MiB;
constexpr size_t WS_R1 = 128 * MiB;
constexpr size_t WS_XM = WS_R1, WS_ZM = WS_R1 + 64 * MiB, WS_XR = WS_R1 + 128 * MiB, WS_YR = WS_R1 + 192 * MiB;
constexpr size_t WS_XC = 384 * MiB;
constexpr size_t WS_U = 448 * MiB;
constexpr size_t WS_END = 512 * MiB;
constexpr int LDS_BYTES = 147456;

typedef float f32x2_t __attribute__((ext_vector_type(2)));
typedef __bf16 bf16x2_t __attribute__((ext_vector_type(2)));
__device__ __forceinline__ unsigned pk2(float lo, float hi) { const f32x2_t v = {lo, hi}; const bf16x2_t b = __builtin_convertvector(v, bf16x2_t); return __builtin_bit_cast(unsigned, b); }
__device__ __forceinline__ float bflo(unsigned u) { return __uint_as_float(u << 16); }
__device__ __forceinline__ float bfhi(unsigned u) { return __uint_as_float(u & 0xffff0000u); }
__device__ __forceinline__ float bf1(bf16_t u) { return __uint_as_float(((unsigned)u) << 16); }
__device__ __forceinline__ void unpack8(const u32x4 v, float* x) { x[0] = bflo(v.x); x[1] = bfhi(v.x); x[2] = bflo(v.y); x[3] = bfhi(v.y); x[4] = bflo(v.z); x[5] = bfhi(v.z); x[6] = bflo(v.w); x[7] = bfhi(v.w); }
__device__ __forceinline__ u32x4 pack8(const float* x) { u32x4 o; o.x = pk2(x[0], x[1]); o.y = pk2(x[2], x[3]); o.z = pk2(x[4], x[5]); o.w = pk2(x[6], x[7]); return o; }
__device__ __forceinline__ float sigmoidf_(float x) { return __builtin_amdgcn_rcpf(1.0f + __expf(-x)); }
__device__ __forceinline__ float siluf_(float x) { return x * __builtin_amdgcn_rcpf(1.0f + __expf(-x)); }
__device__ __forceinline__ float logsigf_(float x) { return fminf(x, 0.f) - __logf(1.0f + __expf(-fabsf(x))); }
__device__ __forceinline__ float logsig_acc_(float x) { return fminf(x, 0.f) - log1pf(expf(-fabsf(x))); }
__device__ __forceinline__ float geluf_(float x) { const float u = 0.7978845608028654f * (x + 0.044715f * x * x * x); const float t = 1.0f - 2.0f * __builtin_amdgcn_rcpf(1.0f + __expf(2.0f * u)); return 0.5f * x * (1.0f + t); }
__device__ __forceinline__ int opaque_tid() { int t = threadIdx.x; asm volatile("" : "+v"(t)); return t; }
__device__ __forceinline__ float wave_sum(float v) {
#pragma unroll
    for (int o = 1; o < 64; o <<= 1) v += __shfl_xor(v, o);
    return v;
}

namespace pg8 {
constexpr int BM = 256, BK = 64, HALF = 128, HTB = HALF * BK * 2, STAGE_BYTES = 8 * HTB, NXCD = 8, WGM = 8;
__host__ __device__ __forceinline__ int lds_byte(int r, int c) { const int st = (r >> 4) * 2 + (c >> 5), rr = r & 15, cc = c & 31, ob = rr * 64 + cc * 2; return st * 1024 + (ob ^ (((ob >> 9) & 1) << 5)); }
__host__ __device__ __forceinline__ void stage_rc(int b, int& R, int& C) { const int st = b / 1024, sb = b % 1024, swz = sb ^ (((sb >> 9) & 1) << 5); R = (st >> 1) * 16 + swz / 64; C = (st & 1) * 32 + (swz % 64) / 2; }
__host__ __device__ __forceinline__ int perm32(int rho) { const int n = rho >> 4, i = rho & 15; return 8 * (i >> 2) + 4 * n + (i & 3); }

struct Unit { int pm, pn; };
struct Gemm { const bf16_t* A; const bf16_t* Bt; int K; int lda; int ksplit; long kdelta; int a_pn_shift; int a_pn_bytes; };

struct StaticOrder {
    int nM, nN, nwg, G, c;
    __device__ void init(int M, int N, int G_, int c_) { nM = M / BM; nN = N / BM; nwg = nM * nN; G = G_; c = c_; }
    __device__ bool next(int i, Unit& u) const {
        const long L = (long)i * G + c; if (L >= nwg) return false;
        int wgid = (int)L; { const int q = nwg / NXCD, r = nwg % NXCD, xcd = wgid % NXCD, off = wgid / NXCD; wgid = (xcd < r ? xcd * (q + 1) : r * (q + 1) + (xcd - r) * q) + off; }
        const int nig = WGM * nN, gid = wgid / nig, fm = gid * WGM, gsz = (nM - fm) < WGM ? (nM - fm) : WGM;
        u.pm = fm + ((wgid % nig) % gsz); u.pn = (wgid % nig) / gsz; return true;
    }
};
struct ListOrder {
    int first, cnt, nshift;
    __device__ bool next(int i, Unit& u) const { if (i >= cnt) return false; const int L = first + i; u.pm = L >> nshift; u.pn = L & ((1 << nshift) - 1); return true; }
};

__device__ __forceinline__ float row_scale(const float* SS, int r) {
    const f32x4* p = (const f32x4*)(SS + (size_t)r * 16);
    const f32x4 a = p[0], b = p[1], c = p[2], d = p[3];
    const float s = ((a[0] + a[1]) + (a[2] + a[3])) + ((b[0] + b[1]) + (b[2] + b[3])) + ((c[0] + c[1]) + (c[2] + c[3])) + ((d[0] + d[1]) + (d[2] + d[3]));
    return rsqrtf(s * (1.0f / 1024.0f) + EPS);
}

__device__ __forceinline__ void row_scales8(const float* SS, int row0, int fq, float (&rs)[8]) {
    f32x4 v[8];
#pragma unroll
    for (int q = 0; q < 8; ++q) v[q] = *(const f32x4*)(SS + (size_t)(row0 + (q >> 2) * HALF + (q & 3) * 16) * 16 + fq * 4);
#pragma unroll
    for (int q = 0; q < 8; ++q) { float s = (v[q][0] + v[q][1]) + (v[q][2] + v[q][3]); s += __shfl_xor(s, 16); s += __shfl_xor(s, 32); rs[q] = rsqrtf(s * (1.0f / 1024.0f) + EPS); }
}
struct EpiSwiGLU {
    bf16_t* O; const float* SS;
    __device__ __forceinline__ void operator()(const f32x4 (&acc)[2][2][4][2], const Unit& u, int wr, int wc, int fr, int fq) const {
        const int row0 = u.pm * BM + wr * 64 + fr, col0 = u.pn * HALF + wc * 32 + 8 * fq;
        float rs8[8]; row_scales8(SS, row0, fq, rs8);
#pragma unroll
        for (int ai = 0; ai < 2; ++ai)
#pragma unroll
            for (int m = 0; m < 4; ++m) {
                const int r = row0 + ai * HALF + m * 16; const float rs = rs8[ai * 4 + m];
                float o[8];
#pragma unroll
                for (int n = 0; n < 2; ++n)
#pragma unroll
                    for (int j = 0; j < 4; ++j) { const float g = acc[ai][0][m][n][j] * rs, up = acc[ai][1][m][n][j] * rs; o[n * 4 + j] = siluf_(g) * up; }
                *(u32x4*)(O + (size_t)r * FF + col0) = pack8(o);
            }
    }
};
struct EpiResid {
    const float* Xin; float* Xout; bf16_t* XBo; float* SSo; float alpha;
    __device__ __forceinline__ void operator()(const f32x4 (&acc)[2][2][4][2], const Unit& u, int wr, int wc, int fr, int fq) const {
        const int row0 = u.pm * BM + wr * 64 + fr, col0 = u.pn * BM + wc * 32 + 8 * fq;
#pragma unroll
        for (int ai = 0; ai < 2; ++ai)
#pragma unroll
            for (int m = 0; m < 4; ++m) {
                const int r = row0 + ai * HALF + m * 16; float ss = 0.f;
#pragma unroll
                for (int bj = 0; bj < 2; ++bj) {
                    const size_t off = (size_t)r * D + col0 + bj * HALF;
                    const f32x4 x0 = *(const f32x4*)(Xin + off), x1 = *(const f32x4*)(Xin + off + 4);
                    const f32x4 v0 = x0 + acc[ai][bj][m][0] * alpha, v1 = x1 + acc[ai][bj][m][1] * alpha;
                    *(f32x4*)(Xout + off) = v0; *(f32x4*)(Xout + off + 4) = v1;
                    ss += (v0[0] * v0[0] + v0[1] * v0[1]) + (v0[2] * v0[2] + v0[3] * v0[3]) + (v1[0] * v1[0] + v1[1] * v1[1]) + (v1[2] * v1[2] + v1[3] * v1[3]);
                    if (XBo) { u32x4 w; w.x = pk2(v0[0], v0[1]); w.y = pk2(v0[2], v0[3]); w.z = pk2(v1[0], v1[1]); w.w = pk2(v1[2], v1[3]); *(u32x4*)(XBo + off) = w; }
                }
                ss += __shfl_xor(ss, 16); ss += __shfl_xor(ss, 32);
                if (fq == 0) SSo[(size_t)r * 16 + u.pn * 4 + wc] = ss;
            }
    }
};
struct EpiProj {
    bf16_t* O; const float* SS;
    __device__ __forceinline__ void operator()(const f32x4 (&acc)[2][2][4][2], const Unit& u, int wr, int wc, int fr, int fq) const {
        bf16_t* base = O + (size_t)(u.pn >> 2) * ((size_t)T * D);
        const int row0 = u.pm * BM + wr * 64 + fr, col0 = (u.pn & 3) * BM + wc * 32 + 8 * fq;
        float rs8[8]; row_scales8(SS, row0, fq, rs8);
#pragma unroll
        for (int ai = 0; ai < 2; ++ai)
#pragma unroll
            for (int m = 0; m < 4; ++m) {
                const int r = row0 + ai * HALF + m * 16; const float rs = rs8[ai * 4 + m];
#pragma unroll
                for (int bj = 0; bj < 2; ++bj) {
                    const f32x4 v0 = acc[ai][bj][m][0] * rs, v1 = acc[ai][bj][m][1] * rs;
                    u32x4 w; w.x = pk2(v0[0], v0[1]); w.y = pk2(v0[2], v0[3]); w.z = pk2(v1[0], v1[1]); w.w = pk2(v1[2], v1[3]);
                    *(u32x4*)(base + (size_t)r * D + col0 + bj * HALF) = w;
                }
            }
    }
};
__device__ __forceinline__ float neg_expm1_(float x) {
    const float p = -x * (1.0f + x * (0.5f + x * (0.16666667f + x * (0.041666668f + x * 0.0083333338f))));
    const float e = 1.0f - __expf(x);
    return (x > -0.3f) ? p : e;
}
struct EpiRg {
    const bf16_t* XCR; const float* ba; const float* bx; const float* c8t; bf16_t* LOGA; bf16_t* U;
    __device__ __forceinline__ void operator()(const f32x4 (&acc)[2][2][4][2], const Unit& u, int wr, int wc, int fr, int fq) const {
        const int row0 = u.pm * BM + wr * 64 + fr, ch0 = (u.pn >> 1) * 256 + (u.pn & 1) * HALF + wc * 32 + 8 * fq;
#pragma unroll
        for (int n = 0; n < 2; ++n) {
            const int ch = ch0 + 4 * n;
            const f32x4 b_a = *(const f32x4*)(ba + ch), b_x = *(const f32x4*)(bx + ch), c8 = *(const f32x4*)(c8t + ch);
#pragma unroll
            for (int ai = 0; ai < 2; ++ai)
#pragma unroll
                for (int m = 0; m < 4; ++m) {
                    const int r = row0 + ai * HALF + m * 16;
                    const u32x2 xv = *(const u32x2*)(XCR + (size_t)r * D + ch);
                    const float xc[4] = {bflo(xv.x), bfhi(xv.x), bflo(xv.y), bfhi(xv.y)};
                    float la[4], uu[4];
#pragma unroll
                    for (int j = 0; j < 4; ++j) {
                        const float rg = sigmoidf_(acc[ai][0][m][n][j] + b_a[j]), ig = sigmoidf_(acc[ai][1][m][n][j] + b_x[j]);
                        la[j] = c8[j] * rg;
                        uu[j] = __builtin_amdgcn_sqrtf(fmaxf(neg_expm1_(2.0f * la[j]), 0.f)) * (ig * xc[j]);
                    }
                    u32x2 w0, w1; w0.x = pk2(la[0], la[1]); w0.y = pk2(la[2], la[3]); w1.x = pk2(uu[0], uu[1]); w1.y = pk2(uu[2], uu[3]);
                    *(u32x2*)(LOGA + (size_t)r * D + ch) = w0; *(u32x2*)(U + (size_t)r * D + ch) = w1;
                    __builtin_amdgcn_sched_barrier(0);
                }
        }
    }
};
struct EpiGates {
    float* G; const float* bg;
    __device__ __forceinline__ void operator()(const f32x4 (&acc)[2][2][4][2], const Unit& u, int wr, int wc, int fr, int fq) const {
        if (wc != 0 || fq != 0) return;
        const int row0 = u.pm * BM + wr * 64 + fr;
        const f32x4 b0 = *(const f32x4*)(bg), b1 = *(const f32x4*)(bg + 4);
#pragma unroll
        for (int ai = 0; ai < 2; ++ai)
#pragma unroll
            for (int m = 0; m < 4; ++m) {
                const int r = row0 + ai * HALF + m * 16;
                f32x4 v0 = acc[ai][0][m][0] + b0, v1 = acc[ai][0][m][1] + b1;
                for (int j = 0; j < 4; ++j) v1[j] = logsigf_(v1[j]);
                *(f32x4*)(G + (size_t)r * 8) = v0; *(f32x4*)(G + (size_t)r * 8 + 4) = v1;
            }
    }
};

template <class Epi, class Sched>
__device__ __forceinline__ void gemm_phase(LAS unsigned char* lds, const Gemm g, const Sched& S, const Epi& E) {
    const int tid = opaque_tid(), wid = __builtin_amdgcn_readfirstlane(tid >> 6), lane = tid & 63, wr = wid >> 2, wc = wid & 3, fr = lane & 15, fq = lane >> 4;
    const int K = g.K, nt = K / BK, lda = g.lda;
    unsigned voffA[2], voffB[2];
#pragma unroll
    for (int i = 0; i < 2; ++i) { int R, C; stage_rc(tid * 16 + i * 8192, R, C); const int Rb = (R & ~31) + perm32(R & 31);
        voffA[i] = (unsigned)(R * lda + C) * 2u; voffB[i] = (unsigned)(Rb * K + C) * 2u; }
    const size_t kstep = (size_t)(BK * 2);
    const size_t hstepA = (size_t)HALF * lda * 2, tstepA = 2 * hstepA;
    const size_t hstepB = (size_t)HALF * K * 2, tstepB = 2 * hstepB;
    const unsigned ldsw = (unsigned)wid * 1024u;
    const int aoff = lds_byte(wr * 64 + fr, fq * 8), boff = lds_byte(wc * 32 + fr, fq * 8);
    const int ksplit = g.ksplit; const long kdelta = g.kdelta;
#define PG8_AK(t) ((long)(t) * (long)kstep + (((t) >= ksplit) ? kdelta : 0l))
#define PG8_SA(b, h) (((b) * 2 + (h)) * HTB)
#define PG8_SB(b, h) ((4 + (b) * 2 + (h)) * HTB)
#define PG8_STAGE(bufoff, gbase, voff) do { _Pragma("unroll") for (int _i = 0; _i < 2; ++_i) \
        __builtin_amdgcn_global_load_lds((const unsigned*)((const char*)(gbase) + (voff)[_i]), (LAS unsigned*)(lds + (bufoff) + ldsw + _i * 8192), 16, 0, 0); } while (0)
#define PG8_LDA(dst, b, h) do { _Pragma("unroll") for (int m = 0; m < 4; ++m) _Pragma("unroll") for (int k = 0; k < 2; ++k) dst[m][k] = *(const LAS bf16x8*)(lds + PG8_SA(b, h) + aoff + m * 2048 + k * 1024); } while (0)
#define PG8_LDB(dst, b, h) do { _Pragma("unroll") for (int n = 0; n < 2; ++n) _Pragma("unroll") for (int k = 0; k < 2; ++k) dst[n][k] = *(const LAS bf16x8*)(lds + PG8_SB(b, h) + boff + n * 2048 + k * 1024); } while (0)
#define PG8_MMA(ai, bj, At, Bt) do { __builtin_amdgcn_s_setprio(1); _Pragma("unroll") for (int m = 0; m < 4; ++m) _Pragma("unroll") for (int n = 0; n < 2; ++n) _Pragma("unroll") for (int k = 0; k < 2; ++k) \
        acc[ai][bj][m][n] = __builtin_amdgcn_mfma_f32_16x16x32_bf16(Bt[n][k], At[m][k], acc[ai][bj][m][n], 0, 0, 0); __builtin_amdgcn_s_setprio(0); } while (0)
#define PG8_WAIT_V(n) asm volatile("s_waitcnt vmcnt(" #n ")" ::: "memory")
#define PG8_WAIT_L(n) asm volatile("s_waitcnt lgkmcnt(" #n ")" ::: "memory")
#define PG8_BAR __builtin_amdgcn_s_barrier()
#define PG8_SCHED __builtin_amdgcn_sched_barrier(0)
    Unit cur, nxt; int ui = 0;
    if (!S.next(0, cur)) return;
    f32x4 acc[2][2][4][2];
#pragma unroll
    for (int a = 0; a < 2; ++a)
#pragma unroll
        for (int b = 0; b < 2; ++b)
#pragma unroll
            for (int m = 0; m < 4; ++m)
#pragma unroll
                for (int n = 0; n < 2; ++n) acc[a][b][m][n] = (f32x4){0.f, 0.f, 0.f, 0.f};
    bf16x8 At[4][2], B0[2][2], B1[2][2];
    const char* cA = (const char*)g.A + (size_t)cur.pm * tstepA + (size_t)(cur.pn >> g.a_pn_shift) * g.a_pn_bytes;
    const char* cB = (const char*)g.Bt + (size_t)cur.pn * tstepB;
    {
        PG8_STAGE(PG8_SB(0, 0), cB, voffB); PG8_STAGE(PG8_SB(0, 1), cB + hstepB, voffB); PG8_STAGE(PG8_SA(0, 0), cA, voffA); PG8_STAGE(PG8_SA(0, 1), cA + hstepA, voffA);
        if (wr == 1) PG8_BAR;
        PG8_WAIT_V(2); PG8_BAR;
        PG8_STAGE(PG8_SB(1, 0), cB + kstep, voffB); PG8_STAGE(PG8_SA(1, 0), cA + PG8_AK(1), voffA); PG8_STAGE(PG8_SB(1, 1), cB + hstepB + kstep, voffB);
        PG8_WAIT_V(6); PG8_BAR;
    }
    for (;;) {
        const bool has_next = S.next(ui + 1, nxt);
        const char* nA = has_next ? (const char*)g.A + (size_t)nxt.pm * tstepA + (size_t)(nxt.pn >> g.a_pn_shift) * g.a_pn_bytes : cA;
        const char* nB = has_next ? (const char*)g.Bt + (size_t)nxt.pn * tstepB : cB;
#pragma nounroll
        for (int t = 0; t < nt; t += 2) {
            const bool last = (t == nt - 2);
            const char* a1 = cA + PG8_AK(t + 1);
            const char* a2 = last ? nA : cA + PG8_AK(t + 2); const char* b2 = last ? nB : cB + (size_t)(t + 2) * kstep;
            const char* a3 = last ? nA + PG8_AK(1) : cA + PG8_AK(t + 3); const char* b3 = b2 + kstep;
            PG8_LDB(B0, 0, 0); PG8_LDB(B1, 0, 1); PG8_SCHED; PG8_LDA(At, 0, 0); PG8_STAGE(PG8_SA(1, 1), a1 + hstepA, voffA);
            PG8_WAIT_V(8); PG8_WAIT_L(0); PG8_BAR; PG8_MMA(0, 0, At, B0); PG8_MMA(0, 1, At, B1); PG8_BAR; PG8_SCHED;
            PG8_LDA(At, 0, 1); PG8_STAGE(PG8_SB(0, 0), b2, voffB); PG8_STAGE(PG8_SB(0, 1), b2 + hstepB, voffB); PG8_STAGE(PG8_SA(0, 0), a2, voffA);
            PG8_WAIT_V(8); PG8_WAIT_L(0); PG8_BAR; PG8_MMA(1, 0, At, B0); PG8_MMA(1, 1, At, B1); PG8_BAR; PG8_SCHED;
            PG8_LDB(B0, 1, 0); PG8_LDB(B1, 1, 1); PG8_SCHED; PG8_LDA(At, 1, 0); PG8_STAGE(PG8_SA(0, 1), a2 + hstepA, voffA);
            PG8_WAIT_V(8); PG8_WAIT_L(0); PG8_BAR; PG8_MMA(0, 0, At, B0); PG8_MMA(0, 1, At, B1); PG8_BAR; PG8_SCHED;
            PG8_LDA(At, 1, 1); PG8_STAGE(PG8_SB(1, 0), b3, voffB); PG8_STAGE(PG8_SB(1, 1), b3 + hstepB, voffB); PG8_STAGE(PG8_SA(1, 0), a3, voffA);
            PG8_WAIT_V(8); PG8_WAIT_L(0); PG8_BAR; PG8_MMA(1, 0, At, B0); PG8_MMA(1, 1, At, B1); PG8_BAR; PG8_SCHED;
        }
        if (wr == 0) PG8_BAR;
        E(acc, cur, wr, wc, fr, fq);
        if (!has_next) break;
#pragma unroll
        for (int a = 0; a < 2; ++a)
#pragma unroll
            for (int b = 0; b < 2; ++b)
#pragma unroll
                for (int m = 0; m < 4; ++m)
#pragma unroll
                    for (int n = 0; n < 2; ++n) acc[a][b][m][n] = (f32x4){0.f, 0.f, 0.f, 0.f};
        cur = nxt; cA = nA; cB = nB; ++ui;
        if (wr == 1) PG8_BAR;
    }
    PG8_WAIT_V(0);
    PG8_BAR;
#undef PG8_AK
#undef PG8_SA
#undef PG8_SB
#undef PG8_STAGE
#undef PG8_LDA
#undef PG8_LDB
#undef PG8_MMA
#undef PG8_WAIT_V
#undef PG8_WAIT_L
#undef PG8_BAR
#undef PG8_SCHED
}
}

struct Args { const float* in[31]; float* out; unsigned char* ws; };
enum { I_X = 0, I_NF1, I_WG1, I_WU1, I_WD1, I_NMIX, I_WIN, I_MCW, I_MCB, I_WQ, I_WK, I_WV, I_WGATES, I_BGATES, I_LNW, I_SKIP, I_RCW, I_RCB, I_RWA, I_RBA, I_RWX, I_RBX, I_LAM,
       I_ONM, I_ONR, I_WOUT, I_NF2, I_WG2, I_WU2, I_WD2, I_NFIN };

template <class F> __device__ __forceinline__ void tr_item(F src, int K, bf16_t* WT, float* scr, int item, int nblk, int lane) {
    const int kb = item / nblk, nb = item % nblk, k0 = 64 * kb, n0 = 32 * nb;
#pragma unroll 8
    for (int i = 0; i < 32; ++i) { const int kk = 2 * i + (lane >> 5); scr[kk * 33 + (lane & 31)] = src(k0 + kk, n0 + (lane & 31)); }
    __builtin_amdgcn_wave_barrier();
    const int c = lane & 7;
#pragma unroll
    for (int j = 0; j < 4; ++j) { const int n = (lane >> 3) + 8 * j; const float* s = scr + (8 * c) * 33 + n;
        u32x4 o; o.x = pk2(s[0 * 33], s[1 * 33]); o.y = pk2(s[2 * 33], s[3 * 33]); o.z = pk2(s[4 * 33], s[5 * 33]); o.w = pk2(s[6 * 33], s[7 * 33]);
        *(u32x4*)(WT + (size_t)(n0 + n) * K + k0 + 8 * c) = o; }
    __builtin_amdgcn_wave_barrier();
}

__device__ __forceinline__ void p0_prologue(const Args& a, unsigned char* lds) {
    const int tid = opaque_tid(), lane = tid & 63, wave = tid >> 6;
    const int gw = blockIdx.x * 8 + wave, NGW = gridDim.x * 8;
    float* scr = (float*)(lds + wave * 16384);
    unsigned char* ws = a.ws;
    constexpr int I1 = 16 * 176, I2 = 44 * 32, I3 = 16 * 128, I4 = 4 * 64, I5 = 32 * 32;
    constexpr int NIT = I1 + I2 + I3 + I4 + I5 + I1 + I2;
    for (int it = gw; it < NIT; it += NGW) {
        int r = it;
        if (r < I1) { const float* wg = a.in[I_WG1]; const float* wu = a.in[I_WU1]; const float* gn = a.in[I_NF1];
            tr_item([=](int k, int n) { const int c = (n >> 8) * 128 + (n & 127); return (((n >> 7) & 1) ? wu : wg)[(size_t)k * FF + c] * gn[k]; }, 1024, (bf16_t*)(ws + WS_WGU1), scr, r, 176, lane); continue; } r -= I1;
        if (r < I2) { const float* wd = a.in[I_WD1];
            tr_item([=](int k, int n) { return wd[(size_t)k * D + n]; }, FF, (bf16_t*)(ws + WS_WD1), scr, r, 32, lane); continue; } r -= I2;
        if (r < I3) { const float* w = a.in[I_WIN]; const float* gn = a.in[I_NMIX];
            tr_item([=](int k, int n) { return w[(size_t)k * 4096 + n] * gn[k]; }, 1024, (bf16_t*)(ws + WS_WIN), scr, r, 128, lane); continue; } r -= I3;
        if (r < I4) { const float* wa = a.in[I_RWA]; const float* wx = a.in[I_RWX];
            tr_item([=](int k, int n) { const int pn = n >> 8, blk = pn >> 1, hh = pn & 1, sel = (n >> 7) & 1, c = hh * 128 + (n & 127); return (sel ? wx : wa)[(size_t)blk * 65536 + (size_t)k * 256 + c]; }, 256, (bf16_t*)(ws + WS_WRG), scr, r, 64, lane); continue; } r -= I4;
        if (r < I5) { const float* w = a.in[I_WOUT]; const float* gm = a.in[I_ONM]; const float* gr = a.in[I_ONR];
            tr_item([=](int k, int n) { return w[(size_t)k * D + n] * (k < 1024 ? gm[k] : gr[k - 1024]); }, 2048, (bf16_t*)(ws + WS_WOUT), scr, r, 32, lane); continue; } r -= I5;
        if (r < I1) { const float* wg = a.in[I_WG2]; const float* wu = a.in[I_WU2]; const float* gn = a.in[I_NF2];
            tr_item([=](int k, int n) { const int c = (n >> 8) * 128 + (n & 127); return (((n >> 7) & 1) ? wu : wg)[(size_t)k * FF + c] * gn[k]; }, 1024, (bf16_t*)(ws + WS_WGU2), scr, r, 176, lane); continue; } r -= I1;
        { const float* wd = a.in[I_WD2];
            tr_item([=](int k, int n) { return wd[(size_t)k * D + n]; }, FF, (bf16_t*)(ws + WS_WD2), scr, r, 32, lane); }
    }
    {
        bf16_t* WG8 = (bf16_t*)(ws + WS_WG8);
        const float* wq = a.in[I_WQ]; const float* wk = a.in[I_WK]; const float* wv = a.in[I_WV]; const float* Wg = a.in[I_WGATES];
        const int gt = blockIdx.x * 512 + tid, NT = gridDim.x * 512;
        for (int e = gt; e < 256 * 2048 / 8; e += NT) {
            const int g = e / 256, k0 = (e % 256) * 8;
            float o[8];
#pragma unroll
            for (int j = 0; j < 8; ++j) {
                float v = 0.f;
                if (g < 8) { const int k = k0 + j, c = k & 1023, n = c >> 2, i = c & 3;
                    if (k < 1024) { for (int oo = 0; oo < 4; ++oo) v += wq[n * 16 + i * 4 + oo] * Wg[(size_t)(4 * n + oo) * 8 + g] + wk[n * 16 + i * 4 + oo] * Wg[(size_t)(1024 + 4 * n + oo) * 8 + g]; }
                    else { for (int oo = 0; oo < 4; ++oo) v += wv[n * 16 + i * 4 + oo] * Wg[(size_t)(2048 + 4 * n + oo) * 8 + g]; } }
                o[j] = v;
            }
            *(u32x4*)(WG8 + (size_t)g * 2048 + k0) = pack8(o);
        }
    }
    if (blockIdx.x == 0) { float* C8 = (float*)(ws + WS_C8); const float* lam = a.in[I_LAM]; for (int e = tid; e < 1024; e += 512) C8[e] = 8.0f * logsig_acc_(lam[e]); }
    {
        const float* x = a.in[I_X]; bf16_t* XB = (bf16_t*)(ws + WS_XB); float* SS = (float*)(ws + WS_SSA);
        for (int m = gw; m < T; m += NGW) {
            const f32x4* xr = (const f32x4*)(x + (size_t)m * D) + lane;
            f32x4 v[4]; float s = 0.f;
#pragma unroll
            for (int j = 0; j < 4; ++j) { v[j] = xr[64 * j]; s += (v[j][0] * v[j][0] + v[j][1] * v[j][1]) + (v[j][2] * v[j][2] + v[j][3] * v[j][3]); }
            s = wave_sum(s);
            u32x2* o8 = (u32x2*)(XB + (size_t)m * D) + lane;
#pragma unroll
            for (int j = 0; j < 4; ++j) { u32x2 w; w.x = pk2(v[j][0], v[j][1]); w.y = pk2(v[j][2], v[j][3]); o8[64 * j] = w; }
            if (lane < 16) SS[(size_t)m * 16 + lane] = (lane == 0) ? s : 0.f;
        }
    }
}

template <bool SILU> __device__ __forceinline__ void conv_part(const bf16_t* in, bf16_t* out, const float* cw, const float* cb, int t0, int c0) {
    float w[4][8], b[8];
#pragma unroll
    for (int tap = 0; tap < 4; ++tap) { const f32x4 p = *(const f32x4*)(cw + tap * D + c0), q = *(const f32x4*)(cw + tap * D + c0 + 4); for (int j = 0; j < 4; ++j) { w[tap][j] = p[j]; w[tap][4 + j] = q[j]; } }
    { const f32x4 p = *(const f32x4*)(cb + c0), q = *(const f32x4*)(cb + c0 + 4); for (int j = 0; j < 4; ++j) { b[j] = p[j]; b[4 + j] = q[j]; } }
    float h0[8], h1[8], h2[8];
    const bool first = (t0 % SEQ) == 0;
    if (first) { for (int j = 0; j < 8; ++j) { h0[j] = 0.f; h1[j] = 0.f; h2[j] = 0.f; } }
    else {
        unpack8(*(const u32x4*)(in + (size_t)(t0 - 3) * D + c0), h0); unpack8(*(const u32x4*)(in + (size_t)(t0 - 2) * D + c0), h1); unpack8(*(const u32x4*)(in + (size_t)(t0 - 1) * D + c0), h2);
    }
    u32x4 cur[8];
#pragma unroll
    for (int i = 0; i < 8; ++i) cur[i] = *(const u32x4*)(in + (size_t)(t0 + i) * D + c0);
#pragma unroll
    for (int i = 0; i < 8; ++i) {
        float x[8], y[8]; unpack8(cur[i], x);
#pragma unroll
        for (int j = 0; j < 8; ++j) { float v = b[j] + w[0][j] * h0[j] + w[1][j] * h1[j] + w[2][j] * h2[j] + w[3][j] * x[j]; y[j] = SILU ? siluf_(v) : v; h0[j] = h1[j]; h1[j] = h2[j]; h2[j] = x[j]; }
        *(u32x4*)(out + (size_t)(t0 + i) * D + c0) = pack8(y);
    }
}
__device__ __forceinline__ void p4_conv(const Args& a) {
    unsigned char* ws = a.ws; const int tid = opaque_tid(), cgp = tid & 127, ts = tid >> 7;
    for (int u = blockIdx.x; u < T / 32; u += gridDim.x) {
        const int t0 = u * 32 + ts * 8, c0 = cgp * 8;
        conv_part<true>((const bf16_t*)(ws + WS_XM), (bf16_t*)(ws + WS_XC), a.in[I_MCW], a.in[I_MCB], t0, c0);
        conv_part<false>((const bf16_t*)(ws + WS_XR), (bf16_t*)(ws + WS_XB), a.in[I_RCW], a.in[I_RCB], t0, c0);
    }
}

__device__ __forceinline__ void p6_rg_agg(const Args& a) {
    unsigned char* ws = a.ws; const int tid = opaque_tid();
    const unsigned* LOGA = (const unsigned*)(ws + WS_XR); const unsigned* U = (const unsigned*)(ws + WS_U); float* AGG = (float*)(ws + WS_AGG);
    for (int tile = blockIdx.x; tile < 256; tile += gridDim.x) {
        const size_t row0 = (size_t)tile * 128;
        float sl0 = 0.f, sl1 = 0.f, h0 = 0.f, h1 = 0.f;
        for (int i0 = 0; i0 < 128; i0 += 16) {
            unsigned la[16], uu[16];
#pragma unroll
            for (int i = 0; i < 16; ++i) { la[i] = LOGA[(row0 + i0 + i) * 512 + tid]; uu[i] = U[(row0 + i0 + i) * 512 + tid]; }
#pragma unroll
            for (int i = 0; i < 16; ++i) { const float l0 = bflo(la[i]), l1 = bfhi(la[i]); sl0 += l0; sl1 += l1; h0 = __expf(l0) * h0 + bflo(uu[i]); h1 = __expf(l1) * h1 + bfhi(uu[i]); }
        }
        f32x4 o = {sl0, h0, sl1, h1};
        *(f32x4*)(AGG + ((size_t)tile * 1024 + 2 * tid) * 2) = o;
    }
}

template <int CTRL, int RMASK> __device__ __forceinline__ float dppf(float old, float src) {
    return __builtin_bit_cast(float, __builtin_amdgcn_update_dpp(__builtin_bit_cast(int, old), __builtin_bit_cast(int, src), CTRL, RMASK, 0xf, false));
}
__device__ __forceinline__ float readlane_f(float v, int l) { return __builtin_bit_cast(float, __builtin_amdgcn_readlane(__builtin_bit_cast(int, v), l)); }

namespace ml {
constexpr int QP = 264, SP = 72;
constexpr int O_QS = 0, O_KS = 33792, O_SS = 67584, O_VT = 76800, O_VW = 81408, O_CS = 86016, O_OSM = 102912, O_TAB = 111360, O_WTS = 113920, O_END = 126208;
}
__device__ __forceinline__ unsigned char* sraw_ptr(unsigned char* ws, int u) {
    return u < 1600 ? ws + (size_t)u * 5120 : (u < 2000 ? ws + 62 * MiB + (size_t)(u - 1600) * 5120 : ws + 12 * MiB + 512 * 1024 + (size_t)(u - 2000) * 5120);
}
__device__ __forceinline__ void p5b_sraw(const Args& a, unsigned char* lds) {
    using namespace ml;
    unsigned char* ws = a.ws;
    const int tid = opaque_tid(), lane = tid & 63, w = __builtin_amdgcn_readfirstlane(tid >> 6), fr = lane & 15, fq = lane >> 4;
    bf16_t* Qs = (bf16_t*)(lds + O_QS); bf16_t* Ks = (bf16_t*)(lds + O_KS); float* WTS = (float*)(lds + O_WTS);
    const bf16_t* XC = (const bf16_t*)(ws + WS_XC);
    const int srow = tid >> 5, scol = (tid & 31) * 8;
    for (int g = blockIdx.x; g < 256; g += gridDim.x) {
        const int bh = g >> 4, c0 = (g & 15) * 8, b = bh >> 2, h = bh & 3;
        __syncthreads();
        for (int e = tid; e < 1024; e += 512) { const int gg = e >> 4, bb = (e >> 2) & 3, aa = e & 3; const float* wq = a.in[I_WQ] + (h * 64 + gg) * 16; const float* wk = a.in[I_WK] + (h * 64 + gg) * 16;
            float v = 0.f; for (int o = 0; o < 4; ++o) v += wq[bb * 4 + o] * wk[aa * 4 + o]; WTS[e] = v * 0.0625f; }
        __syncthreads();
        const int lg0 = (tid & 31) * 2;
        f32x4 Wq[2][4];
#pragma unroll
        for (int g2 = 0; g2 < 2; ++g2)
#pragma unroll
            for (int i = 0; i < 4; ++i) Wq[g2][i] = *(const f32x4*)(WTS + (lg0 + g2) * 16 + i * 4);
        for (int cc = 0; cc < 8; ++cc) {
            const int c = c0 + cc; const size_t t0 = (size_t)b * SEQ + (size_t)c * 64;
            u32x4 xr[4];
#pragma unroll
            for (int i = 0; i < 4; ++i) xr[i] = *(const u32x4*)(XC + (t0 + srow + 16 * i) * D + h * 256 + scol);
#pragma unroll
            for (int i = 0; i < 4; ++i) {
                float x[8]; unpack8(xr[i], x);
                float q[8];
#pragma unroll
                for (int g2 = 0; g2 < 2; ++g2) {
                    const f32x4 qq = Wq[g2][0] * x[4 * g2] + Wq[g2][1] * x[4 * g2 + 1] + Wq[g2][2] * x[4 * g2 + 2] + Wq[g2][3] * x[4 * g2 + 3];
                    for (int j = 0; j < 4; ++j) q[4 * g2 + j] = qq[j];
                }
                const int r = srow + 16 * i;
                *(u32x4*)(Qs + r * QP + scol) = pack8(q); *(u32x4*)(Ks + r * QP + scol) = xr[i];
            }
            __syncthreads();
            {
                unsigned char* sp = sraw_ptr(ws, bh * 128 + c);
#define S_DECODE(li, it, jt) do { if ((li) < 4) { it = 3; jt = (li); } else if ((li) < 7) { it = 2; jt = (li) - 4; } else if ((li) < 9) { it = 1; jt = (li) - 7; } else { it = 0; jt = 0; } } while (0)
#define S_EPI(li, sv) do { u32x2 wv_; wv_.x = pk2(sv[0], sv[1]); wv_.y = pk2(sv[2], sv[3]); *(u32x2*)(sp + (li) * 512 + lane * 8) = wv_; } while (0)
                int it0, jt0, it1 = 0, jt1 = 0; S_DECODE(w, it0, jt0);
                const bool two = (w < 2); if (two) S_DECODE(w + 8, it1, jt1);
                f32x4 sA = (f32x4){0.f, 0.f, 0.f, 0.f}, sB = sA, tA = sA, tB = sA;
                const bf16_t* k0p = Ks + (jt0 * 16 + fr) * QP + fq * 8; const bf16_t* q0p = Qs + (it0 * 16 + fr) * QP + fq * 8;
                const bf16_t* k1p = Ks + (jt1 * 16 + fr) * QP + fq * 8; const bf16_t* q1p = Qs + (it1 * 16 + fr) * QP + fq * 8;
#pragma unroll
                for (int ks = 0; ks < 8; ks += 2) {
                    sA = __builtin_amdgcn_mfma_f32_16x16x32_bf16(*(const bf16x8*)(k0p + ks * 32), *(const bf16x8*)(q0p + ks * 32), sA, 0, 0, 0);
                    sB = __builtin_amdgcn_mfma_f32_16x16x32_bf16(*(const bf16x8*)(k0p + ks * 32 + 32), *(const bf16x8*)(q0p + ks * 32 + 32), sB, 0, 0, 0);
                    if (two) {
                        tA = __builtin_amdgcn_mfma_f32_16x16x32_bf16(*(const bf16x8*)(k1p + ks * 32), *(const bf16x8*)(q1p + ks * 32), tA, 0, 0, 0);
                        tB = __builtin_amdgcn_mfma_f32_16x16x32_bf16(*(const bf16x8*)(k1p + ks * 32 + 32), *(const bf16x8*)(q1p + ks * 32 + 32), tB, 0, 0, 0);
                    }
                }
                const f32x4 s0 = sA + sB; S_EPI(w, s0);
                if (two) { const f32x4 s1 = tA + tB; S_EPI(w + 8, s1); }
#undef S_DECODE
#undef S_EPI
            }
            __syncthreads();
        }
    }
}

__device__ __forceinline__ void p6_mlstm(const Args& a, unsigned char* lds) {
    using namespace ml;
    unsigned char* ws = a.ws;
    const int tid = opaque_tid(), lane = tid & 63, w = __builtin_amdgcn_readfirstlane(tid >> 6), fr = lane & 15, fq = lane >> 4;
    bf16_t* Qs = (bf16_t*)(lds + O_QS); bf16_t* Ks = (bf16_t*)(lds + O_KS); bf16_t* Ss = (bf16_t*)(lds + O_SS);
    bf16_t* Vt = (bf16_t*)(lds + O_VT); bf16_t* Vw = (bf16_t*)(lds + O_VW); bf16_t* Cs = (bf16_t*)(lds + O_CS);
    float* Osm = (float*)(lds + O_OSM); float* TAB = (float*)(lds + O_TAB); float* WTS = (float*)(lds + O_WTS);
    const bf16_t* XC = (const bf16_t*)(ws + WS_XC); const bf16_t* XM = (const bf16_t*)(ws + WS_XM); const float* GATES = (const float*)(ws + WS_GATES);
    bf16_t* HM = (bf16_t*)(ws + WS_XB);
    for (int unit = blockIdx.x; unit < 256; unit += gridDim.x) {
        const int xcd = unit & 7, idx = unit >> 3, bh = xcd * 2 + (idx >> 4), vs = idx & 15, b = bh >> 2, h = bh & 3;
        __syncthreads();
        for (int e = tid; e < 64 * SP / 2; e += 512) ((unsigned*)Ss)[e] = 0u;
        for (int e = tid; e < 32 * SP / 2; e += 512) { const int row = e / (SP / 2); ((unsigned*)Vt)[e] = (row == 16) ? 0x3F803F80u : 0u; ((unsigned*)Vw)[e] = 0u; }
        for (int e = tid; e < 32 * QP / 2; e += 512) ((unsigned*)Cs)[e] = 0u;
        for (int e = tid; e < 1024; e += 512) { const int g = e >> 4, bb = (e >> 2) & 3, aa = e & 3; const float* wq = a.in[I_WQ] + (h * 64 + g) * 16; const float* wk = a.in[I_WK] + (h * 64 + g) * 16;
            float v = 0.f; for (int o = 0; o < 4; ++o) v += wq[bb * 4 + o] * wk[aa * 4 + o]; WTS[e] = v * 0.0625f; }
        for (int e = tid; e < 1024; e += 512) WTS[2048 + e] = a.in[I_WV][h * 1024 + e];
        f32x4 Cacc[2][2];
#pragma unroll
        for (int i = 0; i < 2; ++i)
#pragma unroll
            for (int j = 0; j < 2; ++j) Cacc[i][j] = (f32x4){0.f, 0.f, 0.f, 0.f};
        const int srow = tid >> 5, scol = (tid & 31) * 8;
        const int vrow = tid >> 1, vhalf = tid & 1;
        const size_t tbase = (size_t)b * SEQ;
        u32x4 xr[4], xmr = (u32x4){0u, 0u, 0u, 0u}; float gi, gf;
        u32x2 sr0 = (u32x2){0u, 0u}, sr1 = (u32x2){0u, 0u};
        {
            const size_t t0 = tbase;
#pragma unroll
            for (int i = 0; i < 4; ++i) xr[i] = *(const u32x4*)(XC + (t0 + srow + 16 * i) * D + h * 256 + scol);
            if (tid < 128) xmr = *(const u32x4*)(XM + (t0 + vrow) * D + h * 256 + vs * 16 + vhalf * 8);
            gi = GATES[(t0 + lane) * 8 + h]; gf = GATES[(t0 + lane) * 8 + 4 + h];
            const unsigned char* sp = sraw_ptr(ws, bh * 128);
            sr0 = *(const u32x2*)(sp + tid * 8); if (tid < 128) sr1 = *(const u32x2*)(sp + 4096 + tid * 8);
        }
        __syncthreads();
        float decay = 0.f, m_cur = -1e30f;
        constexpr int NC = SEQ / 64;
        for (int c = -1; c < NC; ++c) {
            float* tab = TAB + (c & 1) * 320;
            if (c >= 0) {
            __syncthreads();
            {
                const int rt = w & 3, vt = w >> 2;
                f32x4 a1 = (f32x4){0.f, 0.f, 0.f, 0.f}, a2 = (f32x4){0.f, 0.f, 0.f, 0.f};
#pragma unroll
                for (int ks = 0; ks < 2; ++ks) {
                    const bf16x8 sa_ = *(const bf16x8*)(Ss + (rt * 16 + fr) * SP + ks * 32 + fq * 8);
                    const bf16x8 vb = *(const bf16x8*)(Vt + (vt * 16 + fr) * SP + ks * 32 + fq * 8);
                    a1 = __builtin_amdgcn_mfma_f32_16x16x32_bf16(sa_, vb, a1, 0, 0, 0);
                }
#pragma unroll
                for (int ks = 0; ks < 8; ++ks) {
                    const bf16x8 qa = *(const bf16x8*)(Qs + (rt * 16 + fr) * QP + ks * 32 + fq * 8);
                    const bf16x8 cb = *(const bf16x8*)(Cs + (vt * 16 + fr) * QP + ks * 32 + fq * 8);
                    a2 = __builtin_amdgcn_mfma_f32_16x16x32_bf16(qa, cb, a2, 0, 0, 0);
                }
#pragma unroll
                for (int e = 0; e < 4; ++e) { const int i = rt * 16 + fq * 4 + e; Osm[i * 33 + vt * 16 + fr] = a1[e] + tab[128 + i] * a2[e]; }
            }
            {
#pragma unroll
                for (int kl = 0; kl < 2; ++kl)
#pragma unroll
                    for (int vt = 0; vt < 2; ++vt) Cacc[kl][vt] = Cacc[kl][vt] * decay;
#pragma unroll
                for (int kl = 0; kl < 2; ++kl) {
                    const int kcol = (2 * w + kl) * 16 + fr;
#pragma unroll
                    for (int ks = 0; ks < 2; ++ks) {
                        bf16x8 ka;
#pragma unroll
                        for (int e = 0; e < 8; ++e) ka[e] = (short)Ks[(ks * 32 + fq * 8 + e) * QP + kcol];
#pragma unroll
                        for (int vt = 0; vt < 2; ++vt) {
                            const bf16x8 vb = *(const bf16x8*)(Vw + (vt * 16 + fr) * SP + ks * 32 + fq * 8);
                            Cacc[kl][vt] = __builtin_amdgcn_mfma_f32_16x16x32_bf16(ka, vb, Cacc[kl][vt], 0, 0, 0);
                        }
                    }
                }
            }
            }
            u32x4 qpk[4]; float vnx[8], decay_n = 0.f, m_nx = m_cur;
            if (c + 1 < NC) {
                const int lg0 = (tid & 31) * 2;
                f32x4 Wq[2][4];
#pragma unroll
                for (int g2 = 0; g2 < 2; ++g2)
#pragma unroll
                    for (int i = 0; i < 4; ++i) Wq[g2][i] = *(const f32x4*)(WTS + (lg0 + g2) * 16 + i * 4);
#pragma unroll
                for (int i = 0; i < 4; ++i) {
                    float x[8]; unpack8(xr[i], x);
                    float q[8];
#pragma unroll
                    for (int g2 = 0; g2 < 2; ++g2) {
                        const f32x4 qq = Wq[g2][0] * x[4 * g2] + Wq[g2][1] * x[4 * g2 + 1] + Wq[g2][2] * x[4 * g2 + 2] + Wq[g2][3] * x[4 * g2 + 3];
                        for (int j = 0; j < 4; ++j) q[4 * g2 + j] = qq[j];
                    }
                    qpk[i] = pack8(q);
                }
                if (tid < 128) {
                    float x[8]; unpack8(xmr, x);
                    const int lgv = vs * 4 + vhalf * 2;
#pragma unroll
                    for (int g2 = 0; g2 < 2; ++g2) {
                        const float* Wv = WTS + 2048 + (lgv + g2) * 16;
#pragma unroll
                        for (int o = 0; o < 4; ++o) vnx[4 * g2 + o] = Wv[0 * 4 + o] * x[4 * g2] + Wv[1 * 4 + o] * x[4 * g2 + 1] + Wv[2 * 4 + o] * x[4 * g2 + 2] + Wv[3 * 4 + o] * x[4 * g2 + 3];
                    }
                }
                float sa = gf, sc = gi;
#define SCAN_STEP(CTRL, RM) do { const float ao = dppf<CTRL, RM>(0.f, sa), co = dppf<CTRL, RM>(-INFINITY, sc); sc = fmaxf(co + sa, sc); sa = ao + sa; } while (0)
                SCAN_STEP(0x111, 0xf); SCAN_STEP(0x112, 0xf); SCAN_STEP(0x114, 0xf); SCAN_STEP(0x118, 0xf);
                SCAN_STEP(0x142, 0xa);
                SCAN_STEP(0x143, 0xc);
#undef SCAN_STEP
                const float Mi = fmaxf(m_cur + sa, sc);
                const float gtot = readlane_f(sa, 63); m_nx = readlane_f(Mi, 63);
                decay_n = __expf(gtot + m_cur - m_nx);
                if (w == 0) {
                    float* tn = TAB + ((c + 1) & 1) * 320;
                    tn[lane] = sa - Mi; tn[64 + lane] = gi - sa; tn[128 + lane] = __expf(sa + m_cur - Mi); tn[192 + lane] = __expf(-Mi); tn[256 + lane] = __expf(gtot - sa + gi - m_nx);
                }
            }
            if (c >= 0) {
            __syncthreads();
            {
#pragma unroll
                for (int kl = 0; kl < 2; ++kl)
#pragma unroll
                    for (int vt = 0; vt < 2; ++vt) {
                        u32x2 wv; wv.x = pk2(Cacc[kl][vt][0], Cacc[kl][vt][1]); wv.y = pk2(Cacc[kl][vt][2], Cacc[kl][vt][3]);
                        *(u32x2*)(Cs + (vt * 16 + fr) * QP + (2 * w + kl) * 16 + fq * 4) = wv;
                    }
                const int i = tid >> 3, vp = (tid & 7) * 2;
                const float den = Osm[i * 33 + 16], dn = fmaxf(fabsf(den), tab[192 + i]);
                const float rdn = __builtin_amdgcn_rcpf(dn); const float h0 = Osm[i * 33 + vp] * rdn, h1 = Osm[i * 33 + vp + 1] * rdn;
                *(unsigned*)(HM + ((size_t)(bh * 16 + vs) * SEQ + (size_t)c * 64 + i) * 16 + vp) = pk2(h0, h1);
            }
            }
            if (c + 1 < NC) {
#pragma unroll
                for (int i = 0; i < 4; ++i) { const int r = srow + 16 * i; *(u32x4*)(Qs + r * QP + scol) = qpk[i]; *(u32x4*)(Ks + r * QP + scol) = xr[i]; }
                if (c < 0) __syncthreads();
                const float* tn = TAB + ((c + 1) & 1) * 320;
                if (tid < 128) {
                    const float wk = tn[256 + vrow];
#pragma unroll
                    for (int e = 0; e < 8; ++e) { Vt[(vhalf * 8 + e) * SP + vrow] = (bf16_t)(pk2(vnx[e], 0.f) & 0xffffu); Vw[(vhalf * 8 + e) * SP + vrow] = (bf16_t)(pk2(vnx[e] * wk, 0.f) & 0xffffu); }
                } else if (tid < 192) { Vw[16 * SP + (tid - 128)] = (bf16_t)(pk2(tn[256 + tid - 128], 0.f) & 0xffffu); }
#define SS_ITEM(li, sr) do { int it_, jt_; if ((li) < 4) { it_ = 3; jt_ = (li); } else if ((li) < 7) { it_ = 2; jt_ = (li) - 4; } else if ((li) < 9) { it_ = 1; jt_ = (li) - 7; } else { it_ = 0; jt_ = 0; } \
        const int i_ = it_ * 16 + fr, j0_ = jt_ * 16 + fq * 4; const float rf_ = tn[i_]; const f32x4 cf_ = *(const f32x4*)(tn + 64 + j0_); \
        const float sv_[4] = {bflo((sr).x), bfhi((sr).x), bflo((sr).y), bfhi((sr).y)}; float o_[4]; \
        _Pragma("unroll") for (int e = 0; e < 4; ++e) o_[e] = (j0_ + e <= i_) ? sv_[e] * __expf(rf_ + cf_[e]) : 0.f; \
        u32x2 wv_; wv_.x = pk2(o_[0], o_[1]); wv_.y = pk2(o_[2], o_[3]); *(u32x2*)(Ss + i_ * SP + j0_) = wv_; } while (0)
                SS_ITEM(w, sr0);
                if (w < 2) SS_ITEM(w + 8, sr1);
#undef SS_ITEM
                decay = decay_n; m_cur = m_nx;
                if (c + 2 < NC) {
                    const size_t t2 = tbase + (size_t)(c + 2) * 64;
#pragma unroll
                    for (int i = 0; i < 4; ++i) xr[i] = *(const u32x4*)(XC + (t2 + srow + 16 * i) * D + h * 256 + scol);
                    if (tid < 128) xmr = *(const u32x4*)(XM + (t2 + vrow) * D + h * 256 + vs * 16 + vhalf * 8);
                    gi = GATES[(t2 + lane) * 8 + h]; gf = GATES[(t2 + lane) * 8 + 4 + h];
                    const unsigned char* sp = sraw_ptr(ws, bh * 128 + c + 2);
                    sr0 = *(const u32x2*)(sp + tid * 8); if (tid < 128) sr1 = *(const u32x2*)(sp + 4096 + tid * 8);
                }
            }
        }
    }
}

__device__ __forceinline__ void p7_mlstm_fin(const Args& a) {
    unsigned char* ws = a.ws; const int tid = opaque_tid(), lane = tid & 63, wave = tid >> 6;
    const int gw = blockIdx.x * 8 + wave, NGW = gridDim.x * 8;
    const bf16_t* HM = (const bf16_t*)(ws + WS_XB); const bf16_t* XC = (const bf16_t*)(ws + WS_XC); bf16_t* ZM = (bf16_t*)(ws + WS_ZM);
    float lnw[16], skp[16];
#pragma unroll
    for (int j = 0; j < 4; ++j) { const f32x4 p = *(const f32x4*)(a.in[I_LNW] + lane * 16 + 4 * j), q = *(const f32x4*)(a.in[I_SKIP] + lane * 16 + 4 * j); for (int e = 0; e < 4; ++e) { lnw[4 * j + e] = p[e]; skp[4 * j + e] = q[e]; } }
    for (int m = gw; m < T; m += NGW) {
        const size_t off = (size_t)m * D + lane * 16;
        float hv[16], xc[16], z[16];
        { const size_t hoff = ((size_t)(((m / SEQ) * 4 + (lane >> 4)) * 16 + (lane & 15)) * SEQ + (size_t)(m % SEQ)) * 16;
          unpack8(*(const u32x4*)(HM + hoff), hv); unpack8(*(const u32x4*)(HM + hoff + 8), hv + 8); }
        unpack8(*(const u32x4*)(XC + off), xc); unpack8(*(const u32x4*)(XC + off + 8), xc + 8);
        unpack8(*(const u32x4*)(ZM + off), z); unpack8(*(const u32x4*)(ZM + off + 8), z + 8);
        float s = 0.f;
#pragma unroll
        for (int e = 0; e < 16; ++e) s += hv[e];
        s += __shfl_xor(s, 1); s += __shfl_xor(s, 2); s += __shfl_xor(s, 4); s += __shfl_xor(s, 8);
        const float mu = s * (1.0f / 256.0f); float q = 0.f;
#pragma unroll
        for (int e = 0; e < 16; ++e) { hv[e] -= mu; q += hv[e] * hv[e]; }
        q += __shfl_xor(q, 1); q += __shfl_xor(q, 2); q += __shfl_xor(q, 4); q += __shfl_xor(q, 8);
        const float rstd = rsqrtf(q * (1.0f / 256.0f) + EPS);
        float o[16], ss = 0.f;
#pragma unroll
        for (int e = 0; e < 16; ++e) { o[e] = (hv[e] * rstd * lnw[e] + skp[e] * xc[e]) * siluf_(z[e]); ss += o[e] * o[e]; }
        ss = wave_sum(ss);
        const float rs = rsqrtf(ss * (1.0f / 1024.0f) + EPS);
#pragma unroll
        for (int e = 0; e < 16; ++e) o[e] *= rs;
        *(u32x4*)(ZM + off) = pack8(o); *(u32x4*)(ZM + off + 8) = pack8(o + 8);
    }
}
__device__ __forceinline__ void p7_rg_fin(const Args& a, unsigned char* lds) {
    unsigned char* ws = a.ws; const int tid = opaque_tid();
    unsigned* LOGA = (unsigned*)(ws + WS_XR); const unsigned* U = (const unsigned*)(ws + WS_U); const unsigned* YR = (const unsigned*)(ws + WS_YR); const float* AGG = (const float*)(ws + WS_AGG);
    float* Ot = (float*)lds;
    constexpr int OP = 1028;
    for (int tile = blockIdx.x; tile < 256; tile += gridDim.x) {
        const int tc = tile & 63, tb = tile & ~63;
        float h0 = 0.f, h1 = 0.f;
        for (int p = 0; p < tc; ++p) { const f32x4 g = *(const f32x4*)(AGG + ((size_t)(tb + p) * 1024 + 2 * tid) * 2); h0 = __expf(g[0]) * h0 + g[1]; h1 = __expf(g[2]) * h1 + g[3]; }
        const size_t row0 = (size_t)tile * 128;
        for (int i0 = 0; i0 < 128; i0 += 16) {
            unsigned la[16], uu[16], yy[16];
#pragma unroll
            for (int i = 0; i < 16; ++i) { const size_t o = (row0 + i0 + i) * 512 + tid; la[i] = LOGA[o]; uu[i] = U[o]; yy[i] = YR[o]; }
            __syncthreads();
#pragma unroll
            for (int i = 0; i < 16; ++i) {
                h0 = __expf(bflo(la[i])) * h0 + bflo(uu[i]); h1 = __expf(bfhi(la[i])) * h1 + bfhi(uu[i]);
                Ot[i * OP + 2 * tid] = h0 * geluf_(bflo(yy[i])); Ot[i * OP + 2 * tid + 1] = h1 * geluf_(bfhi(yy[i]));
            }
            __syncthreads();
            {
                const int row = tid >> 5, sub = tid & 31;
                f32x4 v[4][2]; float ss = 0.f;
#pragma unroll
                for (int q = 0; q < 4; ++q)
#pragma unroll
                    for (int hh = 0; hh < 2; ++hh) { v[q][hh] = *(const f32x4*)(Ot + row * OP + q * 256 + sub * 8 + hh * 4); const f32x4 t = v[q][hh]; ss += (t[0] * t[0] + t[1] * t[1]) + (t[2] * t[2] + t[3] * t[3]); }
                ss += __shfl_xor(ss, 1); ss += __shfl_xor(ss, 2); ss += __shfl_xor(ss, 4); ss += __shfl_xor(ss, 8); ss += __shfl_xor(ss, 16);
                const float rs = rsqrtf(ss * (1.0f / 1024.0f) + EPS);
                bf16_t* orow = (bf16_t*)LOGA + (row0 + i0 + row) * D;
#pragma unroll
                for (int q = 0; q < 4; ++q) { const f32x4 p = v[q][0] * rs, r = v[q][1] * rs; u32x4 wv; wv.x = pk2(p[0], p[1]); wv.y = pk2(p[2], p[3]); wv.z = pk2(r[0], r[1]); wv.w = pk2(r[2], r[3]); *(u32x4*)(orow + q * 256 + sub * 8) = wv; }
            }
        }
        __syncthreads();
    }
}

__device__ __forceinline__ void p11_final(const Args& a) {
    const int tid = opaque_tid(), lane = tid & 63, wave = tid >> 6;
    const int gw = blockIdx.x * 8 + wave, NGW = gridDim.x * 8;
    const float* SS = (const float*)(a.ws + WS_SSD); const float* gn = a.in[I_NFIN];
    f32x4 g[4];
#pragma unroll
    for (int j = 0; j < 4; ++j) g[j] = *((const f32x4*)gn + lane + 64 * j);
    for (int m = gw; m < T; m += NGW) {
        const float rs = pg8::row_scale(SS, m);
        f32x4* xr = (f32x4*)(a.out + (size_t)m * D) + lane;
#pragma unroll
        for (int j = 0; j < 4; ++j) { f32x4 v = xr[64 * j]; v = v * rs * g[j]; xr[64 * j] = v; }
    }
}


#define XB_TMO      128
#define XB_XCNT(j)  (256  + 64 * (j))
#define XB_XSUB(j)  (1280 + 64 * (j))
#define XB_XGEN(j)  (2304 + 64 * (j))
#define XB_TOP      3328
#define XB_TOPGEN   3392
#define XCD_BAR_WORDS 3456
#define XB_SPIN_CAP (1u << 18)
__device__ __forceinline__ unsigned xb_ld(unsigned* p)              { return __hip_atomic_load(p, __ATOMIC_RELAXED, __HIP_MEMORY_SCOPE_AGENT); }
__device__ __forceinline__ unsigned xb_add(unsigned* p, unsigned v) { return __hip_atomic_fetch_add(p, v, __ATOMIC_RELAXED, __HIP_MEMORY_SCOPE_AGENT); }
__device__ __forceinline__ unsigned xb_xcc_id() { return (unsigned)__builtin_amdgcn_s_getreg((3 << 11) | 20) & 0xFu; }
#define XB_SPIN(cond, bar) do { unsigned _sp = 0; while (cond) { __builtin_amdgcn_s_sleep(1); \
    if ((++_sp & 255u) == 0u) { if (xb_ld(&(bar)[XB_TMO])) break; if (_sp > XB_SPIN_CAP) { atomicAdd(&(bar)[XB_TMO], 1u); break; } } } } while (0)
struct XcdBarrier { unsigned* bar; unsigned x; volatile LAS unsigned* st; };
__device__ __forceinline__ XcdBarrier xcd_barrier_post(unsigned* bar, volatile LAS unsigned* st) {
    XcdBarrier b; b.bar = bar; b.x = xb_xcc_id(); b.st = st;
    if (threadIdx.x == 0) (void)xb_add(&bar[XB_XCNT(b.x)], 1u);
    return b;
}
__device__ __forceinline__ void xcd_barrier_complete(unsigned* bar, unsigned x, unsigned& nloc, unsigned& nx) {
    const unsigned G = gridDim.x * gridDim.y * gridDim.z;
    unsigned sum, cnt, mine, sp = 0u;
    for (;;) {
        sum = 0u; cnt = 0u; mine = 0u;
#pragma unroll
        for (unsigned j = 0; j < 16; ++j) { const unsigned c = xb_ld(&bar[XB_XCNT(j)]); sum += c; cnt += (c > 0u) ? 1u : 0u; mine = (j == x) ? c : mine; }
        if (sum == G) break;
        __builtin_amdgcn_s_sleep(1);
        if ((++sp & 255u) == 0u) { if (xb_ld(&bar[XB_TMO])) break; if (sp > XB_SPIN_CAP) { atomicAdd(&bar[XB_TMO], 1u); break; } }
    }
    nloc = mine > 0u ? mine : 1u; nx = cnt > 0u ? cnt : 1u;
}
__device__ __forceinline__ void xcd_barrier(const XcdBarrier& b) {
    asm volatile("s_waitcnt vmcnt(0)" ::: "memory");
    __syncthreads();
    if (threadIdx.x == 0) {
        unsigned* bar = b.bar;
        __builtin_amdgcn_s_waitcnt(0);
        unsigned nloc = b.st[0], nx = b.st[1];
        if (nloc == 0u) { xcd_barrier_complete(bar, b.x, nloc, nx); b.st[0] = nloc; b.st[1] = nx; }
        const unsigned old = xb_add(&bar[XB_XSUB(b.x)], 1u);
        const unsigned gen = old / nloc;
        if (old + 1u == (gen + 1u) * nloc) {
            __builtin_amdgcn_fence(__ATOMIC_RELEASE, "agent");
            asm volatile("s_waitcnt vmcnt(0)" ::: "memory");
            const unsigned og = xb_add(&bar[XB_TOP], 1u);
            const unsigned tg = og / nx;
            if (og + 1u == (tg + 1u) * nx) xb_add(&bar[XB_TOPGEN], 1u);
            else XB_SPIN(xb_ld(&bar[XB_TOPGEN]) == tg, bar);
            __builtin_amdgcn_fence(__ATOMIC_ACQUIRE, "agent");
            xb_add(&bar[XB_XGEN(b.x)], 1u);
            asm volatile("s_waitcnt vmcnt(0)" ::: "memory");
        } else {
            XB_SPIN(xb_ld(&bar[XB_XGEN(b.x)]) == gen, bar);
            __builtin_amdgcn_fence(__ATOMIC_ACQUIRE, "agent");
            asm volatile("s_waitcnt vmcnt(0)" ::: "memory");
        }
    }
    __syncthreads();
}
#define GSYNC() xcd_barrier(xbar)
__global__ void __launch_bounds__(512, 2) mk_fwd(Args args) {
    extern __shared__ __attribute__((aligned(16))) unsigned char lds_raw[];
    cg::grid_group grid = cg::this_grid();
    LAS unsigned char* lds = (LAS unsigned char*)lds_raw;
    unsigned char* ws = args.ws;
    const int G = gridDim.x, bid = blockIdx.x;
    volatile LAS unsigned* xst = (volatile LAS unsigned*)(lds + (LDS_BYTES - 64));
    if (threadIdx.x == 0) { xst[0] = 0u; xst[1] = 0u; }
    __syncthreads();
    const XcdBarrier xbar = xcd_barrier_post((unsigned*)(ws + WS_BAR), xst);
    bf16_t* XB = (bf16_t*)(ws + WS_XB); bf16_t* ACT = (bf16_t*)(ws + WS_R1);
#ifndef NO_P0
    p0_prologue(args, lds_raw);
#endif
    asm volatile("s_waitcnt vmcnt(0)" ::: "memory"); __threadfence(); grid.sync();
#ifndef NO_P1
    { const pg8::Gemm gUp1{XB, (const bf16_t*)(ws + WS_WGU1), 1024, 1024, 1 << 30, 0, 0, 0}; pg8::StaticOrder S; S.init(T, 2 * FF, G, bid); pg8::EpiSwiGLU E{ACT, (const float*)(ws + WS_SSA)}; pg8::gemm_phase(lds, gUp1, S, E); }
#endif
    GSYNC();
#ifndef NO_P2
    { const pg8::Gemm gDn1{ACT, (const bf16_t*)(ws + WS_WD1), FF, FF, 1 << 30, 0, 0, 0}; pg8::StaticOrder S; S.init(T, D, G, bid); pg8::EpiResid E{args.in[I_X], args.out, XB, (float*)(ws + WS_SSB), 0.5f}; pg8::gemm_phase(lds, gDn1, S, E); }
#endif
    GSYNC();
#ifndef NO_P3
    { const pg8::Gemm gIn{XB, (const bf16_t*)(ws + WS_WIN), 1024, 1024, 1 << 30, 0, 0, 0}; pg8::StaticOrder S; S.init(T, 4096, G, bid); pg8::EpiProj E{(bf16_t*)(ws + WS_XM), (const float*)(ws + WS_SSB)}; pg8::gemm_phase(lds, gIn, S, E); }
#endif
    GSYNC();
#ifndef NO_P4
    p4_conv(args);
#endif
    GSYNC();
#ifndef NO_P5
    {
        const pg8::Gemm gRg{XB  , (const bf16_t*)(ws + WS_WRG), 256, 1024, 1 << 30, 0, 1, 512};
        const pg8::Gemm gGt{(const bf16_t*)(ws + WS_XC), (const bf16_t*)(ws + WS_WG8), 2048, 1024, 16, (long)WS_XM - (long)WS_XC - 16 * 128, 0, 0};
        pg8::EpiGates Eg{(float*)(ws + WS_GATES), args.in[I_BGATES]};
        pg8::EpiRg Er{XB, args.in[I_RBA], args.in[I_RBX], (const float*)(ws + WS_C8), (bf16_t*)(ws + WS_XR), (bf16_t*)(ws + WS_U)};
        if (G == 256) {
#ifndef NO_P5G
            if (bid < 128) { pg8::ListOrder S{bid, 1, 0}; pg8::gemm_phase(lds, gGt, S, Eg); }
#endif
#ifndef NO_P5R
            if (bid >= 128) { pg8::ListOrder S{(bid - 128) * 8, 8, 3}; pg8::gemm_phase(lds, gRg, S, Er); }
#endif
        } else {
#ifndef NO_P5G
            for (int u = bid; u < 128; u += G) { pg8::ListOrder S{u, 1, 0}; pg8::gemm_phase(lds, gGt, S, Eg); }
#endif
#ifndef NO_P5R
            for (int u = bid; u < 128; u += G) { pg8::ListOrder S{u * 8, 8, 3}; pg8::gemm_phase(lds, gRg, S, Er); }
#endif
        }
    }
#endif
    GSYNC();
#ifndef NO_P6A
    p6_rg_agg(args);
#endif
    p5b_sraw(args, lds_raw);
    GSYNC();
#ifndef NO_P6
    p6_mlstm(args, lds_raw);
#endif
    GSYNC();
#ifndef NO_P7A
    p7_mlstm_fin(args);
#endif
#ifndef NO_P7B
    p7_rg_fin(args, lds_raw);
#endif
    GSYNC();
#ifndef NO_P8
    { const pg8::Gemm gOut{(const bf16_t*)(ws + WS_ZM)  , (const bf16_t*)(ws + WS_WOUT), 2048, 1024, 16, (long)(64 * MiB) - 16 * 128, 0, 0}; pg8::StaticOrder S; S.init(T, D, G, bid); pg8::EpiResid E{args.out, args.out, XB, (float*)(ws + WS_SSC), 1.0f}; pg8::gemm_phase(lds, gOut, S, E); }
#endif
    GSYNC();
#ifndef NO_P9
    { const pg8::Gemm gUp2{XB, (const bf16_t*)(ws + WS_WGU2), 1024, 1024, 1 << 30, 0, 0, 0}; pg8::StaticOrder S; S.init(T, 2 * FF, G, bid); pg8::EpiSwiGLU E{ACT, (const float*)(ws + WS_SSC)}; pg8::gemm_phase(lds, gUp2, S, E); }
#endif
    GSYNC();
#ifndef NO_P10
    { const pg8::Gemm gDn2{ACT, (const bf16_t*)(ws + WS_WD2), FF, FF, 1 << 30, 0, 0, 0}; pg8::StaticOrder S; S.init(T, D, G, bid); pg8::EpiResid E{args.out, args.out, nullptr, (float*)(ws + WS_SSD), 0.5f}; pg8::gemm_phase(lds, gDn2, S, E); }
#endif
    GSYNC();
#ifndef NO_P11
    p11_final(args);
#endif
}

extern "C" void kernel_launch(void* const* d_in, const int* in_sizes, int n_in, void* d_out, int out_size, void* d_ws, size_t ws_size, hipStream_t stream) {
    static int grid = 0;
    if (grid == 0) {
        if (n_in != 31 || in_sizes[0] != T * D || out_size != T * D || ws_size < WS_END) { fprintf(stderr, "kernel_launch: unexpected shapes (n_in %d, in0 %d, out %d, ws %zu)\n", n_in, n_in > 0 ? in_sizes[0] : -1, out_size, ws_size); grid = -1; return; }
        int dev = 0, cus = 0, per_cu = 0;
        if (hipGetDevice(&dev) != hipSuccess || hipDeviceGetAttribute(&cus, hipDeviceAttributeMultiprocessorCount, dev) != hipSuccess) { grid = -1; return; }
        if (hipFuncSetAttribute((const void*)mk_fwd, hipFuncAttributeMaxDynamicSharedMemorySize, LDS_BYTES) != hipSuccess) { fprintf(stderr, "kernel_launch: hipFuncSetAttribute failed\n"); grid = -1; return; }
        if (hipOccupancyMaxActiveBlocksPerMultiprocessor(&per_cu, (const void*)mk_fwd, 512, LDS_BYTES) != hipSuccess || per_cu < 1) { fprintf(stderr, "kernel_launch: occupancy query says %d\n", per_cu); (void)hipGetLastError(); grid = -1; return; }
        grid = cus;
    }
    if (grid < 0) return;
    if (hipMemsetAsync((char*)d_ws + WS_BAR, 0, 16384, stream) != hipSuccess) { fprintf(stderr, "kernel_launch: memset of barrier words failed\n"); return; }
    Args a{};
    for (int i = 0; i < 31; ++i) a.in[i] = (const float*)d_in[i];
    a.out = (float*)d_out; a.ws = (unsigned char*)d_ws;
    void* kargs[] = {&a};
    hipError_t e = hipLaunchCooperativeKernel((const void*)mk_fwd, dim3(grid), dim3(512), kargs, LDS_BYTES, stream);
    if (e != hipSuccess) fprintf(stderr, "kernel_launch: cooperative launch failed: %s (grid %d)\n", hipGetErrorString(e), grid);
}
```

```cpp
#include <hip/hip_runtime.h>
#include <hip/hip_cooperative_groups.h>
#include <cstdio>
#include <cstdint>
namespace cg = cooperative_groups;

#define LAS __attribute__((address_space(3)))
typedef unsigned short bf16_t;
typedef short bf16x8 __attribute__((ext_vector_type(8)));
typedef float f32x4 __attribute__((ext_vector_type(4)));
typedef unsigned u32x4 __attribute__((ext_vector_type(4)));
typedef unsigned u32x2 __attribute__((ext_vector_type(2)));

constexpr int T = 32768, D = 1024, FF = 2816, SEQ = 8192, NB = 4;
constexpr float EPS = 1e-6f;
constexpr size_t MiB = 1u << 20;
constexpr size_t WS_SSA = 0, WS_SSB = 2 * MiB, WS_SSC = 4 * MiB, WS_SSD = 6 * MiB;
constexpr size_t WS_GATES = 8 * MiB;
constexpr size_t WS_AGG = 9 * MiB;
constexpr size_t WS_BAR = 14 * MiB;
constexpr size_t WS_C8 = 12 * MiB;
constexpr size_t WS_WG8 = 11 * MiB;
constexpr size_t WS_WGU1 = 16 * MiB;
constexpr size_t WS_WD1 = WS_WGU1 + 11 * MiB;
constexpr size_t WS_WIN = WS_WD1 + 11 * MiB / 2;
constexpr size_t WS_WRG = WS_WIN + 8 * MiB;
constexpr size_t WS_WOUT = WS_WRG + 1 * MiB;
constexpr size_t WS_WGU2 = WS_WOUT + 4 * MiB;
constexpr size_t WS_WD2 = WS_WGU2 + 11 * MiB;
constexpr size_t WS_XB = 64 * MiB;
constexpr size_t WS_R1 = 128 * MiB;
constexpr size_t WS_XM = WS_R1, WS_ZM = WS_R1 + 64 * MiB, WS_XR = WS_R1 + 128 * MiB, WS_YR = WS_R1 + 192 * MiB;
constexpr size_t WS_XC = 384 * MiB;
constexpr size_t WS_U = 448 * MiB;
constexpr size_t WS_END = 512 * MiB;
constexpr int LDS_BYTES = 147456;

typedef float f32x2_t __attribute__((ext_vector_type(2)));
typedef __bf16 bf16x2_t __attribute__((ext_vector_type(2)));
__device__ __forceinline__ unsigned pk2(float lo, float hi) { const f32x2_t v = {lo, hi}; const bf16x2_t b = __builtin_convertvector(v, bf16x2_t); return __builtin_bit_cast(unsigned, b); }
__device__ __forceinline__ float bflo(unsigned u) { return __uint_as_float(u << 16); }
__device__ __forceinline__ float bfhi(unsigned u) { return __uint_as_float(u & 0xffff0000u); }
__device__ __forceinline__ float bf1(bf16_t u) { return __uint_as_float(((unsigned)u) << 16); }
__device__ __forceinline__ void unpack8(const u32x4 v, float* x) { x[0] = bflo(v.x); x[1] = bfhi(v.x); x[2] = bflo(v.y); x[3] = bfhi(v.y); x[4] = bflo(v.z); x[5] = bfhi(v.z); x[6] = bflo(v.w); x[7] = bfhi(v.w); }
__device__ __forceinline__ u32x4 pack8(const float* x) { u32x4 o; o.x = pk2(x[0], x[1]); o.y = pk2(x[2], x[3]); o.z = pk2(x[4], x[5]); o.w = pk2(x[6], x[7]); return o; }
__device__ __forceinline__ float sigmoidf_(float x) { return __builtin_amdgcn_rcpf(1.0f + __expf(-x)); }
__device__ __forceinline__ float siluf_(float x) { return x * __builtin_amdgcn_rcpf(1.0f + __expf(-x)); }
__device__ __forceinline__ float logsigf_(float x) { return fminf(x, 0.f) - __logf(1.0f + __expf(-fabsf(x))); }
__device__ __forceinline__ float logsig_acc_(float x) { return fminf(x, 0.f) - log1pf(expf(-fabsf(x))); }
__device__ __forceinline__ float geluf_(float x) { const float u = 0.7978845608028654f * (x + 0.044715f * x * x * x); const float t = 1.0f - 2.0f * __builtin_amdgcn_rcpf(1.0f + __expf(2.0f * u)); return 0.5f * x * (1.0f + t); }
__device__ __forceinline__ int opaque_tid() { int t = threadIdx.x; asm volatile("" : "+v"(t)); return t; }
__device__ __forceinline__ float wave_sum(float v) {
#pragma unroll
    for (int o = 1; o < 64; o <<= 1) v += __shfl_xor(v, o);
    return v;
}

namespace pg8 {
constexpr int BM = 256, BK = 64, HALF = 128, HTB = HALF * BK * 2, STAGE_BYTES = 8 * HTB, NXCD = 8, WGM = 8;
__host__ __device__ __forceinline__ int lds_byte(int r, int c) { const int st = (r >> 4) * 2 + (c >> 5), rr = r & 15, cc = c & 31, ob = rr * 64 + cc * 2; return st * 1024 + (ob ^ (((ob >> 9) & 1) << 5)); }
__host__ __device__ __forceinline__ void stage_rc(int b, int& R, int& C) { const int st = b / 1024, sb = b % 1024, swz = sb ^ (((sb >> 9) & 1) << 5); R = (st >> 1) * 16 + swz / 64; C = (st & 1) * 32 + (swz % 64) / 2; }
__host__ __device__ __forceinline__ int perm32(int rho) { const int n = rho >> 4, i = rho & 15; return 8 * (i >> 2) + 4 * n + (i & 3); }

struct Unit { int pm, pn; };
struct Gemm { const bf16_t* A; const bf16_t* Bt; int K; int lda; int ksplit; long kdelta; int a_pn_shift; int a_pn_bytes; };

struct StaticOrder {
    int nM, nN, nwg, G, c;
    __device__ void init(int M, int N, int G_, int c_) { nM = M / BM; nN = N / BM; nwg = nM * nN; G = G_; c = c_; }
    __device__ bool next(int i, Unit& u) const {
        const long L = (long)i * G + c; if (L >= nwg) return false;
        int wgid = (int)L; { const int q = nwg / NXCD, r = nwg % NXCD, xcd = wgid % NXCD, off = wgid / NXCD; wgid = (xcd < r ? xcd * (q + 1) : r * (q + 1) + (xcd - r) * q) + off; }
        const int nig = WGM * nN, gid = wgid / nig, fm = gid * WGM, gsz = (nM - fm) < WGM ? (nM - fm) : WGM;
        u.pm = fm + ((wgid % nig) % gsz); u.pn = (wgid % nig) / gsz; return true;
    }
};
struct ListOrder {
    int first, cnt, nshift;
    __device__ bool next(int i, Unit& u) const { if (i >= cnt) return false; const int L = first + i; u.pm = L >> nshift; u.pn = L & ((1 << nshift) - 1); return true; }
};

__device__ __forceinline__ float row_scale(const float* SS, int r) {
    const f32x4* p = (const f32x4*)(SS + (size_t)r * 16);
    const f32x4 a = p[0], b = p[1], c = p[2], d = p[3];
    const float s = ((a[0] + a[1]) + (a[2] + a[3])) + ((b[0] + b[1]) + (b[2] + b[3])) + ((c[0] + c[1]) + (c[2] + c[3])) + ((d[0] + d[1]) + (d[2] + d[3]));
    return rsqrtf(s * (1.0f / 1024.0f) + EPS);
}

__device__ __forceinline__ void row_scales8(const float* SS, int row0, int fq, float (&rs)[8]) {
    f32x4 v[8];
#pragma unroll
    for (int q = 0; q < 8; ++q) v[q] = *(const f32x4*)(SS + (size_t)(row0 + (q >> 2) * HALF + (q & 3) * 16) * 16 + fq * 4);
#pragma unroll
    for (int q = 0; q < 8; ++q) { float s = (v[q][0] + v[q][1]) + (v[q][2] + v[q][3]); s += __shfl_xor(s, 16); s += __shfl_xor(s, 32); rs[q] = rsqrtf(s * (1.0f / 1024.0f) + EPS); }
}
struct EpiSwiGLU {
    bf16_t* O; const float* SS;
    __device__ __forceinline__ void operator()(const f32x4 (&acc)[2][2][4][2], const Unit& u, int wr, int wc, int fr, int fq) const {
        const int row0 = u.pm * BM + wr * 64 + fr, col0 = u.pn * HALF + wc * 32 + 8 * fq;
        float rs8[8]; row_scales8(SS, row0, fq, rs8);
#pragma unroll
        for (int ai = 0; ai < 2; ++ai)
#pragma unroll
            for (int m = 0; m < 4; ++m) {
                const int r = row0 + ai * HALF + m * 16; const float rs = rs8[ai * 4 + m];
                float o[8];
#pragma unroll
                for (int n = 0; n < 2; ++n)
#pragma unroll
                    for (int j = 0; j < 4; ++j) { const float g = acc[ai][0][m][n][j] * rs, up = acc[ai][1][m][n][j] * rs; o[n * 4 + j] = siluf_(g) * up; }
                *(u32x4*)(O + (size_t)r * FF + col0) = pack8(o);
            }
    }
};
struct EpiResid {
    const float* Xin; float* Xout; bf16_t* XBo; float* SSo; float alpha;
    __device__ __forceinline__ void operator()(const f32x4 (&acc)[2][2][4][2], const Unit& u, int wr, int wc, int fr, int fq) const {
        const int row0 = u.pm * BM + wr * 64 + fr, col0 = u.pn * BM + wc * 32 + 8 * fq;
#pragma unroll
        for (int ai = 0; ai < 2; ++ai)
#pragma unroll
            for (int m = 0; m < 4; ++m) {
                const int r = row0 + ai * HALF + m * 16; float ss = 0.f;
#pragma unroll
                for (int bj = 0; bj < 2; ++bj) {
                    const size_t off = (size_t)r * D + col0 + bj * HALF;
                    const f32x4 x0 = *(const f32x4*)(Xin + off), x1 = *(const f32x4*)(Xin + off + 4);
                    const f32x4 v0 = x0 + acc[ai][bj][m][0] * alpha, v1 = x1 + acc[ai][bj][m][1] * alpha;
                    *(f32x4*)(Xout + off) = v0; *(f32x4*)(Xout + off + 4) = v1;
                    ss += (v0[0] * v0[0] + v0[1] * v0[1]) + (v0[2] * v0[2] + v0[3] * v0[3]) + (v1[0] * v1[0] + v1[1] * v1[1]) + (v1[2] * v1[2] + v1[3] * v1[3]);
                    if (XBo) { u32x4 w; w.x = pk2(v0[0], v0[1]); w.y = pk2(v0[2], v0[3]); w.z = pk2(v1[0], v1[1]); w.w = pk2(v1[2], v1[3]); *(u32x4*)(XBo + off) = w; }
                }
                ss += __shfl_xor(ss, 16); ss += __shfl_xor(ss, 32);
                if (fq == 0) SSo[(size_t)r * 16 + u.pn * 4 + wc] = ss;
            }
    }
};
struct EpiResidB {
    const float* XinF; const bf16_t* XinB; bf16_t* O1; bf16_t* O2; float* SSo; float alpha;
    __device__ __forceinline__ void operator()(const f32x4 (&acc)[2][2][4][2], const Unit& u, int wr, int wc, int fr, int fq) const {
        const int row0 = u.pm * BM + wr * 64 + fr, col0 = u.pn * BM + wc * 32 + 8 * fq;
#pragma unroll
        for (int ai = 0; ai < 2; ++ai)
#pragma unroll
            for (int m = 0; m < 4; ++m) {
                const int r = row0 + ai * HALF + m * 16; float ss = 0.f;
#pragma unroll
                for (int bj = 0; bj < 2; ++bj) {
                    const size_t off = (size_t)r * D + col0 + bj * HALF;
                    f32x4 x0, x1;
                    if (XinF) { x0 = *(const f32x4*)(XinF + off); x1 = *(const f32x4*)(XinF + off + 4); }
                    else { const u32x4 xb = *(const u32x4*)(XinB + off); x0 = (f32x4){bflo(xb.x), bfhi(xb.x), bflo(xb.y), bfhi(xb.y)}; x1 = (f32x4){bflo(xb.z), bfhi(xb.z), bflo(xb.w), bfhi(xb.w)}; }
                    const f32x4 v0 = x0 + acc[ai][bj][m][0] * alpha, v1 = x1 + acc[ai][bj][m][1] * alpha;
                    ss += (v0[0] * v0[0] + v0[1] * v0[1]) + (v0[2] * v0[2] + v0[3] * v0[3]) + (v1[0] * v1[0] + v1[1] * v1[1]) + (v1[2] * v1[2] + v1[3] * v1[3]);
                    u32x4 w; w.x = pk2(v0[0], v0[1]); w.y = pk2(v0[2], v0[3]); w.z = pk2(v1[0], v1[1]); w.w = pk2(v1[2], v1[3]);
                    *(u32x4*)(O1 + off) = w; if (O2) *(u32x4*)(O2 + off) = w;
                }
                ss += __shfl_xor(ss, 16); ss += __shfl_xor(ss, 32);
                if (fq == 0) SSo[(size_t)r * 16 + u.pn * 4 + wc] = ss;
            }
    }
};
struct EpiProj {
    bf16_t* O; const float* SS;
    __device__ __forceinline__ void operator()(const f32x4 (&acc)[2][2][4][2], const Unit& u, int wr, int wc, int fr, int fq) const {
        bf16_t* base = O + (size_t)(u.pn >> 2) * ((size_t)T * D);
        const int row0 = u.pm * BM + wr * 64 + fr, col0 = (u.pn & 3) * BM + wc * 32 + 8 * fq;
        float rs8[8]; row_scales8(SS, row0, fq, rs8);
#pragma unroll
        for (int ai = 0; ai < 2; ++ai)
#pragma unroll
            for (int m = 0; m < 4; ++m) {
                const int r = row0 + ai * HALF + m * 16; const float rs = rs8[ai * 4 + m];
#pragma unroll
                for (int bj = 0; bj < 2; ++bj) {
                    const f32x4 v0 = acc[ai][bj][m][0] * rs, v1 = acc[ai][bj][m][1] * rs;
                    u32x4 w; w.x = pk2(v0[0], v0[1]); w.y = pk2(v0[2], v0[3]); w.z = pk2(v1[0], v1[1]); w.w = pk2(v1[2], v1[3]);
                    *(u32x4*)(base + (size_t)r * D + col0 + bj * HALF) = w;
                }
            }
    }
};
__device__ __forceinline__ float neg_expm1_(float x) {
    const float p = -x * (1.0f + x * (0.5f + x * (0.16666667f + x * (0.041666668f + x * 0.0083333338f))));
    const float e = 1.0f - __expf(x);
    return (x > -0.3f) ? p : e;
}
struct EpiRg {
    const bf16_t* XCR; const float* ba; const float* bx; const float* c8t; bf16_t* LOGA; bf16_t* U;
    __device__ __forceinline__ void operator()(const f32x4 (&acc)[2][2][4][2], const Unit& u, int wr, int wc, int fr, int fq) const {
        const int row0 = u.pm * BM + wr * 64 + fr, ch0 = (u.pn >> 1) * 256 + (u.pn & 1) * HALF + wc * 32 + 8 * fq;
#pragma unroll
        for (int n = 0; n < 2; ++n) {
            const int ch = ch0 + 4 * n;
            const f32x4 b_a = *(const f32x4*)(ba + ch), b_x = *(const f32x4*)(bx + ch), c8 = *(const f32x4*)(c8t + ch);
#pragma unroll
            for (int ai = 0; ai < 2; ++ai)
#pragma unroll
                for (int m = 0; m < 4; ++m) {
                    const int r = row0 + ai * HALF + m * 16;
                    const u32x2 xv = *(const u32x2*)(XCR + (size_t)r * D + ch);
                    const float xc[4] = {bflo(xv.x), bfhi(xv.x), bflo(xv.y), bfhi(xv.y)};
                    float la[4], uu[4];
#pragma unroll
                    for (int j = 0; j < 4; ++j) {
                        const float rg = sigmoidf_(acc[ai][0][m][n][j] + b_a[j]), ig = sigmoidf_(acc[ai][1][m][n][j] + b_x[j]);
                        la[j] = c8[j] * rg;
                        uu[j] = __builtin_amdgcn_sqrtf(fmaxf(neg_expm1_(2.0f * la[j]), 0.f)) * (ig * xc[j]);
                    }
                    u32x2 w0, w1; w0.x = pk2(la[0], la[1]); w0.y = pk2(la[2], la[3]); w1.x = pk2(uu[0], uu[1]); w1.y = pk2(uu[2], uu[3]);
                    *(u32x2*)(LOGA + (size_t)r * D + ch) = w0; *(u32x2*)(U + (size_t)r * D + ch) = w1;
                    __builtin_amdgcn_sched_barrier(0);
                }
        }
    }
};
struct EpiGates {
    float* G; const float* bg;
    __device__ __forceinline__ void operator()(const f32x4 (&acc)[2][2][4][2], const Unit& u, int wr, int wc, int fr, int fq) const {
        if (wc != 0 || fq != 0) return;
        const int row0 = u.pm * BM + wr * 64 + fr;
        const f32x4 b0 = *(const f32x4*)(bg), b1 = *(const f32x4*)(bg + 4);
#pragma unroll
        for (int ai = 0; ai < 2; ++ai)
#pragma unroll
            for (int m = 0; m < 4; ++m) {
                const int r = row0 + ai * HALF + m * 16;
                f32x4 v0 = acc[ai][0][m][0] + b0, v1 = acc[ai][0][m][1] + b1;
                for (int j = 0; j < 4; ++j) v1[j] = logsigf_(v1[j]);
                *(f32x4*)(G + (size_t)r * 8) = v0; *(f32x4*)(G + (size_t)r * 8 + 4) = v1;
            }
    }
};

template <class Epi, class Sched>
__device__ __forceinline__ void gemm_phase(LAS unsigned char* lds, const Gemm g, const Sched& S, const Epi& E) {
    const int tid = opaque_tid(), wid = __builtin_amdgcn_readfirstlane(tid >> 6), lane = tid & 63, wr = wid >> 2, wc = wid & 3, fr = lane & 15, fq = lane >> 4;
    const int K = g.K, nt = K / BK, lda = g.lda;
    unsigned voffA[2], voffB[2];
#pragma unroll
    for (int i = 0; i < 2; ++i) { int R, C; stage_rc(tid * 16 + i * 8192, R, C); const int Rb = (R & ~31) + perm32(R & 31);
        voffA[i] = (unsigned)(R * lda + C) * 2u; voffB[i] = (unsigned)(Rb * K + C) * 2u; }
    const size_t kstep = (size_t)(BK * 2);
    const size_t hstepA = (size_t)HALF * lda * 2, tstepA = 2 * hstepA;
    const size_t hstepB = (size_t)HALF * K * 2, tstepB = 2 * hstepB;
    const unsigned ldsw = (unsigned)wid * 1024u;
    const int aoff = lds_byte(wr * 64 + fr, fq * 8), boff = lds_byte(wc * 32 + fr, fq * 8);
    const int ksplit = g.ksplit; const long kdelta = g.kdelta;
#define PG8_AK(t) ((long)(t) * (long)kstep + (((t) >= ksplit) ? kdelta : 0l))
#define PG8_SA(b, h) (((b) * 2 + (h)) * HTB)
#define PG8_SB(b, h) ((4 + (b) * 2 + (h)) * HTB)
#define PG8_STAGE(bufoff, gbase, voff) do { _Pragma("unroll") for (int _i = 0; _i < 2; ++_i) \
        __builtin_amdgcn_global_load_lds((const unsigned*)((const char*)(gbase) + (voff)[_i]), (LAS unsigned*)(lds + (bufoff) + ldsw + _i * 8192), 16, 0, 0); } while (0)
#define PG8_LDA(dst, b, h) do { _Pragma("unroll") for (int m = 0; m < 4; ++m) _Pragma("unroll") for (int k = 0; k < 2; ++k) dst[m][k] = *(const LAS bf16x8*)(lds + PG8_SA(b, h) + aoff + m * 2048 + k * 1024); } while (0)
#define PG8_LDB(dst, b, h) do { _Pragma("unroll") for (int n = 0; n < 2; ++n) _Pragma("unroll") for (int k = 0; k < 2; ++k) dst[n][k] = *(const LAS bf16x8*)(lds + PG8_SB(b, h) + boff + n * 2048 + k * 1024); } while (0)
#define PG8_MMA(ai, bj, At, Bt) do { __builtin_amdgcn_s_setprio(1); _Pragma("unroll") for (int m = 0; m < 4; ++m) _Pragma("unroll") for (int n = 0; n < 2; ++n) _Pragma("unroll") for (int k = 0; k < 2; ++k) \
        acc[ai][bj][m][n] = __builtin_amdgcn_mfma_f32_16x16x32_bf16(Bt[n][k], At[m][k], acc[ai][bj][m][n], 0, 0, 0); __builtin_amdgcn_s_setprio(0); } while (0)
#define PG8_WAIT_V(n) asm volatile("s_waitcnt vmcnt(" #n ")" ::: "memory")
#define PG8_WAIT_L(n) asm volatile("s_waitcnt lgkmcnt(" #n ")" ::: "memory")
#define PG8_BAR __builtin_amdgcn_s_barrier()
#define PG8_SCHED __builtin_amdgcn_sched_barrier(0)
    Unit cur, nxt; int ui = 0;
    if (!S.next(0, cur)) return;
    f32x4 acc[2][2][4][2];
#pragma unroll
    for (int a = 0; a < 2; ++a)
#pragma unroll
        for (int b = 0; b < 2; ++b)
#pragma unroll
            for (int m = 0; m < 4; ++m)
#pragma unroll
                for (int n = 0; n < 2; ++n) acc[a][b][m][n] = (f32x4){0.f, 0.f, 0.f, 0.f};
    bf16x8 At[4][2], B0[2][2], B1[2][2];
    const char* cA = (const char*)g.A + (size_t)cur.pm * tstepA + (size_t)(cur.pn >> g.a_pn_shift) * g.a_pn_bytes;
    const char* cB = (const char*)g.Bt + (size_t)cur.pn * tstepB;
    {
        PG8_STAGE(PG8_SB(0, 0), cB, voffB); PG8_STAGE(PG8_SB(0, 1), cB + hstepB, voffB); PG8_STAGE(PG8_SA(0, 0), cA, voffA); PG8_STAGE(PG8_SA(0, 1), cA + hstepA, voffA);
        if (wr == 1) PG8_BAR;
        PG8_WAIT_V(2); PG8_BAR;
        PG8_STAGE(PG8_SB(1, 0), cB + kstep, voffB); PG8_STAGE(PG8_SA(1, 0), cA + PG8_AK(1), voffA); PG8_STAGE(PG8_SB(1, 1), cB + hstepB + kstep, voffB);
        PG8_WAIT_V(6); PG8_BAR;
    }
    for (;;) {
        const bool has_next = S.next(ui + 1, nxt);
        const char* nA = has_next ? (const char*)g.A + (size_t)nxt.pm * tstepA + (size_t)(nxt.pn >> g.a_pn_shift) * g.a_pn_bytes : cA;
        const char* nB = has_next ? (const char*)g.Bt + (size_t)nxt.pn * tstepB : cB;
#pragma nounroll
        for (int t = 0; t < nt; t += 2) {
            const bool last = (t == nt - 2);
            const char* a1 = cA + PG8_AK(t + 1);
            const char* a2 = last ? nA : cA + PG8_AK(t + 2); const char* b2 = last ? nB : cB + (size_t)(t + 2) * kstep;
            const char* a3 = last ? nA + PG8_AK(1) : cA + PG8_AK(t + 3); const char* b3 = b2 + kstep;
            PG8_LDB(B0, 0, 0); PG8_LDB(B1, 0, 1); PG8_SCHED; PG8_LDA(At, 0, 0); PG8_STAGE(PG8_SA(1, 1), a1 + hstepA, voffA);
            PG8_WAIT_V(8); PG8_WAIT_L(0); PG8_BAR; PG8_MMA(0, 0, At, B0); PG8_MMA(0, 1, At, B1); PG8_BAR; PG8_SCHED;
            PG8_LDA(At, 0, 1); PG8_STAGE(PG8_SB(0, 0), b2, voffB); PG8_STAGE(PG8_SB(0, 1), b2 + hstepB, voffB); PG8_STAGE(PG8_SA(0, 0), a2, voffA);
            PG8_WAIT_V(8); PG8_WAIT_L(0); PG8_BAR; PG8_MMA(1, 0, At, B0); PG8_MMA(1, 1, At, B1); PG8_BAR; PG8_SCHED;
            PG8_LDB(B0, 1, 0); PG8_LDB(B1, 1, 1); PG8_SCHED; PG8_LDA(At, 1, 0); PG8_STAGE(PG8_SA(0, 1), a2 + hstepA, voffA);
            PG8_WAIT_V(8); PG8_WAIT_L(0); PG8_BAR; PG8_MMA(0, 0, At, B0); PG8_MMA(0, 1, At, B1); PG8_BAR; PG8_SCHED;
            PG8_LDA(At, 1, 1); PG8_STAGE(PG8_SB(1, 0), b3, voffB); PG8_STAGE(PG8_SB(1, 1), b3 + hstepB, voffB); PG8_STAGE(PG8_SA(1, 0), a3, voffA);
            PG8_WAIT_V(8); PG8_WAIT_L(0); PG8_BAR; PG8_MMA(1, 0, At, B0); PG8_MMA(1, 1, At, B1); PG8_BAR; PG8_SCHED;
        }
        if (wr == 0) PG8_BAR;
        E(acc, cur, wr, wc, fr, fq);
        if (!has_next) break;
#pragma unroll
        for (int a = 0; a < 2; ++a)
#pragma unroll
            for (int b = 0; b < 2; ++b)
#pragma unroll
                for (int m = 0; m < 4; ++m)
#pragma unroll
                    for (int n = 0; n < 2; ++n) acc[a][b][m][n] = (f32x4){0.f, 0.f, 0.f, 0.f};
        cur = nxt; cA = nA; cB = nB; ++ui;
        if (wr == 1) PG8_BAR;
    }
    PG8_WAIT_V(0);
    PG8_BAR;
#undef PG8_AK
#undef PG8_SA
#undef PG8_SB
#undef PG8_STAGE
#undef PG8_LDA
#undef PG8_LDB
#undef PG8_MMA
#undef PG8_WAIT_V
#undef PG8_WAIT_L
#undef PG8_BAR
#undef PG8_SCHED
}
}

struct Args { const float* in[31]; float* out; unsigned char* ws; };
enum { I_X = 0, I_NF1, I_WG1, I_WU1, I_WD1, I_NMIX, I_WIN, I_MCW, I_MCB, I_WQ, I_WK, I_WV, I_WGATES, I_BGATES, I_LNW, I_SKIP, I_RCW, I_RCB, I_RWA, I_RBA, I_RWX, I_RBX, I_LAM,
       I_ONM, I_ONR, I_WOUT, I_NF2, I_WG2, I_WU2, I_WD2, I_NFIN };

template <class F> __device__ __forceinline__ void tr_item(F src, int K, bf16_t* WT, float* scr, int item, int nblk, int lane) {
    const int kb = item / nblk, nb = item % nblk, k0 = 64 * kb, n0 = 32 * nb;
#pragma unroll 8
    for (int i = 0; i < 32; ++i) { const int kk = 2 * i + (lane >> 5); scr[kk * 33 + (lane & 31)] = src(k0 + kk, n0 + (lane & 31)); }
    __builtin_amdgcn_wave_barrier();
    const int c = lane & 7;
#pragma unroll
    for (int j = 0; j < 4; ++j) { const int n = (lane >> 3) + 8 * j; const float* s = scr + (8 * c) * 33 + n;
        u32x4 o; o.x = pk2(s[0 * 33], s[1 * 33]); o.y = pk2(s[2 * 33], s[3 * 33]); o.z = pk2(s[4 * 33], s[5 * 33]); o.w = pk2(s[6 * 33], s[7 * 33]);
        *(u32x4*)(WT + (size_t)(n0 + n) * K + k0 + 8 * c) = o; }
    __builtin_amdgcn_wave_barrier();
}

__device__ __forceinline__ void p0_prologue(const Args& a, unsigned char* lds) {
    const int tid = opaque_tid(), lane = tid & 63, wave = tid >> 6;
    const int gw = blockIdx.x * 8 + wave, NGW = gridDim.x * 8;
    float* scr = (float*)(lds + wave * 16384);
    unsigned char* ws = a.ws;
    constexpr int I1 = 16 * 176, I2 = 44 * 32, I3 = 16 * 128, I4 = 4 * 64, I5 = 32 * 32;
    constexpr int NIT = I1 + I2 + I3 + I4 + I5 + I1 + I2;
    for (int it = gw; it < NIT; it += NGW) {
        int r = it;
        if (r < I1) { const float* wg = a.in[I_WG1]; const float* wu = a.in[I_WU1]; const float* gn = a.in[I_NF1];
            tr_item([=](int k, int n) { const int c = (n >> 8) * 128 + (n & 127); return (((n >> 7) & 1) ? wu : wg)[(size_t)k * FF + c] * gn[k]; }, 1024, (bf16_t*)(ws + WS_WGU1), scr, r, 176, lane); continue; } r -= I1;
        if (r < I2) { const float* wd = a.in[I_WD1];
            tr_item([=](int k, int n) { return wd[(size_t)k * D + n]; }, FF, (bf16_t*)(ws + WS_WD1), scr, r, 32, lane); continue; } r -= I2;
        if (r < I3) { const float* w = a.in[I_WIN]; const float* gn = a.in[I_NMIX];
            tr_item([=](int k, int n) { return w[(size_t)k * 4096 + n] * gn[k]; }, 1024, (bf16_t*)(ws + WS_WIN), scr, r, 128, lane); continue; } r -= I3;
        if (r < I4) { const float* wa = a.in[I_RWA]; const float* wx = a.in[I_RWX];
            tr_item([=](int k, int n) { const int pn = n >> 8, blk = pn >> 1, hh = pn & 1, sel = (n >> 7) & 1, c = hh * 128 + (n & 127); return (sel ? wx : wa)[(size_t)blk * 65536 + (size_t)k * 256 + c]; }, 256, (bf16_t*)(ws + WS_WRG), scr, r, 64, lane); continue; } r -= I4;
        if (r < I5) { const float* w = a.in[I_WOUT]; const float* gm = a.in[I_ONM]; const float* gr = a.in[I_ONR];
            tr_item([=](int k, int n) { return w[(size_t)k * D + n] * (k < 1024 ? gm[k] : gr[k - 1024]); }, 2048, (bf16_t*)(ws + WS_WOUT), scr, r, 32, lane); continue; } r -= I5;
        if (r < I1) { const float* wg = a.in[I_WG2]; const float* wu = a.in[I_WU2]; const float* gn = a.in[I_NF2];
            tr_item([=](int k, int n) { const int c = (n >> 8) * 128 + (n & 127); return (((n >> 7) & 1) ? wu : wg)[(size_t)k * FF + c] * gn[k]; }, 1024, (bf16_t*)(ws + WS_WGU2), scr, r, 176, lane); continue; } r -= I1;
        { const float* wd = a.in[I_WD2];
            tr_item([=](int k, int n) { return wd[(size_t)k * D + n]; }, FF, (bf16_t*)(ws + WS_WD2), scr, r, 32, lane); }
    }
    {
        bf16_t* WG8 = (bf16_t*)(ws + WS_WG8);
        const float* wq = a.in[I_WQ]; const float* wk = a.in[I_WK]; const float* wv = a.in[I_WV]; const float* Wg = a.in[I_WGATES];
        const int gt = blockIdx.x * 512 + tid, NT = gridDim.x * 512;
        for (int e = gt; e < 256 * 2048 / 8; e += NT) {
            const int g = e / 256, k0 = (e % 256) * 8;
            float o[8];
#pragma unroll
            for (int j = 0; j < 8; ++j) {
                float v = 0.f;
                if (g < 8) { const int k = k0 + j, c = k & 1023, n = c >> 2, i = c & 3;
                    if (k < 1024) { for (int oo = 0; oo < 4; ++oo) v += wq[n * 16 + i * 4 + oo] * Wg[(size_t)(4 * n + oo) * 8 + g] + wk[n * 16 + i * 4 + oo] * Wg[(size_t)(1024 + 4 * n + oo) * 8 + g]; }
                    else { for (int oo = 0; oo < 4; ++oo) v += wv[n * 16 + i * 4 + oo] * Wg[(size_t)(2048 + 4 * n + oo) * 8 + g]; } }
                o[j] = v;
            }
            *(u32x4*)(WG8 + (size_t)g * 2048 + k0) = pack8(o);
        }
    }
    if (blockIdx.x == 0) { float* C8 = (float*)(ws + WS_C8); const float* lam = a.in[I_LAM]; for (int e = tid; e < 1024; e += 512) C8[e] = 8.0f * logsig_acc_(lam[e]); }
    {
        const float* x = a.in[I_X]; bf16_t* XB = (bf16_t*)(ws + WS_XB); float* SS = (float*)(ws + WS_SSA);
        for (int m = gw; m < T; m += NGW) {
            const f32x4* xr = (const f32x4*)(x + (size_t)m * D) + lane;
            f32x4 v[4]; float s = 0.f;
#pragma unroll
            for (int j = 0; j < 4; ++j) { v[j] = xr[64 * j]; s += (v[j][0] * v[j][0] + v[j][1] * v[j][1]) + (v[j][2] * v[j][2] + v[j][3] * v[j][3]); }
            s = wave_sum(s);
            u32x2* o8 = (u32x2*)(XB + (size_t)m * D) + lane;
#pragma unroll
            for (int j = 0; j < 4; ++j) { u32x2 w; w.x = pk2(v[j][0], v[j][1]); w.y = pk2(v[j][2], v[j][3]); o8[64 * j] = w; }
            if (lane < 16) SS[(size_t)m * 16 + lane] = (lane == 0) ? s : 0.f;
        }
    }
}

template <bool SILU> __device__ __forceinline__ void conv_part(const bf16_t* in, bf16_t* out, const float* cw, const float* cb, int t0, int c0) {
    float w[4][8], b[8];
#pragma unroll
    for (int tap = 0; tap < 4; ++tap) { const f32x4 p = *(const f32x4*)(cw + tap * D + c0), q = *(const f32x4*)(cw + tap * D + c0 + 4); for (int j = 0; j < 4; ++j) { w[tap][j] = p[j]; w[tap][4 + j] = q[j]; } }
    { const f32x4 p = *(const f32x4*)(cb + c0), q = *(const f32x4*)(cb + c0 + 4); for (int j = 0; j < 4; ++j) { b[j] = p[j]; b[4 + j] = q[j]; } }
    float h0[8], h1[8], h2[8];
    const bool first = (t0 % SEQ) == 0;
    if (first) { for (int j = 0; j < 8; ++j) { h0[j] = 0.f; h1[j] = 0.f; h2[j] = 0.f; } }
    else {
        unpack8(*(const u32x4*)(in + (size_t)(t0 - 3) * D + c0), h0); unpack8(*(const u32x4*)(in + (size_t)(t0 - 2) * D + c0), h1); unpack8(*(const u32x4*)(in + (size_t)(t0 - 1) * D + c0), h2);
    }
    u32x4 cur[8];
#pragma unroll
    for (int i = 0; i < 8; ++i) cur[i] = *(const u32x4*)(in + (size_t)(t0 + i) * D + c0);
#pragma unroll
    for (int i = 0; i < 8; ++i) {
        float x[8], y[8]; unpack8(cur[i], x);
#pragma unroll
        for (int j = 0; j < 8; ++j) { float v = b[j] + w[0][j] * h0[j] + w[1][j] * h1[j] + w[2][j] * h2[j] + w[3][j] * x[j]; y[j] = SILU ? siluf_(v) : v; h0[j] = h1[j]; h1[j] = h2[j]; h2[j] = x[j]; }
        *(u32x4*)(out + (size_t)(t0 + i) * D + c0) = pack8(y);
    }
}
__device__ __forceinline__ void p4_conv(const Args& a) {
    unsigned char* ws = a.ws; const int tid = opaque_tid(), cgp = tid & 127, ts = tid >> 7;
    for (int u = blockIdx.x; u < T / 32; u += gridDim.x) {
        const int t0 = u * 32 + ts * 8, c0 = cgp * 8;
        conv_part<true>((const bf16_t*)(ws + WS_XM), (bf16_t*)(ws + WS_XC), a.in[I_MCW], a.in[I_MCB], t0, c0);
        conv_part<false>((const bf16_t*)(ws + WS_XR), (bf16_t*)(ws + WS_XB), a.in[I_RCW], a.in[I_RCB], t0, c0);
    }
}

__device__ __forceinline__ void p6_rg_agg(const Args& a) {
    unsigned char* ws = a.ws; const int tid = opaque_tid();
    const unsigned* LOGA = (const unsigned*)(ws + WS_XR); const unsigned* U = (const unsigned*)(ws + WS_U); float* AGG = (float*)(ws + WS_AGG);
    for (int tile = blockIdx.x; tile < 256; tile += gridDim.x) {
        const size_t row0 = (size_t)tile * 128;
        float sl0 = 0.f, sl1 = 0.f, h0 = 0.f, h1 = 0.f;
        for (int i0 = 0; i0 < 128; i0 += 16) {
            unsigned la[16], uu[16];
#pragma unroll
            for (int i = 0; i < 16; ++i) { la[i] = LOGA[(row0 + i0 + i) * 512 + tid]; uu[i] = U[(row0 + i0 + i) * 512 + tid]; }
#pragma unroll
            for (int i = 0; i < 16; ++i) { const float l0 = bflo(la[i]), l1 = bfhi(la[i]); sl0 += l0; sl1 += l1; h0 = __expf(l0) * h0 + bflo(uu[i]); h1 = __expf(l1) * h1 + bfhi(uu[i]); }
        }
        f32x4 o = {sl0, h0, sl1, h1};
        *(f32x4*)(AGG + ((size_t)tile * 1024 + 2 * tid) * 2) = o;
    }
}

template <int CTRL, int RMASK> __device__ __forceinline__ float dppf(float old, float src) {
    return __builtin_bit_cast(float, __builtin_amdgcn_update_dpp(__builtin_bit_cast(int, old), __builtin_bit_cast(int, src), CTRL, RMASK, 0xf, false));
}
__device__ __forceinline__ float readlane_f(float v, int l) { return __builtin_bit_cast(float, __builtin_amdgcn_readlane(__builtin_bit_cast(int, v), l)); }

namespace ml {
constexpr int QP = 264, SP = 72;
constexpr int O_QS = 0, O_KS = 33792, O_SS = 67584, O_VT = 76800, O_VW = 81408, O_CS = 86016, O_OSM = 102912, O_TAB = 111360, O_WTS = 113920, O_END = 126208;
}
__device__ __forceinline__ unsigned char* sraw_ptr(unsigned char* ws, int u) {
    return u < 1600 ? ws + (size_t)u * 5120 : (u < 2000 ? ws + 62 * MiB + (size_t)(u - 1600) * 5120 : ws + 12 * MiB + 512 * 1024 + (size_t)(u - 2000) * 5120);
}
__device__ __forceinline__ void p5b_sraw(const Args& a, unsigned char* lds) {
    using namespace ml;
    unsigned char* ws = a.ws;
    const int tid = opaque_tid(), lane = tid & 63, w = __builtin_amdgcn_readfirstlane(tid >> 6), fr = lane & 15, fq = lane >> 4;
    bf16_t* Qs = (bf16_t*)(lds + O_QS); bf16_t* Ks = (bf16_t*)(lds + O_KS); float* WTS = (float*)(lds + O_WTS);
    const bf16_t* XC = (const bf16_t*)(ws + WS_XC);
    const int srow = tid >> 5, scol = (tid & 31) * 8;
    for (int g = blockIdx.x; g < 256; g += gridDim.x) {
        const int bh = g >> 4, c0 = (g & 15) * 8, b = bh >> 2, h = bh & 3;
        __syncthreads();
        for (int e = tid; e < 1024; e += 512) { const int gg = e >> 4, bb = (e >> 2) & 3, aa = e & 3; const float* wq = a.in[I_WQ] + (h * 64 + gg) * 16; const float* wk = a.in[I_WK] + (h * 64 + gg) * 16;
            float v = 0.f; for (int o = 0; o < 4; ++o) v += wq[bb * 4 + o] * wk[aa * 4 + o]; WTS[e] = v * 0.0625f; }
        __syncthreads();
        const int lg0 = (tid & 31) * 2;
        f32x4 Wq[2][4];
#pragma unroll
        for (int g2 = 0; g2 < 2; ++g2)
#pragma unroll
            for (int i = 0; i < 4; ++i) Wq[g2][i] = *(const f32x4*)(WTS + (lg0 + g2) * 16 + i * 4);
        for (int cc = 0; cc < 8; ++cc) {
            const int c = c0 + cc; const size_t t0 = (size_t)b * SEQ + (size_t)c * 64;
            u32x4 xr[4];
#pragma unroll
            for (int i = 0; i < 4; ++i) xr[i] = *(const u32x4*)(XC + (t0 + srow + 16 * i) * D + h * 256 + scol);
#pragma unroll
            for (int i = 0; i < 4; ++i) {
                float x[8]; unpack8(xr[i], x);
                float q[8];
#pragma unroll
                for (int g2 = 0; g2 < 2; ++g2) {
                    const f32x4 qq = Wq[g2][0] * x[4 * g2] + Wq[g2][1] * x[4 * g2 + 1] + Wq[g2][2] * x[4 * g2 + 2] + Wq[g2][3] * x[4 * g2 + 3];
                    for (int j = 0; j < 4; ++j) q[4 * g2 + j] = qq[j];
                }
                const int r = srow + 16 * i;
                *(u32x4*)(Qs + r * QP + scol) = pack8(q); *(u32x4*)(Ks + r * QP + scol) = xr[i];
            }
            __syncthreads();
            {
                unsigned char* sp = sraw_ptr(ws, bh * 128 + c);
#define S_DECODE(li, it, jt) do { if ((li) < 4) { it = 3; jt = (li); } else if ((li) < 7) { it = 2; jt = (li) - 4; } else if ((li) < 9) { it = 1; jt = (li) - 7; } else { it = 0; jt = 0; } } while (0)
#define S_EPI(li, sv) do { u32x2 wv_; wv_.x = pk2(sv[0], sv[1]); wv_.y = pk2(sv[2], sv[3]); *(u32x2*)(sp + (li) * 512 + lane * 8) = wv_; } while (0)
                int it0, jt0, it1 = 0, jt1 = 0; S_DECODE(w, it0, jt0);
                const bool two = (w < 2); if (two) S_DECODE(w + 8, it1, jt1);
                f32x4 sA = (f32x4){0.f, 0.f, 0.f, 0.f}, sB = sA, tA = sA, tB = sA;
                const bf16_t* k0p = Ks + (jt0 * 16 + fr) * QP + fq * 8; const bf16_t* q0p = Qs + (it0 * 16 + fr) * QP + fq * 8;
                const bf16_t* k1p = Ks + (jt1 * 16 + fr) * QP + fq * 8; const bf16_t* q1p = Qs + (it1 * 16 + fr) * QP + fq * 8;
#pragma unroll
                for (int ks = 0; ks < 8; ks += 2) {
                    sA = __builtin_amdgcn_mfma_f32_16x16x32_bf16(*(const bf16x8*)(k0p + ks * 32), *(const bf16x8*)(q0p + ks * 32), sA, 0, 0, 0);
                    sB = __builtin_amdgcn_mfma_f32_16x16x32_bf16(*(const bf16x8*)(k0p + ks * 32 + 32), *(const bf16x8*)(q0p + ks * 32 + 32), sB, 0, 0, 0);
                    if (two) {
                        tA = __builtin_amdgcn_mfma_f32_16x16x32_bf16(*(const bf16x8*)(k1p + ks * 32), *(const bf16x8*)(q1p + ks * 32), tA, 0, 0, 0);
                        tB = __builtin_amdgcn_mfma_f32_16x16x32_bf16(*(const bf16x8*)(k1p + ks * 32 + 32), *(const bf16x8*)(q1p + ks * 32 + 32), tB, 0, 0, 0);
                    }
                }
                const f32x4 s0 = sA + sB; S_EPI(w, s0);
                if (two) { const f32x4 s1 = tA + tB; S_EPI(w + 8, s1); }
#undef S_DECODE
#undef S_EPI
            }
            __syncthreads();
        }
    }
}

__device__ __forceinline__ void p6_mlstm(const Args& a, unsigned char* lds) {
    using namespace ml;
    unsigned char* ws = a.ws;
    const int tid = opaque_tid(), lane = tid & 63, w = __builtin_amdgcn_readfirstlane(tid >> 6), fr = lane & 15, fq = lane >> 4;
    bf16_t* Qs = (bf16_t*)(lds + O_QS); bf16_t* Ks = (bf16_t*)(lds + O_KS); bf16_t* Ss = (bf16_t*)(lds + O_SS);
    bf16_t* Vt = (bf16_t*)(lds + O_VT); bf16_t* Vw = (bf16_t*)(lds + O_VW); bf16_t* Cs = (bf16_t*)(lds + O_CS);
    float* Osm = (float*)(lds + O_OSM); float* TAB = (float*)(lds + O_TAB); float* WTS = (float*)(lds + O_WTS);
    const bf16_t* XC = (const bf16_t*)(ws + WS_XC); const bf16_t* XM = (const bf16_t*)(ws + WS_XM); const float* GATES = (const float*)(ws + WS_GATES);
    bf16_t* HM = (bf16_t*)(ws + WS_XB);
    for (int unit = blockIdx.x; unit < 256; unit += gridDim.x) {
        const int xcd = unit & 7, idx = unit >> 3, bh = xcd * 2 + (idx >> 4), vs = idx & 15, b = bh >> 2, h = bh & 3;
        __syncthreads();
        for (int e = tid; e < 64 * SP / 2; e += 512) ((unsigned*)Ss)[e] = 0u;
        for (int e = tid; e < 32 * SP / 2; e += 512) { const int row = e / (SP / 2); ((unsigned*)Vt)[e] = (row == 16) ? 0x3F803F80u : 0u; ((unsigned*)Vw)[e] = 0u; }
        for (int e = tid; e < 32 * QP / 2; e += 512) ((unsigned*)Cs)[e] = 0u;
        for (int e = tid; e < 1024; e += 512) { const int g = e >> 4, bb = (e >> 2) & 3, aa = e & 3; const float* wq = a.in[I_WQ] + (h * 64 + g) * 16; const float* wk = a.in[I_WK] + (h * 64 + g) * 16;
            float v = 0.f; for (int o = 0; o < 4; ++o) v += wq[bb * 4 + o] * wk[aa * 4 + o]; WTS[e] = v * 0.0625f; }
        for (int e = tid; e < 1024; e += 512) WTS[2048 + e] = a.in[I_WV][h * 1024 + e];
        f32x4 Cacc[2][2];
#pragma unroll
        for (int i = 0; i < 2; ++i)
#pragma unroll
            for (int j = 0; j < 2; ++j) Cacc[i][j] = (f32x4){0.f, 0.f, 0.f, 0.f};
        const int srow = tid >> 5, scol = (tid & 31) * 8;
        const int vrow = tid >> 1, vhalf = tid & 1;
        const size_t tbase = (size_t)b * SEQ;
        u32x4 xr[4], xmr = (u32x4){0u, 0u, 0u, 0u}; float gi, gf;
        u32x2 sr0 = (u32x2){0u, 0u}, sr1 = (u32x2){0u, 0u};
        {
            const size_t t0 = tbase;
#pragma unroll
            for (int i = 0; i < 4; ++i) xr[i] = *(const u32x4*)(XC + (t0 + srow + 16 * i) * D + h * 256 + scol);
            if (tid < 128) xmr = *(const u32x4*)(XM + (t0 + vrow) * D + h * 256 + vs * 16 + vhalf * 8);
            gi = GATES[(t0 + lane) * 8 + h]; gf = GATES[(t0 + lane) * 8 + 4 + h];
            const unsigned char* sp = sraw_ptr(ws, bh * 128);
            sr0 = *(const u32x2*)(sp + tid * 8); if (tid < 128) sr1 = *(const u32x2*)(sp + 4096 + tid * 8);
        }
        __syncthreads();
        float decay = 0.f, m_cur = -1e30f;
        constexpr int NC = SEQ / 64;
        for (int c = -1; c < NC; ++c) {
            float* tab = TAB + (c & 1) * 320;
            if (c >= 0) {
            __syncthreads();
            {
                const int rt = w & 3, vt = w >> 2;
                f32x4 a1 = (f32x4){0.f, 0.f, 0.f, 0.f}, a2 = (f32x4){0.f, 0.f, 0.f, 0.f};
#pragma unroll
                for (int ks = 0; ks < 2; ++ks) {
                    const bf16x8 sa_ = *(const bf16x8*)(Ss + (rt * 16 + fr) * SP + ks * 32 + fq * 8);
                    const bf16x8 vb = *(const bf16x8*)(Vt + (vt * 16 + fr) * SP + ks * 32 + fq * 8);
                    a1 = __builtin_amdgcn_mfma_f32_16x16x32_bf16(sa_, vb, a1, 0, 0, 0);
                }
#pragma unroll
                for (int ks = 0; ks < 8; ++ks) {
                    const bf16x8 qa = *(const bf16x8*)(Qs + (rt * 16 + fr) * QP + ks * 32 + fq * 8);
                    const bf16x8 cb = *(const bf16x8*)(Cs + (vt * 16 + fr) * QP + ks * 32 + fq * 8);
                    a2 = __builtin_amdgcn_mfma_f32_16x16x32_bf16(qa, cb, a2, 0, 0, 0);
                }
#pragma unroll
                for (int e = 0; e < 4; ++e) { const int i = rt * 16 + fq * 4 + e; Osm[i * 33 + vt * 16 + fr] = a1[e] + tab[128 + i] * a2[e]; }
            }
            {
#pragma unroll
                for (int kl = 0; kl < 2; ++kl)
#pragma unroll
                    for (int vt = 0; vt < 2; ++vt) Cacc[kl][vt] = Cacc[kl][vt] * decay;
#pragma unroll
                for (int kl = 0; kl < 2; ++kl) {
                    const int kcol = (2 * w + kl) * 16 + fr;
#pragma unroll
                    for (int ks = 0; ks < 2; ++ks) {
                        bf16x8 ka;
#pragma unroll
                        for (int e = 0; e < 8; ++e) ka[e] = (short)Ks[(ks * 32 + fq * 8 + e) * QP + kcol];
#pragma unroll
                        for (int vt = 0; vt < 2; ++vt) {
                            const bf16x8 vb = *(const bf16x8*)(Vw + (vt * 16 + fr) * SP + ks * 32 + fq * 8);
                            Cacc[kl][vt] = __builtin_amdgcn_mfma_f32_16x16x32_bf16(ka, vb, Cacc[kl][vt], 0, 0, 0);
                        }
                    }
                }
            }
            }
            u32x4 qpk[4]; float vnx[8], decay_n = 0.f, m_nx = m_cur;
            if (c + 1 < NC) {
                const int lg0 = (tid & 31) * 2;
                f32x4 Wq[2][4];
#pragma unroll
                for (int g2 = 0; g2 < 2; ++g2)
#pragma unroll
                    for (int i = 0; i < 4; ++i) Wq[g2][i] = *(const f32x4*)(WTS + (lg0 + g2) * 16 + i * 4);
#pragma unroll
                for (int i = 0; i < 4; ++i) {
                    float x[8]; unpack8(xr[i], x);
                    float q[8];
#pragma unroll
                    for (int g2 = 0; g2 < 2; ++g2) {
                        const f32x4 qq = Wq[g2][0] * x[4 * g2] + Wq[g2][1] * x[4 * g2 + 1] + Wq[g2][2] * x[4 * g2 + 2] + Wq[g2][3] * x[4 * g2 + 3];
                        for (int j = 0; j < 4; ++j) q[4 * g2 + j] = qq[j];
                    }
                    qpk[i] = pack8(q);
                }
                if (tid < 128) {
                    float x[8]; unpack8(xmr, x);
                    const int lgv = vs * 4 + vhalf * 2;
#pragma unroll
                    for (int g2 = 0; g2 < 2; ++g2) {
                        const float* Wv = WTS + 2048 + (lgv + g2) * 16;
#pragma unroll
                        for (int o = 0; o < 4; ++o) vnx[4 * g2 + o] = Wv[0 * 4 + o] * x[4 * g2] + Wv[1 * 4 + o] * x[4 * g2 + 1] + Wv[2 * 4 + o] * x[4 * g2 + 2] + Wv[3 * 4 + o] * x[4 * g2 + 3];
                    }
                }
                float sa = gf, sc = gi;
#define SCAN_STEP(CTRL, RM) do { const float ao = dppf<CTRL, RM>(0.f, sa), co = dppf<CTRL, RM>(-INFINITY, sc); sc = fmaxf(co + sa, sc); sa = ao + sa; } while (0)
                SCAN_STEP(0x111, 0xf); SCAN_STEP(0x112, 0xf); SCAN_STEP(0x114, 0xf); SCAN_STEP(0x118, 0xf);
                SCAN_STEP(0x142, 0xa);
                SCAN_STEP(0x143, 0xc);
#undef SCAN_STEP
                const float Mi = fmaxf(m_cur + sa, sc);
                const float gtot = readlane_f(sa, 63); m_nx = readlane_f(Mi, 63);
                decay_n = __expf(gtot + m_cur - m_nx);
                if (w == 0) {
                    float* tn = TAB + ((c + 1) & 1) * 320;
                    tn[lane] = sa - Mi; tn[64 + lane] = gi - sa; tn[128 + lane] = __expf(sa + m_cur - Mi); tn[192 + lane] = __expf(-Mi); tn[256 + lane] = __expf(gtot - sa + gi - m_nx);
                }
            }
            if (c >= 0) {
            __syncthreads();
            {
#pragma unroll
                for (int kl = 0; kl < 2; ++kl)
#pragma unroll
                    for (int vt = 0; vt < 2; ++vt) {
                        u32x2 wv; wv.x = pk2(Cacc[kl][vt][0], Cacc[kl][vt][1]); wv.y = pk2(Cacc[kl][vt][2], Cacc[kl][vt][3]);
                        *(u32x2*)(Cs + (vt * 16 + fr) * QP + (2 * w + kl) * 16 + fq * 4) = wv;
                    }
                const int i = tid >> 3, vp = (tid & 7) * 2;
                const float den = Osm[i * 33 + 16], dn = fmaxf(fabsf(den), tab[192 + i]);
                const float rdn = __builtin_amdgcn_rcpf(dn); const float h0 = Osm[i * 33 + vp] * rdn, h1 = Osm[i * 33 + vp + 1] * rdn;
                *(unsigned*)(HM + ((size_t)(bh * 16 + vs) * SEQ + (size_t)c * 64 + i) * 16 + vp) = pk2(h0, h1);
            }
            }
            if (c + 1 < NC) {
#pragma unroll
                for (int i = 0; i < 4; ++i) { const int r = srow + 16 * i; *(u32x4*)(Qs + r * QP + scol) = qpk[i]; *(u32x4*)(Ks + r * QP + scol) = xr[i]; }
                if (c < 0) __syncthreads();
                const float* tn = TAB + ((c + 1) & 1) * 320;
                if (tid < 128) {
                    const float wk = tn[256 + vrow];
#pragma unroll
                    for (int e = 0; e < 8; ++e) { Vt[(vhalf * 8 + e) * SP + vrow] = (bf16_t)(pk2(vnx[e], 0.f) & 0xffffu); Vw[(vhalf * 8 + e) * SP + vrow] = (bf16_t)(pk2(vnx[e] * wk, 0.f) & 0xffffu); }
                } else if (tid < 192) { Vw[16 * SP + (tid - 128)] = (bf16_t)(pk2(tn[256 + tid - 128], 0.f) & 0xffffu); }
#define SS_ITEM(li, sr) do { int it_, jt_; if ((li) < 4) { it_ = 3; jt_ = (li); } else if ((li) < 7) { it_ = 2; jt_ = (li) - 4; } else if ((li) < 9) { it_ = 1; jt_ = (li) - 7; } else { it_ = 0; jt_ = 0; } \
        const int i_ = it_ * 16 + fr, j0_ = jt_ * 16 + fq * 4; const float rf_ = tn[i_]; const f32x4 cf_ = *(const f32x4*)(tn + 64 + j0_); \
        const float sv_[4] = {bflo((sr).x), bfhi((sr).x), bflo((sr).y), bfhi((sr).y)}; float o_[4]; \
        _Pragma("unroll") for (int e = 0; e < 4; ++e) o_[e] = (j0_ + e <= i_) ? sv_[e] * __expf(rf_ + cf_[e]) : 0.f; \
        u32x2 wv_; wv_.x = pk2(o_[0], o_[1]); wv_.y = pk2(o_[2], o_[3]); *(u32x2*)(Ss + i_ * SP + j0_) = wv_; } while (0)
                SS_ITEM(w, sr0);
                if (w < 2) SS_ITEM(w + 8, sr1);
#undef SS_ITEM
                decay = decay_n; m_cur = m_nx;
                if (c + 2 < NC) {
                    const size_t t2 = tbase + (size_t)(c + 2) * 64;
#pragma unroll
                    for (int i = 0; i < 4; ++i) xr[i] = *(const u32x4*)(XC + (t2 + srow + 16 * i) * D + h * 256 + scol);
                    if (tid < 128) xmr = *(const u32x4*)(XM + (t2 + vrow) * D + h * 256 + vs * 16 + vhalf * 8);
                    gi = GATES[(t2 + lane) * 8 + h]; gf = GATES[(t2 + lane) * 8 + 4 + h];
                    const unsigned char* sp = sraw_ptr(ws, bh * 128 + c + 2);
                    sr0 = *(const u32x2*)(sp + tid * 8); if (tid < 128) sr1 = *(const u32x2*)(sp + 4096 + tid * 8);
                }
            }
        }
    }
}

__device__ __forceinline__ void p7_mlstm_fin(const Args& a) {
    unsigned char* ws = a.ws; const int tid = opaque_tid(), lane = tid & 63, wave = tid >> 6;
    const int gw = blockIdx.x * 8 + wave, NGW = gridDim.x * 8;
    const bf16_t* HM = (const bf16_t*)(ws + WS_XB); const bf16_t* XC = (const bf16_t*)(ws + WS_XC); bf16_t* ZM = (bf16_t*)(ws + WS_ZM);
    float lnw[16], skp[16];
#pragma unroll
    for (int j = 0; j < 4; ++j) { const f32x4 p = *(const f32x4*)(a.in[I_LNW] + lane * 16 + 4 * j), q = *(const f32x4*)(a.in[I_SKIP] + lane * 16 + 4 * j); for (int e = 0; e < 4; ++e) { lnw[4 * j + e] = p[e]; skp[4 * j + e] = q[e]; } }
    for (int m = gw; m < T; m += NGW) {
        const size_t off = (size_t)m * D + lane * 16;
        float hv[16], xc[16], z[16];
        { const size_t hoff = ((size_t)(((m / SEQ) * 4 + (lane >> 4)) * 16 + (lane & 15)) * SEQ + (size_t)(m % SEQ)) * 16;
          unpack8(*(const u32x4*)(HM + hoff), hv); unpack8(*(const u32x4*)(HM + hoff + 8), hv + 8); }
        unpack8(*(const u32x4*)(XC + off), xc); unpack8(*(const u32x4*)(XC + off + 8), xc + 8);
        unpack8(*(const u32x4*)(ZM + off), z); unpack8(*(const u32x4*)(ZM + off + 8), z + 8);
        float s = 0.f;
#pragma unroll
        for (int e = 0; e < 16; ++e) s += hv[e];
        s += __shfl_xor(s, 1); s += __shfl_xor(s, 2); s += __shfl_xor(s, 4); s += __shfl_xor(s, 8);
        const float mu = s * (1.0f / 256.0f); float q = 0.f;
#pragma unroll
        for (int e = 0; e < 16; ++e) { hv[e] -= mu; q += hv[e] * hv[e]; }
        q += __shfl_xor(q, 1); q += __shfl_xor(q, 2); q += __shfl_xor(q, 4); q += __shfl_xor(q, 8);
        const float rstd = rsqrtf(q * (1.0f / 256.0f) + EPS);
        float o[16], ss = 0.f;
#pragma unroll
        for (int e = 0; e < 16; ++e) { o[e] = (hv[e] * rstd * lnw[e] + skp[e] * xc[e]) * siluf_(z[e]); ss += o[e] * o[e]; }
        ss = wave_sum(ss);
        const float rs = rsqrtf(ss * (1.0f / 1024.0f) + EPS);
#pragma unroll
        for (int e = 0; e < 16; ++e) o[e] *= rs;
        *(u32x4*)(ZM + off) = pack8(o); *(u32x4*)(ZM + off + 8) = pack8(o + 8);
    }
}
__device__ __forceinline__ void p7_rg_fin(const Args& a, unsigned char* lds) {
    unsigned char* ws = a.ws; const int tid = opaque_tid();
    unsigned* LOGA = (unsigned*)(ws + WS_XR); const unsigned* U = (const unsigned*)(ws + WS_U); const unsigned* YR = (const unsigned*)(ws + WS_YR); const float* AGG = (const float*)(ws + WS_AGG);
    float* Ot = (float*)lds;
    constexpr int OP = 1028;
    for (int tile = blockIdx.x; tile < 256; tile += gridDim.x) {
        const int tc = tile & 63, tb = tile & ~63;
        float h0 = 0.f, h1 = 0.f;
        for (int p = 0; p < tc; ++p) { const f32x4 g = *(const f32x4*)(AGG + ((size_t)(tb + p) * 1024 + 2 * tid) * 2); h0 = __expf(g[0]) * h0 + g[1]; h1 = __expf(g[2]) * h1 + g[3]; }
        const size_t row0 = (size_t)tile * 128;
        for (int i0 = 0; i0 < 128; i0 += 16) {
            unsigned la[16], uu[16], yy[16];
#pragma unroll
            for (int i = 0; i < 16; ++i) { const size_t o = (row0 + i0 + i) * 512 + tid; la[i] = LOGA[o]; uu[i] = U[o]; yy[i] = YR[o]; }
            __syncthreads();
#pragma unroll
            for (int i = 0; i < 16; ++i) {
                h0 = __expf(bflo(la[i])) * h0 + bflo(uu[i]); h1 = __expf(bfhi(la[i])) * h1 + bfhi(uu[i]);
                Ot[i * OP + 2 * tid] = h0 * geluf_(bflo(yy[i])); Ot[i * OP + 2 * tid + 1] = h1 * geluf_(bfhi(yy[i]));
            }
            __syncthreads();
            {
                const int row = tid >> 5, sub = tid & 31;
                f32x4 v[4][2]; float ss = 0.f;
#pragma unroll
                for (int q = 0; q < 4; ++q)
#pragma unroll
                    for (int hh = 0; hh < 2; ++hh) { v[q][hh] = *(const f32x4*)(Ot + row * OP + q * 256 + sub * 8 + hh * 4); const f32x4 t = v[q][hh]; ss += (t[0] * t[0] + t[1] * t[1]) + (t[2] * t[2] + t[3] * t[3]); }
                ss += __shfl_xor(ss, 1); ss += __shfl_xor(ss, 2); ss += __shfl_xor(ss, 4); ss += __shfl_xor(ss, 8); ss += __shfl_xor(ss, 16);
                const float rs = rsqrtf(ss * (1.0f / 1024.0f) + EPS);
                bf16_t* orow = (bf16_t*)LOGA + (row0 + i0 + row) * D;
#pragma unroll
                for (int q = 0; q < 4; ++q) { const f32x4 p = v[q][0] * rs, r = v[q][1] * rs; u32x4 wv; wv.x = pk2(p[0], p[1]); wv.y = pk2(p[2], p[3]); wv.z = pk2(r[0], r[1]); wv.w = pk2(r[2], r[3]); *(u32x4*)(orow + q * 256 + sub * 8) = wv; }
            }
        }
        __syncthreads();
    }
}

__device__ __forceinline__ void p11_final(const Args& a) {
    const int tid = opaque_tid(), lane = tid & 63, wave = tid >> 6;
    const int gw = blockIdx.x * 8 + wave, NGW = gridDim.x * 8;
    const float* SS = (const float*)(a.ws + WS_SSD); const float* gn = a.in[I_NFIN]; const bf16_t* X3 = (const bf16_t*)(a.ws + WS_XB);
    f32x4 g[4];
#pragma unroll
    for (int j = 0; j < 4; ++j) g[j] = *((const f32x4*)gn + lane * 4 + j);
    for (int m = gw; m < T; m += NGW) {
        const float rs = pg8::row_scale(SS, m);
        const size_t off = (size_t)m * D + lane * 16;
        float x[16]; unpack8(*(const u32x4*)(X3 + off), x); unpack8(*(const u32x4*)(X3 + off + 8), x + 8);
        f32x4* o = (f32x4*)(a.out + off);
#pragma unroll
        for (int j = 0; j < 4; ++j) { f32x4 v = (f32x4){x[4 * j], x[4 * j + 1], x[4 * j + 2], x[4 * j + 3]}; o[j] = v * rs * g[j]; }
    }
}

#define XB_TMO      128
#define XB_XCNT(j)  (256  + 64 * (j))
#define XB_XSUB(j)  (1280 + 64 * (j))
#define XB_XGEN(j)  (2304 + 64 * (j))
#define XB_TOP      3328
#define XB_TOPGEN   3392
#define XCD_BAR_WORDS 3456
#define XB_SPIN_CAP (1u << 18)
__device__ __forceinline__ unsigned xb_ld(unsigned* p)              { return __hip_atomic_load(p, __ATOMIC_RELAXED, __HIP_MEMORY_SCOPE_AGENT); }
__device__ __forceinline__ unsigned xb_add(unsigned* p, unsigned v) { return __hip_atomic_fetch_add(p, v, __ATOMIC_RELAXED, __HIP_MEMORY_SCOPE_AGENT); }
__device__ __forceinline__ unsigned xb_xcc_id() { return (unsigned)__builtin_amdgcn_s_getreg((3 << 11) | 20) & 0xFu; }
#define XB_SPIN(cond, bar) do { unsigned _sp = 0; while (cond) { __builtin_amdgcn_s_sleep(1); \
    if ((++_sp & 255u) == 0u) { if (xb_ld(&(bar)[XB_TMO])) break; if (_sp > XB_SPIN_CAP) { atomicAdd(&(bar)[XB_TMO], 1u); break; } } } } while (0)
struct XcdBarrier { unsigned* bar; unsigned x; volatile LAS unsigned* st; };
__device__ __forceinline__ XcdBarrier xcd_barrier_post(unsigned* bar, volatile LAS unsigned* st) {
    XcdBarrier b; b.bar = bar; b.x = xb_xcc_id(); b.st = st;
    if (threadIdx.x == 0) (void)xb_add(&bar[XB_XCNT(b.x)], 1u);
    return b;
}
__device__ __forceinline__ void xcd_barrier_complete(unsigned* bar, unsigned x, unsigned& nloc, unsigned& nx) {
    const unsigned G = gridDim.x * gridDim.y * gridDim.z;
    unsigned sum, cnt, mine, sp = 0u;
    for (;;) {
        sum = 0u; cnt = 0u; mine = 0u;
#pragma unroll
        for (unsigned j = 0; j < 16; ++j) { const unsigned c = xb_ld(&bar[XB_XCNT(j)]); sum += c; cnt += (c > 0u) ? 1u : 0u; mine = (j == x) ? c : mine; }
        if (sum == G) break;
        __builtin_amdgcn_s_sleep(1);
        if ((++sp & 255u) == 0u) { if (xb_ld(&bar[XB_TMO])) break; if (sp > XB_SPIN_CAP) { atomicAdd(&bar[XB_TMO], 1u); break; } }
    }
    nloc = mine > 0u ? mine : 1u; nx = cnt > 0u ? cnt : 1u;
}
__device__ __forceinline__ void xcd_barrier(const XcdBarrier& b) {
    asm volatile("s_waitcnt vmcnt(0)" ::: "memory");
    __syncthreads();
    if (threadIdx.x == 0) {
        unsigned* bar = b.bar;
        __builtin_amdgcn_s_waitcnt(0);
        unsigned nloc = b.st[0], nx = b.st[1];
        if (nloc == 0u) { xcd_barrier_complete(bar, b.x, nloc, nx); b.st[0] = nloc; b.st[1] = nx; }
        const unsigned old = xb_add(&bar[XB_XSUB(b.x)], 1u);
        const unsigned gen = old / nloc;
        if (old + 1u == (gen + 1u) * nloc) {
            __builtin_amdgcn_fence(__ATOMIC_RELEASE, "agent");
            asm volatile("s_waitcnt vmcnt(0)" ::: "memory");
            const unsigned og = xb_add(&bar[XB_TOP], 1u);
            const unsigned tg = og / nx;
            if (og + 1u == (tg + 1u) * nx) xb_add(&bar[XB_TOPGEN], 1u);
            else XB_SPIN(xb_ld(&bar[XB_TOPGEN]) == tg, bar);
            __builtin_amdgcn_fence(__ATOMIC_ACQUIRE, "agent");
            xb_add(&bar[XB_XGEN(b.x)], 1u);
            asm volatile("s_waitcnt vmcnt(0)" ::: "memory");
        } else {
            XB_SPIN(xb_ld(&bar[XB_XGEN(b.x)]) == gen, bar);
            __builtin_amdgcn_fence(__ATOMIC_ACQUIRE, "agent");
            asm volatile("s_waitcnt vmcnt(0)" ::: "memory");
        }
    }
    __syncthreads();
}
#define GSYNC() xcd_barrier(xbar)
__global__ void __launch_bounds__(512, 2) mk_fwd(Args args) {
    extern __shared__ __attribute__((aligned(16))) unsigned char lds_raw[];
    cg::grid_group grid = cg::this_grid();
    LAS unsigned char* lds = (LAS unsigned char*)lds_raw;
    unsigned char* ws = args.ws;
    const int G = gridDim.x, bid = blockIdx.x;
    volatile LAS unsigned* xst = (volatile LAS unsigned*)(lds + (LDS_BYTES - 64));
    if (threadIdx.x == 0) { xst[0] = 0u; xst[1] = 0u; }
    __syncthreads();
    const XcdBarrier xbar = xcd_barrier_post((unsigned*)(ws + WS_BAR), xst);
    bf16_t* XB = (bf16_t*)(ws + WS_XB); bf16_t* ACT = (bf16_t*)(ws + WS_R1);
#ifndef NO_P0
    p0_prologue(args, lds_raw);
#endif
    asm volatile("s_waitcnt vmcnt(0)" ::: "memory"); __threadfence(); grid.sync();
#ifndef NO_P1
    { const pg8::Gemm gUp1{XB, (const bf16_t*)(ws + WS_WGU1), 1024, 1024, 1 << 30, 0, 0, 0}; pg8::StaticOrder S; S.init(T, 2 * FF, G, bid); pg8::EpiSwiGLU E{ACT, (const float*)(ws + WS_SSA)}; pg8::gemm_phase(lds, gUp1, S, E); }
#endif
    GSYNC();
#ifndef NO_P2
    { const pg8::Gemm gDn1{ACT, (const bf16_t*)(ws + WS_WD1), FF, FF, 1 << 30, 0, 0, 0}; pg8::StaticOrder S; S.init(T, D, G, bid); pg8::EpiResidB E{args.in[I_X], nullptr, XB, (bf16_t*)args.out  , (float*)(ws + WS_SSB), 0.5f}; pg8::gemm_phase(lds, gDn1, S, E); }
#endif
    GSYNC();
#ifndef NO_P3
    { const pg8::Gemm gIn{XB, (const bf16_t*)(ws + WS_WIN), 1024, 1024, 1 << 30, 0, 0, 0}; pg8::StaticOrder S; S.init(T, 4096, G, bid); pg8::EpiProj E{(bf16_t*)(ws + WS_XM), (const float*)(ws + WS_SSB)}; pg8::gemm_phase(lds, gIn, S, E); }
#endif
    GSYNC();
#ifndef NO_P4
    p4_conv(args);
#endif
    GSYNC();
#ifndef NO_P5
    {
        const pg8::Gemm gRg{XB  , (const bf16_t*)(ws + WS_WRG), 256, 1024, 1 << 30, 0, 1, 512};
        const pg8::Gemm gGt{(const bf16_t*)(ws + WS_XC), (const bf16_t*)(ws + WS_WG8), 2048, 1024, 16, (long)WS_XM - (long)WS_XC - 16 * 128, 0, 0};
        pg8::EpiGates Eg{(float*)(ws + WS_GATES), args.in[I_BGATES]};
        pg8::EpiRg Er{XB, args.in[I_RBA], args.in[I_RBX], (const float*)(ws + WS_C8), (bf16_t*)(ws + WS_XR), (bf16_t*)(ws + WS_U)};
        if (G == 256) {
#ifndef NO_P5G
            if (bid < 128) { pg8::ListOrder S{bid, 1, 0}; pg8::gemm_phase(lds, gGt, S, Eg); }
#endif
#ifndef NO_P5R
            if (bid >= 128) { pg8::ListOrder S{(bid - 128) * 8, 8, 3}; pg8::gemm_phase(lds, gRg, S, Er); }
#endif
        } else {
#ifndef NO_P5G
            for (int u = bid; u < 128; u += G) { pg8::ListOrder S{u, 1, 0}; pg8::gemm_phase(lds, gGt, S, Eg); }
#endif
#ifndef NO_P5R
            for (int u = bid; u < 128; u += G) { pg8::ListOrder S{u * 8, 8, 3}; pg8::gemm_phase(lds, gRg, S, Er); }
#endif
        }
    }
#endif
    GSYNC();
#ifndef NO_P6A
    p6_rg_agg(args);
#endif
    p5b_sraw(args, lds_raw);
    GSYNC();
#ifndef NO_P6
    p6_mlstm(args, lds_raw);
#endif
    GSYNC();
#ifndef NO_P7A
    p7_mlstm_fin(args);
#endif
#ifndef NO_P7B
    p7_rg_fin(args, lds_raw);
#endif
    GSYNC();
#ifndef NO_P8
    { const pg8::Gemm gOut{(const bf16_t*)(ws + WS_ZM)  , (const bf16_t*)(ws + WS_WOUT), 2048, 1024, 16, (long)(64 * MiB) - 16 * 128, 0, 0}; pg8::StaticOrder S; S.init(T, D, G, bid); pg8::EpiResidB E{nullptr, (const bf16_t*)args.out, XB, nullptr, (float*)(ws + WS_SSC), 1.0f}; pg8::gemm_phase(lds, gOut, S, E); }
#endif
    GSYNC();
#ifndef NO_P9
    { const pg8::Gemm gUp2{XB, (const bf16_t*)(ws + WS_WGU2), 1024, 1024, 1 << 30, 0, 0, 0}; pg8::StaticOrder S; S.init(T, 2 * FF, G, bid); pg8::EpiSwiGLU E{ACT, (const float*)(ws + WS_SSC)}; pg8::gemm_phase(lds, gUp2, S, E); }
#endif
    GSYNC();
#ifndef NO_P10
    { const pg8::Gemm gDn2{ACT, (const bf16_t*)(ws + WS_WD2), FF, FF, 1 << 30, 0, 0, 0}; pg8::StaticOrder S; S.init(T, D, G, bid); pg8::EpiResidB E{nullptr, XB, XB  , nullptr, (float*)(ws + WS_SSD), 0.5f}; pg8::gemm_phase(lds, gDn2, S, E); }
#endif
    GSYNC();
#ifndef NO_P11
    p11_final(args);
#endif
}

extern "C" void kernel_launch(void* const* d_in, const int* in_sizes, int n_in, void* d_out, int out_size, void* d_ws, size_t ws_size, hipStream_t stream) {
    static int grid = 0;
    if (grid == 0) {
        if (n_in != 31 || in_sizes[0] != T * D || out_size != T * D || ws_size < WS_END) { fprintf(stderr, "kernel_launch: unexpected shapes (n_in %d, in0 %d, out %d, ws %zu)\n", n_in, n_in > 0 ? in_sizes[0] : -1, out_size, ws_size); grid = -1; return; }
        int dev = 0, cus = 0, per_cu = 0;
        if (hipGetDevice(&dev) != hipSuccess || hipDeviceGetAttribute(&cus, hipDeviceAttributeMultiprocessorCount, dev) != hipSuccess) { grid = -1; return; }
        if (hipFuncSetAttribute((const void*)mk_fwd, hipFuncAttributeMaxDynamicSharedMemorySize, LDS_BYTES) != hipSuccess) { fprintf(stderr, "kernel_launch: hipFuncSetAttribute failed\n"); grid = -1; return; }
        if (hipOccupancyMaxActiveBlocksPerMultiprocessor(&per_cu, (const void*)mk_fwd, 512, LDS_BYTES) != hipSuccess || per_cu < 1) { fprintf(stderr, "kernel_launch: occupancy query says %d\n", per_cu); (void)hipGetLastError(); grid = -1; return; }
        grid = cus;
    }
    if (grid < 0) return;
    if (hipMemsetAsync((char*)d_ws + WS_BAR, 0, 16384, stream) != hipSuccess) { fprintf(stderr, "kernel_launch: memset of barrier words failed\n"); return; }
    Args a{};
    for (int i = 0; i < 31; ++i) a.in[i] = (const float*)d_in[i];
    a.out = (float*)d_out; a.ws = (unsigned char*)d_ws;
    void* kargs[] = {&a};
    hipError_t e = hipLaunchCooperativeKernel((const void*)mk_fwd, dim3(grid), dim3(512), kargs, LDS_BYTES, stream);
    if (e != hipSuccess) fprintf(stderr, "kernel_launch: cooperative launch failed: %s (grid %d)\n", hipGetErrorString(e), grid);
}
```

```cpp
#include <hip/hip_runtime.h>
#include <hip/hip_cooperative_groups.h>
#include <cstdio>
#include <cstdint>
namespace cg = cooperative_groups;

#define LAS __attribute__((address_space(3)))
typedef unsigned short bf16_t;
typedef short bf16x8 __attribute__((ext_vector_type(8)));
typedef float f32x4 __attribute__((ext_vector_type(4)));
typedef unsigned u32x4 __attribute__((ext_vector_type(4)));
typedef unsigned u32x2 __attribute__((ext_vector_type(2)));

constexpr int T = 32768, D = 1024, FF = 2816, SEQ = 8192, NB = 4;
constexpr float EPS = 1e-6f;
constexpr size_t MiB = 1u << 20;
constexpr size_t WS_SSA = 0, WS_SSB = 2 * MiB, WS_SSC = 4 * MiB, WS_SSD = 6 * MiB;
constexpr size_t WS_GATES = 8 * MiB;
constexpr size_t WS_AGG = 9 * MiB;
constexpr size_t WS_BAR = 14 * MiB;
constexpr size_t WS_C8 = 12 * MiB;
constexpr size_t WS_WG8 = 11 * MiB;
constexpr size_t WS_WGU1 = 16 * MiB;
constexpr size_t WS_WD1 = WS_WGU1 + 11 * MiB;
constexpr size_t WS_WIN = WS_WD1 + 11 * MiB / 2;
constexpr size_t WS_WRG = WS_WIN + 8 * MiB;
constexpr size_t WS_WOUT = WS_WRG + 1 * MiB;
constexpr size_t WS_WGU2 = WS_WOUT + 4 * MiB;
constexpr size_t WS_WD2 = WS_WGU2 + 11 * MiB;
constexpr size_t WS_XB = 64 * MiB;
constexpr size_t WS_R1 = 128 * MiB;
constexpr size_t WS_XM = WS_R1, WS_ZM = WS_R1 + 64 * MiB, WS_XR = WS_R1 + 128 * MiB, WS_YR = WS_R1 + 192 * MiB;
constexpr size_t WS_XC = 384 * MiB;
constexpr size_t WS_U = 448 * MiB;
constexpr size_t WS_END = 512 * MiB;
constexpr int LDS_BYTES = 147456;

typedef float f32x2_t __attribute__((ext_vector_type(2)));
typedef __bf16 bf16x2_t __attribute__((ext_vector_type(2)));
__device__ __forceinline__ unsigned pk2(float lo, float hi) { const f32x2_t v = {lo, hi}; const bf16x2_t b = __builtin_convertvector(v, bf16x2_t); return __builtin_bit_cast(unsigned, b); }
__device__ __forceinline__ float bflo(unsigned u) { return __uint_as_float(u << 16); }
__device__ __forceinline__ float bfhi(unsigned u) { return __uint_as_float(u & 0xffff0000u); }
__device__ __forceinline__ float bf1(bf16_t u) { return __uint_as_float(((unsigned)u) << 16); }
__device__ __forceinline__ void unpack8(const u32x4 v, float* x) { x[0] = bflo(v.x); x[1] = bfhi(v.x); x[2] = bflo(v.y); x[3] = bfhi(v.y); x[4] = bflo(v.z); x[5] = bfhi(v.z); x[6] = bflo(v.w); x[7] = bfhi(v.w); }
__device__ __forceinline__ u32x4 pack8(const float* x) { u32x4 o; o.x = pk2(x[0], x[1]); o.y = pk2(x[2], x[3]); o.z = pk2(x[4], x[5]); o.w = pk2(x[6], x[7]); return o; }
__device__ __forceinline__ float sigmoidf_(float x) { return __builtin_amdgcn_rcpf(1.0f + __expf(-x)); }
__device__ __forceinline__ float siluf_(float x) { return x * __builtin_amdgcn_rcpf(1.0f + __expf(-x)); }
__device__ __forceinline__ float logsigf_(float x) { return fminf(x, 0.f) - __logf(1.0f + __expf(-fabsf(x))); }
__device__ __forceinline__ float logsig_acc_(float x) { return fminf(x, 0.f) - log1pf(expf(-fabsf(x))); }
__device__ __forceinline__ float geluf_(float x) { const float u = 0.7978845608028654f * (x + 0.044715f * x * x * x); const float t = 1.0f - 2.0f * __builtin_amdgcn_rcpf(1.0f + __expf(2.0f * u)); return 0.5f * x * (1.0f + t); }
__device__ __forceinline__ int opaque_tid() { int t = threadIdx.x; asm volatile("" : "+v"(t)); return t; }
__device__ __forceinline__ float wave_sum(float v) {
#pragma unroll
    for (int o = 1; o < 64; o <<= 1) v += __shfl_xor(v, o);
    return v;
}

namespace pg8 {
constexpr int BM = 256, BK = 64, HALF = 128, HTB = HALF * BK * 2, STAGE_BYTES = 8 * HTB, NXCD = 8, WGM = 8;
__host__ __device__ __forceinline__ int lds_byte(int r, int c) { const int st = (r >> 4) * 2 + (c >> 5), rr = r & 15, cc = c & 31, ob = rr * 64 + cc * 2; return st * 1024 + (ob ^ (((ob >> 9) & 1) << 5)); }
__host__ __device__ __forceinline__ void stage_rc(int b, int& R, int& C) { const int st = b / 1024, sb = b % 1024, swz = sb ^ (((sb >> 9) & 1) << 5); R = (st >> 1) * 16 + swz / 64; C = (st & 1) * 32 + (swz % 64) / 2; }
__host__ __device__ __forceinline__ int perm32(int rho) { const int n = rho >> 4, i = rho & 15; return 8 * (i >> 2) + 4 * n + (i & 3); }

struct Unit { int pm, pn; };
struct Gemm { const bf16_t* A; const bf16_t* Bt; int K; int lda; int ksplit; long kdelta; int a_pn_shift; int a_pn_bytes; };

struct StaticOrder {
    int nM, nN, nwg, G, c;
    __device__ void init(int M, int N, int G_, int c_) { nM = M / BM; nN = N / BM; nwg = nM * nN; G = G_; c = c_; }
    __device__ bool next(int i, Unit& u) const {
        const long L = (long)i * G + c; if (L >= nwg) return false;
        int wgid = (int)L; { const int q = nwg / NXCD, r = nwg % NXCD, xcd = wgid % NXCD, off = wgid / NXCD; wgid = (xcd < r ? xcd * (q + 1) : r * (q + 1) + (xcd - r) * q) + off; }
        const int nig = WGM * nN, gid = wgid / nig, fm = gid * WGM, gsz = (nM - fm) < WGM ? (nM - fm) : WGM;
        u.pm = fm + ((wgid % nig) % gsz); u.pn = (wgid % nig) / gsz; return true;
    }
};
struct ListOrder {
    int first, cnt, nshift;
    __device__ bool next(int i, Unit& u) const { if (i >= cnt) return false; const int L = first + i; u.pm = L >> nshift; u.pn = L & ((1 << nshift) - 1); return true; }
};

__device__ __forceinline__ float row_scale(const float* SS, int r) {
    const f32x4* p = (const f32x4*)(SS + (size_t)r * 16);
    const f32x4 a = p[0], b = p[1], c = p[2], d = p[3];
    const float s = ((a[0] + a[1]) + (a[2] + a[3])) + ((b[0] + b[1]) + (b[2] + b[3])) + ((c[0] + c[1]) + (c[2] + c[3])) + ((d[0] + d[1]) + (d[2] + d[3]));
    return rsqrtf(s * (1.0f / 1024.0f) + EPS);
}

__device__ __forceinline__ void row_scales8(const float* SS, int row0, int fq, float (&rs)[8]) {
    f32x4 v[8];
#pragma unroll
    for (int q = 0; q < 8; ++q) v[q] = *(const f32x4*)(SS + (size_t)(row0 + (q >> 2) * HALF + (q & 3) * 16) * 16 + fq * 4);
#pragma unroll
    for (int q = 0; q < 8; ++q) { float s = (v[q][0] + v[q][1]) + (v[q][2] + v[q][3]); s += __shfl_xor(s, 16); s += __shfl_xor(s, 32); rs[q] = rsqrtf(s * (1.0f / 1024.0f) + EPS); }
}
struct EpiSwiGLU {
    bf16_t* O; const float* SS;
    __device__ __forceinline__ void operator()(const f32x4 (&acc)[2][2][4][2], const Unit& u, int wr, int wc, int fr, int fq) const {
        const int row0 = u.pm * BM + wr * 64 + fr, col0 = u.pn * HALF + wc * 32 + 8 * fq;
        float rs8[8]; row_scales8(SS, row0, fq, rs8);
#pragma unroll
        for (int ai = 0; ai < 2; ++ai)
#pragma unroll
            for (int m = 0; m < 4; ++m) {
                const int r = row0 + ai * HALF + m * 16; const float rs = rs8[ai * 4 + m];
                float o[8];
#pragma unroll
                for (int n = 0; n < 2; ++n)
#pragma unroll
                    for (int j = 0; j < 4; ++j) { const float g = acc[ai][0][m][n][j] * rs, up = acc[ai][1][m][n][j] * rs; o[n * 4 + j] = siluf_(g) * up; }
                *(u32x4*)(O + (size_t)r * FF + col0) = pack8(o);
            }
    }
};
struct EpiResid {
    const float* Xin; float* Xout; bf16_t* XBo; float* SSo; float alpha;
    __device__ __forceinline__ void operator()(const f32x4 (&acc)[2][2][4][2], const Unit& u, int wr, int wc, int fr, int fq) const {
        const int row0 = u.pm * BM + wr * 64 + fr, col0 = u.pn * BM + wc * 32 + 8 * fq;
#pragma unroll
        for (int ai = 0; ai < 2; ++ai)
#pragma unroll
            for (int m = 0; m < 4; ++m) {
                const int r = row0 + ai * HALF + m * 16; float ss = 0.f;
#pragma unroll
                for (int bj = 0; bj < 2; ++bj) {
                    const size_t off = (size_t)r * D + col0 + bj * HALF;
                    const f32x4 x0 = *(const f32x4*)(Xin + off), x1 = *(const f32x4*)(Xin + off + 4);
                    const f32x4 v0 = x0 + acc[ai][bj][m][0] * alpha, v1 = x1 + acc[ai][bj][m][1] * alpha;
                    *(f32x4*)(Xout + off) = v0; *(f32x4*)(Xout + off + 4) = v1;
                    ss += (v0[0] * v0[0] + v0[1] * v0[1]) + (v0[2] * v0[2] + v0[3] * v0[3]) + (v1[0] * v1[0] + v1[1] * v1[1]) + (v1[2] * v1[2] + v1[3] * v1[3]);
                    if (XBo) { u32x4 w; w.x = pk2(v0[0], v0[1]); w.y = pk2(v0[2], v0[3]); w.z = pk2(v1[0], v1[1]); w.w = pk2(v1[2], v1[3]); *(u32x4*)(XBo + off) = w; }
                }
                ss += __shfl_xor(ss, 16); ss += __shfl_xor(ss, 32);
                if (fq == 0) SSo[(size_t)r * 16 + u.pn * 4 + wc] = ss;
            }
    }
};
struct EpiResidB {
    const float* XinF; const bf16_t* XinB; bf16_t* O1; bf16_t* O2; float* SSo; float alpha;
    __device__ __forceinline__ void operator()(const f32x4 (&acc)[2][2][4][2], const Unit& u, int wr, int wc, int fr, int fq) const {
        const int row0 = u.pm * BM + wr * 64 + fr, col0 = u.pn * BM + wc * 32 + 8 * fq;
#pragma unroll
        for (int ai = 0; ai < 2; ++ai)
#pragma unroll
            for (int m = 0; m < 4; ++m) {
                const int r = row0 + ai * HALF + m * 16; float ss = 0.f;
#pragma unroll
                for (int bj = 0; bj < 2; ++bj) {
                    const size_t off = (size_t)r * D + col0 + bj * HALF;
                    f32x4 x0, x1;
                    if (XinF) { x0 = *(const f32x4*)(XinF + off); x1 = *(const f32x4*)(XinF + off + 4); }
                    else { const u32x4 xb = *(const u32x4*)(XinB + off); x0 = (f32x4){bflo(xb.x), bfhi(xb.x), bflo(xb.y), bfhi(xb.y)}; x1 = (f32x4){bflo(xb.z), bfhi(xb.z), bflo(xb.w), bfhi(xb.w)}; }
                    const f32x4 v0 = x0 + acc[ai][bj][m][0] * alpha, v1 = x1 + acc[ai][bj][m][1] * alpha;
                    ss += (v0[0] * v0[0] + v0[1] * v0[1]) + (v0[2] * v0[2] + v0[3] * v0[3]) + (v1[0] * v1[0] + v1[1] * v1[1]) + (v1[2] * v1[2] + v1[3] * v1[3]);
                    u32x4 w; w.x = pk2(v0[0], v0[1]); w.y = pk2(v0[2], v0[3]); w.z = pk2(v1[0], v1[1]); w.w = pk2(v1[2], v1[3]);
                    *(u32x4*)(O1 + off) = w; if (O2) *(u32x4*)(O2 + off) = w;
                }
                ss += __shfl_xor(ss, 16); ss += __shfl_xor(ss, 32);
                if (fq == 0) SSo[(size_t)r * 16 + u.pn * 4 + wc] = ss;
            }
    }
};
struct EpiProj {
    bf16_t* O; const float* SS;
    __device__ __forceinline__ void operator()(const f32x4 (&acc)[2][2][4][2], const Unit& u, int wr, int wc, int fr, int fq) const {
        bf16_t* base = O + (size_t)(u.pn >> 2) * ((size_t)T * D);
        const int row0 = u.pm * BM + wr * 64 + fr, col0 = (u.pn & 3) * BM + wc * 32 + 8 * fq;
        float rs8[8]; row_scales8(SS, row0, fq, rs8);
#pragma unroll
        for (int ai = 0; ai < 2; ++ai)
#pragma unroll
            for (int m = 0; m < 4; ++m) {
                const int r = row0 + ai * HALF + m * 16; const float rs = rs8[ai * 4 + m];
#pragma unroll
                for (int bj = 0; bj < 2; ++bj) {
                    const f32x4 v0 = acc[ai][bj][m][0] * rs, v1 = acc[ai][bj][m][1] * rs;
                    u32x4 w; w.x = pk2(v0[0], v0[1]); w.y = pk2(v0[2], v0[3]); w.z = pk2(v1[0], v1[1]); w.w = pk2(v1[2], v1[3]);
                    *(u32x4*)(base + (size_t)r * D + col0 + bj * HALF) = w;
                }
            }
    }
};
__device__ __forceinline__ float neg_expm1_(float x) {
    const float p = -x * (1.0f + x * (0.5f + x * (0.16666667f + x * (0.041666668f + x * 0.0083333338f))));
    const float e = 1.0f - __expf(x);
    return (x > -0.3f) ? p : e;
}
struct EpiRg {
    const bf16_t* XCR; const float* ba; const float* bx; const float* c8t; bf16_t* LOGA; bf16_t* U;
    __device__ __forceinline__ void operator()(const f32x4 (&acc)[2][2][4][2], const Unit& u, int wr, int wc, int fr, int fq) const {
        const int row0 = u.pm * BM + wr * 64 + fr, ch0 = (u.pn >> 1) * 256 + (u.pn & 1) * HALF + wc * 32 + 8 * fq;
#pragma unroll
        for (int n = 0; n < 2; ++n) {
            const int ch = ch0 + 4 * n;
            const f32x4 b_a = *(const f32x4*)(ba + ch), b_x = *(const f32x4*)(bx + ch), c8 = *(const f32x4*)(c8t + ch);
#pragma unroll
            for (int ai = 0; ai < 2; ++ai)
#pragma unroll
                for (int m = 0; m < 4; ++m) {
                    const int r = row0 + ai * HALF + m * 16;
                    const u32x2 xv = *(const u32x2*)(XCR + (size_t)r * D + ch);
                    const float xc[4] = {bflo(xv.x), bfhi(xv.x), bflo(xv.y), bfhi(xv.y)};
                    float la[4], uu[4];
#pragma unroll
                    for (int j = 0; j < 4; ++j) {
                        const float rg = sigmoidf_(acc[ai][0][m][n][j] + b_a[j]), ig = sigmoidf_(acc[ai][1][m][n][j] + b_x[j]);
                        la[j] = c8[j] * rg;
                        uu[j] = __builtin_amdgcn_sqrtf(fmaxf(neg_expm1_(2.0f * la[j]), 0.f)) * (ig * xc[j]);
                    }
                    u32x2 w0, w1; w0.x = pk2(la[0], la[1]); w0.y = pk2(la[2], la[3]); w1.x = pk2(uu[0], uu[1]); w1.y = pk2(uu[2], uu[3]);
                    *(u32x2*)(LOGA + (size_t)r * D + ch) = w0; *(u32x2*)(U + (size_t)r * D + ch) = w1;
                    __builtin_amdgcn_sched_barrier(0);
                }
        }
    }
};
struct EpiGates {
    float* G; const float* bg;
    __device__ __forceinline__ void operator()(const f32x4 (&acc)[2][2][4][2], const Unit& u, int wr, int wc, int fr, int fq) const {
        if (wc != 0 || fq != 0) return;
        const int row0 = u.pm * BM + wr * 64 + fr;
        const f32x4 b0 = *(const f32x4*)(bg), b1 = *(const f32x4*)(bg + 4);
#pragma unroll
        for (int ai = 0; ai < 2; ++ai)
#pragma unroll
            for (int m = 0; m < 4; ++m) {
                const int r = row0 + ai * HALF + m * 16;
                f32x4 v0 = acc[ai][0][m][0] + b0, v1 = acc[ai][0][m][1] + b1;
                for (int j = 0; j < 4; ++j) v1[j] = logsigf_(v1[j]);
                *(f32x4*)(G + (size_t)r * 8) = v0; *(f32x4*)(G + (size_t)r * 8 + 4) = v1;
            }
    }
};

template <class Epi, class Sched>
__device__ __forceinline__ void gemm_phase(LAS unsigned char* lds, const Gemm g, const Sched& S, const Epi& E) {
    const int tid = opaque_tid(), wid = __builtin_amdgcn_readfirstlane(tid >> 6), lane = tid & 63, wr = wid >> 2, wc = wid & 3, fr = lane & 15, fq = lane >> 4;
    const int K = g.K, nt = K / BK, lda = g.lda;
    unsigned voffA[2], voffB[2];
#pragma unroll
    for (int i = 0; i < 2; ++i) { int R, C; stage_rc(tid * 16 + i * 8192, R, C); const int Rb = (R & ~31) + perm32(R & 31);
        voffA[i] = (unsigned)(R * lda + C) * 2u; voffB[i] = (unsigned)(Rb * K + C) * 2u; }
    const size_t kstep = (size_t)(BK * 2);
    const size_t hstepA = (size_t)HALF * lda * 2, tstepA = 2 * hstepA;
    const size_t hstepB = (size_t)HALF * K * 2, tstepB = 2 * hstepB;
    const unsigned ldsw = (unsigned)wid * 1024u;
    const int aoff = lds_byte(wr * 64 + fr, fq * 8), boff = lds_byte(wc * 32 + fr, fq * 8);
    const int ksplit = g.ksplit; const long kdelta = g.kdelta;
#define PG8_AK(t) ((long)(t) * (long)kstep + (((t) >= ksplit) ? kdelta : 0l))
#define PG8_SA(b, h) (((b) * 2 + (h)) * HTB)
#define PG8_SB(b, h) ((4 + (b) * 2 + (h)) * HTB)
#define PG8_STAGE(bufoff, gbase, voff) do { _Pragma("unroll") for (int _i = 0; _i < 2; ++_i) \
        __builtin_amdgcn_global_load_lds((const unsigned*)((const char*)(gbase) + (voff)[_i]), (LAS unsigned*)(lds + (bufoff) + ldsw + _i * 8192), 16, 0, 0); } while (0)
#define PG8_LDA(dst, b, h) do { _Pragma("unroll") for (int m = 0; m < 4; ++m) _Pragma("unroll") for (int k = 0; k < 2; ++k) dst[m][k] = *(const LAS bf16x8*)(lds + PG8_SA(b, h) + aoff + m * 2048 + k * 1024); } while (0)
#define PG8_LDB(dst, b, h) do { _Pragma("unroll") for (int n = 0; n < 2; ++n) _Pragma("unroll") for (int k = 0; k < 2; ++k) dst[n][k] = *(const LAS bf16x8*)(lds + PG8_SB(b, h) + boff + n * 2048 + k * 1024); } while (0)
#define PG8_MMA(ai, bj, At, Bt) do { __builtin_amdgcn_s_setprio(1); _Pragma("unroll") for (int m = 0; m < 4; ++m) _Pragma("unroll") for (int n = 0; n < 2; ++n) _Pragma("unroll") for (int k = 0; k < 2; ++k) \
        acc[ai][bj][m][n] = __builtin_amdgcn_mfma_f32_16x16x32_bf16(Bt[n][k], At[m][k], acc[ai][bj][m][n], 0, 0, 0); __builtin_amdgcn_s_setprio(0); } while (0)
#define PG8_WAIT_V(n) asm volatile("s_waitcnt vmcnt(" #n ")" ::: "memory")
#define PG8_WAIT_L(n) asm volatile("s_waitcnt lgkmcnt(" #n ")" ::: "memory")
#define PG8_BAR __builtin_amdgcn_s_barrier()
#define PG8_SCHED __builtin_amdgcn_sched_barrier(0)
    Unit cur, nxt; int ui = 0;
    if (!S.next(0, cur)) return;
    f32x4 acc[2][2][4][2];
#pragma unroll
    for (int a = 0; a < 2; ++a)
#pragma unroll
        for (int b = 0; b < 2; ++b)
#pragma unroll
            for (int m = 0; m < 4; ++m)
#pragma unroll
                for (int n = 0; n < 2; ++n) acc[a][b][m][n] = (f32x4){0.f, 0.f, 0.f, 0.f};
    bf16x8 At[4][2], B0[2][2], B1[2][2];
    const char* cA = (const char*)g.A + (size_t)cur.pm * tstepA + (size_t)(cur.pn >> g.a_pn_shift) * g.a_pn_bytes;
    const char* cB = (const char*)g.Bt + (size_t)cur.pn * tstepB;
    {
        PG8_STAGE(PG8_SB(0, 0), cB, voffB); PG8_STAGE(PG8_SB(0, 1), cB + hstepB, voffB); PG8_STAGE(PG8_SA(0, 0), cA, voffA); PG8_STAGE(PG8_SA(0, 1), cA + hstepA, voffA);
        if (wr == 1) PG8_BAR;
        PG8_WAIT_V(2); PG8_BAR;
        PG8_STAGE(PG8_SB(1, 0), cB + kstep, voffB); PG8_STAGE(PG8_SA(1, 0), cA + PG8_AK(1), voffA); PG8_STAGE(PG8_SB(1, 1), cB + hstepB + kstep, voffB);
        PG8_WAIT_V(6); PG8_BAR;
    }
    for (;;) {
        const bool has_next = S.next(ui + 1, nxt);
        const char* nA = has_next ? (const char*)g.A + (size_t)nxt.pm * tstepA + (size_t)(nxt.pn >> g.a_pn_shift) * g.a_pn_bytes : cA;
        const char* nB = has_next ? (const char*)g.Bt + (size_t)nxt.pn * tstepB : cB;
#pragma nounroll
        for (int t = 0; t < nt; t += 2) {
            const bool last = (t == nt - 2);
            const char* a1 = cA + PG8_AK(t + 1);
            const char* a2 = last ? nA : cA + PG8_AK(t + 2); const char* b2 = last ? nB : cB + (size_t)(t + 2) * kstep;
            const char* a3 = last ? nA + PG8_AK(1) : cA + PG8_AK(t + 3); const char* b3 = b2 + kstep;
            PG8_LDB(B0, 0, 0); PG8_LDB(B1, 0, 1); PG8_SCHED; PG8_LDA(At, 0, 0); PG8_STAGE(PG8_SA(1, 1), a1 + hstepA, voffA);
            PG8_WAIT_V(8); PG8_WAIT_L(0); PG8_BAR; PG8_MMA(0, 0, At, B0); PG8_MMA(0, 1, At, B1); PG8_BAR; PG8_SCHED;
            PG8_LDA(At, 0, 1); PG8_STAGE(PG8_SB(0, 0), b2, voffB); PG8_STAGE(PG8_SB(0, 1), b2 + hstepB, voffB); PG8_STAGE(PG8_SA(0, 0), a2, voffA);
            PG8_WAIT_V(8); PG8_WAIT_L(0); PG8_BAR; PG8_MMA(1, 0, At, B0); PG8_MMA(1, 1, At, B1); PG8_BAR; PG8_SCHED;
            PG8_LDB(B0, 1, 0); PG8_LDB(B1, 1, 1); PG8_SCHED; PG8_LDA(At, 1, 0); PG8_STAGE(PG8_SA(0, 1), a2 + hstepA, voffA);
            PG8_WAIT_V(8); PG8_WAIT_L(0); PG8_BAR; PG8_MMA(0, 0, At, B0); PG8_MMA(0, 1, At, B1); PG8_BAR; PG8_SCHED;
            PG8_LDA(At, 1, 1); PG8_STAGE(PG8_SB(1, 0), b3, voffB); PG8_STAGE(PG8_SB(1, 1), b3 + hstepB, voffB); PG8_STAGE(PG8_SA(1, 0), a3, voffA);
            PG8_WAIT_V(8); PG8_WAIT_L(0); PG8_BAR; PG8_MMA(1, 0, At, B0); PG8_MMA(1, 1, At, B1); PG8_BAR; PG8_SCHED;
        }
        if (wr == 0) PG8_BAR;
        E(acc, cur, wr, wc, fr, fq);
        if (!has_next) break;
#pragma unroll
        for (int a = 0; a < 2; ++a)
#pragma unroll
            for (int b = 0; b < 2; ++b)
#pragma unroll
                for (int m = 0; m < 4; ++m)
#pragma unroll
                    for (int n = 0; n < 2; ++n) acc[a][b][m][n] = (f32x4){0.f, 0.f, 0.f, 0.f};
        cur = nxt; cA = nA; cB = nB; ++ui;
        if (wr == 1) PG8_BAR;
    }
    PG8_WAIT_V(0);
    PG8_BAR;
#undef PG8_AK
#undef PG8_SA
#undef PG8_SB
#undef PG8_STAGE
#undef PG8_LDA
#undef PG8_LDB
#undef PG8_MMA
#undef PG8_WAIT_V
#undef PG8_WAIT_L
#undef PG8_BAR
#undef PG8_SCHED
}
}

struct Args { const float* in[31]; float* out; unsigned char* ws; };
enum { I_X = 0, I_NF1, I_WG1, I_WU1, I_WD1, I_NMIX, I_WIN, I_MCW, I_MCB, I_WQ, I_WK, I_WV, I_WGATES, I_BGATES, I_LNW, I_SKIP, I_RCW, I_RCB, I_RWA, I_RBA, I_RWX, I_RBX, I_LAM,
       I_ONM, I_ONR, I_WOUT, I_NF2, I_WG2, I_WU2, I_WD2, I_NFIN };

template <class F> __device__ __forceinline__ void tr_item(F src, int K, bf16_t* WT, float* scr, int item, int nblk, int lane) {
    const int kb = item / nblk, nb = item % nblk, k0 = 64 * kb, n0 = 32 * nb;
#pragma unroll 8
    for (int i = 0; i < 32; ++i) { const int kk = 2 * i + (lane >> 5); scr[kk * 33 + (lane & 31)] = src(k0 + kk, n0 + (lane & 31)); }
    __builtin_amdgcn_wave_barrier();
    const int c = lane & 7;
#pragma unroll
    for (int j = 0; j < 4; ++j) { const int n = (lane >> 3) + 8 * j; const float* s = scr + (8 * c) * 33 + n;
        u32x4 o; o.x = pk2(s[0 * 33], s[1 * 33]); o.y = pk2(s[2 * 33], s[3 * 33]); o.z = pk2(s[4 * 33], s[5 * 33]); o.w = pk2(s[6 * 33], s[7 * 33]);
        *(u32x4*)(WT + (size_t)(n0 + n) * K + k0 + 8 * c) = o; }
    __builtin_amdgcn_wave_barrier();
}

__device__ __forceinline__ void p0_prologue(const Args& a, unsigned char* lds) {
    const int tid = opaque_tid(), lane = tid & 63, wave = tid >> 6;
    const int gw = blockIdx.x * 8 + wave, NGW = gridDim.x * 8;
    float* scr = (float*)(lds + wave * 16384);
    unsigned char* ws = a.ws;
    constexpr int I1 = 16 * 176, I2 = 44 * 32, I3 = 16 * 128, I4 = 4 * 64, I5 = 32 * 32;
    constexpr int NIT = I1 + I2 + I3 + I4 + I5 + I1 + I2;
    for (int it = gw; it < NIT; it += NGW) {
        int r = it;
        if (r < I1) { const float* wg = a.in[I_WG1]; const float* wu = a.in[I_WU1]; const float* gn = a.in[I_NF1];
            tr_item([=](int k, int n) { const int c = (n >> 8) * 128 + (n & 127); return (((n >> 7) & 1) ? wu : wg)[(size_t)k * FF + c] * gn[k]; }, 1024, (bf16_t*)(ws + WS_WGU1), scr, r, 176, lane); continue; } r -= I1;
        if (r < I2) { const float* wd = a.in[I_WD1];
            tr_item([=](int k, int n) { return wd[(size_t)k * D + n]; }, FF, (bf16_t*)(ws + WS_WD1), scr, r, 32, lane); continue; } r -= I2;
        if (r < I3) { const float* w = a.in[I_WIN]; const float* gn = a.in[I_NMIX];
            tr_item([=](int k, int n) { return w[(size_t)k * 4096 + n] * gn[k]; }, 1024, (bf16_t*)(ws + WS_WIN), scr, r, 128, lane); continue; } r -= I3;
        if (r < I4) { const float* wa = a.in[I_RWA]; const float* wx = a.in[I_RWX];
            tr_item([=](int k, int n) { const int pn = n >> 8, blk = pn >> 1, hh = pn & 1, sel = (n >> 7) & 1, c = hh * 128 + (n & 127); return (sel ? wx : wa)[(size_t)blk * 65536 + (size_t)k * 256 + c]; }, 256, (bf16_t*)(ws + WS_WRG), scr, r, 64, lane); continue; } r -= I4;
        if (r < I5) { const float* w = a.in[I_WOUT]; const float* gm = a.in[I_ONM]; const float* gr = a.in[I_ONR];
            tr_item([=](int k, int n) { return w[(size_t)k * D + n] * (k < 1024 ? gm[k] : gr[k - 1024]); }, 2048, (bf16_t*)(ws + WS_WOUT), scr, r, 32, lane); continue; } r -= I5;
        if (r < I1) { const float* wg = a.in[I_WG2]; const float* wu = a.in[I_WU2]; const float* gn = a.in[I_NF2];
            tr_item([=](int k, int n) { const int c = (n >> 8) * 128 + (n & 127); return (((n >> 7) & 1) ? wu : wg)[(size_t)k * FF + c] * gn[k]; }, 1024, (bf16_t*)(ws + WS_WGU2), scr, r, 176, lane); continue; } r -= I1;
        { const float* wd = a.in[I_WD2];
            tr_item([=](int k, int n) { return wd[(size_t)k * D + n]; }, FF, (bf16_t*)(ws + WS_WD2), scr, r, 32, lane); }
    }
    {
        bf16_t* WG8 = (bf16_t*)(ws + WS_WG8);
        const float* wq = a.in[I_WQ]; const float* wk = a.in[I_WK]; const float* wv = a.in[I_WV]; const float* Wg = a.in[I_WGATES];
        const int gt = blockIdx.x * 512 + tid, NT = gridDim.x * 512;
        for (int e = gt; e < 256 * 2048 / 8; e += NT) {
            const int g = e / 256, k0 = (e % 256) * 8;
            float o[8];
#pragma unroll
            for (int j = 0; j < 8; ++j) {
                float v = 0.f;
                if (g < 8) { const int k = k0 + j, c = k & 1023, n = c >> 2, i = c & 3;
                    if (k < 1024) { for (int oo = 0; oo < 4; ++oo) v += wq[n * 16 + i * 4 + oo] * Wg[(size_t)(4 * n + oo) * 8 + g] + wk[n * 16 + i * 4 + oo] * Wg[(size_t)(1024 + 4 * n + oo) * 8 + g]; }
                    else { for (int oo = 0; oo < 4; ++oo) v += wv[n * 16 + i * 4 + oo] * Wg[(size_t)(2048 + 4 * n + oo) * 8 + g]; } }
                o[j] = v;
            }
            *(u32x4*)(WG8 + (size_t)g * 2048 + k0) = pack8(o);
        }
    }
    if (blockIdx.x == 0) { float* C8 = (float*)(ws + WS_C8); const float* lam = a.in[I_LAM]; for (int e = tid; e < 1024; e += 512) C8[e] = 8.0f * logsig_acc_(lam[e]); }
    {
        const float* x = a.in[I_X]; bf16_t* XB = (bf16_t*)(ws + WS_XB); float* SS = (float*)(ws + WS_SSA);
        for (int m = gw; m < T; m += NGW) {
            const f32x4* xr = (const f32x4*)(x + (size_t)m * D) + lane;
            f32x4 v[4]; float s = 0.f;
#pragma unroll
            for (int j = 0; j < 4; ++j) { v[j] = xr[64 * j]; s += (v[j][0] * v[j][0] + v[j][1] * v[j][1]) + (v[j][2] * v[j][2] + v[j][3] * v[j][3]); }
            s = wave_sum(s);
            u32x2* o8 = (u32x2*)(XB + (size_t)m * D) + lane;
#pragma unroll
            for (int j = 0; j < 4; ++j) { u32x2 w; w.x = pk2(v[j][0], v[j][1]); w.y = pk2(v[j][2], v[j][3]); o8[64 * j] = w; }
            if (lane < 16) SS[(size_t)m * 16 + lane] = (lane == 0) ? s : 0.f;
        }
    }
}

template <bool SILU> __device__ __forceinline__ void conv_part(const bf16_t* in, bf16_t* out, const float* cw, const float* cb, int t0, int c0) {
    float w[4][8], b[8];
#pragma unroll
    for (int tap = 0; tap < 4; ++tap) { const f32x4 p = *(const f32x4*)(cw + tap * D + c0), q = *(const f32x4*)(cw + tap * D + c0 + 4); for (int j = 0; j < 4; ++j) { w[tap][j] = p[j]; w[tap][4 + j] = q[j]; } }
    { const f32x4 p = *(const f32x4*)(cb + c0), q = *(const f32x4*)(cb + c0 + 4); for (int j = 0; j < 4; ++j) { b[j] = p[j]; b[4 + j] = q[j]; } }
    float h0[8], h1[8], h2[8];
    const bool first = (t0 % SEQ) == 0;
    if (first) { for (int j = 0; j < 8; ++j) { h0[j] = 0.f; h1[j] = 0.f; h2[j] = 0.f; } }
    else {
        unpack8(*(const u32x4*)(in + (size_t)(t0 - 3) * D + c0), h0); unpack8(*(const u32x4*)(in + (size_t)(t0 - 2) * D + c0), h1); unpack8(*(const u32x4*)(in + (size_t)(t0 - 1) * D + c0), h2);
    }
    u32x4 cur[8];
#pragma unroll
    for (int i = 0; i < 8; ++i) cur[i] = *(const u32x4*)(in + (size_t)(t0 + i) * D + c0);
#pragma unroll
    for (int i = 0; i < 8; ++i) {
        float x[8], y[8]; unpack8(cur[i], x);
#pragma unroll
        for (int j = 0; j < 8; ++j) { float v = b[j] + w[0][j] * h0[j] + w[1][j] * h1[j] + w[2][j] * h2[j] + w[3][j] * x[j]; y[j] = SILU ? siluf_(v) : v; h0[j] = h1[j]; h1[j] = h2[j]; h2[j] = x[j]; }
        *(u32x4*)(out + (size_t)(t0 + i) * D + c0) = pack8(y);
    }
}
__device__ __forceinline__ void p4_conv(const Args& a) {
    unsigned char* ws = a.ws; const int tid = opaque_tid(), cgp = tid & 127, ts = tid >> 7;
    for (int u = blockIdx.x; u < T / 32; u += gridDim.x) {
        const int t0 = u * 32 + ts * 8, c0 = cgp * 8;
        conv_part<true>((const bf16_t*)(ws + WS_XM), (bf16_t*)(ws + WS_XC), a.in[I_MCW], a.in[I_MCB], t0, c0);
        conv_part<false>((const bf16_t*)(ws + WS_XR), (bf16_t*)a.out + (size_t)T * D  , a.in[I_RCW], a.in[I_RCB], t0, c0);
    }
}

__device__ __forceinline__ void p6_rg_agg(const Args& a) {
    unsigned char* ws = a.ws; const int tid = opaque_tid();
    const unsigned* LOGA = (const unsigned*)(ws + WS_XR); const unsigned* U = (const unsigned*)(ws + WS_U); float* AGG = (float*)(ws + WS_AGG);
    for (int tile = blockIdx.x; tile < 256; tile += gridDim.x) {
        const size_t row0 = (size_t)tile * 128;
        float sl0 = 0.f, sl1 = 0.f, h0 = 0.f, h1 = 0.f;
        for (int i0 = 0; i0 < 128; i0 += 16) {
            unsigned la[16], uu[16];
#pragma unroll
            for (int i = 0; i < 16; ++i) { la[i] = LOGA[(row0 + i0 + i) * 512 + tid]; uu[i] = U[(row0 + i0 + i) * 512 + tid]; }
#pragma unroll
            for (int i = 0; i < 16; ++i) { const float l0 = bflo(la[i]), l1 = bfhi(la[i]); sl0 += l0; sl1 += l1; h0 = __expf(l0) * h0 + bflo(uu[i]); h1 = __expf(l1) * h1 + bfhi(uu[i]); }
        }
        f32x4 o = {sl0, h0, sl1, h1};
        *(f32x4*)(AGG + ((size_t)tile * 1024 + 2 * tid) * 2) = o;
    }
}

template <int CTRL, int RMASK> __device__ __forceinline__ float dppf(float old, float src) {
    return __builtin_bit_cast(float, __builtin_amdgcn_update_dpp(__builtin_bit_cast(int, old), __builtin_bit_cast(int, src), CTRL, RMASK, 0xf, false));
}
__device__ __forceinline__ float readlane_f(float v, int l) { return __builtin_bit_cast(float, __builtin_amdgcn_readlane(__builtin_bit_cast(int, v), l)); }

namespace ml {
constexpr int QP = 264, SP = 72;
constexpr int O_QS = 0, O_KS = 33792, O_SS = 67584, O_VT = 76800, O_VW = 81408, O_CS = 86016, O_OSM = 102912, O_TAB = 111360, O_WTS = 113920, O_END = 126208;
}
__device__ __forceinline__ unsigned char* sraw_ptr(unsigned char* ws, int u) {
    return u < 1600 ? ws + (size_t)u * 5120 : (u < 2000 ? ws + 62 * MiB + (size_t)(u - 1600) * 5120 : ws + 12 * MiB + 512 * 1024 + (size_t)(u - 2000) * 5120);
}
__device__ __forceinline__ void p5b_sraw(const Args& a, unsigned char* lds) {
    using namespace ml;
    unsigned char* ws = a.ws;
    const int tid = opaque_tid(), lane = tid & 63, w = __builtin_amdgcn_readfirstlane(tid >> 6), fr = lane & 15, fq = lane >> 4;
    bf16_t* Qs = (bf16_t*)(lds + O_QS); bf16_t* Ks = (bf16_t*)(lds + O_KS); float* WTS = (float*)(lds + O_WTS);
    const bf16_t* XC = (const bf16_t*)(ws + WS_XC);
    const int srow = tid >> 5, scol = (tid & 31) * 8;
    for (int g = blockIdx.x; g < 256; g += gridDim.x) {
        const int bh = g >> 4, c0 = (g & 15) * 8, b = bh >> 2, h = bh & 3;
        __syncthreads();
        for (int e = tid; e < 1024; e += 512) { const int gg = e >> 4, bb = (e >> 2) & 3, aa = e & 3; const float* wq = a.in[I_WQ] + (h * 64 + gg) * 16; const float* wk = a.in[I_WK] + (h * 64 + gg) * 16;
            float v = 0.f; for (int o = 0; o < 4; ++o) v += wq[bb * 4 + o] * wk[aa * 4 + o]; WTS[e] = v * 0.0625f; }
        __syncthreads();
        const int lg0 = (tid & 31) * 2;
        f32x4 Wq[2][4];
#pragma unroll
        for (int g2 = 0; g2 < 2; ++g2)
#pragma unroll
            for (int i = 0; i < 4; ++i) Wq[g2][i] = *(const f32x4*)(WTS + (lg0 + g2) * 16 + i * 4);
        for (int cc = 0; cc < 8; ++cc) {
            const int c = c0 + cc; const size_t t0 = (size_t)b * SEQ + (size_t)c * 64;
            u32x4 xr[4];
#pragma unroll
            for (int i = 0; i < 4; ++i) xr[i] = *(const u32x4*)(XC + (t0 + srow + 16 * i) * D + h * 256 + scol);
#pragma unroll
            for (int i = 0; i < 4; ++i) {
                float x[8]; unpack8(xr[i], x);
                float q[8];
#pragma unroll
                for (int g2 = 0; g2 < 2; ++g2) {
                    const f32x4 qq = Wq[g2][0] * x[4 * g2] + Wq[g2][1] * x[4 * g2 + 1] + Wq[g2][2] * x[4 * g2 + 2] + Wq[g2][3] * x[4 * g2 + 3];
                    for (int j = 0; j < 4; ++j) q[4 * g2 + j] = qq[j];
                }
                const int r = srow + 16 * i;
                *(u32x4*)(Qs + r * QP + scol) = pack8(q); *(u32x4*)(Ks + r * QP + scol) = xr[i];
            }
            __syncthreads();
            {
                unsigned char* sp = sraw_ptr(ws, bh * 128 + c);
#define S_DECODE(li, it, jt) do { if ((li) < 4) { it = 3; jt = (li); } else if ((li) < 7) { it = 2; jt = (li) - 4; } else if ((li) < 9) { it = 1; jt = (li) - 7; } else { it = 0; jt = 0; } } while (0)
#define S_EPI(li, sv) do { u32x2 wv_; wv_.x = pk2(sv[0], sv[1]); wv_.y = pk2(sv[2], sv[3]); *(u32x2*)(sp + (li) * 512 + lane * 8) = wv_; } while (0)
                int it0, jt0, it1 = 0, jt1 = 0; S_DECODE(w, it0, jt0);
                const bool two = (w < 2); if (two) S_DECODE(w + 8, it1, jt1);
                f32x4 sA = (f32x4){0.f, 0.f, 0.f, 0.f}, sB = sA, tA = sA, tB = sA;
                const bf16_t* k0p = Ks + (jt0 * 16 + fr) * QP + fq * 8; const bf16_t* q0p = Qs + (it0 * 16 + fr) * QP + fq * 8;
                const bf16_t* k1p = Ks + (jt1 * 16 + fr) * QP + fq * 8; const bf16_t* q1p = Qs + (it1 * 16 + fr) * QP + fq * 8;
#pragma unroll
                for (int ks = 0; ks < 8; ks += 2) {
                    sA = __builtin_amdgcn_mfma_f32_16x16x32_bf16(*(const bf16x8*)(k0p + ks * 32), *(const bf16x8*)(q0p + ks * 32), sA, 0, 0, 0);
                    sB = __builtin_amdgcn_mfma_f32_16x16x32_bf16(*(const bf16x8*)(k0p + ks * 32 + 32), *(const bf16x8*)(q0p + ks * 32 + 32), sB, 0, 0, 0);
                    if (two) {
                        tA = __builtin_amdgcn_mfma_f32_16x16x32_bf16(*(const bf16x8*)(k1p + ks * 32), *(const bf16x8*)(q1p + ks * 32), tA, 0, 0, 0);
                        tB = __builtin_amdgcn_mfma_f32_16x16x32_bf16(*(const bf16x8*)(k1p + ks * 32 + 32), *(const bf16x8*)(q1p + ks * 32 + 32), tB, 0, 0, 0);
                    }
                }
                const f32x4 s0 = sA + sB; S_EPI(w, s0);
                if (two) { const f32x4 s1 = tA + tB; S_EPI(w + 8, s1); }
#undef S_DECODE
#undef S_EPI
            }
            __syncthreads();
        }
    }
}

__device__ __forceinline__ void p6_mlstm(const Args& a, unsigned char* lds) {
    using namespace ml;
    unsigned char* ws = a.ws;
    const int tid = opaque_tid(), lane = tid & 63, w = __builtin_amdgcn_readfirstlane(tid >> 6), fr = lane & 15, fq = lane >> 4;
    bf16_t* Qs = (bf16_t*)(lds + O_QS); bf16_t* Ks = (bf16_t*)(lds + O_KS); bf16_t* Ss = (bf16_t*)(lds + O_SS);
    bf16_t* Vt = (bf16_t*)(lds + O_VT); bf16_t* Vw = (bf16_t*)(lds + O_VW); bf16_t* Cs = (bf16_t*)(lds + O_CS);
    float* Osm = (float*)(lds + O_OSM); float* TAB = (float*)(lds + O_TAB); float* WTS = (float*)(lds + O_WTS);
    const bf16_t* XC = (const bf16_t*)(ws + WS_XC); const bf16_t* XM = (const bf16_t*)(ws + WS_XM); const float* GATES = (const float*)(ws + WS_GATES);
    bf16_t* HM = (bf16_t*)a.out + (size_t)T * D;
    for (int unit = blockIdx.x; unit < 256; unit += gridDim.x) {
        const int xcd = unit & 7, idx = unit >> 3, bh = xcd * 2 + (idx >> 4), vs = idx & 15, b = bh >> 2, h = bh & 3;
        __syncthreads();
        for (int e = tid; e < 64 * SP / 2; e += 512) ((unsigned*)Ss)[e] = 0u;
        for (int e = tid; e < 32 * SP / 2; e += 512) { const int row = e / (SP / 2); ((unsigned*)Vt)[e] = (row == 16) ? 0x3F803F80u : 0u; ((unsigned*)Vw)[e] = 0u; }
        for (int e = tid; e < 32 * QP / 2; e += 512) ((unsigned*)Cs)[e] = 0u;
        for (int e = tid; e < 1024; e += 512) { const int g = e >> 4, bb = (e >> 2) & 3, aa = e & 3; const float* wq = a.in[I_WQ] + (h * 64 + g) * 16; const float* wk = a.in[I_WK] + (h * 64 + g) * 16;
            float v = 0.f; for (int o = 0; o < 4; ++o) v += wq[bb * 4 + o] * wk[aa * 4 + o]; WTS[e] = v * 0.0625f; }
        for (int e = tid; e < 1024; e += 512) WTS[2048 + e] = a.in[I_WV][h * 1024 + e];
        f32x4 Cacc[2][2];
#pragma unroll
        for (int i = 0; i < 2; ++i)
#pragma unroll
            for (int j = 0; j < 2; ++j) Cacc[i][j] = (f32x4){0.f, 0.f, 0.f, 0.f};
        const int srow = tid >> 5, scol = (tid & 31) * 8;
        const int vrow = tid >> 1, vhalf = tid & 1;
        const size_t tbase = (size_t)b * SEQ;
        u32x4 xr[4], xmr = (u32x4){0u, 0u, 0u, 0u}; float gi, gf;
        u32x2 sr0 = (u32x2){0u, 0u}, sr1 = (u32x2){0u, 0u};
        {
            const size_t t0 = tbase;
#pragma unroll
            for (int i = 0; i < 4; ++i) xr[i] = *(const u32x4*)(XC + (t0 + srow + 16 * i) * D + h * 256 + scol);
            if (tid < 128) xmr = *(const u32x4*)(XM + (t0 + vrow) * D + h * 256 + vs * 16 + vhalf * 8);
            gi = GATES[(t0 + lane) * 8 + h]; gf = GATES[(t0 + lane) * 8 + 4 + h];
            const unsigned char* sp = sraw_ptr(ws, bh * 128);
            sr0 = *(const u32x2*)(sp + tid * 8); if (tid < 128) sr1 = *(const u32x2*)(sp + 4096 + tid * 8);
        }
        __syncthreads();
        float decay = 0.f, m_cur = -1e30f;
        constexpr int NC = SEQ / 64;
        for (int c = -1; c < NC; ++c) {
            float* tab = TAB + (c & 1) * 320;
            if (c >= 0) {
            __syncthreads();
            {
                const int rt = w & 3, vt = w >> 2;
                f32x4 a1 = (f32x4){0.f, 0.f, 0.f, 0.f}, a2 = (f32x4){0.f, 0.f, 0.f, 0.f};
#pragma unroll
                for (int ks = 0; ks < 2; ++ks) {
                    const bf16x8 sa_ = *(const bf16x8*)(Ss + (rt * 16 + fr) * SP + ks * 32 + fq * 8);
                    const bf16x8 vb = *(const bf16x8*)(Vt + (vt * 16 + fr) * SP + ks * 32 + fq * 8);
                    a1 = __builtin_amdgcn_mfma_f32_16x16x32_bf16(sa_, vb, a1, 0, 0, 0);
                }
#pragma unroll
                for (int ks = 0; ks < 8; ++ks) {
                    const bf16x8 qa = *(const bf16x8*)(Qs + (rt * 16 + fr) * QP + ks * 32 + fq * 8);
                    const bf16x8 cb = *(const bf16x8*)(Cs + (vt * 16 + fr) * QP + ks * 32 + fq * 8);
                    a2 = __builtin_amdgcn_mfma_f32_16x16x32_bf16(qa, cb, a2, 0, 0, 0);
                }
#pragma unroll
                for (int e = 0; e < 4; ++e) { const int i = rt * 16 + fq * 4 + e; Osm[i * 33 + vt * 16 + fr] = a1[e] + tab[128 + i] * a2[e]; }
            }
            {
#pragma unroll
                for (int kl = 0; kl < 2; ++kl)
#pragma unroll
                    for (int vt = 0; vt < 2; ++vt) Cacc[kl][vt] = Cacc[kl][vt] * decay;
#pragma unroll
                for (int kl = 0; kl < 2; ++kl) {
                    const int kcol = (2 * w + kl) * 16 + fr;
#pragma unroll
                    for (int ks = 0; ks < 2; ++ks) {
                        bf16x8 ka;
#pragma unroll
                        for (int e = 0; e < 8; ++e) ka[e] = (short)Ks[(ks * 32 + fq * 8 + e) * QP + kcol];
#pragma unroll
                        for (int vt = 0; vt < 2; ++vt) {
                            const bf16x8 vb = *(const bf16x8*)(Vw + (vt * 16 + fr) * SP + ks * 32 + fq * 8);
                            Cacc[kl][vt] = __builtin_amdgcn_mfma_f32_16x16x32_bf16(ka, vb, Cacc[kl][vt], 0, 0, 0);
                        }
                    }
                }
            }
            }
            u32x4 qpk[4]; float vnx[8], decay_n = 0.f, m_nx = m_cur;
            if (c + 1 < NC) {
                const int lg0 = (tid & 31) * 2;
                f32x4 Wq[2][4];
#pragma unroll
                for (int g2 = 0; g2 < 2; ++g2)
#pragma unroll
                    for (int i = 0; i < 4; ++i) Wq[g2][i] = *(const f32x4*)(WTS + (lg0 + g2) * 16 + i * 4);
#pragma unroll
                for (int i = 0; i < 4; ++i) {
                    float x[8]; unpack8(xr[i], x);
                    float q[8];
#pragma unroll
                    for (int g2 = 0; g2 < 2; ++g2) {
                        const f32x4 qq = Wq[g2][0] * x[4 * g2] + Wq[g2][1] * x[4 * g2 + 1] + Wq[g2][2] * x[4 * g2 + 2] + Wq[g2][3] * x[4 * g2 + 3];
                        for (int j = 0; j < 4; ++j) q[4 * g2 + j] = qq[j];
                    }
                    qpk[i] = pack8(q);
                }
                if (tid < 128) {
                    float x[8]; unpack8(xmr, x);
                    const int lgv = vs * 4 + vhalf * 2;
#pragma unroll
                    for (int g2 = 0; g2 < 2; ++g2) {
                        const float* Wv = WTS + 2048 + (lgv + g2) * 16;
#pragma unroll
                        for (int o = 0; o < 4; ++o) vnx[4 * g2 + o] = Wv[0 * 4 + o] * x[4 * g2] + Wv[1 * 4 + o] * x[4 * g2 + 1] + Wv[2 * 4 + o] * x[4 * g2 + 2] + Wv[3 * 4 + o] * x[4 * g2 + 3];
                    }
                }
                float sa = gf, sc = gi;
#define SCAN_STEP(CTRL, RM) do { const float ao = dppf<CTRL, RM>(0.f, sa), co = dppf<CTRL, RM>(-INFINITY, sc); sc = fmaxf(co + sa, sc); sa = ao + sa; } while (0)
                SCAN_STEP(0x111, 0xf); SCAN_STEP(0x112, 0xf); SCAN_STEP(0x114, 0xf); SCAN_STEP(0x118, 0xf);
                SCAN_STEP(0x142, 0xa);
                SCAN_STEP(0x143, 0xc);
#undef SCAN_STEP
                const float Mi = fmaxf(m_cur + sa, sc);
                const float gtot = readlane_f(sa, 63); m_nx = readlane_f(Mi, 63);
                decay_n = __expf(gtot + m_cur - m_nx);
                if (w == 0) {
                    float* tn = TAB + ((c + 1) & 1) * 320;
                    tn[lane] = sa - Mi; tn[64 + lane] = gi - sa; tn[128 + lane] = __expf(sa + m_cur - Mi); tn[192 + lane] = __expf(-Mi); tn[256 + lane] = __expf(gtot - sa + gi - m_nx);
                }
            }
            if (c >= 0) {
            __syncthreads();
            {
#pragma unroll
                for (int kl = 0; kl < 2; ++kl)
#pragma unroll
                    for (int vt = 0; vt < 2; ++vt) {
                        u32x2 wv; wv.x = pk2(Cacc[kl][vt][0], Cacc[kl][vt][1]); wv.y = pk2(Cacc[kl][vt][2], Cacc[kl][vt][3]);
                        *(u32x2*)(Cs + (vt * 16 + fr) * QP + (2 * w + kl) * 16 + fq * 4) = wv;
                    }
                const int i = tid >> 3, vp = (tid & 7) * 2;
                const float den = Osm[i * 33 + 16], dn = fmaxf(fabsf(den), tab[192 + i]);
                const float rdn = __builtin_amdgcn_rcpf(dn); const float h0 = Osm[i * 33 + vp] * rdn, h1 = Osm[i * 33 + vp + 1] * rdn;
                *(unsigned*)(HM + ((size_t)(bh * 16 + vs) * SEQ + (size_t)c * 64 + i) * 16 + vp) = pk2(h0, h1);
            }
            }
            if (c + 1 < NC) {
#pragma unroll
                for (int i = 0; i < 4; ++i) { const int r = srow + 16 * i; *(u32x4*)(Qs + r * QP + scol) = qpk[i]; *(u32x4*)(Ks + r * QP + scol) = xr[i]; }
                if (c < 0) __syncthreads();
                const float* tn = TAB + ((c + 1) & 1) * 320;
                if (tid < 128) {
                    const float wk = tn[256 + vrow];
#pragma unroll
                    for (int e = 0; e < 8; ++e) { Vt[(vhalf * 8 + e) * SP + vrow] = (bf16_t)(pk2(vnx[e], 0.f) & 0xffffu); Vw[(vhalf * 8 + e) * SP + vrow] = (bf16_t)(pk2(vnx[e] * wk, 0.f) & 0xffffu); }
                } else if (tid < 192) { Vw[16 * SP + (tid - 128)] = (bf16_t)(pk2(tn[256 + tid - 128], 0.f) & 0xffffu); }
#define SS_ITEM(li, sr) do { int it_, jt_; if ((li) < 4) { it_ = 3; jt_ = (li); } else if ((li) < 7) { it_ = 2; jt_ = (li) - 4; } else if ((li) < 9) { it_ = 1; jt_ = (li) - 7; } else { it_ = 0; jt_ = 0; } \
        const int i_ = it_ * 16 + fr, j0_ = jt_ * 16 + fq * 4; const float rf_ = tn[i_]; const f32x4 cf_ = *(const f32x4*)(tn + 64 + j0_); \
        const float sv_[4] = {bflo((sr).x), bfhi((sr).x), bflo((sr).y), bfhi((sr).y)}; float o_[4]; \
        _Pragma("unroll") for (int e = 0; e < 4; ++e) o_[e] = (j0_ + e <= i_) ? sv_[e] * __expf(rf_ + cf_[e]) : 0.f; \
        u32x2 wv_; wv_.x = pk2(o_[0], o_[1]); wv_.y = pk2(o_[2], o_[3]); *(u32x2*)(Ss + i_ * SP + j0_) = wv_; } while (0)
                SS_ITEM(w, sr0);
                if (w < 2) SS_ITEM(w + 8, sr1);
#undef SS_ITEM
                decay = decay_n; m_cur = m_nx;
                if (c + 2 < NC) {
                    const size_t t2 = tbase + (size_t)(c + 2) * 64;
#pragma unroll
                    for (int i = 0; i < 4; ++i) xr[i] = *(const u32x4*)(XC + (t2 + srow + 16 * i) * D + h * 256 + scol);
                    if (tid < 128) xmr = *(const u32x4*)(XM + (t2 + vrow) * D + h * 256 + vs * 16 + vhalf * 8);
                    gi = GATES[(t2 + lane) * 8 + h]; gf = GATES[(t2 + lane) * 8 + 4 + h];
                    const unsigned char* sp = sraw_ptr(ws, bh * 128 + c + 2);
                    sr0 = *(const u32x2*)(sp + tid * 8); if (tid < 128) sr1 = *(const u32x2*)(sp + 4096 + tid * 8);
                }
            }
        }
    }
}

__device__ __forceinline__ void p7_mlstm_fin(const Args& a) {
    unsigned char* ws = a.ws; const int tid = opaque_tid(), lane = tid & 63, wave = tid >> 6;
    const int gw = blockIdx.x * 8 + wave, NGW = gridDim.x * 8;
    const bf16_t* HM = (const bf16_t*)a.out + (size_t)T * D; const bf16_t* XC = (const bf16_t*)(ws + WS_XC); bf16_t* ZM = (bf16_t*)(ws + WS_ZM);
    float lnw[16], skp[16];
#pragma unroll
    for (int j = 0; j < 4; ++j) { const f32x4 p = *(const f32x4*)(a.in[I_LNW] + lane * 16 + 4 * j), q = *(const f32x4*)(a.in[I_SKIP] + lane * 16 + 4 * j); for (int e = 0; e < 4; ++e) { lnw[4 * j + e] = p[e]; skp[4 * j + e] = q[e]; } }
    for (int m = gw; m < T; m += NGW) {
        const size_t off = (size_t)m * D + lane * 16;
        float hv[16], xc[16], z[16];
        { const size_t hoff = ((size_t)(((m / SEQ) * 4 + (lane >> 4)) * 16 + (lane & 15)) * SEQ + (size_t)(m % SEQ)) * 16;
          unpack8(*(const u32x4*)(HM + hoff), hv); unpack8(*(const u32x4*)(HM + hoff + 8), hv + 8); }
        unpack8(*(const u32x4*)(XC + off), xc); unpack8(*(const u32x4*)(XC + off + 8), xc + 8);
        unpack8(*(const u32x4*)(ZM + off), z); unpack8(*(const u32x4*)(ZM + off + 8), z + 8);
        float s = 0.f;
#pragma unroll
        for (int e = 0; e < 16; ++e) s += hv[e];
        s += __shfl_xor(s, 1); s += __shfl_xor(s, 2); s += __shfl_xor(s, 4); s += __shfl_xor(s, 8);
        const float mu = s * (1.0f / 256.0f); float q = 0.f;
#pragma unroll
        for (int e = 0; e < 16; ++e) { hv[e] -= mu; q += hv[e] * hv[e]; }
        q += __shfl_xor(q, 1); q += __shfl_xor(q, 2); q += __shfl_xor(q, 4); q += __shfl_xor(q, 8);
        const float rstd = rsqrtf(q * (1.0f / 256.0f) + EPS);
        float o[16], ss = 0.f;
#pragma unroll
        for (int e = 0; e < 16; ++e) { o[e] = (hv[e] * rstd * lnw[e] + skp[e] * xc[e]) * siluf_(z[e]); ss += o[e] * o[e]; }
        ss = wave_sum(ss);
        const float rs = rsqrtf(ss * (1.0f / 1024.0f) + EPS);
#pragma unroll
        for (int e = 0; e < 16; ++e) o[e] *= rs;
        *(u32x4*)(ZM + off) = pack8(o); *(u32x4*)(ZM + off + 8) = pack8(o + 8);
    }
}
__device__ __forceinline__ void p7_rg_fin(const Args& a, unsigned char* lds) {
    unsigned char* ws = a.ws; const int tid = opaque_tid();
    unsigned* LOGA = (unsigned*)(ws + WS_XR); const unsigned* U = (const unsigned*)(ws + WS_U); const unsigned* YR = (const unsigned*)(ws + WS_YR); const float* AGG = (const float*)(ws + WS_AGG);
    float* Ot = (float*)lds;
    constexpr int OP = 1028;
    for (int tile = blockIdx.x; tile < 256; tile += gridDim.x) {
        const int tc = tile & 63, tb = tile & ~63;
        float h0 = 0.f, h1 = 0.f;
        for (int p = 0; p < tc; ++p) { const f32x4 g = *(const f32x4*)(AGG + ((size_t)(tb + p) * 1024 + 2 * tid) * 2); h0 = __expf(g[0]) * h0 + g[1]; h1 = __expf(g[2]) * h1 + g[3]; }
        const size_t row0 = (size_t)tile * 128;
        for (int i0 = 0; i0 < 128; i0 += 16) {
            unsigned la[16], uu[16], yy[16];
#pragma unroll
            for (int i = 0; i < 16; ++i) { const size_t o = (row0 + i0 + i) * 512 + tid; la[i] = LOGA[o]; uu[i] = U[o]; yy[i] = YR[o]; }
            __syncthreads();
#pragma unroll
            for (int i = 0; i < 16; ++i) {
                h0 = __expf(bflo(la[i])) * h0 + bflo(uu[i]); h1 = __expf(bfhi(la[i])) * h1 + bfhi(uu[i]);
                Ot[i * OP + 2 * tid] = h0 * geluf_(bflo(yy[i])); Ot[i * OP + 2 * tid + 1] = h1 * geluf_(bfhi(yy[i]));
            }
            __syncthreads();
            {
                const int row = tid >> 5, sub = tid & 31;
                f32x4 v[4][2]; float ss = 0.f;
#pragma unroll
                for (int q = 0; q < 4; ++q)
#pragma unroll
                    for (int hh = 0; hh < 2; ++hh) { v[q][hh] = *(const f32x4*)(Ot + row * OP + q * 256 + sub * 8 + hh * 4); const f32x4 t = v[q][hh]; ss += (t[0] * t[0] + t[1] * t[1]) + (t[2] * t[2] + t[3] * t[3]); }
                ss += __shfl_xor(ss, 1); ss += __shfl_xor(ss, 2); ss += __shfl_xor(ss, 4); ss += __shfl_xor(ss, 8); ss += __shfl_xor(ss, 16);
                const float rs = rsqrtf(ss * (1.0f / 1024.0f) + EPS);
                bf16_t* orow = (bf16_t*)LOGA + (row0 + i0 + row) * D;
#pragma unroll
                for (int q = 0; q < 4; ++q) { const f32x4 p = v[q][0] * rs, r = v[q][1] * rs; u32x4 wv; wv.x = pk2(p[0], p[1]); wv.y = pk2(p[2], p[3]); wv.z = pk2(r[0], r[1]); wv.w = pk2(r[2], r[3]); *(u32x4*)(orow + q * 256 + sub * 8) = wv; }
            }
        }
        __syncthreads();
    }
}

__device__ __forceinline__ void p11_final(const Args& a) {
    const int tid = opaque_tid(), lane = tid & 63, wave = tid >> 6;
    const int gw = blockIdx.x * 8 + wave, NGW = gridDim.x * 8;
    const float* SS = (const float*)(a.ws + WS_SSD); const float* gn = a.in[I_NFIN]; const bf16_t* X3 = (const bf16_t*)(a.ws + WS_XB);
    f32x4 g[4];
#pragma unroll
    for (int j = 0; j < 4; ++j) g[j] = *((const f32x4*)gn + lane * 4 + j);
    for (int m = gw; m < T; m += NGW) {
        const float rs = pg8::row_scale(SS, m);
        const size_t off = (size_t)m * D + lane * 16;
        float x[16]; unpack8(*(const u32x4*)(X3 + off), x); unpack8(*(const u32x4*)(X3 + off + 8), x + 8);
        f32x4* o = (f32x4*)(a.out + off);
#pragma unroll
        for (int j = 0; j < 4; ++j) { f32x4 v = (f32x4){x[4 * j], x[4 * j + 1], x[4 * j + 2], x[4 * j + 3]}; o[j] = v * rs * g[j]; }
    }
}

#define XB_TMO      128
#define XB_XCNT(j)  (256  + 64 * (j))
#define XB_XSUB(j)  (1280 + 64 * (j))
#define XB_XGEN(j)  (2304 + 64 * (j))
#define XB_TOP      3328
#define XB_TOPGEN   3392
#define XCD_BAR_WORDS 3456
#define XB_SPIN_CAP (1u << 18)
__device__ __forceinline__ unsigned xb_ld(unsigned* p)              { return __hip_atomic_load(p, __ATOMIC_RELAXED, __HIP_MEMORY_SCOPE_AGENT); }
__device__ __forceinline__ unsigned xb_add(unsigned* p, unsigned v) { return __hip_atomic_fetch_add(p, v, __ATOMIC_RELAXED, __HIP_MEMORY_SCOPE_AGENT); }
__device__ __forceinline__ unsigned xb_xcc_id() { return (unsigned)__builtin_amdgcn_s_getreg((3 << 11) | 20) & 0xFu; }
#define XB_SPIN(cond, bar) do { unsigned _sp = 0; while (cond) { __builtin_amdgcn_s_sleep(1); \
    if ((++_sp & 255u) == 0u) { if (xb_ld(&(bar)[XB_TMO])) break; if (_sp > XB_SPIN_CAP) { atomicAdd(&(bar)[XB_TMO], 1u); break; } } } } while (0)
struct XcdBarrier { unsigned* bar; unsigned x; volatile LAS unsigned* st; };
__device__ __forceinline__ XcdBarrier xcd_barrier_post(unsigned* bar, volatile LAS unsigned* st) {
    XcdBarrier b; b.bar = bar; b.x = xb_xcc_id(); b.st = st;
    if (threadIdx.x == 0) (void)xb_add(&bar[XB_XCNT(b.x)], 1u);
    return b;
}
__device__ __forceinline__ void xcd_barrier_complete(unsigned* bar, unsigned x, unsigned& nloc, unsigned& nx) {
    const unsigned G = gridDim.x * gridDim.y * gridDim.z;
    unsigned sum, cnt, mine, sp = 0u;
    for (;;) {
        sum = 0u; cnt = 0u; mine = 0u;
#pragma unroll
        for (unsigned j = 0; j < 16; ++j) { const unsigned c = xb_ld(&bar[XB_XCNT(j)]); sum += c; cnt += (c > 0u) ? 1u : 0u; mine = (j == x) ? c : mine; }
        if (sum == G) break;
        __builtin_amdgcn_s_sleep(1);
        if ((++sp & 255u) == 0u) { if (xb_ld(&bar[XB_TMO])) break; if (sp > XB_SPIN_CAP) { atomicAdd(&bar[XB_TMO], 1u); break; } }
    }
    nloc = mine > 0u ? mine : 1u; nx = cnt > 0u ? cnt : 1u;
}
__device__ __forceinline__ void xcd_barrier(const XcdBarrier& b) {
    asm volatile("s_waitcnt vmcnt(0)" ::: "memory");
    __syncthreads();
    if (threadIdx.x == 0) {
        unsigned* bar = b.bar;
        __builtin_amdgcn_s_waitcnt(0);
        unsigned nloc = b.st[0], nx = b.st[1];
        if (nloc == 0u) { xcd_barrier_complete(bar, b.x, nloc, nx); b.st[0] = nloc; b.st[1] = nx; }
        const unsigned old = xb_add(&bar[XB_XSUB(b.x)], 1u);
        const unsigned gen = old / nloc;
        if (old + 1u == (gen + 1u) * nloc) {
            __builtin_amdgcn_fence(__ATOMIC_RELEASE, "agent");
            asm volatile("s_waitcnt vmcnt(0)" ::: "memory");
            const unsigned og = xb_add(&bar[XB_TOP], 1u);
            const unsigned tg = og / nx;
            if (og + 1u == (tg + 1u) * nx) xb_add(&bar[XB_TOPGEN], 1u);
            else XB_SPIN(xb_ld(&bar[XB_TOPGEN]) == tg, bar);
            __builtin_amdgcn_fence(__ATOMIC_ACQUIRE, "agent");
            xb_add(&bar[XB_XGEN(b.x)], 1u);
            asm volatile("s_waitcnt vmcnt(0)" ::: "memory");
        } else {
            XB_SPIN(xb_ld(&bar[XB_XGEN(b.x)]) == gen, bar);
            __builtin_amdgcn_fence(__ATOMIC_ACQUIRE, "agent");
            asm volatile("s_waitcnt vmcnt(0)" ::: "memory");
        }
    }
    __syncthreads();
}
#define GSYNC() xcd_barrier(xbar)
__global__ void __launch_bounds__(512, 2) mk_fwd(Args args) {
    extern __shared__ __attribute__((aligned(16))) unsigned char lds_raw[];
    cg::grid_group grid = cg::this_grid();
    LAS unsigned char* lds = (LAS unsigned char*)lds_raw;
    unsigned char* ws = args.ws;
    const int G = gridDim.x, bid = blockIdx.x;
    volatile LAS unsigned* xst = (volatile LAS unsigned*)(lds + (LDS_BYTES - 64));
    if (threadIdx.x == 0) { xst[0] = 0u; xst[1] = 0u; }
    __syncthreads();
    const XcdBarrier xbar = xcd_barrier_post((unsigned*)(ws + WS_BAR), xst);
    bf16_t* XB = (bf16_t*)(ws + WS_XB); bf16_t* ACT = (bf16_t*)(ws + WS_R1);
#ifndef NO_P0
    p0_prologue(args, lds_raw);
#endif
    asm volatile("s_waitcnt vmcnt(0)" ::: "memory"); __threadfence(); grid.sync();
#ifndef NO_P1
    { const pg8::Gemm gUp1{XB, (const bf16_t*)(ws + WS_WGU1), 1024, 1024, 1 << 30, 0, 0, 0}; pg8::StaticOrder S; S.init(T, 2 * FF, G, bid); pg8::EpiSwiGLU E{ACT, (const float*)(ws + WS_SSA)}; pg8::gemm_phase(lds, gUp1, S, E); }
#endif
    GSYNC();
#ifndef NO_P2
    { const pg8::Gemm gDn1{ACT, (const bf16_t*)(ws + WS_WD1), FF, FF, 1 << 30, 0, 0, 0}; pg8::StaticOrder S; S.init(T, D, G, bid); pg8::EpiResidB E{nullptr, XB  , XB  , nullptr, (float*)(ws + WS_SSB), 0.5f}; pg8::gemm_phase(lds, gDn1, S, E); }
#endif
    GSYNC();
#ifndef NO_P3
    { const pg8::Gemm gIn{XB, (const bf16_t*)(ws + WS_WIN), 1024, 1024, 1 << 30, 0, 0, 0}; pg8::StaticOrder S; S.init(T, 4096, G, bid); pg8::EpiProj E{(bf16_t*)(ws + WS_XM), (const float*)(ws + WS_SSB)}; pg8::gemm_phase(lds, gIn, S, E); }
#endif
    GSYNC();
#ifndef NO_P4
    p4_conv(args);
#endif
    GSYNC();
#ifndef NO_P5
    {
        const bf16_t* XCR = (const bf16_t*)args.out + (size_t)T * D;
        const pg8::Gemm gRg{XCR, (const bf16_t*)(ws + WS_WRG), 256, 1024, 1 << 30, 0, 1, 512};
        const pg8::Gemm gGt{(const bf16_t*)(ws + WS_XC), (const bf16_t*)(ws + WS_WG8), 2048, 1024, 16, (long)WS_XM - (long)WS_XC - 16 * 128, 0, 0};
        pg8::EpiGates Eg{(float*)(ws + WS_GATES), args.in[I_BGATES]};
        pg8::EpiRg Er{XCR, args.in[I_RBA], args.in[I_RBX], (const float*)(ws + WS_C8), (bf16_t*)(ws + WS_XR), (bf16_t*)(ws + WS_U)};
        if (G == 256) {
#ifndef NO_P5G
            if (bid < 128) { pg8::ListOrder S{bid, 1, 0}; pg8::gemm_phase(lds, gGt, S, Eg); }
#endif
#ifndef NO_P5R
            if (bid >= 128) { pg8::ListOrder S{(bid - 128) * 8, 8, 3}; pg8::gemm_phase(lds, gRg, S, Er); }
#endif
        } else {
#ifndef NO_P5G
            for (int u = bid; u < 128; u += G) { pg8::ListOrder S{u, 1, 0}; pg8::gemm_phase(lds, gGt, S, Eg); }
#endif
#ifndef NO_P5R
            for (int u = bid; u < 128; u += G) { pg8::ListOrder S{u * 8, 8, 3}; pg8::gemm_phase(lds, gRg, S, Er); }
#endif
        }
    }
#endif
    GSYNC();
#ifndef NO_P6A
    p6_rg_agg(args);
#endif
    p5b_sraw(args, lds_raw);
    GSYNC();
#ifndef NO_P6
    p6_mlstm(args, lds_raw);
#endif
    GSYNC();
#ifndef NO_P7A
    p7_mlstm_fin(args);
#endif
#ifndef NO_P7B
    p7_rg_fin(args, lds_raw);
#endif
    GSYNC();
#ifndef NO_P8
    { const pg8::Gemm gOut{(const bf16_t*)(ws + WS_ZM)  , (const bf16_t*)(ws + WS_WOUT), 2048, 1024, 16, (long)(64 * MiB) - 16 * 128, 0, 0}; pg8::StaticOrder S; S.init(T, D, G, bid); pg8::EpiResidB E{nullptr, XB, XB  , nullptr, (float*)(ws + WS_SSC), 1.0f}; pg8::gemm_phase(lds, gOut, S, E); }
#endif
    GSYNC();
#ifndef NO_P9
    { const pg8::Gemm gUp2{XB, (const bf16_t*)(ws + WS_WGU2), 1024, 1024, 1 << 30, 0, 0, 0}; pg8::StaticOrder S; S.init(T, 2 * FF, G, bid); pg8::EpiSwiGLU E{ACT, (const float*)(ws + WS_SSC)}; pg8::gemm_phase(lds, gUp2, S, E); }
#endif
    GSYNC();
#ifndef NO_P10
    { const pg8::Gemm gDn2{ACT, (const bf16_t*)(ws + WS_WD2), FF, FF, 1 << 30, 0, 0, 0}; pg8::StaticOrder S; S.init(T, D, G, bid); pg8::EpiResidB E{nullptr, XB, XB  , nullptr, (float*)(ws + WS_SSD), 0.5f}; pg8::gemm_phase(lds, gDn2, S, E); }
#endif
    GSYNC();
#ifndef NO_P11
    p11_final(args);
#endif
}

extern "C" void kernel_launch(void* const* d_in, const int* in_sizes, int n_in, void* d_out, int out_size, void* d_ws, size_t ws_size, hipStream_t stream) {
    static int grid = 0;
    if (grid == 0) {
        if (n_in != 31 || in_sizes[0] != T * D || out_size != T * D || ws_size < WS_END) { fprintf(stderr, "kernel_launch: unexpected shapes (n_in %d, in0 %d, out %d, ws %zu)\n", n_in, n_in > 0 ? in_sizes[0] : -1, out_size, ws_size); grid = -1; return; }
        int dev = 0, cus = 0, per_cu = 0;
        if (hipGetDevice(&dev) != hipSuccess || hipDeviceGetAttribute(&cus, hipDeviceAttributeMultiprocessorCount, dev) != hipSuccess) { grid = -1; return; }
        if (hipFuncSetAttribute((const void*)mk_fwd, hipFuncAttributeMaxDynamicSharedMemorySize, LDS_BYTES) != hipSuccess) { fprintf(stderr, "kernel_launch: hipFuncSetAttribute failed\n"); grid = -1; return; }
        if (hipOccupancyMaxActiveBlocksPerMultiprocessor(&per_cu, (const void*)mk_fwd, 512, LDS_BYTES) != hipSuccess || per_cu < 1) { fprintf(stderr, "kernel_launch: occupancy query says %d\n", per_cu); (void)hipGetLastError(); grid = -1; return; }
        grid = cus;
    }
    if (grid < 0) return;
    if (hipMemsetAsync((char*)d_ws + WS_BAR, 0, 16384, stream) != hipSuccess) { fprintf(stderr, "kernel_launch: memset of barrier words failed\n"); return; }
    Args a{};
    for (int i = 0; i < 31; ++i) a.in[i] = (const float*)d_in[i];
    a.out = (float*)d_out; a.ws = (unsigned char*)d_ws;
    void* kargs[] = {&a};
    hipError_t e = hipLaunchCooperativeKernel((const void*)mk_fwd, dim3(grid), dim3(512), kargs, LDS_BYTES, stream);
    if (e != hipSuccess) fprintf(stderr, "kernel_launch: cooperative launch failed: %s (grid %d)\n", hipGetErrorString(e), grid);
}
```

```cpp
#include <hip/hip_runtime.h>
#include <hip/hip_cooperative_groups.h>
#include <cstdio>
#include <cstdint>
namespace cg = cooperative_groups;

#define LAS __attribute__((address_space(3)))
typedef unsigned short bf16_t;
typedef short bf16x8 __attribute__((ext_vector_type(8)));
typedef float f32x4 __attribute__((ext_vector_type(4)));
typedef unsigned u32x4 __attribute__((ext_vector_type(4)));
typedef unsigned u32x2 __attribute__((ext_vector_type(2)));

constexpr int T = 32768, D = 1024, FF = 2816, SEQ = 8192, NB = 4;
constexpr float EPS = 1e-6f;
constexpr size_t MiB = 1u << 20;
constexpr size_t WS_SSA = 0, WS_SSB = 2 * MiB, WS_SSC = 4 * MiB, WS_SSD = 6 * MiB;
constexpr size_t WS_GATES = 8 * MiB;
constexpr size_t WS_AGG = 9 * MiB;
constexpr size_t WS_BAR = 14 * MiB;
constexpr size_t WS_C8 = 12 * MiB;
constexpr size_t WS_WG8 = 11 * MiB;
constexpr size_t WS_WGU1 = 16 * MiB;
constexpr size_t WS_WD1 = WS_WGU1 + 11 * MiB;
constexpr size_t WS_WIN = WS_WD1 + 11 * MiB / 2;
constexpr size_t WS_WRG = WS_WIN + 8 * MiB;
constexpr size_t WS_WOUT = WS_WRG + 1 * MiB;
constexpr size_t WS_WGU2 = WS_WOUT + 4 * MiB;
constexpr size_t WS_WD2 = WS_WGU2 + 11 * MiB;
constexpr size_t WS_XB = 64 * MiB;
constexpr size_t WS_R1 = 128 * MiB;
constexpr size_t WS_XM = WS_R1, WS_ZM = WS_R1 + 64 * MiB, WS_XR = WS_R1 + 128 * MiB, WS_YR = WS_R1 + 192 * MiB;
constexpr size_t WS_XC = 384 * MiB;
constexpr size_t WS_U = 448 * MiB;
constexpr size_t WS_END = 512 * MiB;
constexpr int LDS_BYTES = 147456;

typedef float f32x2_t __attribute__((ext_vector_type(2)));
typedef __bf16 bf16x2_t __attribute__((ext_vector_type(2)));
__device__ __forceinline__ unsigned pk2(float lo, float hi) { const f32x2_t v = {lo, hi}; const bf16x2_t b = __builtin_convertvector(v, bf16x2_t); return __builtin_bit_cast(unsigned, b); }
__device__ __forceinline__ float bflo(unsigned u) { return __uint_as_float(u << 16); }
__device__ __forceinline__ float bfhi(unsigned u) { return __uint_as_float(u & 0xffff0000u); }
__device__ __forceinline__ float bf1(bf16_t u) { return __uint_as_float(((unsigned)u) << 16); }
__device__ __forceinline__ void unpack8(const u32x4 v, float* x) { x[0] = bflo(v.x); x[1] = bfhi(v.x); x[2] = bflo(v.y); x[3] = bfhi(v.y); x[4] = bflo(v.z); x[5] = bfhi(v.z); x[6] = bflo(v.w); x[7] = bfhi(v.w); }
__device__ __forceinline__ u32x4 pack8(const float* x) { u32x4 o; o.x = pk2(x[0], x[1]); o.y = pk2(x[2], x[3]); o.z = pk2(x[4], x[5]); o.w = pk2(x[6], x[7]); return o; }
__device__ __forceinline__ float sigmoidf_(float x) { return __builtin_amdgcn_rcpf(1.0f + __expf(-x)); }
__device__ __forceinline__ float siluf_(float x) { return x * __builtin_amdgcn_rcpf(1.0f + __expf(-x)); }
__device__ __forceinline__ float logsigf_(float x) { return fminf(x, 0.f) - __logf(1.0f + __expf(-fabsf(x))); }
__device__ __forceinline__ float logsig_acc_(float x) { return fminf(x, 0.f) - log1pf(expf(-fabsf(x))); }
__device__ __forceinline__ float geluf_(float x) { const float u = 0.7978845608028654f * (x + 0.044715f * x * x * x); const float t = 1.0f - 2.0f * __builtin_amdgcn_rcpf(1.0f + __expf(2.0f * u)); return 0.5f * x * (1.0f + t); }
__device__ __forceinline__ int opaque_tid() { int t = threadIdx.x; asm volatile("" : "+v"(t)); return t; }
__device__ __forceinline__ float wave_sum(float v) {
#pragma unroll
    for (int o = 1; o < 64; o <<= 1) v += __shfl_xor(v, o);
    return v;
}

namespace pg8 {
constexpr int BM = 256, BK = 64, HALF = 128, HTB = HALF * BK * 2, STAGE_BYTES = 8 * HTB, NXCD = 8, WGM = 8;
__host__ __device__ __forceinline__ int lds_byte(int r, int c) { const int st = (r >> 4) * 2 + (c >> 5), rr = r & 15, cc = c & 31, ob = rr * 64 + cc * 2; return st * 1024 + (ob ^ (((ob >> 9) & 1) << 5)); }
__host__ __device__ __forceinline__ void stage_rc(int b, int& R, int& C) { const int st = b / 1024, sb = b % 1024, swz = sb ^ (((sb >> 9) & 1) << 5); R = (st >> 1) * 16 + swz / 64; C = (st & 1) * 32 + (swz % 64) / 2; }
__host__ __device__ __forceinline__ int perm32(int rho) { const int n = rho >> 4, i = rho & 15; return 8 * (i >> 2) + 4 * n + (i & 3); }

struct Unit { int pm, pn; };
struct Gemm { const bf16_t* A; const bf16_t* Bt; int K; int lda; int ksplit; long kdelta; int a_pn_shift; int a_pn_bytes; };

struct StaticOrder {
    int nM, nN, nwg, G, c;
    __device__ void init(int M, int N, int G_, int c_) { nM = M / BM; nN = N / BM; nwg = nM * nN; G = G_; c = c_; }
    __device__ bool next(int i, Unit& u) const {
        const long L = (long)i * G + c; if (L >= nwg) return false;
        int wgid = (int)L; { const int q = nwg / NXCD, r = nwg % NXCD, xcd = wgid % NXCD, off = wgid / NXCD; wgid = (xcd < r ? xcd * (q + 1) : r * (q + 1) + (xcd - r) * q) + off; }
        const int nig = WGM * nN, gid = wgid / nig, fm = gid * WGM, gsz = (nM - fm) < WGM ? (nM - fm) : WGM;
        u.pm = fm + ((wgid % nig) % gsz); u.pn = (wgid % nig) / gsz; return true;
    }
};
struct ListOrder {
    int first, cnt, nshift;
    __device__ bool next(int i, Unit& u) const { if (i >= cnt) return false; const int L = first + i; u.pm = L >> nshift; u.pn = L & ((1 << nshift) - 1); return true; }
};

__device__ __forceinline__ float row_scale(const float* SS, int r) {
    const f32x4* p = (const f32x4*)(SS + (size_t)r * 16);
    const f32x4 a = p[0], b = p[1], c = p[2], d = p[3];
    const float s = ((a[0] + a[1]) + (a[2] + a[3])) + ((b[0] + b[1]) + (b[2] + b[3])) + ((c[0] + c[1]) + (c[2] + c[3])) + ((d[0] + d[1]) + (d[2] + d[3]));
    return rsqrtf(s * (1.0f / 1024.0f) + EPS);
}

__device__ __forceinline__ void row_scales8(const float* SS, int row0, int fq, float (&rs)[8]) {
    f32x4 v[8];
#pragma unroll
    for (int q = 0; q < 8; ++q) v[q] = *(const f32x4*)(SS + (size_t)(row0 + (q >> 2) * HALF + (q & 3) * 16) * 16 + fq * 4);
#pragma unroll
    for (int q = 0; q < 8; ++q) { float s = (v[q][0] + v[q][1]) + (v[q][2] + v[q][3]); s += __shfl_xor(s, 16); s += __shfl_xor(s, 32); rs[q] = rsqrtf(s * (1.0f / 1024.0f) + EPS); }
}
struct EpiSwiGLU {
    bf16_t* O; const float* SS;
    __device__ __forceinline__ void operator()(const f32x4 (&acc)[2][2][4][2], const Unit& u, int wr, int wc, int fr, int fq) const {
        const int row0 = u.pm * BM + wr * 64 + fr, col0 = u.pn * HALF + wc * 32 + 8 * fq;
        float rs8[8]; row_scales8(SS, row0, fq, rs8);
#pragma unroll
        for (int ai = 0; ai < 2; ++ai)
#pragma unroll
            for (int m = 0; m < 4; ++m) {
                const int r = row0 + ai * HALF + m * 16; const float rs = rs8[ai * 4 + m];
                float o[8];
#pragma unroll
                for (int n = 0; n < 2; ++n)
#pragma unroll
                    for (int j = 0; j < 4; ++j) { const float g = acc[ai][0][m][n][j] * rs, up = acc[ai][1][m][n][j] * rs; o[n * 4 + j] = siluf_(g) * up; }
                *(u32x4*)(O + (size_t)r * FF + col0) = pack8(o);
            }
    }
};
struct EpiResid {
    const float* Xin; float* Xout; bf16_t* XBo; float* SSo; float alpha;
    __device__ __forceinline__ void operator()(const f32x4 (&acc)[2][2][4][2], const Unit& u, int wr, int wc, int fr, int fq) const {
        const int row0 = u.pm * BM + wr * 64 + fr, col0 = u.pn * BM + wc * 32 + 8 * fq;
#pragma unroll
        for (int ai = 0; ai < 2; ++ai)
#pragma unroll
            for (int m = 0; m < 4; ++m) {
                const int r = row0 + ai * HALF + m * 16; float ss = 0.f;
#pragma unroll
                for (int bj = 0; bj < 2; ++bj) {
                    const size_t off = (size_t)r * D + col0 + bj * HALF;
                    const f32x4 x0 = *(const f32x4*)(Xin + off), x1 = *(const f32x4*)(Xin + off + 4);
                    const f32x4 v0 = x0 + acc[ai][bj][m][0] * alpha, v1 = x1 + acc[ai][bj][m][1] * alpha;
                    *(f32x4*)(Xout + off) = v0; *(f32x4*)(Xout + off + 4) = v1;
                    ss += (v0[0] * v0[0] + v0[1] * v0[1]) + (v0[2] * v0[2] + v0[3] * v0[3]) + (v1[0] * v1[0] + v1[1] * v1[1]) + (v1[2] * v1[2] + v1[3] * v1[3]);
                    if (XBo) { u32x4 w; w.x = pk2(v0[0], v0[1]); w.y = pk2(v0[2], v0[3]); w.z = pk2(v1[0], v1[1]); w.w = pk2(v1[2], v1[3]); *(u32x4*)(XBo + off) = w; }
                }
                ss += __shfl_xor(ss, 16); ss += __shfl_xor(ss, 32);
                if (fq == 0) SSo[(size_t)r * 16 + u.pn * 4 + wc] = ss;
            }
    }
};
struct EpiResidB {
    const float* XinF; const bf16_t* XinB; bf16_t* O1; bf16_t* O2; float* SSo; float alpha;
    __device__ __forceinline__ void operator()(const f32x4 (&acc)[2][2][4][2], const Unit& u, int wr, int wc, int fr, int fq) const {
        const int row0 = u.pm * BM + wr * 64 + fr, col0 = u.pn * BM + wc * 32 + 8 * fq;
#pragma unroll
        for (int ai = 0; ai < 2; ++ai)
#pragma unroll
            for (int m = 0; m < 4; ++m) {
                const int r = row0 + ai * HALF + m * 16; float ss = 0.f;
#pragma unroll
                for (int bj = 0; bj < 2; ++bj) {
                    const size_t off = (size_t)r * D + col0 + bj * HALF;
                    f32x4 x0, x1;
                    if (XinF) { x0 = *(const f32x4*)(XinF + off); x1 = *(const f32x4*)(XinF + off + 4); }
                    else { const u32x4 xb = *(const u32x4*)(XinB + off); x0 = (f32x4){bflo(xb.x), bfhi(xb.x), bflo(xb.y), bfhi(xb.y)}; x1 = (f32x4){bflo(xb.z), bfhi(xb.z), bflo(xb.w), bfhi(xb.w)}; }
                    const f32x4 v0 = x0 + acc[ai][bj][m][0] * alpha, v1 = x1 + acc[ai][bj][m][1] * alpha;
                    ss += (v0[0] * v0[0] + v0[1] * v0[1]) + (v0[2] * v0[2] + v0[3] * v0[3]) + (v1[0] * v1[0] + v1[1] * v1[1]) + (v1[2] * v1[2] + v1[3] * v1[3]);
                    u32x4 w; w.x = pk2(v0[0], v0[1]); w.y = pk2(v0[2], v0[3]); w.z = pk2(v1[0], v1[1]); w.w = pk2(v1[2], v1[3]);
                    *(u32x4*)(O1 + off) = w; if (O2) *(u32x4*)(O2 + off) = w;
                }
                ss += __shfl_xor(ss, 16); ss += __shfl_xor(ss, 32);
                if (fq == 0) SSo[(size_t)r * 16 + u.pn * 4 + wc] = ss;
            }
    }
};
struct EpiProj {
    bf16_t* O; const float* SS;
    __device__ __forceinline__ void operator()(const f32x4 (&acc)[2][2][4][2], const Unit& u, int wr, int wc, int fr, int fq) const {
        bf16_t* base = O + (size_t)(u.pn >> 2) * ((size_t)T * D);
        const int row0 = u.pm * BM + wr * 64 + fr, col0 = (u.pn & 3) * BM + wc * 32 + 8 * fq;
        float rs8[8]; row_scales8(SS, row0, fq, rs8);
#pragma unroll
        for (int ai = 0; ai < 2; ++ai)
#pragma unroll
            for (int m = 0; m < 4; ++m) {
                const int r = row0 + ai * HALF + m * 16; const float rs = rs8[ai * 4 + m];
#pragma unroll
                for (int bj = 0; bj < 2; ++bj) {
                    const f32x4 v0 = acc[ai][bj][m][0] * rs, v1 = acc[ai][bj][m][1] * rs;
                    u32x4 w; w.x = pk2(v0[0], v0[1]); w.y = pk2(v0[2], v0[3]); w.z = pk2(v1[0], v1[1]); w.w = pk2(v1[2], v1[3]);
                    *(u32x4*)(base + (size_t)r * D + col0 + bj * HALF) = w;
                }
            }
    }
};
__device__ __forceinline__ float neg_expm1_(float x) {
    const float p = -x * (1.0f + x * (0.5f + x * (0.16666667f + x * (0.041666668f + x * 0.0083333338f))));
    const float e = 1.0f - __expf(x);
    return (x > -0.3f) ? p : e;
}
struct EpiRg {
    const bf16_t* XCR; const float* ba; const float* bx; const float* c8t; bf16_t* LOGA; bf16_t* U;
    __device__ __forceinline__ void operator()(const f32x4 (&acc)[2][2][4][2], const Unit& u, int wr, int wc, int fr, int fq) const {
        const int row0 = u.pm * BM + wr * 64 + fr, ch0 = (u.pn >> 1) * 256 + (u.pn & 1) * HALF + wc * 32 + 8 * fq;
#pragma unroll
        for (int n = 0; n < 2; ++n) {
            const int ch = ch0 + 4 * n;
            const f32x4 b_a = *(const f32x4*)(ba + ch), b_x = *(const f32x4*)(bx + ch), c8 = *(const f32x4*)(c8t + ch);
#pragma unroll
            for (int ai = 0; ai < 2; ++ai)
#pragma unroll
                for (int m = 0; m < 4; ++m) {
                    const int r = row0 + ai * HALF + m * 16;
                    const u32x2 xv = *(const u32x2*)(XCR + (size_t)r * D + ch);
                    const float xc[4] = {bflo(xv.x), bfhi(xv.x), bflo(xv.y), bfhi(xv.y)};
                    float la[4], uu[4];
#pragma unroll
                    for (int j = 0; j < 4; ++j) {
                        const float rg = sigmoidf_(acc[ai][0][m][n][j] + b_a[j]), ig = sigmoidf_(acc[ai][1][m][n][j] + b_x[j]);
                        la[j] = c8[j] * rg;
                        uu[j] = __builtin_amdgcn_sqrtf(fmaxf(neg_expm1_(2.0f * la[j]), 0.f)) * (ig * xc[j]);
                    }
                    u32x2 w0, w1; w0.x = pk2(la[0], la[1]); w0.y = pk2(la[2], la[3]); w1.x = pk2(uu[0], uu[1]); w1.y = pk2(uu[2], uu[3]);
                    *(u32x2*)(LOGA + (size_t)r * D + ch) = w0; *(u32x2*)(U + (size_t)r * D + ch) = w1;
                    __builtin_amdgcn_sched_barrier(0);
                }
        }
    }
};
struct EpiGates {
    float* G; const float* bg;
    __device__ __forceinline__ void operator()(const f32x4 (&acc)[2][2][4][2], const Unit& u, int wr, int wc, int fr, int fq) const {
        if (wc != 0 || fq != 0) return;
        const int row0 = u.pm * BM + wr * 64 + fr;
        const f32x4 b0 = *(const f32x4*)(bg), b1 = *(const f32x4*)(bg + 4);
#pragma unroll
        for (int ai = 0; ai < 2; ++ai)
#pragma unroll
            for (int m = 0; m < 4; ++m) {
                const int r = row0 + ai * HALF + m * 16;
                f32x4 v0 = acc[ai][0][m][0] + b0, v1 = acc[ai][0][m][1] + b1;
                for (int j = 0; j < 4; ++j) v1[j] = logsigf_(v1[j]);
                *(f32x4*)(G + (size_t)r * 8) = v0; *(f32x4*)(G + (size_t)r * 8 + 4) = v1;
            }
    }
};

template <class Epi, class Sched>
__device__ __forceinline__ void gemm_phase(LAS unsigned char* lds, const Gemm g, const Sched& S, const Epi& E) {
    const int tid = opaque_tid(), wid = __builtin_amdgcn_readfirstlane(tid >> 6), lane = tid & 63, wr = wid >> 2, wc = wid & 3, fr = lane & 15, fq = lane >> 4;
    const int K = g.K, nt = K / BK, lda = g.lda;
    unsigned voffA[2], voffB[2];
#pragma unroll
    for (int i = 0; i < 2; ++i) { int R, C; stage_rc(tid * 16 + i * 8192, R, C); const int Rb = (R & ~31) + perm32(R & 31);
        voffA[i] = (unsigned)(R * lda + C) * 2u; voffB[i] = (unsigned)(Rb * K + C) * 2u; }
    const size_t kstep = (size_t)(BK * 2);
    const size_t hstepA = (size_t)HALF * lda * 2, tstepA = 2 * hstepA;
    const size_t hstepB = (size_t)HALF * K * 2, tstepB = 2 * hstepB;
    const unsigned ldsw = (unsigned)wid * 1024u;
    const int aoff = lds_byte(wr * 64 + fr, fq * 8), boff = lds_byte(wc * 32 + fr, fq * 8);
    const int ksplit = g.ksplit; const long kdelta = g.kdelta;
#define PG8_AK(t) ((long)(t) * (long)kstep + (((t) >= ksplit) ? kdelta : 0l))
#define PG8_SA(b, h) (((b) * 2 + (h)) * HTB)
#define PG8_SB(b, h) ((4 + (b) * 2 + (h)) * HTB)
#define PG8_STAGE(bufoff, gbase, voff) do { _Pragma("unroll") for (int _i = 0; _i < 2; ++_i) \
        __builtin_amdgcn_global_load_lds((const unsigned*)((const char*)(gbase) + (voff)[_i]), (LAS unsigned*)(lds + (bufoff) + ldsw + _i * 8192), 16, 0, 0); } while (0)
#define PG8_LDA(dst, b, h) do { _Pragma("unroll") for (int m = 0; m < 4; ++m) _Pragma("unroll") for (int k = 0; k < 2; ++k) dst[m][k] = *(const LAS bf16x8*)(lds + PG8_SA(b, h) + aoff + m * 2048 + k * 1024); } while (0)
#define PG8_LDB(dst, b, h) do { _Pragma("unroll") for (int n = 0; n < 2; ++n) _Pragma("unroll") for (int k = 0; k < 2; ++k) dst[n][k] = *(const LAS bf16x8*)(lds + PG8_SB(b, h) + boff + n * 2048 + k * 1024); } while (0)
#define PG8_MMA(ai, bj, At, Bt) do { __builtin_amdgcn_s_setprio(1); _Pragma("unroll") for (int m = 0; m < 4; ++m) _Pragma("unroll") for (int n = 0; n < 2; ++n) _Pragma("unroll") for (int k = 0; k < 2; ++k) \
        acc[ai][bj][m][n] = __builtin_amdgcn_mfma_f32_16x16x32_bf16(Bt[n][k], At[m][k], acc[ai][bj][m][n], 0, 0, 0); __builtin_amdgcn_s_setprio(0); } while (0)
#define PG8_WAIT_V(n) asm volatile("s_waitcnt vmcnt(" #n ")" ::: "memory")
#define PG8_WAIT_L(n) asm volatile("s_waitcnt lgkmcnt(" #n ")" ::: "memory")
#define PG8_BAR __builtin_amdgcn_s_barrier()
#define PG8_SCHED __builtin_amdgcn_sched_barrier(0)
    Unit cur, nxt; int ui = 0;
    if (!S.next(0, cur)) return;
    f32x4 acc[2][2][4][2];
#pragma unroll
    for (int a = 0; a < 2; ++a)
#pragma unroll
        for (int b = 0; b < 2; ++b)
#pragma unroll
            for (int m = 0; m < 4; ++m)
#pragma unroll
                for (int n = 0; n < 2; ++n) acc[a][b][m][n] = (f32x4){0.f, 0.f, 0.f, 0.f};
    bf16x8 At[4][2], B0[2][2], B1[2][2];
    const char* cA = (const char*)g.A + (size_t)cur.pm * tstepA + (size_t)(cur.pn >> g.a_pn_shift) * g.a_pn_bytes;
    const char* cB = (const char*)g.Bt + (size_t)cur.pn * tstepB;
    {
        PG8_STAGE(PG8_SB(0, 0), cB, voffB); PG8_STAGE(PG8_SB(0, 1), cB + hstepB, voffB); PG8_STAGE(PG8_SA(0, 0), cA, voffA); PG8_STAGE(PG8_SA(0, 1), cA + hstepA, voffA);
        if (wr == 1) PG8_BAR;
        PG8_WAIT_V(2); PG8_BAR;
        PG8_STAGE(PG8_SB(1, 0), cB + kstep, voffB); PG8_STAGE(PG8_SA(1, 0), cA + PG8_AK(1), voffA); PG8_STAGE(PG8_SB(1, 1), cB + hstepB + kstep, voffB);
        PG8_WAIT_V(6); PG8_BAR;
    }
    for (;;) {
        const bool has_next = S.next(ui + 1, nxt);
        const char* nA = has_next ? (const char*)g.A + (size_t)nxt.pm * tstepA + (size_t)(nxt.pn >> g.a_pn_shift) * g.a_pn_bytes : cA;
        const char* nB = has_next ? (const char*)g.Bt + (size_t)nxt.pn * tstepB : cB;
#pragma nounroll
        for (int t = 0; t < nt; t += 2) {
            const bool last = (t == nt - 2);
            const char* a1 = cA + PG8_AK(t + 1);
            const char* a2 = last ? nA : cA + PG8_AK(t + 2); const char* b2 = last ? nB : cB + (size_t)(t + 2) * kstep;
            const char* a3 = last ? nA + PG8_AK(1) : cA + PG8_AK(t + 3); const char* b3 = b2 + kstep;
            PG8_LDB(B0, 0, 0); PG8_LDB(B1, 0, 1); PG8_SCHED; PG8_LDA(At, 0, 0); PG8_STAGE(PG8_SA(1, 1), a1 + hstepA, voffA);
            PG8_WAIT_V(8); PG8_WAIT_L(0); PG8_BAR; PG8_MMA(0, 0, At, B0); PG8_MMA(0, 1, At, B1); PG8_BAR; PG8_SCHED;
            PG8_LDA(At, 0, 1); PG8_STAGE(PG8_SB(0, 0), b2, voffB); PG8_STAGE(PG8_SB(0, 1), b2 + hstepB, voffB); PG8_STAGE(PG8_SA(0, 0), a2, voffA);
            PG8_WAIT_V(8); PG8_WAIT_L(0); PG8_BAR; PG8_MMA(1, 0, At, B0); PG8_MMA(1, 1, At, B1); PG8_BAR; PG8_SCHED;
            PG8_LDB(B0, 1, 0); PG8_LDB(B1, 1, 1); PG8_SCHED; PG8_LDA(At, 1, 0); PG8_STAGE(PG8_SA(0, 1), a2 + hstepA, voffA);
            PG8_WAIT_V(8); PG8_WAIT_L(0); PG8_BAR; PG8_MMA(0, 0, At, B0); PG8_MMA(0, 1, At, B1); PG8_BAR; PG8_SCHED;
            PG8_LDA(At, 1, 1); PG8_STAGE(PG8_SB(1, 0), b3, voffB); PG8_STAGE(PG8_SB(1, 1), b3 + hstepB, voffB); PG8_STAGE(PG8_SA(1, 0), a3, voffA);
            PG8_WAIT_V(8); PG8_WAIT_L(0); PG8_BAR; PG8_MMA(1, 0, At, B0); PG8_MMA(1, 1, At, B1); PG8_BAR; PG8_SCHED;
        }
        if (wr == 0) PG8_BAR;
        E(acc, cur, wr, wc, fr, fq);
        if (!has_next) break;
#pragma unroll
        for (int a = 0; a < 2; ++a)
#pragma unroll
            for (int b = 0; b < 2; ++b)
#pragma unroll
                for (int m = 0; m < 4; ++m)
#pragma unroll
                    for (int n = 0; n < 2; ++n) acc[a][b][m][n] = (f32x4){0.f, 0.f, 0.f, 0.f};
        cur = nxt; cA = nA; cB = nB; ++ui;
        if (wr == 1) PG8_BAR;
    }
    PG8_WAIT_V(0);
    PG8_BAR;
#undef PG8_AK
#undef PG8_SA
#undef PG8_SB
#undef PG8_STAGE
#undef PG8_LDA
#undef PG8_LDB
#undef PG8_MMA
#undef PG8_WAIT_V
#undef PG8_WAIT_L
#undef PG8_BAR
#undef PG8_SCHED
}
}

struct Args { const float* in[31]; float* out; unsigned char* ws; };
enum { I_X = 0, I_NF1, I_WG1, I_WU1, I_WD1, I_NMIX, I_WIN, I_MCW, I_MCB, I_WQ, I_WK, I_WV, I_WGATES, I_BGATES, I_LNW, I_SKIP, I_RCW, I_RCB, I_RWA, I_RBA, I_RWX, I_RBX, I_LAM,
       I_ONM, I_ONR, I_WOUT, I_NF2, I_WG2, I_WU2, I_WD2, I_NFIN };

template <class F> __device__ __forceinline__ void tr_item(F src, int K, bf16_t* WT, float* scr, int item, int nblk, int lane) {
    const int kb = item / nblk, nb = item % nblk, k0 = 64 * kb, n0 = 32 * nb;
#pragma unroll 8
    for (int i = 0; i < 32; ++i) { const int kk = 2 * i + (lane >> 5); scr[kk * 33 + (lane & 31)] = src(k0 + kk, n0 + (lane & 31)); }
    __builtin_amdgcn_wave_barrier();
    const int c = lane & 7;
#pragma unroll
    for (int j = 0; j < 4; ++j) { const int n = (lane >> 3) + 8 * j; const float* s = scr + (8 * c) * 33 + n;
        u32x4 o; o.x = pk2(s[0 * 33], s[1 * 33]); o.y = pk2(s[2 * 33], s[3 * 33]); o.z = pk2(s[4 * 33], s[5 * 33]); o.w = pk2(s[6 * 33], s[7 * 33]);
        *(u32x4*)(WT + (size_t)(n0 + n) * K + k0 + 8 * c) = o; }
    __builtin_amdgcn_wave_barrier();
}

__device__ __forceinline__ void p0_prologue(const Args& a, unsigned char* lds) {
    const int tid = opaque_tid(), lane = tid & 63, wave = tid >> 6;
    const int gw = blockIdx.x * 8 + wave, NGW = gridDim.x * 8;
    float* scr = (float*)(lds + wave * 16384);
    unsigned char* ws = a.ws;
    constexpr int I1 = 16 * 176, I2 = 44 * 32, I3 = 16 * 128, I4 = 4 * 64, I5 = 32 * 32;
    constexpr int NIT = I1 + I2 + I3 + I4 + I5 + I1 + I2;
    for (int it = gw; it < NIT; it += NGW) {
        int r = it;
        if (r < I1) { const float* wg = a.in[I_WG1]; const float* wu = a.in[I_WU1]; const float* gn = a.in[I_NF1];
            tr_item([=](int k, int n) { const int c = (n >> 8) * 128 + (n & 127); return (((n >> 7) & 1) ? wu : wg)[(size_t)k * FF + c] * gn[k]; }, 1024, (bf16_t*)(ws + WS_WGU1), scr, r, 176, lane); continue; } r -= I1;
        if (r < I2) { const float* wd = a.in[I_WD1];
            tr_item([=](int k, int n) { return wd[(size_t)k * D + n]; }, FF, (bf16_t*)(ws + WS_WD1), scr, r, 32, lane); continue; } r -= I2;
        if (r < I3) { const float* w = a.in[I_WIN]; const float* gn = a.in[I_NMIX];
            tr_item([=](int k, int n) { return w[(size_t)k * 4096 + n] * gn[k]; }, 1024, (bf16_t*)(ws + WS_WIN), scr, r, 128, lane); continue; } r -= I3;
        if (r < I4) { const float* wa = a.in[I_RWA]; const float* wx = a.in[I_RWX];
            tr_item([=](int k, int n) { const int pn = n >> 8, blk = pn >> 1, hh = pn & 1, sel = (n >> 7) & 1, c = hh * 128 + (n & 127); return (sel ? wx : wa)[(size_t)blk * 65536 + (size_t)k * 256 + c]; }, 256, (bf16_t*)(ws + WS_WRG), scr, r, 64, lane); continue; } r -= I4;
        if (r < I5) { const float* w = a.in[I_WOUT]; const float* gm = a.in[I_ONM]; const float* gr = a.in[I_ONR];
            tr_item([=](int k, int n) { return w[(size_t)k * D + n] * (k < 1024 ? gm[k] : gr[k - 1024]); }, 2048, (bf16_t*)(ws + WS_WOUT), scr, r, 32, lane); continue; } r -= I5;
        if (r < I1) { const float* wg = a.in[I_WG2]; const float* wu = a.in[I_WU2]; const float* gn = a.in[I_NF2];
            tr_item([=](int k, int n) { const int c = (n >> 8) * 128 + (n & 127); return (((n >> 7) & 1) ? wu : wg)[(size_t)k * FF + c] * gn[k]; }, 1024, (bf16_t*)(ws + WS_WGU2), scr, r, 176, lane); continue; } r -= I1;
        { const float* wd = a.in[I_WD2];
            tr_item([=](int k, int n) { return wd[(size_t)k * D + n]; }, FF, (bf16_t*)(ws + WS_WD2), scr, r, 32, lane); }
    }
    {
        bf16_t* WG8 = (bf16_t*)(ws + WS_WG8);
        const float* wq = a.in[I_WQ]; const float* wk = a.in[I_WK]; const float* wv = a.in[I_WV]; const float* Wg = a.in[I_WGATES];
        const int gt = blockIdx.x * 512 + tid, NT = gridDim.x * 512;
        for (int e = gt; e < 256 * 2048 / 8; e += NT) {
            const int g = e / 256, k0 = (e % 256) * 8;
            float o[8];
#pragma unroll
            for (int j = 0; j < 8; ++j) {
                float v = 0.f;
                if (g < 8) { const int k = k0 + j, c = k & 1023, n = c >> 2, i = c & 3;
                    if (k < 1024) { for (int oo = 0; oo < 4; ++oo) v += wq[n * 16 + i * 4 + oo] * Wg[(size_t)(4 * n + oo) * 8 + g] + wk[n * 16 + i * 4 + oo] * Wg[(size_t)(1024 + 4 * n + oo) * 8 + g]; }
                    else { for (int oo = 0; oo < 4; ++oo) v += wv[n * 16 + i * 4 + oo] * Wg[(size_t)(2048 + 4 * n + oo) * 8 + g]; } }
                o[j] = v;
            }
            *(u32x4*)(WG8 + (size_t)g * 2048 + k0) = pack8(o);
        }
    }
    if (blockIdx.x == 0) { float* C8 = (float*)(ws + WS_C8); const float* lam = a.in[I_LAM]; for (int e = tid; e < 1024; e += 512) C8[e] = 8.0f * logsig_acc_(lam[e]); }
    {
        const float* x = a.in[I_X]; bf16_t* XB = (bf16_t*)(ws + WS_XB); float* SS = (float*)(ws + WS_SSA);
        for (int m = gw; m < T; m += NGW) {
            const f32x4* xr = (const f32x4*)(x + (size_t)m * D) + lane;
            f32x4 v[4]; float s = 0.f;
#pragma unroll
            for (int j = 0; j < 4; ++j) { v[j] = xr[64 * j]; s += (v[j][0] * v[j][0] + v[j][1] * v[j][1]) + (v[j][2] * v[j][2] + v[j][3] * v[j][3]); }
            s = wave_sum(s);
            u32x2* o8 = (u32x2*)(XB + (size_t)m * D) + lane;
#pragma unroll
            for (int j = 0; j < 4; ++j) { u32x2 w; w.x = pk2(v[j][0], v[j][1]); w.y = pk2(v[j][2], v[j][3]); o8[64 * j] = w; }
            if (lane < 16) SS[(size_t)m * 16 + lane] = (lane == 0) ? s : 0.f;
        }
    }
}

template <bool SILU> __device__ __forceinline__ void conv_part(const bf16_t* in, bf16_t* out, const float* cw, const float* cb, int t0, int c0) {
    float w[4][8], b[8];
#pragma unroll
    for (int tap = 0; tap < 4; ++tap) { const f32x4 p = *(const f32x4*)(cw + tap * D + c0), q = *(const f32x4*)(cw + tap * D + c0 + 4); for (int j = 0; j < 4; ++j) { w[tap][j] = p[j]; w[tap][4 + j] = q[j]; } }
    { const f32x4 p = *(const f32x4*)(cb + c0), q = *(const f32x4*)(cb + c0 + 4); for (int j = 0; j < 4; ++j) { b[j] = p[j]; b[4 + j] = q[j]; } }
    float h0[8], h1[8], h2[8];
    const bool first = (t0 % SEQ) == 0;
    if (first) { for (int j = 0; j < 8; ++j) { h0[j] = 0.f; h1[j] = 0.f; h2[j] = 0.f; } }
    else {
        unpack8(*(const u32x4*)(in + (size_t)(t0 - 3) * D + c0), h0); unpack8(*(const u32x4*)(in + (size_t)(t0 - 2) * D + c0), h1); unpack8(*(const u32x4*)(in + (size_t)(t0 - 1) * D + c0), h2);
    }
    u32x4 cur[8];
#pragma unroll
    for (int i = 0; i < 8; ++i) cur[i] = *(const u32x4*)(in + (size_t)(t0 + i) * D + c0);
#pragma unroll
    for (int i = 0; i < 8; ++i) {
        float x[8], y[8]; unpack8(cur[i], x);
#pragma unroll
        for (int j = 0; j < 8; ++j) { float v = b[j] + w[0][j] * h0[j] + w[1][j] * h1[j] + w[2][j] * h2[j] + w[3][j] * x[j]; y[j] = SILU ? siluf_(v) : v; h0[j] = h1[j]; h1[j] = h2[j]; h2[j] = x[j]; }
        *(u32x4*)(out + (size_t)(t0 + i) * D + c0) = pack8(y);
    }
}
__device__ __forceinline__ void p4_conv(const Args& a) {
    unsigned char* ws = a.ws; const int tid = opaque_tid(), cgp = tid & 127, ts = tid >> 7;
    for (int u = blockIdx.x; u < T / 32; u += gridDim.x) {
        const int t0 = u * 32 + ts * 8, c0 = cgp * 8;
        conv_part<true>((const bf16_t*)(ws + WS_XM), (bf16_t*)(ws + WS_XC), a.in[I_MCW], a.in[I_MCB], t0, c0);
        conv_part<false>((const bf16_t*)(ws + WS_XR), (bf16_t*)a.out + (size_t)T * D  , a.in[I_RCW], a.in[I_RCB], t0, c0);
    }
}

__device__ __forceinline__ void p6_rg_agg(const Args& a) {
    unsigned char* ws = a.ws; const int tid = opaque_tid();
    const unsigned* LOGA = (const unsigned*)(ws + WS_XR); const unsigned* U = (const unsigned*)(ws + WS_U); float* AGG = (float*)(ws + WS_AGG);
    for (int tile = blockIdx.x; tile < 256; tile += gridDim.x) {
        const size_t row0 = (size_t)tile * 128;
        float sl0 = 0.f, sl1 = 0.f, h0 = 0.f, h1 = 0.f;
        for (int i0 = 0; i0 < 128; i0 += 16) {
            unsigned la[16], uu[16];
#pragma unroll
            for (int i = 0; i < 16; ++i) { la[i] = LOGA[(row0 + i0 + i) * 512 + tid]; uu[i] = U[(row0 + i0 + i) * 512 + tid]; }
#pragma unroll
            for (int i = 0; i < 16; ++i) { const float l0 = bflo(la[i]), l1 = bfhi(la[i]); sl0 += l0; sl1 += l1; h0 = __expf(l0) * h0 + bflo(uu[i]); h1 = __expf(l1) * h1 + bfhi(uu[i]); }
        }
        f32x4 o = {sl0, h0, sl1, h1};
        *(f32x4*)(AGG + ((size_t)tile * 1024 + 2 * tid) * 2) = o;
    }
}

template <int CTRL, int RMASK> __device__ __forceinline__ float dppf(float old, float src) {
    return __builtin_bit_cast(float, __builtin_amdgcn_update_dpp(__builtin_bit_cast(int, old), __builtin_bit_cast(int, src), CTRL, RMASK, 0xf, false));
}
__device__ __forceinline__ float readlane_f(float v, int l) { return __builtin_bit_cast(float, __builtin_amdgcn_readlane(__builtin_bit_cast(int, v), l)); }

namespace ml {
constexpr int QP = 264, SP = 72;
constexpr int O_QS = 0, O_KS = 33792, O_SS = 67584, O_VT = 76800, O_VW = 81408, O_CS = 86016, O_OSM = 102912, O_TAB = 111360, O_WTS = 113920, O_END = 126208;
}
__device__ __forceinline__ unsigned char* sraw_ptr(unsigned char* ws, int u) {
    return u < 1600 ? ws + (size_t)u * 5120 : (u < 2000 ? ws + 62 * MiB + (size_t)(u - 1600) * 5120 : ws + 12 * MiB + 512 * 1024 + (size_t)(u - 2000) * 5120);
}
__device__ __forceinline__ void p5b_sraw(const Args& a, unsigned char* lds) {
    using namespace ml;
    unsigned char* ws = a.ws;
    const int tid = opaque_tid(), lane = tid & 63, w = __builtin_amdgcn_readfirstlane(tid >> 6), fr = lane & 15, fq = lane >> 4;
    bf16_t* Qs = (bf16_t*)(lds + O_QS); bf16_t* Ks = (bf16_t*)(lds + O_KS); float* WTS = (float*)(lds + O_WTS);
    const bf16_t* XC = (const bf16_t*)(ws + WS_XC);
    const int srow = tid >> 5, scol = (tid & 31) * 8;
    for (int g = blockIdx.x; g < 256; g += gridDim.x) {
        const int bh = g >> 4, c0 = (g & 15) * 8, b = bh >> 2, h = bh & 3;
        __syncthreads();
        for (int e = tid; e < 1024; e += 512) { const int gg = e >> 4, bb = (e >> 2) & 3, aa = e & 3; const float* wq = a.in[I_WQ] + (h * 64 + gg) * 16; const float* wk = a.in[I_WK] + (h * 64 + gg) * 16;
            float v = 0.f; for (int o = 0; o < 4; ++o) v += wq[bb * 4 + o] * wk[aa * 4 + o]; WTS[e] = v * 0.0625f; }
        __syncthreads();
        const int lg0 = (tid & 31) * 2;
        f32x4 Wq[2][4];
#pragma unroll
        for (int g2 = 0; g2 < 2; ++g2)
#pragma unroll
            for (int i = 0; i < 4; ++i) Wq[g2][i] = *(const f32x4*)(WTS + (lg0 + g2) * 16 + i * 4);
        for (int cc = 0; cc < 8; ++cc) {
            const int c = c0 + cc; const size_t t0 = (size_t)b * SEQ + (size_t)c * 64;
            u32x4 xr[4];
#pragma unroll
            for (int i = 0; i < 4; ++i) xr[i] = *(const u32x4*)(XC + (t0 + srow + 16 * i) * D + h * 256 + scol);
#pragma unroll
            for (int i = 0; i < 4; ++i) {
                float x[8]; unpack8(xr[i], x);
                float q[8];
#pragma unroll
                for (int g2 = 0; g2 < 2; ++g2) {
                    const f32x4 qq = Wq[g2][0] * x[4 * g2] + Wq[g2][1] * x[4 * g2 + 1] + Wq[g2][2] * x[4 * g2 + 2] + Wq[g2][3] * x[4 * g2 + 3];
                    for (int j = 0; j < 4; ++j) q[4 * g2 + j] = qq[j];
                }
                const int r = srow + 16 * i;
                *(u32x4*)(Qs + r * QP + scol) = pack8(q); *(u32x4*)(Ks + r * QP + scol) = xr[i];
            }
            __syncthreads();
            {
                unsigned char* sp = sraw_ptr(ws, bh * 128 + c);
#define S_DECODE(li, it, jt) do { if ((li) < 4) { it = 3; jt = (li); } else if ((li) < 7) { it = 2; jt = (li) - 4; } else if ((li) < 9) { it = 1; jt = (li) - 7; } else { it = 0; jt = 0; } } while (0)
#define S_EPI(li, sv) do { u32x2 wv_; wv_.x = pk2(sv[0], sv[1]); wv_.y = pk2(sv[2], sv[3]); *(u32x2*)(sp + (li) * 512 + lane * 8) = wv_; } while (0)
                int it0, jt0, it1 = 0, jt1 = 0; S_DECODE(w, it0, jt0);
                const bool two = (w < 2); if (two) S_DECODE(w + 8, it1, jt1);
                f32x4 sA = (f32x4){0.f, 0.f, 0.f, 0.f}, sB = sA, tA = sA, tB = sA;
                const bf16_t* k0p = Ks + (jt0 * 16 + fr) * QP + fq * 8; const bf16_t* q0p = Qs + (it0 * 16 + fr) * QP + fq * 8;
                const bf16_t* k1p = Ks + (jt1 * 16 + fr) * QP + fq * 8; const bf16_t* q1p = Qs + (it1 * 16 + fr) * QP + fq * 8;
#pragma unroll
                for (int ks = 0; ks < 8; ks += 2) {
                    sA = __builtin_amdgcn_mfma_f32_16x16x32_bf16(*(const bf16x8*)(k0p + ks * 32), *(const bf16x8*)(q0p + ks * 32), sA, 0, 0, 0);
                    sB = __builtin_amdgcn_mfma_f32_16x16x32_bf16(*(const bf16x8*)(k0p + ks * 32 + 32), *(const bf16x8*)(q0p + ks * 32 + 32), sB, 0, 0, 0);
                    if (two) {
                        tA = __builtin_amdgcn_mfma_f32_16x16x32_bf16(*(const bf16x8*)(k1p + ks * 32), *(const bf16x8*)(q1p + ks * 32), tA, 0, 0, 0);
                        tB = __builtin_amdgcn_mfma_f32_16x16x32_bf16(*(const bf16x8*)(k1p + ks * 32 + 32), *(const bf16x8*)(q1p + ks * 32 + 32), tB, 0, 0, 0);
                    }
                }
                const f32x4 s0 = sA + sB; S_EPI(w, s0);
                if (two) { const f32x4 s1 = tA + tB; S_EPI(w + 8, s1); }
#undef S_DECODE
#undef S_EPI
            }
            __syncthreads();
        }
    }
}

__device__ __forceinline__ void p6_mlstm(const Args& a, unsigned char* lds) {
    using namespace ml;
    unsigned char* ws = a.ws;
    const int tid = opaque_tid(), lane = tid & 63, w = __builtin_amdgcn_readfirstlane(tid >> 6), fr = lane & 15, fq = lane >> 4;
    bf16_t* Qs = (bf16_t*)(lds + O_QS); bf16_t* Ks = (bf16_t*)(lds + O_KS); bf16_t* Ss = (bf16_t*)(lds + O_SS);
    bf16_t* Vt = (bf16_t*)(lds + O_VT); bf16_t* Vw = (bf16_t*)(lds + O_VW); bf16_t* Cs = (bf16_t*)(lds + O_CS);
    float* Osm = (float*)(lds + O_OSM); float* TAB = (float*)(lds + O_TAB); float* WTS = (float*)(lds + O_WTS);
    const bf16_t* XC = (const bf16_t*)(ws + WS_XC); const bf16_t* XM = (const bf16_t*)(ws + WS_XM); const float* GATES = (const float*)(ws + WS_GATES);
    bf16_t* HM = (bf16_t*)a.out + (size_t)T * D;
    for (int unit = blockIdx.x; unit < 256; unit += gridDim.x) {
        const int xcd = unit & 7, idx = unit >> 3, bh = xcd * 2 + (idx >> 4), vs = idx & 15, b = bh >> 2, h = bh & 3;
        __syncthreads();
        for (int e = tid; e < 64 * SP / 2; e += 512) ((unsigned*)Ss)[e] = 0u;
        for (int e = tid; e < 32 * SP / 2; e += 512) { const int row = e / (SP / 2); ((unsigned*)Vt)[e] = (row == 16) ? 0x3F803F80u : 0u; ((unsigned*)Vw)[e] = 0u; }
        for (int e = tid; e < 32 * QP / 2; e += 512) ((unsigned*)Cs)[e] = 0u;
        for (int e = tid; e < 1024; e += 512) { const int g = e >> 4, bb = (e >> 2) & 3, aa = e & 3; const float* wq = a.in[I_WQ] + (h * 64 + g) * 16; const float* wk = a.in[I_WK] + (h * 64 + g) * 16;
            float v = 0.f; for (int o = 0; o < 4; ++o) v += wq[bb * 4 + o] * wk[aa * 4 + o]; WTS[e] = v * 0.0625f; }
        for (int e = tid; e < 1024; e += 512) WTS[2048 + e] = a.in[I_WV][h * 1024 + e];
        f32x4 Cacc[2][2];
#pragma unroll
        for (int i = 0; i < 2; ++i)
#pragma unroll
            for (int j = 0; j < 2; ++j) Cacc[i][j] = (f32x4){0.f, 0.f, 0.f, 0.f};
        const int srow = tid >> 5, scol = (tid & 31) * 8;
        const int vrow = tid >> 1, vhalf = tid & 1;
        const size_t tbase = (size_t)b * SEQ;
        u32x4 xr[4], xmr = (u32x4){0u, 0u, 0u, 0u}; float gi, gf;
        u32x2 sr0 = (u32x2){0u, 0u}, sr1 = (u32x2){0u, 0u};
        {
            const size_t t0 = tbase;
#pragma unroll
            for (int i = 0; i < 4; ++i) xr[i] = *(const u32x4*)(XC + (t0 + srow + 16 * i) * D + h * 256 + scol);
            if (tid < 128) xmr = *(const u32x4*)(XM + (t0 + vrow) * D + h * 256 + vs * 16 + vhalf * 8);
            gi = GATES[(t0 + lane) * 8 + h]; gf = GATES[(t0 + lane) * 8 + 4 + h];
            const unsigned char* sp = sraw_ptr(ws, bh * 128);
            sr0 = *(const u32x2*)(sp + tid * 8); if (tid < 128) sr1 = *(const u32x2*)(sp + 4096 + tid * 8);
        }
        __syncthreads();
        float decay = 0.f, m_cur = -1e30f;
        constexpr int NC = SEQ / 64;
        for (int c = -1; c < NC; ++c) {
            float* tab = TAB + (c & 1) * 320;
            if (c >= 0) {
            __syncthreads();
            {
                const int rt = w & 3, vt = w >> 2;
                f32x4 a1 = (f32x4){0.f, 0.f, 0.f, 0.f}, a2 = (f32x4){0.f, 0.f, 0.f, 0.f};
#pragma unroll
                for (int ks = 0; ks < 2; ++ks) {
                    const bf16x8 sa_ = *(const bf16x8*)(Ss + (rt * 16 + fr) * SP + ks * 32 + fq * 8);
                    const bf16x8 vb = *(const bf16x8*)(Vt + (vt * 16 + fr) * SP + ks * 32 + fq * 8);
                    a1 = __builtin_amdgcn_mfma_f32_16x16x32_bf16(sa_, vb, a1, 0, 0, 0);
                }
#pragma unroll
                for (int ks = 0; ks < 8; ++ks) {
                    const bf16x8 qa = *(const bf16x8*)(Qs + (rt * 16 + fr) * QP + ks * 32 + fq * 8);
                    const bf16x8 cb = *(const bf16x8*)(Cs + (vt * 16 + fr) * QP + ks * 32 + fq * 8);
                    a2 = __builtin_amdgcn_mfma_f32_16x16x32_bf16(qa, cb, a2, 0, 0, 0);
                }
#pragma unroll
                for (int e = 0; e < 4; ++e) { const int i = rt * 16 + fq * 4 + e; Osm[i * 33 + vt * 16 + fr] = a1[e] + tab[128 + i] * a2[e]; }
            }
            {
#pragma unroll
                for (int kl = 0; kl < 2; ++kl)
#pragma unroll
                    for (int vt = 0; vt < 2; ++vt) Cacc[kl][vt] = Cacc[kl][vt] * decay;
#pragma unroll
                for (int kl = 0; kl < 2; ++kl) {
                    const int kcol = (2 * w + kl) * 16 + fr;
#pragma unroll
                    for (int ks = 0; ks < 2; ++ks) {
                        bf16x8 ka;
#pragma unroll
                        for (int e = 0; e < 8; ++e) ka[e] = (short)Ks[(ks * 32 + fq * 8 + e) * QP + kcol];
#pragma unroll
                        for (int vt = 0; vt < 2; ++vt) {
                            const bf16x8 vb = *(const bf16x8*)(Vw + (vt * 16 + fr) * SP + ks * 32 + fq * 8);
                            Cacc[kl][vt] = __builtin_amdgcn_mfma_f32_16x16x32_bf16(ka, vb, Cacc[kl][vt], 0, 0, 0);
                        }
                    }
                }
            }
            }
            u32x4 qpk[4]; float vnx[8], decay_n = 0.f, m_nx = m_cur;
            if (c + 1 < NC) {
                const int lg0 = (tid & 31) * 2;
                f32x4 Wq[2][4];
#pragma unroll
                for (int g2 = 0; g2 < 2; ++g2)
#pragma unroll
                    for (int i = 0; i < 4; ++i) Wq[g2][i] = *(const f32x4*)(WTS + (lg0 + g2) * 16 + i * 4);
#pragma unroll
                for (int i = 0; i < 4; ++i) {
                    float x[8]; unpack8(xr[i], x);
                    float q[8];
#pragma unroll
                    for (int g2 = 0; g2 < 2; ++g2) {
                        const f32x4 qq = Wq[g2][0] * x[4 * g2] + Wq[g2][1] * x[4 * g2 + 1] + Wq[g2][2] * x[4 * g2 + 2] + Wq[g2][3] * x[4 * g2 + 3];
                        for (int j = 0; j < 4; ++j) q[4 * g2 + j] = qq[j];
                    }
                    qpk[i] = pack8(q);
                }
                if (tid < 128) {
                    float x[8]; unpack8(xmr, x);
                    const int lgv = vs * 4 + vhalf * 2;
#pragma unroll
                    for (int g2 = 0; g2 < 2; ++g2) {
                        const float* Wv = WTS + 2048 + (lgv + g2) * 16;
#pragma unroll
                        for (int o = 0; o < 4; ++o) vnx[4 * g2 + o] = Wv[0 * 4 + o] * x[4 * g2] + Wv[1 * 4 + o] * x[4 * g2 + 1] + Wv[2 * 4 + o] * x[4 * g2 + 2] + Wv[3 * 4 + o] * x[4 * g2 + 3];
                    }
                }
                float sa = gf, sc = gi;
#define SCAN_STEP(CTRL, RM) do { const float ao = dppf<CTRL, RM>(0.f, sa), co = dppf<CTRL, RM>(-INFINITY, sc); sc = fmaxf(co + sa, sc); sa = ao + sa; } while (0)
                SCAN_STEP(0x111, 0xf); SCAN_STEP(0x112, 0xf); SCAN_STEP(0x114, 0xf); SCAN_STEP(0x118, 0xf);
                SCAN_STEP(0x142, 0xa);
                SCAN_STEP(0x143, 0xc);
#undef SCAN_STEP
                const float Mi = fmaxf(m_cur + sa, sc);
                const float gtot = readlane_f(sa, 63); m_nx = readlane_f(Mi, 63);
                decay_n = __expf(gtot + m_cur - m_nx);
                if (w == 0) {
                    float* tn = TAB + ((c + 1) & 1) * 320;
                    tn[lane] = sa - Mi; tn[64 + lane] = gi - sa; tn[128 + lane] = __expf(sa + m_cur - Mi); tn[192 + lane] = __expf(-Mi); tn[256 + lane] = __expf(gtot - sa + gi - m_nx);
                }
            }
            if (c >= 0) {
            __syncthreads();
            {
#pragma unroll
                for (int kl = 0; kl < 2; ++kl)
#pragma unroll
                    for (int vt = 0; vt < 2; ++vt) {
                        u32x2 wv; wv.x = pk2(Cacc[kl][vt][0], Cacc[kl][vt][1]); wv.y = pk2(Cacc[kl][vt][2], Cacc[kl][vt][3]);
                        *(u32x2*)(Cs + (vt * 16 + fr) * QP + (2 * w + kl) * 16 + fq * 4) = wv;
                    }
                const int i = tid >> 3, vp = (tid & 7) * 2;
                const float den = Osm[i * 33 + 16], dn = fmaxf(fabsf(den), tab[192 + i]);
                const float rdn = __builtin_amdgcn_rcpf(dn); const float h0 = Osm[i * 33 + vp] * rdn, h1 = Osm[i * 33 + vp + 1] * rdn;
                *(unsigned*)(HM + ((size_t)(bh * 16 + vs) * SEQ + (size_t)c * 64 + i) * 16 + vp) = pk2(h0, h1);
            }
            }
            if (c + 1 < NC) {
#pragma unroll
                for (int i = 0; i < 4; ++i) { const int r = srow + 16 * i; *(u32x4*)(Qs + r * QP + scol) = qpk[i]; *(u32x4*)(Ks + r * QP + scol) = xr[i]; }
                if (c < 0) __syncthreads();
                const float* tn = TAB + ((c + 1) & 1) * 320;
                if (tid < 128) {
                    const float wk = tn[256 + vrow];
#pragma unroll
                    for (int e = 0; e < 8; ++e) { Vt[(vhalf * 8 + e) * SP + vrow] = (bf16_t)(pk2(vnx[e], 0.f) & 0xffffu); Vw[(vhalf * 8 + e) * SP + vrow] = (bf16_t)(pk2(vnx[e] * wk, 0.f) & 0xffffu); }
                } else if (tid < 192) { Vw[16 * SP + (tid - 128)] = (bf16_t)(pk2(tn[256 + tid - 128], 0.f) & 0xffffu); }
#define SS_ITEM(li, sr) do { int it_, jt_; if ((li) < 4) { it_ = 3; jt_ = (li); } else if ((li) < 7) { it_ = 2; jt_ = (li) - 4; } else if ((li) < 9) { it_ = 1; jt_ = (li) - 7; } else { it_ = 0; jt_ = 0; } \
        const int i_ = it_ * 16 + fr, j0_ = jt_ * 16 + fq * 4; const float rf_ = tn[i_]; const f32x4 cf_ = *(const f32x4*)(tn + 64 + j0_); \
        const float sv_[4] = {bflo((sr).x), bfhi((sr).x), bflo((sr).y), bfhi((sr).y)}; float o_[4]; \
        _Pragma("unroll") for (int e = 0; e < 4; ++e) o_[e] = (j0_ + e <= i_) ? sv_[e] * __expf(rf_ + cf_[e]) : 0.f; \
        u32x2 wv_; wv_.x = pk2(o_[0], o_[1]); wv_.y = pk2(o_[2], o_[3]); *(u32x2*)(Ss + i_ * SP + j0_) = wv_; } while (0)
                SS_ITEM(w, sr0);
                if (w < 2) SS_ITEM(w + 8, sr1);
#undef SS_ITEM
                decay = decay_n; m_cur = m_nx;
                if (c + 2 < NC) {
                    const size_t t2 = tbase + (size_t)(c + 2) * 64;
#pragma unroll
                    for (int i = 0; i < 4; ++i) xr[i] = *(const u32x4*)(XC + (t2 + srow + 16 * i) * D + h * 256 + scol);
                    if (tid < 128) xmr = *(const u32x4*)(XM + (t2 + vrow) * D + h * 256 + vs * 16 + vhalf * 8);
                    gi = GATES[(t2 + lane) * 8 + h]; gf = GATES[(t2 + lane) * 8 + 4 + h];
                    const unsigned char* sp = sraw_ptr(ws, bh * 128 + c + 2);
                    sr0 = *(const u32x2*)(sp + tid * 8); if (tid < 128) sr1 = *(const u32x2*)(sp + 4096 + tid * 8);
                }
            }
        }
    }
}

__device__ __forceinline__ void p7_mlstm_fin(const Args& a) {
    unsigned char* ws = a.ws; const int tid = opaque_tid(), lane = tid & 63, wave = tid >> 6;
    const int gw = blockIdx.x * 8 + wave, NGW = gridDim.x * 8;
    const bf16_t* HM = (const bf16_t*)a.out + (size_t)T * D; const bf16_t* XC = (const bf16_t*)(ws + WS_XC); bf16_t* ZM = (bf16_t*)(ws + WS_ZM);
    float lnw[16], skp[16];
#pragma unroll
    for (int j = 0; j < 4; ++j) { const f32x4 p = *(const f32x4*)(a.in[I_LNW] + lane * 16 + 4 * j), q = *(const f32x4*)(a.in[I_SKIP] + lane * 16 + 4 * j); for (int e = 0; e < 4; ++e) { lnw[4 * j + e] = p[e]; skp[4 * j + e] = q[e]; } }
    for (int m = gw; m < T; m += NGW) {
        const size_t off = (size_t)m * D + lane * 16;
        float hv[16], xc[16], z[16];
        { const size_t hoff = ((size_t)(((m / SEQ) * 4 + (lane >> 4)) * 16 + (lane & 15)) * SEQ + (size_t)(m % SEQ)) * 16;
          unpack8(*(const u32x4*)(HM + hoff), hv); unpack8(*(const u32x4*)(HM + hoff + 8), hv + 8); }
        unpack8(*(const u32x4*)(XC + off), xc); unpack8(*(const u32x4*)(XC + off + 8), xc + 8);
        unpack8(*(const u32x4*)(ZM + off), z); unpack8(*(const u32x4*)(ZM + off + 8), z + 8);
        float s = 0.f;
#pragma unroll
        for (int e = 0; e < 16; ++e) s += hv[e];
        s += __shfl_xor(s, 1); s += __shfl_xor(s, 2); s += __shfl_xor(s, 4); s += __shfl_xor(s, 8);
        const float mu = s * (1.0f / 256.0f); float q = 0.f;
#pragma unroll
        for (int e = 0; e < 16; ++e) { hv[e] -= mu; q += hv[e] * hv[e]; }
        q += __shfl_xor(q, 1); q += __shfl_xor(q, 2); q += __shfl_xor(q, 4); q += __shfl_xor(q, 8);
        const float rstd = rsqrtf(q * (1.0f / 256.0f) + EPS);
        float o[16], ss = 0.f;
#pragma unroll
        for (int e = 0; e < 16; ++e) { o[e] = (hv[e] * rstd * lnw[e] + skp[e] * xc[e]) * siluf_(z[e]); ss += o[e] * o[e]; }
        ss = wave_sum(ss);
        const float rs = rsqrtf(ss * (1.0f / 1024.0f) + EPS);
#pragma unroll
        for (int e = 0; e < 16; ++e) o[e] *= rs;
        *(u32x4*)(ZM + off) = pack8(o); *(u32x4*)(ZM + off + 8) = pack8(o + 8);
    }
}
__device__ __forceinline__ void p7_rg_fin(const Args& a, unsigned char* lds) {
    unsigned char* ws = a.ws; const int tid = opaque_tid();
    unsigned* LOGA = (unsigned*)(ws + WS_XR); const unsigned* U = (const unsigned*)(ws + WS_U); const unsigned* YR = (const unsigned*)(ws + WS_YR); const float* AGG = (const float*)(ws + WS_AGG);
    float* Ot = (float*)lds;
    constexpr int OP = 1028;
    for (int tile = blockIdx.x; tile < 256; tile += gridDim.x) {
        const int tc = tile & 63, tb = tile & ~63;
        float h0 = 0.f, h1 = 0.f;
        for (int p = 0; p < tc; ++p) { const f32x4 g = *(const f32x4*)(AGG + ((size_t)(tb + p) * 1024 + 2 * tid) * 2); h0 = __expf(g[0]) * h0 + g[1]; h1 = __expf(g[2]) * h1 + g[3]; }
        const size_t row0 = (size_t)tile * 128;
        for (int i0 = 0; i0 < 128; i0 += 16) {
            unsigned la[16], uu[16], yy[16];
#pragma unroll
            for (int i = 0; i < 16; ++i) { const size_t o = (row0 + i0 + i) * 512 + tid; la[i] = LOGA[o]; uu[i] = U[o]; yy[i] = YR[o]; }
            __syncthreads();
#pragma unroll
            for (int i = 0; i < 16; ++i) {
                h0 = __expf(bflo(la[i])) * h0 + bflo(uu[i]); h1 = __expf(bfhi(la[i])) * h1 + bfhi(uu[i]);
                Ot[i * OP + 2 * tid] = h0 * geluf_(bflo(yy[i])); Ot[i * OP + 2 * tid + 1] = h1 * geluf_(bfhi(yy[i]));
            }
            __syncthreads();
            {
                const int row = tid >> 5, sub = tid & 31;
                f32x4 v[4][2]; float ss = 0.f;
#pragma unroll
                for (int q = 0; q < 4; ++q)
#pragma unroll
                    for (int hh = 0; hh < 2; ++hh) { v[q][hh] = *(const f32x4*)(Ot + row * OP + q * 256 + sub * 8 + hh * 4); const f32x4 t = v[q][hh]; ss += (t[0] * t[0] + t[1] * t[1]) + (t[2] * t[2] + t[3] * t[3]); }
                ss += __shfl_xor(ss, 1); ss += __shfl_xor(ss, 2); ss += __shfl_xor(ss, 4); ss += __shfl_xor(ss, 8); ss += __shfl_xor(ss, 16);
                const float rs = rsqrtf(ss * (1.0f / 1024.0f) + EPS);
                bf16_t* orow = (bf16_t*)LOGA + (row0 + i0 + row) * D;
#pragma unroll
                for (int q = 0; q < 4; ++q) { const f32x4 p = v[q][0] * rs, r = v[q][1] * rs; u32x4 wv; wv.x = pk2(p[0], p[1]); wv.y = pk2(p[2], p[3]); wv.z = pk2(r[0], r[1]); wv.w = pk2(r[2], r[3]); *(u32x4*)(orow + q * 256 + sub * 8) = wv; }
            }
        }
        __syncthreads();
    }
}

__device__ __forceinline__ void p11_final(const Args& a) {
    const int tid = opaque_tid(), lane = tid & 63, wave = tid >> 6;
    const int gw = blockIdx.x * 8 + wave, NGW = gridDim.x * 8;
    const float* SS = (const float*)(a.ws + WS_SSD); const float* gn = a.in[I_NFIN]; const bf16_t* X3 = (const bf16_t*)(a.ws + WS_XB);
    f32x4 g[4];
#pragma unroll
    for (int j = 0; j < 4; ++j) g[j] = *((const f32x4*)gn + lane * 4 + j);
    for (int m = gw; m < T; m += NGW) {
        const float rs = pg8::row_scale(SS, m);
        const size_t off = (size_t)m * D + lane * 16;
        float x[16]; unpack8(*(const u32x4*)(X3 + off), x); unpack8(*(const u32x4*)(X3 + off + 8), x + 8);
        f32x4* o = (f32x4*)(a.out + off);
#pragma unroll
        for (int j = 0; j < 4; ++j) { f32x4 v = (f32x4){x[4 * j], x[4 * j + 1], x[4 * j + 2], x[4 * j + 3]}; o[j] = v * rs * g[j]; }
    }
}

#define XB_TMO      128
#define XB_XCNT(j)  (256  + 64 * (j))
#define XB_XSUB(j)  (1280 + 64 * (j))
#define XB_XGEN(j)  (2304 + 64 * (j))
#define XB_TOP      3328
#define XB_TOPGEN   3392
#define XCD_BAR_WORDS 3456
#define XB_SPIN_CAP (1u << 18)
__device__ __forceinline__ unsigned xb_ld(unsigned* p)              { return __hip_atomic_load(p, __ATOMIC_RELAXED, __HIP_MEMORY_SCOPE_AGENT); }
__device__ __forceinline__ unsigned xb_add(unsigned* p, unsigned v) { return __hip_atomic_fetch_add(p, v, __ATOMIC_RELAXED, __HIP_MEMORY_SCOPE_AGENT); }
__device__ __forceinline__ unsigned xb_xcc_id() { return (unsigned)__builtin_amdgcn_s_getreg((3 << 11) | 20) & 0xFu; }
#define XB_SPIN(cond, bar) do { unsigned _sp = 0; while (cond) { __builtin_amdgcn_s_sleep(1); \
    if ((++_sp & 255u) == 0u) { if (xb_ld(&(bar)[XB_TMO])) break; if (_sp > XB_SPIN_CAP) { atomicAdd(&(bar)[XB_TMO], 1u); break; } } } } while (0)
struct XcdBarrier { unsigned* bar; unsigned x; volatile LAS unsigned* st; };
__device__ __forceinline__ XcdBarrier xcd_barrier_post(unsigned* bar, volatile LAS unsigned* st) {
    XcdBarrier b; b.bar = bar; b.x = xb_xcc_id(); b.st = st;
    if (threadIdx.x == 0) (void)xb_add(&bar[XB_XCNT(b.x)], 1u);
    return b;
}
__device__ __forceinline__ void xcd_barrier_complete(unsigned* bar, unsigned x, unsigned& nloc, unsigned& nx) {
    const unsigned G = gridDim.x * gridDim.y * gridDim.z;
    unsigned sum, cnt, mine, sp = 0u;
    for (;;) {
        sum = 0u; cnt = 0u; mine = 0u;
#pragma unroll
        for (unsigned j = 0; j < 16; ++j) { const unsigned c = xb_ld(&bar[XB_XCNT(j)]); sum += c; cnt += (c > 0u) ? 1u : 0u; mine = (j == x) ? c : mine; }
        if (sum == G) break;
        __builtin_amdgcn_s_sleep(1);
        if ((++sp & 255u) == 0u) { if (xb_ld(&bar[XB_TMO])) break; if (sp > XB_SPIN_CAP) { atomicAdd(&bar[XB_TMO], 1u); break; } }
    }
    nloc = mine > 0u ? mine : 1u; nx = cnt > 0u ? cnt : 1u;
}
__device__ __forceinline__ void xcd_barrier(const XcdBarrier& b) {
    asm volatile("s_waitcnt vmcnt(0)" ::: "memory");
    __syncthreads();
    if (threadIdx.x == 0) {
        unsigned* bar = b.bar;
        __builtin_amdgcn_s_waitcnt(0);
        unsigned nloc = b.st[0], nx = b.st[1];
        if (nloc == 0u) { xcd_barrier_complete(bar, b.x, nloc, nx); b.st[0] = nloc; b.st[1] = nx; }
        const unsigned old = xb_add(&bar[XB_XSUB(b.x)], 1u);
        const unsigned gen = old / nloc;
        if (old + 1u == (gen + 1u) * nloc) {
            __builtin_amdgcn_fence(__ATOMIC_RELEASE, "agent");
            asm volatile("s_waitcnt vmcnt(0)" ::: "memory");
            const unsigned og = xb_add(&bar[XB_TOP], 1u);
            const unsigned tg = og / nx;
            if (og + 1u == (tg + 1u) * nx) xb_add(&bar[XB_TOPGEN], 1u);
            else XB_SPIN(xb_ld(&bar[XB_TOPGEN]) == tg, bar);
            __builtin_amdgcn_fence(__ATOMIC_ACQUIRE, "agent");
            xb_add(&bar[XB_XGEN(b.x)], 1u);
            asm volatile("s_waitcnt vmcnt(0)" ::: "memory");
        } else {
            XB_SPIN(xb_ld(&bar[XB_XGEN(b.x)]) == gen, bar);
            __builtin_amdgcn_fence(__ATOMIC_ACQUIRE, "agent");
            asm volatile("s_waitcnt vmcnt(0)" ::: "memory");
        }
    }
    __syncthreads();
}
#define GSYNC() xcd_barrier(xbar)
__global__ void __launch_bounds__(512, 2) mk_fwd(Args args) {
    extern __shared__ __attribute__((aligned(16))) unsigned char lds_raw[];
    cg::grid_group grid = cg::this_grid();
    LAS unsigned char* lds = (LAS unsigned char*)lds_raw;
    unsigned char* ws = args.ws;
    const int G = gridDim.x, bid = blockIdx.x;
    volatile LAS unsigned* xst = (volatile LAS unsigned*)(lds + (LDS_BYTES - 64));
    if (threadIdx.x == 0) { xst[0] = 0u; xst[1] = 0u; }
    __syncthreads();
    const XcdBarrier xbar = xcd_barrier_post((unsigned*)(ws + WS_BAR), xst);
    bf16_t* XB = (bf16_t*)(ws + WS_XB); bf16_t* ACT = (bf16_t*)(ws + WS_R1);
#ifndef NO_P0
    p0_prologue(args, lds_raw);
#endif
    GSYNC();
    if (gridDim.x == 0x7fffffffu) grid.sync();
#ifndef NO_P1
    { const pg8::Gemm gUp1{XB, (const bf16_t*)(ws + WS_WGU1), 1024, 1024, 1 << 30, 0, 0, 0}; pg8::StaticOrder S; S.init(T, 2 * FF, G, bid); pg8::EpiSwiGLU E{ACT, (const float*)(ws + WS_SSA)}; pg8::gemm_phase(lds, gUp1, S, E); }
#endif
    GSYNC();
#ifndef NO_P2
    { const pg8::Gemm gDn1{ACT, (const bf16_t*)(ws + WS_WD1), FF, FF, 1 << 30, 0, 0, 0}; pg8::StaticOrder S; S.init(T, D, G, bid); pg8::EpiResidB E{nullptr, XB  , XB  , nullptr, (float*)(ws + WS_SSB), 0.5f}; pg8::gemm_phase(lds, gDn1, S, E); }
#endif
    GSYNC();
#ifndef NO_P3
    { const pg8::Gemm gIn{XB, (const bf16_t*)(ws + WS_WIN), 1024, 1024, 1 << 30, 0, 0, 0}; pg8::StaticOrder S; S.init(T, 4096, G, bid); pg8::EpiProj E{(bf16_t*)(ws + WS_XM), (const float*)(ws + WS_SSB)}; pg8::gemm_phase(lds, gIn, S, E); }
#endif
    GSYNC();
#ifndef NO_P4
    p4_conv(args);
#endif
    GSYNC();
#ifndef NO_P5
    {
        const bf16_t* XCR = (const bf16_t*)args.out + (size_t)T * D;
        const pg8::Gemm gRg{XCR, (const bf16_t*)(ws + WS_WRG), 256, 1024, 1 << 30, 0, 1, 512};
        const pg8::Gemm gGt{(const bf16_t*)(ws + WS_XC), (const bf16_t*)(ws + WS_WG8), 2048, 1024, 16, (long)WS_XM - (long)WS_XC - 16 * 128, 0, 0};
        pg8::EpiGates Eg{(float*)(ws + WS_GATES), args.in[I_BGATES]};
        pg8::EpiRg Er{XCR, args.in[I_RBA], args.in[I_RBX], (const float*)(ws + WS_C8), (bf16_t*)(ws + WS_XR), (bf16_t*)(ws + WS_U)};
        if (G == 256) {
#ifndef NO_P5G
            if (bid < 128) { pg8::ListOrder S{bid, 1, 0}; pg8::gemm_phase(lds, gGt, S, Eg); }
#endif
#ifndef NO_P5R
            if (bid >= 128) { pg8::ListOrder S{(bid - 128) * 8, 8, 3}; pg8::gemm_phase(lds, gRg, S, Er); }
#endif
        } else {
#ifndef NO_P5G
            for (int u = bid; u < 128; u += G) { pg8::ListOrder S{u, 1, 0}; pg8::gemm_phase(lds, gGt, S, Eg); }
#endif
#ifndef NO_P5R
            for (int u = bid; u < 128; u += G) { pg8::ListOrder S{u * 8, 8, 3}; pg8::gemm_phase(lds, gRg, S, Er); }
#endif
        }
    }
#endif
    GSYNC();
#ifndef NO_P6A
    p6_rg_agg(args);
#endif
    p5b_sraw(args, lds_raw);
    GSYNC();
#ifndef NO_P6
    p6_mlstm(args, lds_raw);
#endif
    GSYNC();
#ifndef NO_P7A
    p7_mlstm_fin(args);
#endif
#ifndef NO_P7B
    p7_rg_fin(args, lds_raw);
#endif
    GSYNC();
#ifndef NO_P8
    { const pg8::Gemm gOut{(const bf16_t*)(ws + WS_ZM)  , (const bf16_t*)(ws + WS_WOUT), 2048, 1024, 16, (long)(64 * MiB) - 16 * 128, 0, 0}; pg8::StaticOrder S; S.init(T, D, G, bid); pg8::EpiResidB E{nullptr, XB, XB  , nullptr, (float*)(ws + WS_SSC), 1.0f}; pg8::gemm_phase(lds, gOut, S, E); }
#endif
    GSYNC();
#ifndef NO_P9
    { const pg8::Gemm gUp2{XB, (const bf16_t*)(ws + WS_WGU2), 1024, 1024, 1 << 30, 0, 0, 0}; pg8::StaticOrder S; S.init(T, 2 * FF, G, bid); pg8::EpiSwiGLU E{ACT, (const float*)(ws + WS_SSC)}; pg8::gemm_phase(lds, gUp2, S, E); }
#endif
    GSYNC();
#ifndef NO_P10
    { const pg8::Gemm gDn2{ACT, (const bf16_t*)(ws + WS_WD2), FF, FF, 1 << 30, 0, 0, 0}; pg8::StaticOrder S; S.init(T, D, G, bid); pg8::EpiResidB E{nullptr, XB, XB  , nullptr, (float*)(ws + WS_SSD), 0.5f}; pg8::gemm_phase(lds, gDn2, S, E); }
#endif
    GSYNC();
#ifndef NO_P11
    p11_final(args);
#endif
}

extern "C" void kernel_launch(void* const* d_in, const int* in_sizes, int n_in, void* d_out, int out_size, void* d_ws, size_t ws_size, hipStream_t stream) {
    static int grid = 0;
    if (grid == 0) {
        if (n_in != 31 || in_sizes[0] != T * D || out_size != T * D || ws_size < WS_END) { fprintf(stderr, "kernel_launch: unexpected shapes (n_in %d, in0 %d, out %d, ws %zu)\n", n_in, n_in > 0 ? in_sizes[0] : -1, out_size, ws_size); grid = -1; return; }
        int dev = 0, cus = 0, per_cu = 0;
        if (hipGetDevice(&dev) != hipSuccess || hipDeviceGetAttribute(&cus, hipDeviceAttributeMultiprocessorCount, dev) != hipSuccess) { grid = -1; return; }
        if (hipFuncSetAttribute((const void*)mk_fwd, hipFuncAttributeMaxDynamicSharedMemorySize, LDS_BYTES) != hipSuccess) { fprintf(stderr, "kernel_launch: hipFuncSetAttribute failed\n"); grid = -1; return; }
        if (hipOccupancyMaxActiveBlocksPerMultiprocessor(&per_cu, (const void*)mk_fwd, 512, LDS_BYTES) != hipSuccess || per_cu < 1) { fprintf(stderr, "kernel_launch: occupancy query says %d\n", per_cu); (void)hipGetLastError(); grid = -1; return; }
        grid = cus;
    }
    if (grid < 0) return;
    if (hipMemsetAsync((char*)d_ws + WS_BAR, 0, 16384, stream) != hipSuccess) { fprintf(stderr, "kernel_launch: memset of barrier words failed\n"); return; }
    Args a{};
    for (int i = 0; i < 31; ++i) a.in[i] = (const float*)d_in[i];
    a.out = (float*)d_out; a.ws = (unsigned char*)d_ws;
    void* kargs[] = {&a};
    hipError_t e = hipLaunchCooperativeKernel((const void*)mk_fwd, dim3(grid), dim3(512), kargs, LDS_BYTES, stream);
    if (e != hipSuccess) fprintf(stderr, "kernel_launch: cooperative launch failed: %s (grid %d)\n", hipGetErrorString(e), grid);
}
```

```cpp
#include <hip/hip_runtime.h>
#include <hip/hip_cooperative_groups.h>
#include <cstdio>
#include <cstdint>
namespace cg = cooperative_groups;

#define LAS __attribute__((address_space(3)))
typedef unsigned short bf16_t;
typedef short bf16x8 __attribute__((ext_vector_type(8)));
typedef float f32x4 __attribute__((ext_vector_type(4)));
typedef unsigned u32x4 __attribute__((ext_vector_type(4)));
typedef unsigned u32x2 __attribute__((ext_vector_type(2)));

constexpr int T = 32768, D = 1024, FF = 2816, SEQ = 8192, NB = 4;
constexpr float EPS = 1e-6f;
constexpr size_t MiB = 1u << 20;
constexpr size_t WS_SSA = 0, WS_SSB = 2 * MiB, WS_SSC = 4 * MiB, WS_SSD = 6 * MiB;
constexpr size_t WS_GATES = 8 * MiB;
constexpr size_t WS_AGG = 9 * MiB;
constexpr size_t WS_BAR = 14 * MiB;
constexpr size_t WS_C8 = 12 * MiB;
constexpr size_t WS_WG8 = 11 * MiB;
constexpr size_t WS_WGU1 = 16 * MiB;
constexpr size_t WS_WD1 = WS_WGU1 + 11 * MiB;
constexpr size_t WS_WIN = WS_WD1 + 11 * MiB / 2;
constexpr size_t WS_WRG = WS_WIN + 8 * MiB;
constexpr size_t WS_WOUT = WS_WRG + 1 * MiB;
constexpr size_t WS_WGU2 = WS_WOUT + 4 * MiB;
constexpr size_t WS_WD2 = WS_WGU2 + 11 * MiB;
constexpr size_t WS_XB = 64 * MiB;
constexpr size_t WS_R1 = 128 * MiB;
constexpr size_t WS_XM = WS_R1, WS_ZM = WS_R1 + 64 * MiB, WS_XR = WS_R1 + 128 * MiB, WS_YR = WS_R1 + 192 * MiB;
constexpr size_t WS_XC = 384 * MiB;
constexpr size_t WS_U = 448 * MiB;
constexpr size_t WS_END = 512 * MiB;
constexpr int LDS_BYTES = 147456;

typedef float f32x2_t __attribute__((ext_vector_type(2)));
typedef __bf16 bf16x2_t __attribute__((ext_vector_type(2)));
__device__ __forceinline__ unsigned pk2(float lo, float hi) { const f32x2_t v = {lo, hi}; const bf16x2_t b = __builtin_convertvector(v, bf16x2_t); return __builtin_bit_cast(unsigned, b); }
__device__ __forceinline__ float bflo(unsigned u) { return __uint_as_float(u << 16); }
__device__ __forceinline__ float bfhi(unsigned u) { return __uint_as_float(u & 0xffff0000u); }
__device__ __forceinline__ float bf1(bf16_t u) { return __uint_as_float(((unsigned)u) << 16); }
__device__ __forceinline__ void unpack8(const u32x4 v, float* x) { x[0] = bflo(v.x); x[1] = bfhi(v.x); x[2] = bflo(v.y); x[3] = bfhi(v.y); x[4] = bflo(v.z); x[5] = bfhi(v.z); x[6] = bflo(v.w); x[7] = bfhi(v.w); }
__device__ __forceinline__ u32x4 pack8(const float* x) { u32x4 o; o.x = pk2(x[0], x[1]); o.y = pk2(x[2], x[3]); o.z = pk2(x[4], x[5]); o.w = pk2(x[6], x[7]); return o; }
__device__ __forceinline__ float sigmoidf_(float x) { return __builtin_amdgcn_rcpf(1.0f + __expf(-x)); }
__device__ __forceinline__ float siluf_(float x) { return x * __builtin_amdgcn_rcpf(1.0f + __expf(-x)); }
__device__ __forceinline__ float logsigf_(float x) { return fminf(x, 0.f) - __logf(1.0f + __expf(-fabsf(x))); }
__device__ __forceinline__ float logsig_acc_(float x) { return fminf(x, 0.f) - log1pf(expf(-fabsf(x))); }
__device__ __forceinline__ float geluf_(float x) { const float u = 0.7978845608028654f * (x + 0.044715f * x * x * x); const float t = 1.0f - 2.0f * __builtin_amdgcn_rcpf(1.0f + __expf(2.0f * u)); return 0.5f * x * (1.0f + t); }
__device__ __forceinline__ int opaque_tid() { int t = threadIdx.x; asm volatile("" : "+v"(t)); return t; }
__device__ __forceinline__ float wave_sum(float v) {
#pragma unroll
    for (int o = 1; o < 64; o <<= 1) v += __shfl_xor(v, o);
    return v;
}

namespace pg8 {
constexpr int BM = 256, BK = 64, HALF = 128, HTB = HALF * BK * 2, STAGE_BYTES = 8 * HTB, NXCD = 8, WGM = 8;
__host__ __device__ __forceinline__ int lds_byte(int r, int c) { const int st = (r >> 4) * 2 + (c >> 5), rr = r & 15, cc = c & 31, ob = rr * 64 + cc * 2; return st * 1024 + (ob ^ (((ob >> 9) & 1) << 5)); }
__host__ __device__ __forceinline__ void stage_rc(int b, int& R, int& C) { const int st = b / 1024, sb = b % 1024, swz = sb ^ (((sb >> 9) & 1) << 5); R = (st >> 1) * 16 + swz / 64; C = (st & 1) * 32 + (swz % 64) / 2; }
__host__ __device__ __forceinline__ int perm32(int rho) { const int n = rho >> 4, i = rho & 15; return 8 * (i >> 2) + 4 * n + (i & 3); }

struct Unit { int pm, pn; };
struct Gemm { const bf16_t* A; const bf16_t* Bt; int K; int lda; int ksplit; long kdelta; int a_pn_shift; int a_pn_bytes; };

struct StaticOrder {
    int nM, nN, nwg, G, c;
    __device__ void init(int M, int N, int G_, int c_) { nM = M / BM; nN = N / BM; nwg = nM * nN; G = G_; c = c_; }
    __device__ bool next(int i, Unit& u) const {
        const long L = (long)i * G + c; if (L >= nwg) return false;
        int wgid = (int)L; { const int q = nwg / NXCD, r = nwg % NXCD, xcd = wgid % NXCD, off = wgid / NXCD; wgid = (xcd < r ? xcd * (q + 1) : r * (q + 1) + (xcd - r) * q) + off; }
        const int nig = WGM * nN, gid = wgid / nig, fm = gid * WGM, gsz = (nM - fm) < WGM ? (nM - fm) : WGM;
        u.pm = fm + ((wgid % nig) % gsz); u.pn = (wgid % nig) / gsz; return true;
    }
};
struct ListOrder {
    int first, cnt, nshift;
    __device__ bool next(int i, Unit& u) const { if (i >= cnt) return false; const int L = first + i; u.pm = L >> nshift; u.pn = L & ((1 << nshift) - 1); return true; }
};

__device__ __forceinline__ float row_scale(const float* SS, int r) {
    const f32x4* p = (const f32x4*)(SS + (size_t)r * 16);
    const f32x4 a = p[0], b = p[1], c = p[2], d = p[3];
    const float s = ((a[0] + a[1]) + (a[2] + a[3])) + ((b[0] + b[1]) + (b[2] + b[3])) + ((c[0] + c[1]) + (c[2] + c[3])) + ((d[0] + d[1]) + (d[2] + d[3]));
    return rsqrtf(s * (1.0f / 1024.0f) + EPS);
}

__device__ __forceinline__ void row_scales8(const float* SS, int row0, int fq, float (&rs)[8]) {
    f32x4 v[8];
#pragma unroll
    for (int q = 0; q < 8; ++q) v[q] = *(const f32x4*)(SS + (size_t)(row0 + (q >> 2) * HALF + (q & 3) * 16) * 16 + fq * 4);
#pragma unroll
    for (int q = 0; q < 8; ++q) { float s = (v[q][0] + v[q][1]) + (v[q][2] + v[q][3]); s += __shfl_xor(s, 16); s += __shfl_xor(s, 32); rs[q] = rsqrtf(s * (1.0f / 1024.0f) + EPS); }
}
struct EpiSwiGLU {
    bf16_t* O; const float* SS;
    __device__ __forceinline__ void operator()(const f32x4 (&acc)[2][2][4][2], const Unit& u, int wr, int wc, int fr, int fq) const {
        const int row0 = u.pm * BM + wr * 64 + fr, col0 = u.pn * HALF + wc * 32 + 8 * fq;
        float rs8[8]; row_scales8(SS, row0, fq, rs8);
#pragma unroll
        for (int ai = 0; ai < 2; ++ai)
#pragma unroll
            for (int m = 0; m < 4; ++m) {
                const int r = row0 + ai * HALF + m * 16; const float rs = rs8[ai * 4 + m];
                float o[8];
#pragma unroll
                for (int n = 0; n < 2; ++n)
#pragma unroll
                    for (int j = 0; j < 4; ++j) { const float g = acc[ai][0][m][n][j] * rs, up = acc[ai][1][m][n][j] * rs; o[n * 4 + j] = siluf_(g) * up; }
                *(u32x4*)(O + (size_t)r * FF + col0) = pack8(o);
            }
    }
};
struct EpiResid {
    const float* Xin; float* Xout; bf16_t* XBo; float* SSo; float alpha;
    __device__ __forceinline__ void operator()(const f32x4 (&acc)[2][2][4][2], const Unit& u, int wr, int wc, int fr, int fq) const {
        const int row0 = u.pm * BM + wr * 64 + fr, col0 = u.pn * BM + wc * 32 + 8 * fq;
#pragma unroll
        for (int ai = 0; ai < 2; ++ai)
#pragma unroll
            for (int m = 0; m < 4; ++m) {
                const int r = row0 + ai * HALF + m * 16; float ss = 0.f;
#pragma unroll
                for (int bj = 0; bj < 2; ++bj) {
                    const size_t off = (size_t)r * D + col0 + bj * HALF;
                    const f32x4 x0 = *(const f32x4*)(Xin + off), x1 = *(const f32x4*)(Xin + off + 4);
                    const f32x4 v0 = x0 + acc[ai][bj][m][0] * alpha, v1 = x1 + acc[ai][bj][m][1] * alpha;
                    *(f32x4*)(Xout + off) = v0; *(f32x4*)(Xout + off + 4) = v1;
                    ss += (v0[0] * v0[0] + v0[1] * v0[1]) + (v0[2] * v0[2] + v0[3] * v0[3]) + (v1[0] * v1[0] + v1[1] * v1[1]) + (v1[2] * v1[2] + v1[3] * v1[3]);
                    if (XBo) { u32x4 w; w.x = pk2(v0[0], v0[1]); w.y = pk2(v0[2], v0[3]); w.z = pk2(v1[0], v1[1]); w.w = pk2(v1[2], v1[3]); *(u32x4*)(XBo + off) = w; }
                }
                ss += __shfl_xor(ss, 16); ss += __shfl_xor(ss, 32);
                if (fq == 0) SSo[(size_t)r * 16 + u.pn * 4 + wc] = ss;
            }
    }
};
struct EpiResidB {
    const float* XinF; const bf16_t* XinB; bf16_t* O1; bf16_t* O2; float* SSo; float alpha;
    __device__ __forceinline__ void operator()(const f32x4 (&acc)[2][2][4][2], const Unit& u, int wr, int wc, int fr, int fq) const {
        const int row0 = u.pm * BM + wr * 64 + fr, col0 = u.pn * BM + wc * 32 + 8 * fq;
#pragma unroll
        for (int ai = 0; ai < 2; ++ai)
#pragma unroll
            for (int m = 0; m < 4; ++m) {
                const int r = row0 + ai * HALF + m * 16; float ss = 0.f;
#pragma unroll
                for (int bj = 0; bj < 2; ++bj) {
                    const size_t off = (size_t)r * D + col0 + bj * HALF;
                    f32x4 x0, x1;
                    if (XinF) { x0 = *(const f32x4*)(XinF + off); x1 = *(const f32x4*)(XinF + off + 4); }
                    else { const u32x4 xb = *(const u32x4*)(XinB + off); x0 = (f32x4){bflo(xb.x), bfhi(xb.x), bflo(xb.y), bfhi(xb.y)}; x1 = (f32x4){bflo(xb.z), bfhi(xb.z), bflo(xb.w), bfhi(xb.w)}; }
                    const f32x4 v0 = x0 + acc[ai][bj][m][0] * alpha, v1 = x1 + acc[ai][bj][m][1] * alpha;
                    ss += (v0[0] * v0[0] + v0[1] * v0[1]) + (v0[2] * v0[2] + v0[3] * v0[3]) + (v1[0] * v1[0] + v1[1] * v1[1]) + (v1[2] * v1[2] + v1[3] * v1[3]);
                    u32x4 w; w.x = pk2(v0[0], v0[1]); w.y = pk2(v0[2], v0[3]); w.z = pk2(v1[0], v1[1]); w.w = pk2(v1[2], v1[3]);
                    *(u32x4*)(O1 + off) = w; if (O2) *(u32x4*)(O2 + off) = w;
                }
                ss += __shfl_xor(ss, 16); ss += __shfl_xor(ss, 32);
                if (fq == 0) SSo[(size_t)r * 16 + u.pn * 4 + wc] = ss;
            }
    }
};
struct EpiProj {
    bf16_t* O; const float* SS;
    __device__ __forceinline__ void operator()(const f32x4 (&acc)[2][2][4][2], const Unit& u, int wr, int wc, int fr, int fq) const {
        bf16_t* base = O + (size_t)(u.pn >> 2) * ((size_t)T * D);
        const int row0 = u.pm * BM + wr * 64 + fr, col0 = (u.pn & 3) * BM + wc * 32 + 8 * fq;
        float rs8[8]; row_scales8(SS, row0, fq, rs8);
#pragma unroll
        for (int ai = 0; ai < 2; ++ai)
#pragma unroll
            for (int m = 0; m < 4; ++m) {
                const int r = row0 + ai * HALF + m * 16; const float rs = rs8[ai * 4 + m];
#pragma unroll
                for (int bj = 0; bj < 2; ++bj) {
                    const f32x4 v0 = acc[ai][bj][m][0] * rs, v1 = acc[ai][bj][m][1] * rs;
                    u32x4 w; w.x = pk2(v0[0], v0[1]); w.y = pk2(v0[2], v0[3]); w.z = pk2(v1[0], v1[1]); w.w = pk2(v1[2], v1[3]);
                    *(u32x4*)(base + (size_t)r * D + col0 + bj * HALF) = w;
                }
            }
    }
};
__device__ __forceinline__ float neg_expm1_(float x) {
    const float p = -x * (1.0f + x * (0.5f + x * (0.16666667f + x * (0.041666668f + x * 0.0083333338f))));
    const float e = 1.0f - __expf(x);
    return (x > -0.3f) ? p : e;
}
struct EpiRg {
    const bf16_t* XCR; const float* ba; const float* bx; const float* c8t; bf16_t* LOGA; bf16_t* U;
    __device__ __forceinline__ void operator()(const f32x4 (&acc)[2][2][4][2], const Unit& u, int wr, int wc, int fr, int fq) const {
        const int row0 = u.pm * BM + wr * 64 + fr, ch0 = (u.pn >> 1) * 256 + (u.pn & 1) * HALF + wc * 32 + 8 * fq;
#pragma unroll
        for (int n = 0; n < 2; ++n) {
            const int ch = ch0 + 4 * n;
            const f32x4 b_a = *(const f32x4*)(ba + ch), b_x = *(const f32x4*)(bx + ch), c8 = *(const f32x4*)(c8t + ch);
#pragma unroll
            for (int ai = 0; ai < 2; ++ai)
#pragma unroll
                for (int m = 0; m < 4; ++m) {
                    const int r = row0 + ai * HALF + m * 16;
                    const u32x2 xv = *(const u32x2*)(XCR + (size_t)r * D + ch);
                    const float xc[4] = {bflo(xv.x), bfhi(xv.x), bflo(xv.y), bfhi(xv.y)};
                    float la[4], uu[4];
#pragma unroll
                    for (int j = 0; j < 4; ++j) {
                        const float rg = sigmoidf_(acc[ai][0][m][n][j] + b_a[j]), ig = sigmoidf_(acc[ai][1][m][n][j] + b_x[j]);
                        la[j] = c8[j] * rg;
                        uu[j] = __builtin_amdgcn_sqrtf(fmaxf(neg_expm1_(2.0f * la[j]), 0.f)) * (ig * xc[j]);
                    }
                    u32x2 w0, w1; w0.x = pk2(la[0], la[1]); w0.y = pk2(la[2], la[3]); w1.x = pk2(uu[0], uu[1]); w1.y = pk2(uu[2], uu[3]);
                    *(u32x2*)(LOGA + (size_t)r * D + ch) = w0; *(u32x2*)(U + (size_t)r * D + ch) = w1;
                    __builtin_amdgcn_sched_barrier(0);
                }
        }
    }
};
struct EpiGates {
    float* G; const float* bg;
    __device__ __forceinline__ void operator()(const f32x4 (&acc)[2][2][4][2], const Unit& u, int wr, int wc, int fr, int fq) const {
        if (wc != 0 || fq != 0) return;
        const int row0 = u.pm * BM + wr * 64 + fr;
        const f32x4 b0 = *(const f32x4*)(bg), b1 = *(const f32x4*)(bg + 4);
#pragma unroll
        for (int ai = 0; ai < 2; ++ai)
#pragma unroll
            for (int m = 0; m < 4; ++m) {
                const int r = row0 + ai * HALF + m * 16;
                f32x4 v0 = acc[ai][0][m][0] + b0, v1 = acc[ai][0][m][1] + b1;
                for (int j = 0; j < 4; ++j) v1[j] = logsigf_(v1[j]);
                *(f32x4*)(G + (size_t)r * 8) = v0; *(f32x4*)(G + (size_t)r * 8 + 4) = v1;
            }
    }
};

template <class Epi, class Sched>
__device__ __forceinline__ void gemm_phase(LAS unsigned char* lds, const Gemm g, const Sched& S, const Epi& E) {
    const int tid = opaque_tid(), wid = __builtin_amdgcn_readfirstlane(tid >> 6), lane = tid & 63, wr = wid >> 2, wc = wid & 3, fr = lane & 15, fq = lane >> 4;
    const int K = g.K, nt = K / BK, lda = g.lda;
    unsigned voffA[2], voffB[2];
#pragma unroll
    for (int i = 0; i < 2; ++i) { int R, C; stage_rc(tid * 16 + i * 8192, R, C); const int Rb = (R & ~31) + perm32(R & 31);
        voffA[i] = (unsigned)(R * lda + C) * 2u; voffB[i] = (unsigned)(Rb * K + C) * 2u; }
    const size_t kstep = (size_t)(BK * 2);
    const size_t hstepA = (size_t)HALF * lda * 2, tstepA = 2 * hstepA;
    const size_t hstepB = (size_t)HALF * K * 2, tstepB = 2 * hstepB;
    const unsigned ldsw = (unsigned)wid * 1024u;
    const int aoff = lds_byte(wr * 64 + fr, fq * 8), boff = lds_byte(wc * 32 + fr, fq * 8);
    const int ksplit = g.ksplit; const long kdelta = g.kdelta;
#define PG8_AK(t) ((long)(t) * (long)kstep + (((t) >= ksplit) ? kdelta : 0l))
#define PG8_SA(b, h) (((b) * 2 + (h)) * HTB)
#define PG8_SB(b, h) ((4 + (b) * 2 + (h)) * HTB)
#define PG8_STAGE(bufoff, gbase, voff) do { _Pragma("unroll") for (int _i = 0; _i < 2; ++_i) \
        __builtin_amdgcn_global_load_lds((const unsigned*)((const char*)(gbase) + (voff)[_i]), (LAS unsigned*)(lds + (bufoff) + ldsw + _i * 8192), 16, 0, 0); } while (0)
#define PG8_LDA(dst, b, h) do { _Pragma("unroll") for (int m = 0; m < 4; ++m) _Pragma("unroll") for (int k = 0; k < 2; ++k) dst[m][k] = *(const LAS bf16x8*)(lds + PG8_SA(b, h) + aoff + m * 2048 + k * 1024); } while (0)
#define PG8_LDB(dst, b, h) do { _Pragma("unroll") for (int n = 0; n < 2; ++n) _Pragma("unroll") for (int k = 0; k < 2; ++k) dst[n][k] = *(const LAS bf16x8*)(lds + PG8_SB(b, h) + boff + n * 2048 + k * 1024); } while (0)
#define PG8_MMA(ai, bj, At, Bt) do { __builtin_amdgcn_s_setprio(1); _Pragma("unroll") for (int m = 0; m < 4; ++m) _Pragma("unroll") for (int n = 0; n < 2; ++n) _Pragma("unroll") for (int k = 0; k < 2; ++k) \
        acc[ai][bj][m][n] = __builtin_amdgcn_mfma_f32_16x16x32_bf16(Bt[n][k], At[m][k], acc[ai][bj][m][n], 0, 0, 0); __builtin_amdgcn_s_setprio(0); } while (0)
#define PG8_WAIT_V(n) asm volatile("s_waitcnt vmcnt(" #n ")" ::: "memory")
#define PG8_WAIT_L(n) asm volatile("s_waitcnt lgkmcnt(" #n ")" ::: "memory")
#define PG8_BAR __builtin_amdgcn_s_barrier()
#define PG8_SCHED __builtin_amdgcn_sched_barrier(0)
    Unit cur, nxt; int ui = 0;
    if (!S.next(0, cur)) return;
    f32x4 acc[2][2][4][2];
#pragma unroll
    for (int a = 0; a < 2; ++a)
#pragma unroll
        for (int b = 0; b < 2; ++b)
#pragma unroll
            for (int m = 0; m < 4; ++m)
#pragma unroll
                for (int n = 0; n < 2; ++n) acc[a][b][m][n] = (f32x4){0.f, 0.f, 0.f, 0.f};
    bf16x8 At[4][2], B0[2][2], B1[2][2];
    const char* cA = (const char*)g.A + (size_t)cur.pm * tstepA + (size_t)(cur.pn >> g.a_pn_shift) * g.a_pn_bytes;
    const char* cB = (const char*)g.Bt + (size_t)cur.pn * tstepB;
    {
        PG8_STAGE(PG8_SB(0, 0), cB, voffB); PG8_STAGE(PG8_SB(0, 1), cB + hstepB, voffB); PG8_STAGE(PG8_SA(0, 0), cA, voffA); PG8_STAGE(PG8_SA(0, 1), cA + hstepA, voffA);
        if (wr == 1) PG8_BAR;
        PG8_WAIT_V(2); PG8_BAR;
        PG8_STAGE(PG8_SB(1, 0), cB + kstep, voffB); PG8_STAGE(PG8_SA(1, 0), cA + PG8_AK(1), voffA); PG8_STAGE(PG8_SB(1, 1), cB + hstepB + kstep, voffB);
        PG8_WAIT_V(6); PG8_BAR;
    }
    for (;;) {
        const bool has_next = S.next(ui + 1, nxt);
        const char* nA = has_next ? (const char*)g.A + (size_t)nxt.pm * tstepA + (size_t)(nxt.pn >> g.a_pn_shift) * g.a_pn_bytes : cA;
        const char* nB = has_next ? (const char*)g.Bt + (size_t)nxt.pn * tstepB : cB;
#pragma nounroll
        for (int t = 0; t < nt; t += 2) {
            const bool last = (t == nt - 2);
            const char* a1 = cA + PG8_AK(t + 1);
            const char* a2 = last ? nA : cA + PG8_AK(t + 2); const char* b2 = last ? nB : cB + (size_t)(t + 2) * kstep;
            const char* a3 = last ? nA + PG8_AK(1) : cA + PG8_AK(t + 3); const char* b3 = b2 + kstep;
            PG8_LDB(B0, 0, 0); PG8_LDB(B1, 0, 1); PG8_SCHED; PG8_LDA(At, 0, 0); PG8_STAGE(PG8_SA(1, 1), a1 + hstepA, voffA);
            PG8_WAIT_V(8); PG8_WAIT_L(0); PG8_BAR; PG8_MMA(0, 0, At, B0); PG8_MMA(0, 1, At, B1); PG8_BAR; PG8_SCHED;
            PG8_LDA(At, 0, 1); PG8_STAGE(PG8_SB(0, 0), b2, voffB); PG8_STAGE(PG8_SB(0, 1), b2 + hstepB, voffB); PG8_STAGE(PG8_SA(0, 0), a2, voffA);
            PG8_WAIT_V(8); PG8_WAIT_L(0); PG8_BAR; PG8_MMA(1, 0, At, B0); PG8_MMA(1, 1, At, B1); PG8_BAR; PG8_SCHED;
            PG8_LDB(B0, 1, 0); PG8_LDB(B1, 1, 1); PG8_SCHED; PG8_LDA(At, 1, 0); PG8_STAGE(PG8_SA(0, 1), a2 + hstepA, voffA);
            PG8_WAIT_V(8); PG8_WAIT_L(0); PG8_BAR; PG8_MMA(0, 0, At, B0); PG8_MMA(0, 1, At, B1); PG8_BAR; PG8_SCHED;
            PG8_LDA(At, 1, 1); PG8_STAGE(PG8_SB(1, 0), b3, voffB); PG8_STAGE(PG8_SB(1, 1), b3 + hstepB, voffB); PG8_STAGE(PG8_SA(1, 0), a3, voffA);
            PG8_WAIT_V(8); PG8_WAIT_L(0); PG8_BAR; PG8_MMA(1, 0, At, B0); PG8_MMA(1, 1, At, B1); PG8_BAR; PG8_SCHED;
        }
        if (wr == 0) PG8_BAR;
        E(acc, cur, wr, wc, fr, fq);
        if (!has_next) break;
#pragma unroll
        for (int a = 0; a < 2; ++a)
#pragma unroll
            for (int b = 0; b < 2; ++b)
#pragma unroll
                for (int m = 0; m < 4; ++m)
#pragma unroll
                    for (int n = 0; n < 2; ++n) acc[a][b][m][n] = (f32x4){0.f, 0.f, 0.f, 0.f};
        cur = nxt; cA = nA; cB = nB; ++ui;
        if (wr == 1) PG8_BAR;
    }
    PG8_WAIT_V(0);
    PG8_BAR;
#undef PG8_AK
#undef PG8_SA
#undef PG8_SB
#undef PG8_STAGE
#undef PG8_LDA
#undef PG8_LDB
#undef PG8_MMA
#undef PG8_WAIT_V
#undef PG8_WAIT_L
#undef PG8_BAR
#undef PG8_SCHED
}
}

struct Args { const float* in[31]; float* out; unsigned char* ws; };
enum { I_X = 0, I_NF1, I_WG1, I_WU1, I_WD1, I_NMIX, I_WIN, I_MCW, I_MCB, I_WQ, I_WK, I_WV, I_WGATES, I_BGATES, I_LNW, I_SKIP, I_RCW, I_RCB, I_RWA, I_RBA, I_RWX, I_RBX, I_LAM,
       I_ONM, I_ONR, I_WOUT, I_NF2, I_WG2, I_WU2, I_WD2, I_NFIN };

template <class F> __device__ __forceinline__ void tr_item(F src, int K, bf16_t* WT, float* scr, int item, int nblk, int lane) {
    const int kb = item / nblk, nb = item % nblk, k0 = 64 * kb, n0 = 32 * nb;
#pragma unroll 8
    for (int i = 0; i < 32; ++i) { const int kk = 2 * i + (lane >> 5); scr[kk * 33 + (lane & 31)] = src(k0 + kk, n0 + (lane & 31)); }
    __builtin_amdgcn_wave_barrier();
    const int c = lane & 7;
#pragma unroll
    for (int j = 0; j < 4; ++j) { const int n = (lane >> 3) + 8 * j; const float* s = scr + (8 * c) * 33 + n;
        u32x4 o; o.x = pk2(s[0 * 33], s[1 * 33]); o.y = pk2(s[2 * 33], s[3 * 33]); o.z = pk2(s[4 * 33], s[5 * 33]); o.w = pk2(s[6 * 33], s[7 * 33]);
        *(u32x4*)(WT + (size_t)(n0 + n) * K + k0 + 8 * c) = o; }
    __builtin_amdgcn_wave_barrier();
}

__device__ __forceinline__ void p0_prologue(const Args& a, unsigned char* lds) {
    const int tid = opaque_tid(), lane = tid & 63, wave = tid >> 6;
    const int gw = blockIdx.x * 8 + wave, NGW = gridDim.x * 8;
    float* scr = (float*)(lds + wave * 16384);
    unsigned char* ws = a.ws;
    constexpr int I1 = 16 * 176, I2 = 44 * 32, I3 = 16 * 128, I4 = 4 * 64, I5 = 32 * 32;
    constexpr int NIT = I1 + I2 + I3 + I4 + I5 + I1 + I2;
    for (int it = gw; it < NIT; it += NGW) {
        int r = it;
        if (r < I1) { const float* wg = a.in[I_WG1]; const float* wu = a.in[I_WU1]; const float* gn = a.in[I_NF1];
            tr_item([=](int k, int n) { const int c = (n >> 8) * 128 + (n & 127); return (((n >> 7) & 1) ? wu : wg)[(size_t)k * FF + c] * gn[k]; }, 1024, (bf16_t*)(ws + WS_WGU1), scr, r, 176, lane); continue; } r -= I1;
        if (r < I2) { const float* wd = a.in[I_WD1];
            tr_item([=](int k, int n) { return wd[(size_t)k * D + n]; }, FF, (bf16_t*)(ws + WS_WD1), scr, r, 32, lane); continue; } r -= I2;
        if (r < I3) { const float* w = a.in[I_WIN]; const float* gn = a.in[I_NMIX];
            tr_item([=](int k, int n) { return w[(size_t)k * 4096 + n] * gn[k]; }, 1024, (bf16_t*)(ws + WS_WIN), scr, r, 128, lane); continue; } r -= I3;
        if (r < I4) { const float* wa = a.in[I_RWA]; const float* wx = a.in[I_RWX];
            tr_item([=](int k, int n) { const int pn = n >> 8, blk = pn >> 1, hh = pn & 1, sel = (n >> 7) & 1, c = hh * 128 + (n & 127); return (sel ? wx : wa)[(size_t)blk * 65536 + (size_t)k * 256 + c]; }, 256, (bf16_t*)(ws + WS_WRG), scr, r, 64, lane); continue; } r -= I4;
        if (r < I5) { const float* w = a.in[I_WOUT]; const float* gm = a.in[I_ONM]; const float* gr = a.in[I_ONR];
            tr_item([=](int k, int n) { return w[(size_t)k * D + n] * (k < 1024 ? gm[k] : gr[k - 1024]); }, 2048, (bf16_t*)(ws + WS_WOUT), scr, r, 32, lane); continue; } r -= I5;
        if (r < I1) { const float* wg = a.in[I_WG2]; const float* wu = a.in[I_WU2]; const float* gn = a.in[I_NF2];
            tr_item([=](int k, int n) { const int c = (n >> 8) * 128 + (n & 127); return (((n >> 7) & 1) ? wu : wg)[(size_t)k * FF + c] * gn[k]; }, 1024, (bf16_t*)(ws + WS_WGU2), scr, r, 176, lane); continue; } r -= I1;
        { const float* wd = a.in[I_WD2];
            tr_item([=](int k, int n) { return wd[(size_t)k * D + n]; }, FF, (bf16_t*)(ws + WS_WD2), scr, r, 32, lane); }
    }
    {
        bf16_t* WG8 = (bf16_t*)(ws + WS_WG8);
        const float* wq = a.in[I_WQ]; const float* wk = a.in[I_WK]; const float* wv = a.in[I_WV]; const float* Wg = a.in[I_WGATES];
        const int gt = blockIdx.x * 512 + tid, NT = gridDim.x * 512;
        for (int e = gt; e < 256 * 2048 / 8; e += NT) {
            const int g = e / 256, k0 = (e % 256) * 8;
            float o[8];
#pragma unroll
            for (int j = 0; j < 8; ++j) {
                float v = 0.f;
                if (g < 8) { const int k = k0 + j, c = k & 1023, n = c >> 2, i = c & 3;
                    if (k < 1024) { for (int oo = 0; oo < 4; ++oo) v += wq[n * 16 + i * 4 + oo] * Wg[(size_t)(4 * n + oo) * 8 + g] + wk[n * 16 + i * 4 + oo] * Wg[(size_t)(1024 + 4 * n + oo) * 8 + g]; }
                    else { for (int oo = 0; oo < 4; ++oo) v += wv[n * 16 + i * 4 + oo] * Wg[(size_t)(2048 + 4 * n + oo) * 8 + g]; } }
                o[j] = v;
            }
            *(u32x4*)(WG8 + (size_t)g * 2048 + k0) = pack8(o);
        }
    }
    if (blockIdx.x == 0) { float* C8 = (float*)(ws + WS_C8); const float* lam = a.in[I_LAM]; for (int e = tid; e < 1024; e += 512) C8[e] = 8.0f * logsig_acc_(lam[e]); }
    {
        const float* x = a.in[I_X]; bf16_t* XB = (bf16_t*)(ws + WS_XB); float* SS = (float*)(ws + WS_SSA);
        for (int m = gw; m < T; m += NGW) {
            const f32x4* xr = (const f32x4*)(x + (size_t)m * D) + lane;
            f32x4 v[4]; float s = 0.f;
#pragma unroll
            for (int j = 0; j < 4; ++j) { v[j] = xr[64 * j]; s += (v[j][0] * v[j][0] + v[j][1] * v[j][1]) + (v[j][2] * v[j][2] + v[j][3] * v[j][3]); }
            s = wave_sum(s);
            u32x2* o8 = (u32x2*)(XB + (size_t)m * D) + lane;
#pragma unroll
            for (int j = 0; j < 4; ++j) { u32x2 w; w.x = pk2(v[j][0], v[j][1]); w.y = pk2(v[j][2], v[j][3]); o8[64 * j] = w; }
            if (lane < 16) SS[(size_t)m * 16 + lane] = (lane == 0) ? s : 0.f;
        }
    }
}

template <bool SILU> __device__ __forceinline__ void conv_part(const bf16_t* in, bf16_t* out, const float* cw, const float* cb, int t0, int c0) {
    float w[4][8], b[8];
#pragma unroll
    for (int tap = 0; tap < 4; ++tap) { const f32x4 p = *(const f32x4*)(cw + tap * D + c0), q = *(const f32x4*)(cw + tap * D + c0 + 4); for (int j = 0; j < 4; ++j) { w[tap][j] = p[j]; w[tap][4 + j] = q[j]; } }
    { const f32x4 p = *(const f32x4*)(cb + c0), q = *(const f32x4*)(cb + c0 + 4); for (int j = 0; j < 4; ++j) { b[j] = p[j]; b[4 + j] = q[j]; } }
    float h0[8], h1[8], h2[8];
    const bool first = (t0 % SEQ) == 0;
    if (first) { for (int j = 0; j < 8; ++j) { h0[j] = 0.f; h1[j] = 0.f; h2[j] = 0.f; } }
    else {
        unpack8(*(const u32x4*)(in + (size_t)(t0 - 3) * D + c0), h0); unpack8(*(const u32x4*)(in + (size_t)(t0 - 2) * D + c0), h1); unpack8(*(const u32x4*)(in + (size_t)(t0 - 1) * D + c0), h2);
    }
    u32x4 cur[8];
#pragma unroll
    for (int i = 0; i < 8; ++i) cur[i] = *(const u32x4*)(in + (size_t)(t0 + i) * D + c0);
#pragma unroll
    for (int i = 0; i < 8; ++i) {
        float x[8], y[8]; unpack8(cur[i], x);
#pragma unroll
        for (int j = 0; j < 8; ++j) { float v = b[j] + w[0][j] * h0[j] + w[1][j] * h1[j] + w[2][j] * h2[j] + w[3][j] * x[j]; y[j] = SILU ? siluf_(v) : v; h0[j] = h1[j]; h1[j] = h2[j]; h2[j] = x[j]; }
        *(u32x4*)(out + (size_t)(t0 + i) * D + c0) = pack8(y);
    }
}
__device__ __forceinline__ void p4_conv(const Args& a) {
    unsigned char* ws = a.ws; const int tid = opaque_tid(), cgp = tid & 127, ts = tid >> 7;
    for (int u = blockIdx.x; u < T / 32; u += gridDim.x) {
        const int t0 = u * 32 + ts * 8, c0 = cgp * 8;
        conv_part<true>((const bf16_t*)(ws + WS_XM), (bf16_t*)(ws + WS_XC), a.in[I_MCW], a.in[I_MCB], t0, c0);
        conv_part<false>((const bf16_t*)(ws + WS_XR), (bf16_t*)a.out + (size_t)T * D  , a.in[I_RCW], a.in[I_RCB], t0, c0);
    }
}

__device__ __forceinline__ void p6_rg_agg(const Args& a) {
    unsigned char* ws = a.ws; const int tid = opaque_tid();
    const unsigned* LOGA = (const unsigned*)(ws + WS_XR); const unsigned* U = (const unsigned*)(ws + WS_U); float* AGG = (float*)(ws + WS_AGG);
    for (int tile = blockIdx.x; tile < 256; tile += gridDim.x) {
        const size_t row0 = (size_t)tile * 128;
        float sl0 = 0.f, sl1 = 0.f, h0 = 0.f, h1 = 0.f;
        for (int i0 = 0; i0 < 128; i0 += 16) {
            unsigned la[16], uu[16];
#pragma unroll
            for (int i = 0; i < 16; ++i) { la[i] = LOGA[(row0 + i0 + i) * 512 + tid]; uu[i] = U[(row0 + i0 + i) * 512 + tid]; }
#pragma unroll
            for (int i = 0; i < 16; ++i) { const float l0 = bflo(la[i]), l1 = bfhi(la[i]); sl0 += l0; sl1 += l1; h0 = __expf(l0) * h0 + bflo(uu[i]); h1 = __expf(l1) * h1 + bfhi(uu[i]); }
        }
        f32x4 o = {sl0, h0, sl1, h1};
        *(f32x4*)(AGG + ((size_t)tile * 1024 + 2 * tid) * 2) = o;
    }
}

template <int CTRL, int RMASK> __device__ __forceinline__ float dppf(float old, float src) {
    return __builtin_bit_cast(float, __builtin_amdgcn_update_dpp(__builtin_bit_cast(int, old), __builtin_bit_cast(int, src), CTRL, RMASK, 0xf, false));
}
__device__ __forceinline__ float readlane_f(float v, int l) { return __builtin_bit_cast(float, __builtin_amdgcn_readlane(__builtin_bit_cast(int, v), l)); }

namespace ml {
constexpr int QP = 264, SP = 72;
constexpr int O_QS = 0, O_KS = 33792, O_SS = 67584, O_VT = 76800, O_VW = 81408, O_CS = 86016, O_OSM = 102912, O_TAB = 111360, O_WTS = 113920, O_END = 126208;
}
__device__ __forceinline__ unsigned char* sraw_ptr(unsigned char* ws, int u) {
    return u < 1600 ? ws + (size_t)u * 5120 : (u < 2000 ? ws + 62 * MiB + (size_t)(u - 1600) * 5120 : ws + 12 * MiB + 512 * 1024 + (size_t)(u - 2000) * 5120);
}
__device__ __forceinline__ void p5b_sraw(const Args& a, unsigned char* lds) {
    using namespace ml;
    unsigned char* ws = a.ws;
    const int tid = opaque_tid(), lane = tid & 63, w = __builtin_amdgcn_readfirstlane(tid >> 6), fr = lane & 15, fq = lane >> 4;
    bf16_t* Qs = (bf16_t*)(lds + O_QS); bf16_t* Ks = (bf16_t*)(lds + O_KS); float* WTS = (float*)(lds + O_WTS);
    const bf16_t* XC = (const bf16_t*)(ws + WS_XC); bf16_t* QG = (bf16_t*)a.out;
    const int srow = tid >> 5, scol = (tid & 31) * 8;
    for (int g = blockIdx.x; g < 256; g += gridDim.x) {
        const int bh = g >> 4, c0 = (g & 15) * 8, b = bh >> 2, h = bh & 3;
        __syncthreads();
        for (int e = tid; e < 1024; e += 512) { const int gg = e >> 4, bb = (e >> 2) & 3, aa = e & 3; const float* wq = a.in[I_WQ] + (h * 64 + gg) * 16; const float* wk = a.in[I_WK] + (h * 64 + gg) * 16;
            float v = 0.f; for (int o = 0; o < 4; ++o) v += wq[bb * 4 + o] * wk[aa * 4 + o]; WTS[e] = v * 0.0625f; }
        __syncthreads();
        const int lg0 = (tid & 31) * 2;
        f32x4 Wq[2][4];
#pragma unroll
        for (int g2 = 0; g2 < 2; ++g2)
#pragma unroll
            for (int i = 0; i < 4; ++i) Wq[g2][i] = *(const f32x4*)(WTS + (lg0 + g2) * 16 + i * 4);
        for (int cc = 0; cc < 8; ++cc) {
            const int c = c0 + cc; const size_t t0 = (size_t)b * SEQ + (size_t)c * 64;
            u32x4 xr[4];
#pragma unroll
            for (int i = 0; i < 4; ++i) xr[i] = *(const u32x4*)(XC + (t0 + srow + 16 * i) * D + h * 256 + scol);
#pragma unroll
            for (int i = 0; i < 4; ++i) {
                float x[8]; unpack8(xr[i], x);
                float q[8];
#pragma unroll
                for (int g2 = 0; g2 < 2; ++g2) {
                    const f32x4 qq = Wq[g2][0] * x[4 * g2] + Wq[g2][1] * x[4 * g2 + 1] + Wq[g2][2] * x[4 * g2 + 2] + Wq[g2][3] * x[4 * g2 + 3];
                    for (int j = 0; j < 4; ++j) q[4 * g2 + j] = qq[j];
                }
                const int r = srow + 16 * i; const u32x4 qp = pack8(q);
                *(u32x4*)(Qs + r * QP + scol) = qp; *(u32x4*)(Ks + r * QP + scol) = xr[i];
                *(u32x4*)(QG + (t0 + r) * D + h * 256 + scol) = qp;
            }
            __syncthreads();
            {
                unsigned char* sp = sraw_ptr(ws, bh * 128 + c);
#define S_DECODE(li, it, jt) do { if ((li) < 4) { it = 3; jt = (li); } else if ((li) < 7) { it = 2; jt = (li) - 4; } else if ((li) < 9) { it = 1; jt = (li) - 7; } else { it = 0; jt = 0; } } while (0)
#define S_EPI(li, sv) do { u32x2 wv_; wv_.x = pk2(sv[0], sv[1]); wv_.y = pk2(sv[2], sv[3]); *(u32x2*)(sp + (li) * 512 + lane * 8) = wv_; } while (0)
                int it0, jt0, it1 = 0, jt1 = 0; S_DECODE(w, it0, jt0);
                const bool two = (w < 2); if (two) S_DECODE(w + 8, it1, jt1);
                f32x4 sA = (f32x4){0.f, 0.f, 0.f, 0.f}, sB = sA, tA = sA, tB = sA;
                const bf16_t* k0p = Ks + (jt0 * 16 + fr) * QP + fq * 8; const bf16_t* q0p = Qs + (it0 * 16 + fr) * QP + fq * 8;
                const bf16_t* k1p = Ks + (jt1 * 16 + fr) * QP + fq * 8; const bf16_t* q1p = Qs + (it1 * 16 + fr) * QP + fq * 8;
#pragma unroll
                for (int ks = 0; ks < 8; ks += 2) {
                    sA = __builtin_amdgcn_mfma_f32_16x16x32_bf16(*(const bf16x8*)(k0p + ks * 32), *(const bf16x8*)(q0p + ks * 32), sA, 0, 0, 0);
                    sB = __builtin_amdgcn_mfma_f32_16x16x32_bf16(*(const bf16x8*)(k0p + ks * 32 + 32), *(const bf16x8*)(q0p + ks * 32 + 32), sB, 0, 0, 0);
                    if (two) {
                        tA = __builtin_amdgcn_mfma_f32_16x16x32_bf16(*(const bf16x8*)(k1p + ks * 32), *(const bf16x8*)(q1p + ks * 32), tA, 0, 0, 0);
                        tB = __builtin_amdgcn_mfma_f32_16x16x32_bf16(*(const bf16x8*)(k1p + ks * 32 + 32), *(const bf16x8*)(q1p + ks * 32 + 32), tB, 0, 0, 0);
                    }
                }
                const f32x4 s0 = sA + sB; S_EPI(w, s0);
                if (two) { const f32x4 s1 = tA + tB; S_EPI(w + 8, s1); }
#undef S_DECODE
#undef S_EPI
            }
            __syncthreads();
        }
    }
}

__device__ __forceinline__ void p6_mlstm(const Args& a, unsigned char* lds) {
    using namespace ml;
    unsigned char* ws = a.ws;
    const int tid = opaque_tid(), lane = tid & 63, w = __builtin_amdgcn_readfirstlane(tid >> 6), fr = lane & 15, fq = lane >> 4;
    bf16_t* Qs = (bf16_t*)(lds + O_QS); bf16_t* Ks = (bf16_t*)(lds + O_KS); bf16_t* Ss = (bf16_t*)(lds + O_SS);
    bf16_t* Vt = (bf16_t*)(lds + O_VT); bf16_t* Vw = (bf16_t*)(lds + O_VW); bf16_t* Cs = (bf16_t*)(lds + O_CS);
    float* Osm = (float*)(lds + O_OSM); float* TAB = (float*)(lds + O_TAB); float* WTS = (float*)(lds + O_WTS);
    const bf16_t* XC = (const bf16_t*)(ws + WS_XC); const bf16_t* XM = (const bf16_t*)(ws + WS_XM); const float* GATES = (const float*)(ws + WS_GATES);
    const bf16_t* QG = (const bf16_t*)a.out;
    bf16_t* HM = (bf16_t*)a.out + (size_t)T * D;
    for (int unit = blockIdx.x; unit < 256; unit += gridDim.x) {
        const int xcd = unit & 7, idx = unit >> 3, bh = xcd * 2 + (idx >> 4), vs = idx & 15, b = bh >> 2, h = bh & 3;
        __syncthreads();
        for (int e = tid; e < 64 * SP / 2; e += 512) ((unsigned*)Ss)[e] = 0u;
        for (int e = tid; e < 32 * SP / 2; e += 512) { const int row = e / (SP / 2); ((unsigned*)Vt)[e] = (row == 16) ? 0x3F803F80u : 0u; ((unsigned*)Vw)[e] = 0u; }
        for (int e = tid; e < 32 * QP / 2; e += 512) ((unsigned*)Cs)[e] = 0u;
        for (int e = tid; e < 1024; e += 512) WTS[2048 + e] = a.in[I_WV][h * 1024 + e];
        f32x4 Cacc[2][2];
#pragma unroll
        for (int i = 0; i < 2; ++i)
#pragma unroll
            for (int j = 0; j < 2; ++j) Cacc[i][j] = (f32x4){0.f, 0.f, 0.f, 0.f};
        const int srow = tid >> 5, scol = (tid & 31) * 8;
        const int vrow = tid >> 1, vhalf = tid & 1;
        const size_t tbase = (size_t)b * SEQ;
        u32x4 xr[4], qr[4], xmr = (u32x4){0u, 0u, 0u, 0u}; float gi, gf;
        u32x2 sr0 = (u32x2){0u, 0u}, sr1 = (u32x2){0u, 0u};
        {
            const size_t t0 = tbase;
#pragma unroll
            for (int i = 0; i < 4; ++i) { xr[i] = *(const u32x4*)(XC + (t0 + srow + 16 * i) * D + h * 256 + scol); qr[i] = *(const u32x4*)(QG + (t0 + srow + 16 * i) * D + h * 256 + scol); }
            if (tid < 128) xmr = *(const u32x4*)(XM + (t0 + vrow) * D + h * 256 + vs * 16 + vhalf * 8);
            gi = GATES[(t0 + lane) * 8 + h]; gf = GATES[(t0 + lane) * 8 + 4 + h];
            const unsigned char* sp = sraw_ptr(ws, bh * 128);
            sr0 = *(const u32x2*)(sp + tid * 8); if (tid < 128) sr1 = *(const u32x2*)(sp + 4096 + tid * 8);
        }
        __syncthreads();
        float decay = 0.f, m_cur = -1e30f;
        constexpr int NC = SEQ / 64;
        for (int c = -1; c < NC; ++c) {
            float* tab = TAB + (c & 1) * 320;
            if (c >= 0) {
            __syncthreads();
            {
                const int rt = w & 3, vt = w >> 2;
                f32x4 a1 = (f32x4){0.f, 0.f, 0.f, 0.f}, a2 = (f32x4){0.f, 0.f, 0.f, 0.f};
#pragma unroll
                for (int ks = 0; ks < 2; ++ks) {
                    const bf16x8 sa_ = *(const bf16x8*)(Ss + (rt * 16 + fr) * SP + ks * 32 + fq * 8);
                    const bf16x8 vb = *(const bf16x8*)(Vt + (vt * 16 + fr) * SP + ks * 32 + fq * 8);
                    a1 = __builtin_amdgcn_mfma_f32_16x16x32_bf16(sa_, vb, a1, 0, 0, 0);
                }
#pragma unroll
                for (int ks = 0; ks < 8; ++ks) {
                    const bf16x8 qa = *(const bf16x8*)(Qs + (rt * 16 + fr) * QP + ks * 32 + fq * 8);
                    const bf16x8 cb = *(const bf16x8*)(Cs + (vt * 16 + fr) * QP + ks * 32 + fq * 8);
                    a2 = __builtin_amdgcn_mfma_f32_16x16x32_bf16(qa, cb, a2, 0, 0, 0);
                }
#pragma unroll
                for (int e = 0; e < 4; ++e) { const int i = rt * 16 + fq * 4 + e; Osm[i * 33 + vt * 16 + fr] = a1[e] + tab[128 + i] * a2[e]; }
            }
            {
#pragma unroll
                for (int kl = 0; kl < 2; ++kl)
#pragma unroll
                    for (int vt = 0; vt < 2; ++vt) Cacc[kl][vt] = Cacc[kl][vt] * decay;
#pragma unroll
                for (int kl = 0; kl < 2; ++kl) {
                    const int kcol = (2 * w + kl) * 16 + fr;
#pragma unroll
                    for (int ks = 0; ks < 2; ++ks) {
                        bf16x8 ka;
#pragma unroll
                        for (int e = 0; e < 8; ++e) ka[e] = (short)Ks[(ks * 32 + fq * 8 + e) * QP + kcol];
#pragma unroll
                        for (int vt = 0; vt < 2; ++vt) {
                            const bf16x8 vb = *(const bf16x8*)(Vw + (vt * 16 + fr) * SP + ks * 32 + fq * 8);
                            Cacc[kl][vt] = __builtin_amdgcn_mfma_f32_16x16x32_bf16(ka, vb, Cacc[kl][vt], 0, 0, 0);
                        }
                    }
                }
            }
            }
            float vnx[8], decay_n = 0.f, m_nx = m_cur;
            if (c + 1 < NC) {
                if (tid < 128) {
                    float x[8]; unpack8(xmr, x);
                    const int lgv = vs * 4 + vhalf * 2;
#pragma unroll
                    for (int g2 = 0; g2 < 2; ++g2) {
                        const float* Wv = WTS + 2048 + (lgv + g2) * 16;
#pragma unroll
                        for (int o = 0; o < 4; ++o) vnx[4 * g2 + o] = Wv[0 * 4 + o] * x[4 * g2] + Wv[1 * 4 + o] * x[4 * g2 + 1] + Wv[2 * 4 + o] * x[4 * g2 + 2] + Wv[3 * 4 + o] * x[4 * g2 + 3];
                    }
                }
                float sa = gf, sc = gi;
#define SCAN_STEP(CTRL, RM) do { const float ao = dppf<CTRL, RM>(0.f, sa), co = dppf<CTRL, RM>(-INFINITY, sc); sc = fmaxf(co + sa, sc); sa = ao + sa; } while (0)
                SCAN_STEP(0x111, 0xf); SCAN_STEP(0x112, 0xf); SCAN_STEP(0x114, 0xf); SCAN_STEP(0x118, 0xf);
                SCAN_STEP(0x142, 0xa);
                SCAN_STEP(0x143, 0xc);
#undef SCAN_STEP
                const float Mi = fmaxf(m_cur + sa, sc);
                const float gtot = readlane_f(sa, 63); m_nx = readlane_f(Mi, 63);
                decay_n = __expf(gtot + m_cur - m_nx);
                if (w == 0) {
                    float* tn = TAB + ((c + 1) & 1) * 320;
                    tn[lane] = sa - Mi; tn[64 + lane] = gi - sa; tn[128 + lane] = __expf(sa + m_cur - Mi); tn[192 + lane] = __expf(-Mi); tn[256 + lane] = __expf(gtot - sa + gi - m_nx);
                }
            }
            if (c >= 0) {
            __syncthreads();
            {
#pragma unroll
                for (int kl = 0; kl < 2; ++kl)
#pragma unroll
                    for (int vt = 0; vt < 2; ++vt) {
                        u32x2 wv; wv.x = pk2(Cacc[kl][vt][0], Cacc[kl][vt][1]); wv.y = pk2(Cacc[kl][vt][2], Cacc[kl][vt][3]);
                        *(u32x2*)(Cs + (vt * 16 + fr) * QP + (2 * w + kl) * 16 + fq * 4) = wv;
                    }
                const int i = tid >> 3, vp = (tid & 7) * 2;
                const float den = Osm[i * 33 + 16], dn = fmaxf(fabsf(den), tab[192 + i]);
                const float rdn = __builtin_amdgcn_rcpf(dn); const float h0 = Osm[i * 33 + vp] * rdn, h1 = Osm[i * 33 + vp + 1] * rdn;
                *(unsigned*)(HM + ((size_t)(bh * 16 + vs) * SEQ + (size_t)c * 64 + i) * 16 + vp) = pk2(h0, h1);
            }
            }
            if (c + 1 < NC) {
#pragma unroll
                for (int i = 0; i < 4; ++i) { const int r = srow + 16 * i; *(u32x4*)(Qs + r * QP + scol) = qr[i]; *(u32x4*)(Ks + r * QP + scol) = xr[i]; }
                if (c < 0) __syncthreads();
                const float* tn = TAB + ((c + 1) & 1) * 320;
                if (tid < 128) {
                    const float wk = tn[256 + vrow];
#pragma unroll
                    for (int e = 0; e < 8; ++e) { Vt[(vhalf * 8 + e) * SP + vrow] = (bf16_t)(pk2(vnx[e], 0.f) & 0xffffu); Vw[(vhalf * 8 + e) * SP + vrow] = (bf16_t)(pk2(vnx[e] * wk, 0.f) & 0xffffu); }
                } else if (tid < 192) { Vw[16 * SP + (tid - 128)] = (bf16_t)(pk2(tn[256 + tid - 128], 0.f) & 0xffffu); }
#define SS_ITEM(li, sr) do { int it_, jt_; if ((li) < 4) { it_ = 3; jt_ = (li); } else if ((li) < 7) { it_ = 2; jt_ = (li) - 4; } else if ((li) < 9) { it_ = 1; jt_ = (li) - 7; } else { it_ = 0; jt_ = 0; } \
        const int i_ = it_ * 16 + fr, j0_ = jt_ * 16 + fq * 4; const float rf_ = tn[i_]; const f32x4 cf_ = *(const f32x4*)(tn + 64 + j0_); \
        const float sv_[4] = {bflo((sr).x), bfhi((sr).x), bflo((sr).y), bfhi((sr).y)}; float o_[4]; \
        _Pragma("unroll") for (int e = 0; e < 4; ++e) o_[e] = (j0_ + e <= i_) ? sv_[e] * __expf(rf_ + cf_[e]) : 0.f; \
        u32x2 wv_; wv_.x = pk2(o_[0], o_[1]); wv_.y = pk2(o_[2], o_[3]); *(u32x2*)(Ss + i_ * SP + j0_) = wv_; } while (0)
                SS_ITEM(w, sr0);
                if (w < 2) SS_ITEM(w + 8, sr1);
#undef SS_ITEM
                decay = decay_n; m_cur = m_nx;
                if (c + 2 < NC) {
                    const size_t t2 = tbase + (size_t)(c + 2) * 64;
#pragma unroll
                    for (int i = 0; i < 4; ++i) { xr[i] = *(const u32x4*)(XC + (t2 + srow + 16 * i) * D + h * 256 + scol); qr[i] = *(const u32x4*)(QG + (t2 + srow + 16 * i) * D + h * 256 + scol); }
                    if (tid < 128) xmr = *(const u32x4*)(XM + (t2 + vrow) * D + h * 256 + vs * 16 + vhalf * 8);
                    gi = GATES[(t2 + lane) * 8 + h]; gf = GATES[(t2 + lane) * 8 + 4 + h];
                    const unsigned char* sp = sraw_ptr(ws, bh * 128 + c + 2);
                    sr0 = *(const u32x2*)(sp + tid * 8); if (tid < 128) sr1 = *(const u32x2*)(sp + 4096 + tid * 8);
                }
            }
        }
    }
}

__device__ __forceinline__ void p7_mlstm_fin(const Args& a) {
    unsigned char* ws = a.ws; const int tid = opaque_tid(), lane = tid & 63, wave = tid >> 6;
    const int gw = blockIdx.x * 8 + wave, NGW = gridDim.x * 8;
    const bf16_t* HM = (const bf16_t*)a.out + (size_t)T * D; const bf16_t* XC = (const bf16_t*)(ws + WS_XC); bf16_t* ZM = (bf16_t*)(ws + WS_ZM);
    float lnw[16], skp[16];
#pragma unroll
    for (int j = 0; j < 4; ++j) { const f32x4 p = *(const f32x4*)(a.in[I_LNW] + lane * 16 + 4 * j), q = *(const f32x4*)(a.in[I_SKIP] + lane * 16 + 4 * j); for (int e = 0; e < 4; ++e) { lnw[4 * j + e] = p[e]; skp[4 * j + e] = q[e]; } }
    for (int m = gw; m < T; m += NGW) {
        const size_t off = (size_t)m * D + lane * 16;
        float hv[16], xc[16], z[16];
        { const size_t hoff = ((size_t)(((m / SEQ) * 4 + (lane >> 4)) * 16 + (lane & 15)) * SEQ + (size_t)(m % SEQ)) * 16;
          unpack8(*(const u32x4*)(HM + hoff), hv); unpack8(*(const u32x4*)(HM + hoff + 8), hv + 8); }
        unpack8(*(const u32x4*)(XC + off), xc); unpack8(*(const u32x4*)(XC + off + 8), xc + 8);
        unpack8(*(const u32x4*)(ZM + off), z); unpack8(*(const u32x4*)(ZM + off + 8), z + 8);
        float s = 0.f;
#pragma unroll
        for (int e = 0; e < 16; ++e) s += hv[e];
        s += __shfl_xor(s, 1); s += __shfl_xor(s, 2); s += __shfl_xor(s, 4); s += __shfl_xor(s, 8);
        const float mu = s * (1.0f / 256.0f); float q = 0.f;
#pragma unroll
        for (int e = 0; e < 16; ++e) { hv[e] -= mu; q += hv[e] * hv[e]; }
        q += __shfl_xor(q, 1); q += __shfl_xor(q, 2); q += __shfl_xor(q, 4); q += __shfl_xor(q, 8);
        const float rstd = rsqrtf(q * (1.0f / 256.0f) + EPS);
        float o[16], ss = 0.f;
#pragma unroll
        for (int e = 0; e < 16; ++e) { o[e] = (hv[e] * rstd * lnw[e] + skp[e] * xc[e]) * siluf_(z[e]); ss += o[e] * o[e]; }
        ss = wave_sum(ss);
        const float rs = rsqrtf(ss * (1.0f / 1024.0f) + EPS);
#pragma unroll
        for (int e = 0; e < 16; ++e) o[e] *= rs;
        *(u32x4*)(ZM + off) = pack8(o); *(u32x4*)(ZM + off + 8) = pack8(o + 8);
    }
}
__device__ __forceinline__ void p7_rg_fin(const Args& a, unsigned char* lds) {
    unsigned char* ws = a.ws; const int tid = opaque_tid();
    unsigned* LOGA = (unsigned*)(ws + WS_XR); const unsigned* U = (const unsigned*)(ws + WS_U); const unsigned* YR = (const unsigned*)(ws + WS_YR); const float* AGG = (const float*)(ws + WS_AGG);
    float* Ot = (float*)lds;
    constexpr int OP = 1028;
    for (int tile = blockIdx.x; tile < 256; tile += gridDim.x) {
        const int tc = tile & 63, tb = tile & ~63;
        float h0 = 0.f, h1 = 0.f;
        for (int p = 0; p < tc; ++p) { const f32x4 g = *(const f32x4*)(AGG + ((size_t)(tb + p) * 1024 + 2 * tid) * 2); h0 = __expf(g[0]) * h0 + g[1]; h1 = __expf(g[2]) * h1 + g[3]; }
        const size_t row0 = (size_t)tile * 128;
        for (int i0 = 0; i0 < 128; i0 += 16) {
            unsigned la[16], uu[16], yy[16];
#pragma unroll
            for (int i = 0; i < 16; ++i) { const size_t o = (row0 + i0 + i) * 512 + tid; la[i] = LOGA[o]; uu[i] = U[o]; yy[i] = YR[o]; }
            __syncthreads();
#pragma unroll
            for (int i = 0; i < 16; ++i) {
                h0 = __expf(bflo(la[i])) * h0 + bflo(uu[i]); h1 = __expf(bfhi(la[i])) * h1 + bfhi(uu[i]);
                Ot[i * OP + 2 * tid] = h0 * geluf_(bflo(yy[i])); Ot[i * OP + 2 * tid + 1] = h1 * geluf_(bfhi(yy[i]));
            }
            __syncthreads();
            {
                const int row = tid >> 5, sub = tid & 31;
                f32x4 v[4][2]; float ss = 0.f;
#pragma unroll
                for (int q = 0; q < 4; ++q)
#pragma unroll
                    for (int hh = 0; hh < 2; ++hh) { v[q][hh] = *(const f32x4*)(Ot + row * OP + q * 256 + sub * 8 + hh * 4); const f32x4 t = v[q][hh]; ss += (t[0] * t[0] + t[1] * t[1]) + (t[2] * t[2] + t[3] * t[3]); }
                ss += __shfl_xor(ss, 1); ss += __shfl_xor(ss, 2); ss += __shfl_xor(ss, 4); ss += __shfl_xor(ss, 8); ss += __shfl_xor(ss, 16);
                const float rs = rsqrtf(ss * (1.0f / 1024.0f) + EPS);
                bf16_t* orow = (bf16_t*)LOGA + (row0 + i0 + row) * D;
#pragma unroll
                for (int q = 0; q < 4; ++q) { const f32x4 p = v[q][0] * rs, r = v[q][1] * rs; u32x4 wv; wv.x = pk2(p[0], p[1]); wv.y = pk2(p[2], p[3]); wv.z = pk2(r[0], r[1]); wv.w = pk2(r[2], r[3]); *(u32x4*)(orow + q * 256 + sub * 8) = wv; }
            }
        }
        __syncthreads();
    }
}

__device__ __forceinline__ void p11_final(const Args& a) {
    const int tid = opaque_tid(), lane = tid & 63, wave = tid >> 6;
    const int gw = blockIdx.x * 8 + wave, NGW = gridDim.x * 8;
    const float* SS = (const float*)(a.ws + WS_SSD); const float* gn = a.in[I_NFIN]; const bf16_t* X3 = (const bf16_t*)(a.ws + WS_XB);
    f32x4 g[4];
#pragma unroll
    for (int j = 0; j < 4; ++j) g[j] = *((const f32x4*)gn + lane * 4 + j);
    for (int m = gw; m < T; m += NGW) {
        const float rs = pg8::row_scale(SS, m);
        const size_t off = (size_t)m * D + lane * 16;
        float x[16]; unpack8(*(const u32x4*)(X3 + off), x); unpack8(*(const u32x4*)(X3 + off + 8), x + 8);
        f32x4* o = (f32x4*)(a.out + off);
#pragma unroll
        for (int j = 0; j < 4; ++j) { f32x4 v = (f32x4){x[4 * j], x[4 * j + 1], x[4 * j + 2], x[4 * j + 3]}; o[j] = v * rs * g[j]; }
    }
}

#define XB_TMO      128
#define XB_XCNT(j)  (256  + 64 * (j))
#define XB_XSUB(j)  (1280 + 64 * (j))
#define XB_XGEN(j)  (2304 + 64 * (j))
#define XB_TOP      3328
#define XB_TOPGEN   3392
#define XCD_BAR_WORDS 3456
#define XB_SPIN_CAP (1u << 18)
__device__ __forceinline__ unsigned xb_ld(unsigned* p)              { return __hip_atomic_load(p, __ATOMIC_RELAXED, __HIP_MEMORY_SCOPE_AGENT); }
__device__ __forceinline__ unsigned xb_add(unsigned* p, unsigned v) { return __hip_atomic_fetch_add(p, v, __ATOMIC_RELAXED, __HIP_MEMORY_SCOPE_AGENT); }
__device__ __forceinline__ unsigned xb_xcc_id() { return (unsigned)__builtin_amdgcn_s_getreg((3 << 11) | 20) & 0xFu; }
#define XB_SPIN(cond, bar) do { unsigned _sp = 0; while (cond) { __builtin_amdgcn_s_sleep(1); \
    if ((++_sp & 255u) == 0u) { if (xb_ld(&(bar)[XB_TMO])) break; if (_sp > XB_SPIN_CAP) { atomicAdd(&(bar)[XB_TMO], 1u); break; } } } } while (0)
struct XcdBarrier { unsigned* bar; unsigned x; volatile LAS unsigned* st; };
__device__ __forceinline__ XcdBarrier xcd_barrier_post(unsigned* bar, volatile LAS unsigned* st) {
    XcdBarrier b; b.bar = bar; b.x = xb_xcc_id(); b.st = st;
    if (threadIdx.x == 0) (void)xb_add(&bar[XB_XCNT(b.x)], 1u);
    return b;
}
__device__ __forceinline__ void xcd_barrier_complete(unsigned* bar, unsigned x, unsigned& nloc, unsigned& nx) {
    const unsigned G = gridDim.x * gridDim.y * gridDim.z;
    unsigned sum, cnt, mine, sp = 0u;
    for (;;) {
        sum = 0u; cnt = 0u; mine = 0u;
#pragma unroll
        for (unsigned j = 0; j < 16; ++j) { const unsigned c = xb_ld(&bar[XB_XCNT(j)]); sum += c; cnt += (c > 0u) ? 1u : 0u; mine = (j == x) ? c : mine; }
        if (sum == G) break;
        __builtin_amdgcn_s_sleep(1);
        if ((++sp & 255u) == 0u) { if (xb_ld(&bar[XB_TMO])) break; if (sp > XB_SPIN_CAP) { atomicAdd(&bar[XB_TMO], 1u); break; } }
    }
    nloc = mine > 0u ? mine : 1u; nx = cnt > 0u ? cnt : 1u;
}
__device__ __forceinline__ void xcd_barrier(const XcdBarrier& b) {
    asm volatile("s_waitcnt vmcnt(0)" ::: "memory");
    __syncthreads();
    if (threadIdx.x == 0) {
        unsigned* bar = b.bar;
        __builtin_amdgcn_s_waitcnt(0);
        unsigned nloc = b.st[0], nx = b.st[1];
        if (nloc == 0u) { xcd_barrier_complete(bar, b.x, nloc, nx); b.st[0] = nloc; b.st[1] = nx; }
        const unsigned old = xb_add(&bar[XB_XSUB(b.x)], 1u);
        const unsigned gen = old / nloc;
        if (old + 1u == (gen + 1u) * nloc) {
            __builtin_amdgcn_fence(__ATOMIC_RELEASE, "agent");
            asm volatile("s_waitcnt vmcnt(0)" ::: "memory");
            const unsigned og = xb_add(&bar[XB_TOP], 1u);
            const unsigned tg = og / nx;
            if (og + 1u == (tg + 1u) * nx) xb_add(&bar[XB_TOPGEN], 1u);
            else XB_SPIN(xb_ld(&bar[XB_TOPGEN]) == tg, bar);
            __builtin_amdgcn_fence(__ATOMIC_ACQUIRE, "agent");
            xb_add(&bar[XB_XGEN(b.x)], 1u);
            asm volatile("s_waitcnt vmcnt(0)" ::: "memory");
        } else {
            XB_SPIN(xb_ld(&bar[XB_XGEN(b.x)]) == gen, bar);
            __builtin_amdgcn_fence(__ATOMIC_ACQUIRE, "agent");
            asm volatile("s_waitcnt vmcnt(0)" ::: "memory");
        }
    }
    __syncthreads();
}
#define GSYNC() xcd_barrier(xbar)
__global__ void __launch_bounds__(512, 2) mk_fwd(Args args) {
    extern __shared__ __attribute__((aligned(16))) unsigned char lds_raw[];
    cg::grid_group grid = cg::this_grid();
    LAS unsigned char* lds = (LAS unsigned char*)lds_raw;
    unsigned char* ws = args.ws;
    const int G = gridDim.x, bid = blockIdx.x;
    volatile LAS unsigned* xst = (volatile LAS unsigned*)(lds + (LDS_BYTES - 64));
    if (threadIdx.x == 0) { xst[0] = 0u; xst[1] = 0u; }
    __syncthreads();
    const XcdBarrier xbar = xcd_barrier_post((unsigned*)(ws + WS_BAR), xst);
    bf16_t* XB = (bf16_t*)(ws + WS_XB); bf16_t* ACT = (bf16_t*)(ws + WS_R1);
#ifndef NO_P0
    p0_prologue(args, lds_raw);
#endif
    GSYNC();
    if (gridDim.x == 0x7fffffffu) grid.sync();
#ifndef NO_P1
    { const pg8::Gemm gUp1{XB, (const bf16_t*)(ws + WS_WGU1), 1024, 1024, 1 << 30, 0, 0, 0}; pg8::StaticOrder S; S.init(T, 2 * FF, G, bid); pg8::EpiSwiGLU E{ACT, (const float*)(ws + WS_SSA)}; pg8::gemm_phase(lds, gUp1, S, E); }
#endif
    GSYNC();
#ifndef NO_P2
    { const pg8::Gemm gDn1{ACT, (const bf16_t*)(ws + WS_WD1), FF, FF, 1 << 30, 0, 0, 0}; pg8::StaticOrder S; S.init(T, D, G, bid); pg8::EpiResidB E{nullptr, XB  , XB  , nullptr, (float*)(ws + WS_SSB), 0.5f}; pg8::gemm_phase(lds, gDn1, S, E); }
#endif
    GSYNC();
#ifndef NO_P3
    { const pg8::Gemm gIn{XB, (const bf16_t*)(ws + WS_WIN), 1024, 1024, 1 << 30, 0, 0, 0}; pg8::StaticOrder S; S.init(T, 4096, G, bid); pg8::EpiProj E{(bf16_t*)(ws + WS_XM), (const float*)(ws + WS_SSB)}; pg8::gemm_phase(lds, gIn, S, E); }
#endif
    GSYNC();
#ifndef NO_P4
    p4_conv(args);
#endif
    GSYNC();
#ifndef NO_P5
    {
        const bf16_t* XCR = (const bf16_t*)args.out + (size_t)T * D;
        const pg8::Gemm gRg{XCR, (const bf16_t*)(ws + WS_WRG), 256, 1024, 1 << 30, 0, 1, 512};
        const pg8::Gemm gGt{(const bf16_t*)(ws + WS_XC), (const bf16_t*)(ws + WS_WG8), 2048, 1024, 16, (long)WS_XM - (long)WS_XC - 16 * 128, 0, 0};
        pg8::EpiGates Eg{(float*)(ws + WS_GATES), args.in[I_BGATES]};
        pg8::EpiRg Er{XCR, args.in[I_RBA], args.in[I_RBX], (const float*)(ws + WS_C8), (bf16_t*)(ws + WS_XR), (bf16_t*)(ws + WS_U)};
        if (G == 256) {
#ifndef NO_P5G
            if (bid < 128) { pg8::ListOrder S{bid, 1, 0}; pg8::gemm_phase(lds, gGt, S, Eg); }
#endif
#ifndef NO_P5R
            if (bid >= 128) { pg8::ListOrder S{(bid - 128) * 8, 8, 3}; pg8::gemm_phase(lds, gRg, S, Er); }
#endif
        } else {
#ifndef NO_P5G
            for (int u = bid; u < 128; u += G) { pg8::ListOrder S{u, 1, 0}; pg8::gemm_phase(lds, gGt, S, Eg); }
#endif
#ifndef NO_P5R
            for (int u = bid; u < 128; u += G) { pg8::ListOrder S{u * 8, 8, 3}; pg8::gemm_phase(lds, gRg, S, Er); }
#endif
        }
    }
#endif
    GSYNC();
#ifndef NO_P6A
    p6_rg_agg(args);
#endif
    p5b_sraw(args, lds_raw);
    GSYNC();
#ifndef NO_P6
    p6_mlstm(args, lds_raw);
#endif
    GSYNC();
#ifndef NO_P7A
    p7_mlstm_fin(args);
#endif
#ifndef NO_P7B
    p7_rg_fin(args, lds_raw);
#endif
    GSYNC();
#ifndef NO_P8
    { const pg8::Gemm gOut{(const bf16_t*)(ws + WS_ZM)  , (const bf16_t*)(ws + WS_WOUT), 2048, 1024, 16, (long)(64 * MiB) - 16 * 128, 0, 0}; pg8::StaticOrder S; S.init(T, D, G, bid); pg8::EpiResidB E{nullptr, XB, XB  , nullptr, (float*)(ws + WS_SSC), 1.0f}; pg8::gemm_phase(lds, gOut, S, E); }
#endif
    GSYNC();
#ifndef NO_P9
    { const pg8::Gemm gUp2{XB, (const bf16_t*)(ws + WS_WGU2), 1024, 1024, 1 << 30, 0, 0, 0}; pg8::StaticOrder S; S.init(T, 2 * FF, G, bid); pg8::EpiSwiGLU E{ACT, (const float*)(ws + WS_SSC)}; pg8::gemm_phase(lds, gUp2, S, E); }
#endif
    GSYNC();
#ifndef NO_P10
    { const pg8::Gemm gDn2{ACT, (const bf16_t*)(ws + WS_WD2), FF, FF, 1 << 30, 0, 0, 0}; pg8::StaticOrder S; S.init(T, D, G, bid); pg8::EpiResidB E{nullptr, XB, XB  , nullptr, (float*)(ws + WS_SSD), 0.5f}; pg8::gemm_phase(lds, gDn2, S, E); }
#endif
    GSYNC();
#ifndef NO_P11
    p11_final(args);
#endif
}

extern "C" void kernel_launch(void* const* d_in, const int* in_sizes, int n_in, void* d_out, int out_size, void* d_ws, size_t ws_size, hipStream_t stream) {
    static int grid = 0;
    if (grid == 0) {
        if (n_in != 31 || in_sizes[0] != T * D || out_size != T * D || ws_size < WS_END) { fprintf(stderr, "kernel_launch: unexpected shapes (n_in %d, in0 %d, out %d, ws %zu)\n", n_in, n_in > 0 ? in_sizes[0] : -1, out_size, ws_size); grid = -1; return; }
        int dev = 0, cus = 0, per_cu = 0;
        if (hipGetDevice(&dev) != hipSuccess || hipDeviceGetAttribute(&cus, hipDeviceAttributeMultiprocessorCount, dev) != hipSuccess) { grid = -1; return; }
        if (hipFuncSetAttribute((const void*)mk_fwd, hipFuncAttributeMaxDynamicSharedMemorySize, LDS_BYTES) != hipSuccess) { fprintf(stderr, "kernel_launch: hipFuncSetAttribute failed\n"); grid = -1; return; }
        if (hipOccupancyMaxActiveBlocksPerMultiprocessor(&per_cu, (const void*)mk_fwd, 512, LDS_BYTES) != hipSuccess || per_cu < 1) { fprintf(stderr, "kernel_launch: occupancy query says %d\n", per_cu); (void)hipGetLastError(); grid = -1; return; }
        grid = cus;
    }
    if (grid < 0) return;
    if (hipMemsetAsync((char*)d_ws + WS_BAR, 0, 16384, stream) != hipSuccess) { fprintf(stderr, "kernel_launch: memset of barrier words failed\n"); return; }
    Args a{};
    for (int i = 0; i < 31; ++i) a.in[i] = (const float*)d_in[i];
    a.out = (float*)d_out; a.ws = (unsigned char*)d_ws;
    void* kargs[] = {&a};
    hipError_t e = hipLaunchCooperativeKernel((const void*)mk_fwd, dim3(grid), dim3(512), kargs, LDS_BYTES, stream);
    if (e != hipSuccess) fprintf(stderr, "kernel_launch: cooperative launch failed: %s (grid %d)\n", hipGetErrorString(e), grid);
}
```

```cpp
#include <hip/hip_runtime.h>
#include <hip/hip_cooperative_groups.h>
#include <cstdio>
#include <cstdint>
namespace cg = cooperative_groups;

#define LAS __attribute__((address_space(3)))
typedef unsigned short bf16_t;
typedef short bf16x8 __attribute__((ext_vector_type(8)));
typedef float f32x4 __attribute__((ext_vector_type(4)));
typedef unsigned u32x4 __attribute__((ext_vector_type(4)));
typedef unsigned u32x2 __attribute__((ext_vector_type(2)));

constexpr int T = 32768, D = 1024, FF = 2816, SEQ = 8192, NB = 4;
constexpr float EPS = 1e-6f;
constexpr size_t MiB = 1u << 20;
constexpr size_t WS_SSA = 0, WS_SSB = 2 * MiB, WS_SSC = 4 * MiB, WS_SSD = 6 * MiB;
constexpr size_t WS_GATES = 8 * MiB;
constexpr size_t WS_AGG = 9 * MiB;
constexpr size_t WS_BAR = 14 * MiB;
constexpr size_t WS_C8 = 12 * MiB;
constexpr size_t WS_WG8 = 11 * MiB;
constexpr size_t WS_WGU1 = 16 * MiB;
constexpr size_t WS_WD1 = WS_WGU1 + 11 * MiB;
constexpr size_t WS_WIN = WS_WD1 + 11 * MiB / 2;
constexpr size_t WS_WRG = WS_WIN + 8 * MiB;
constexpr size_t WS_WOUT = WS_WRG + 1 * MiB;
constexpr size_t WS_WGU2 = WS_WOUT + 4 * MiB;
constexpr size_t WS_WD2 = WS_WGU2 + 11 * MiB;
constexpr size_t WS_XB = 64 * MiB;
constexpr size_t WS_R1 = 128 * MiB;
constexpr size_t WS_XM = WS_R1, WS_ZM = WS_R1 + 64 * MiB, WS_XR = WS_R1 + 128 * MiB, WS_YR = WS_R1 + 192 * MiB;
constexpr size_t WS_XC = 384 * MiB;
constexpr size_t WS_U = 448 * MiB;
constexpr size_t WS_END = 512 * MiB;
constexpr int LDS_BYTES = 147456;

typedef float f32x2_t __attribute__((ext_vector_type(2)));
typedef __bf16 bf16x2_t __attribute__((ext_vector_type(2)));
__device__ __forceinline__ unsigned pk2(float lo, float hi) { const f32x2_t v = {lo, hi}; const bf16x2_t b = __builtin_convertvector(v, bf16x2_t); return __builtin_bit_cast(unsigned, b); }
__device__ __forceinline__ float bflo(unsigned u) { return __uint_as_float(u << 16); }
__device__ __forceinline__ float bfhi(unsigned u) { return __uint_as_float(u & 0xffff0000u); }
__device__ __forceinline__ float bf1(bf16_t u) { return __uint_as_float(((unsigned)u) << 16); }
__device__ __forceinline__ void unpack8(const u32x4 v, float* x) { x[0] = bflo(v.x); x[1] = bfhi(v.x); x[2] = bflo(v.y); x[3] = bfhi(v.y); x[4] = bflo(v.z); x[5] = bfhi(v.z); x[6] = bflo(v.w); x[7] = bfhi(v.w); }
__device__ __forceinline__ u32x4 pack8(const float* x) { u32x4 o; o.x = pk2(x[0], x[1]); o.y = pk2(x[2], x[3]); o.z = pk2(x[4], x[5]); o.w = pk2(x[6], x[7]); return o; }
__device__ __forceinline__ float sigmoidf_(float x) { return __builtin_amdgcn_rcpf(1.0f + __expf(-x)); }
__device__ __forceinline__ float siluf_(float x) { return x * __builtin_amdgcn_rcpf(1.0f + __expf(-x)); }
__device__ __forceinline__ float logsigf_(float x) { return fminf(x, 0.f) - __logf(1.0f + __expf(-fabsf(x))); }
__device__ __forceinline__ float logsig_acc_(float x) { return fminf(x, 0.f) - log1pf(expf(-fabsf(x))); }
__device__ __forceinline__ float geluf_(float x) { const float u = 0.7978845608028654f * (x + 0.044715f * x * x * x); const float t = 1.0f - 2.0f * __builtin_amdgcn_rcpf(1.0f + __expf(2.0f * u)); return 0.5f * x * (1.0f + t); }
__device__ __forceinline__ int opaque_tid() { int t = threadIdx.x; asm volatile("" : "+v"(t)); return t; }
__device__ __forceinline__ float wave_sum(float v) {
#pragma unroll
    for (int o = 1; o < 64; o <<= 1) v += __shfl_xor(v, o);
    return v;
}

namespace pg8 {
constexpr int BM = 256, BK = 64, HALF = 128, HTB = HALF * BK * 2, STAGE_BYTES = 8 * HTB, NXCD = 8, WGM = 8;
__host__ __device__ __forceinline__ int lds_byte(int r, int c) { const int st = (r >> 4) * 2 + (c >> 5), rr = r & 15, cc = c & 31, ob = rr * 64 + cc * 2; return st * 1024 + (ob ^ (((ob >> 9) & 1) << 5)); }
__host__ __device__ __forceinline__ void stage_rc(int b, int& R, int& C) { const int st = b / 1024, sb = b % 1024, swz = sb ^ (((sb >> 9) & 1) << 5); R = (st >> 1) * 16 + swz / 64; C = (st & 1) * 32 + (swz % 64) / 2; }
__host__ __device__ __forceinline__ int perm32(int rho) { const int n = rho >> 4, i = rho & 15; return 8 * (i >> 2) + 4 * n + (i & 3); }

struct Unit { int pm, pn; };
struct Gemm { const bf16_t* A; const bf16_t* Bt; int K; int lda; int ksplit; long kdelta; int a_pn_shift; int a_pn_bytes; };

struct StaticOrder {
    int nM, nN, nwg, G, c;
    __device__ void init(int M, int N, int G_, int c_) { nM = M / BM; nN = N / BM; nwg = nM * nN; G = G_; c = c_; }
    __device__ bool next(int i, Unit& u) const {
        const long L = (long)i * G + c; if (L >= nwg) return false;
        int wgid = (int)L; { const int q = nwg / NXCD, r = nwg % NXCD, xcd = wgid % NXCD, off = wgid / NXCD; wgid = (xcd < r ? xcd * (q + 1) : r * (q + 1) + (xcd - r) * q) + off; }
        const int nig = WGM * nN, gid = wgid / nig, fm = gid * WGM, gsz = (nM - fm) < WGM ? (nM - fm) : WGM;
        u.pm = fm + ((wgid % nig) % gsz); u.pn = (wgid % nig) / gsz; return true;
    }
};
struct ListOrder {
    int first, cnt, nshift;
    __device__ bool next(int i, Unit& u) const { if (i >= cnt) return false; const int L = first + i; u.pm = L >> nshift; u.pn = L & ((1 << nshift) - 1); return true; }
};

__device__ __forceinline__ float row_scale(const float* SS, int r) {
    const f32x4* p = (const f32x4*)(SS + (size_t)r * 16);
    const f32x4 a = p[0], b = p[1], c = p[2], d = p[3];
    const float s = ((a[0] + a[1]) + (a[2] + a[3])) + ((b[0] + b[1]) + (b[2] + b[3])) + ((c[0] + c[1]) + (c[2] + c[3])) + ((d[0] + d[1]) + (d[2] + d[3]));
    return rsqrtf(s * (1.0f / 1024.0f) + EPS);
}

__device__ __forceinline__ void row_scales8(const float* SS, int row0, int fq, float (&rs)[8]) {
    f32x4 v[8];
#pragma unroll
    for (int q = 0; q < 8; ++q) v[q] = *(const f32x4*)(SS + (size_t)(row0 + (q >> 2) * HALF + (q & 3) * 16) * 16 + fq * 4);
#pragma unroll
    for (int q = 0; q < 8; ++q) { float s = (v[q][0] + v[q][1]) + (v[q][2] + v[q][3]); s += __shfl_xor(s, 16); s += __shfl_xor(s, 32); rs[q] = rsqrtf(s * (1.0f / 1024.0f) + EPS); }
}
struct EpiSwiGLU {
    bf16_t* O; const float* SS;
    __device__ __forceinline__ void operator()(const f32x4 (&acc)[2][2][4][2], const Unit& u, int wr, int wc, int fr, int fq) const {
        const int row0 = u.pm * BM + wr * 64 + fr, col0 = u.pn * HALF + wc * 32 + 8 * fq;
        float rs8[8]; row_scales8(SS, row0, fq, rs8);
#pragma unroll
        for (int ai = 0; ai < 2; ++ai)
#pragma unroll
            for (int m = 0; m < 4; ++m) {
                const int r = row0 + ai * HALF + m * 16; const float rs = rs8[ai * 4 + m];
                float o[8];
#pragma unroll
                for (int n = 0; n < 2; ++n)
#pragma unroll
                    for (int j = 0; j < 4; ++j) { const float g = acc[ai][0][m][n][j] * rs, up = acc[ai][1][m][n][j] * rs; o[n * 4 + j] = siluf_(g) * up; }
                *(u32x4*)(O + (size_t)r * FF + col0) = pack8(o);
            }
    }
};
struct EpiResid {
    const float* Xin; float* Xout; bf16_t* XBo; float* SSo; float alpha;
    __device__ __forceinline__ void operator()(const f32x4 (&acc)[2][2][4][2], const Unit& u, int wr, int wc, int fr, int fq) const {
        const int row0 = u.pm * BM + wr * 64 + fr, col0 = u.pn * BM + wc * 32 + 8 * fq;
#pragma unroll
        for (int ai = 0; ai < 2; ++ai)
#pragma unroll
            for (int m = 0; m < 4; ++m) {
                const int r = row0 + ai * HALF + m * 16; float ss = 0.f;
#pragma unroll
                for (int bj = 0; bj < 2; ++bj) {
                    const size_t off = (size_t)r * D + col0 + bj * HALF;
                    const f32x4 x0 = *(const f32x4*)(Xin + off), x1 = *(const f32x4*)(Xin + off + 4);
                    const f32x4 v0 = x0 + acc[ai][bj][m][0] * alpha, v1 = x1 + acc[ai][bj][m][1] * alpha;
                    *(f32x4*)(Xout + off) = v0; *(f32x4*)(Xout + off + 4) = v1;
                    ss += (v0[0] * v0[0] + v0[1] * v0[1]) + (v0[2] * v0[2] + v0[3] * v0[3]) + (v1[0] * v1[0] + v1[1] * v1[1]) + (v1[2] * v1[2] + v1[3] * v1[3]);
                    if (XBo) { u32x4 w; w.x = pk2(v0[0], v0[1]); w.y = pk2(v0[2], v0[3]); w.z = pk2(v1[0], v1[1]); w.w = pk2(v1[2], v1[3]); *(u32x4*)(XBo + off) = w; }
                }
                ss += __shfl_xor(ss, 16); ss += __shfl_xor(ss, 32);
                if (fq == 0) SSo[(size_t)r * 16 + u.pn * 4 + wc] = ss;
            }
    }
};
struct EpiResidB {
    const float* XinF; const bf16_t* XinB; bf16_t* O1; bf16_t* O2; float* SSo; float alpha;
    __device__ __forceinline__ void operator()(const f32x4 (&acc)[2][2][4][2], const Unit& u, int wr, int wc, int fr, int fq) const {
        const int row0 = u.pm * BM + wr * 64 + fr, col0 = u.pn * BM + wc * 32 + 8 * fq;
#pragma unroll
        for (int ai = 0; ai < 2; ++ai)
#pragma unroll
            for (int m = 0; m < 4; ++m) {
                const int r = row0 + ai * HALF + m * 16; float ss = 0.f;
#pragma unroll
                for (int bj = 0; bj < 2; ++bj) {
                    const size_t off = (size_t)r * D + col0 + bj * HALF;
                    f32x4 x0, x1;
                    if (XinF) { x0 = *(const f32x4*)(XinF + off); x1 = *(const f32x4*)(XinF + off + 4); }
                    else { const u32x4 xb = *(const u32x4*)(XinB + off); x0 = (f32x4){bflo(xb.x), bfhi(xb.x), bflo(xb.y), bfhi(xb.y)}; x1 = (f32x4){bflo(xb.z), bfhi(xb.z), bflo(xb.w), bfhi(xb.w)}; }
                    const f32x4 v0 = x0 + acc[ai][bj][m][0] * alpha, v1 = x1 + acc[ai][bj][m][1] * alpha;
                    ss += (v0[0] * v0[0] + v0[1] * v0[1]) + (v0[2] * v0[2] + v0[3] * v0[3]) + (v1[0] * v1[0] + v1[1] * v1[1]) + (v1[2] * v1[2] + v1[3] * v1[3]);
                    u32x4 w; w.x = pk2(v0[0], v0[1]); w.y = pk2(v0[2], v0[3]); w.z = pk2(v1[0], v1[1]); w.w = pk2(v1[2], v1[3]);
                    *(u32x4*)(O1 + off) = w; if (O2) *(u32x4*)(O2 + off) = w;
                }
                ss += __shfl_xor(ss, 16); ss += __shfl_xor(ss, 32);
                if (fq == 0) SSo[(size_t)r * 16 + u.pn * 4 + wc] = ss;
            }
    }
};
struct EpiProj {
    bf16_t* O; const float* SS;
    __device__ __forceinline__ void operator()(const f32x4 (&acc)[2][2][4][2], const Unit& u, int wr, int wc, int fr, int fq) const {
        bf16_t* base = O + (size_t)(u.pn >> 2) * ((size_t)T * D);
        const int row0 = u.pm * BM + wr * 64 + fr, col0 = (u.pn & 3) * BM + wc * 32 + 8 * fq;
        float rs8[8]; row_scales8(SS, row0, fq, rs8);
#pragma unroll
        for (int ai = 0; ai < 2; ++ai)
#pragma unroll
            for (int m = 0; m < 4; ++m) {
                const int r = row0 + ai * HALF + m * 16; const float rs = rs8[ai * 4 + m];
#pragma unroll
                for (int bj = 0; bj < 2; ++bj) {
                    const f32x4 v0 = acc[ai][bj][m][0] * rs, v1 = acc[ai][bj][m][1] * rs;
                    u32x4 w; w.x = pk2(v0[0], v0[1]); w.y = pk2(v0[2], v0[3]); w.z = pk2(v1[0], v1[1]); w.w = pk2(v1[2], v1[3]);
                    *(u32x4*)(base + (size_t)r * D + col0 + bj * HALF) = w;
                }
            }
    }
};
__device__ __forceinline__ float neg_expm1_(float x) {
    const float p = -x * (1.0f + x * (0.5f + x * (0.16666667f + x * (0.041666668f + x * 0.0083333338f))));
    const float e = 1.0f - __expf(x);
    return (x > -0.3f) ? p : e;
}
struct EpiRg {
    const bf16_t* XCR; const float* ba; const float* bx; const float* c8t; bf16_t* LOGA; bf16_t* U;
    __device__ __forceinline__ void operator()(const f32x4 (&acc)[2][2][4][2], const Unit& u, int wr, int wc, int fr, int fq) const {
        const int row0 = u.pm * BM + wr * 64 + fr, ch0 = (u.pn >> 1) * 256 + (u.pn & 1) * HALF + wc * 32 + 8 * fq;
#pragma unroll
        for (int n = 0; n < 2; ++n) {
            const int ch = ch0 + 4 * n;
            const f32x4 b_a = *(const f32x4*)(ba + ch), b_x = *(const f32x4*)(bx + ch), c8 = *(const f32x4*)(c8t + ch);
#pragma unroll
            for (int ai = 0; ai < 2; ++ai)
#pragma unroll
                for (int m = 0; m < 4; ++m) {
                    const int r = row0 + ai * HALF + m * 16;
                    const u32x2 xv = *(const u32x2*)(XCR + (size_t)r * D + ch);
                    const float xc[4] = {bflo(xv.x), bfhi(xv.x), bflo(xv.y), bfhi(xv.y)};
                    float la[4], uu[4];
#pragma unroll
                    for (int j = 0; j < 4; ++j) {
                        const float rg = sigmoidf_(acc[ai][0][m][n][j] + b_a[j]), ig = sigmoidf_(acc[ai][1][m][n][j] + b_x[j]);
                        la[j] = c8[j] * rg;
                        uu[j] = __builtin_amdgcn_sqrtf(fmaxf(neg_expm1_(2.0f * la[j]), 0.f)) * (ig * xc[j]);
                    }
                    u32x2 w0, w1; w0.x = pk2(la[0], la[1]); w0.y = pk2(la[2], la[3]); w1.x = pk2(uu[0], uu[1]); w1.y = pk2(uu[2], uu[3]);
                    *(u32x2*)(LOGA + (size_t)r * D + ch) = w0; *(u32x2*)(U + (size_t)r * D + ch) = w1;
                    __builtin_amdgcn_sched_barrier(0);
                }
        }
    }
};
struct EpiGates {
    float* G; const float* bg;
    __device__ __forceinline__ void operator()(const f32x4 (&acc)[2][2][4][2], const Unit& u, int wr, int wc, int fr, int fq) const {
        if (wc != 0 || fq != 0) return;
        const int row0 = u.pm * BM + wr * 64 + fr;
        const f32x4 b0 = *(const f32x4*)(bg), b1 = *(const f32x4*)(bg + 4);
#pragma unroll
        for (int ai = 0; ai < 2; ++ai)
#pragma unroll
            for (int m = 0; m < 4; ++m) {
                const int r = row0 + ai * HALF + m * 16;
                f32x4 v0 = acc[ai][0][m][0] + b0, v1 = acc[ai][0][m][1] + b1;
                for (int j = 0; j < 4; ++j) v1[j] = logsigf_(v1[j]);
                *(f32x4*)(G + (size_t)r * 8) = v0; *(f32x4*)(G + (size_t)r * 8 + 4) = v1;
            }
    }
};

template <class Epi, class Sched>
__device__ __forceinline__ void gemm_phase(LAS unsigned char* lds, const Gemm g, const Sched& S, const Epi& E) {
    const int tid = opaque_tid(), wid = __builtin_amdgcn_readfirstlane(tid >> 6), lane = tid & 63, wr = wid >> 2, wc = wid & 3, fr = lane & 15, fq = lane >> 4;
    const int K = g.K, nt = K / BK, lda = g.lda;
    unsigned voffA[2], voffB[2];
#pragma unroll
    for (int i = 0; i < 2; ++i) { int R, C; stage_rc(tid * 16 + i * 8192, R, C); const int Rb = (R & ~31) + perm32(R & 31);
        voffA[i] = (unsigned)(R * lda + C) * 2u; voffB[i] = (unsigned)(Rb * K + C) * 2u; }
    const size_t kstep = (size_t)(BK * 2);
    const size_t hstepA = (size_t)HALF * lda * 2, tstepA = 2 * hstepA;
    const size_t hstepB = (size_t)HALF * K * 2, tstepB = 2 * hstepB;
    const unsigned ldsw = (unsigned)wid * 1024u;
    const int aoff = lds_byte(wr * 64 + fr, fq * 8), boff = lds_byte(wc * 32 + fr, fq * 8);
    const int ksplit = g.ksplit; const long kdelta = g.kdelta;
#define PG8_AK(t) ((long)(t) * (long)kstep + (((t) >= ksplit) ? kdelta : 0l))
#define PG8_SA(b, h) (((b) * 2 + (h)) * HTB)
#define PG8_SB(b, h) ((4 + (b) * 2 + (h)) * HTB)
#define PG8_STAGE(bufoff, gbase, voff) do { _Pragma("unroll") for (int _i = 0; _i < 2; ++_i) \
        __builtin_amdgcn_global_load_lds((const unsigned*)((const char*)(gbase) + (voff)[_i]), (LAS unsigned*)(lds + (bufoff) + ldsw + _i * 8192), 16, 0, 0); } while (0)
#define PG8_LDA(dst, b, h) do { _Pragma("unroll") for (int m = 0; m < 4; ++m) _Pragma("unroll") for (int k = 0; k < 2; ++k) dst[m][k] = *(const LAS bf16x8*)(lds + PG8_SA(b, h) + aoff + m * 2048 + k * 1024); } while (0)
#define PG8_LDB(dst, b, h) do { _Pragma("unroll") for (int n = 0; n < 2; ++n) _Pragma("unroll") for (int k = 0; k < 2; ++k) dst[n][k] = *(const LAS bf16x8*)(lds + PG8_SB(b, h) + boff + n * 2048 + k * 1024); } while (0)
#define PG8_MMA(ai, bj, At, Bt) do { __builtin_amdgcn_s_setprio(1); _Pragma("unroll") for (int m = 0; m < 4; ++m) _Pragma("unroll") for (int n = 0; n < 2; ++n) _Pragma("unroll") for (int k = 0; k < 2; ++k) \
        acc[ai][bj][m][n] = __builtin_amdgcn_mfma_f32_16x16x32_bf16(Bt[n][k], At[m][k], acc[ai][bj][m][n], 0, 0, 0); __builtin_amdgcn_s_setprio(0); } while (0)
#define PG8_WAIT_V(n) asm volatile("s_waitcnt vmcnt(" #n ")" ::: "memory")
#define PG8_WAIT_L(n) asm volatile("s_waitcnt lgkmcnt(" #n ")" ::: "memory")
#define PG8_BAR __builtin_amdgcn_s_barrier()
#define PG8_SCHED __builtin_amdgcn_sched_barrier(0)
    Unit cur, nxt; int ui = 0;
    if (!S.next(0, cur)) return;
    f32x4 acc[2][2][4][2];
#pragma unroll
    for (int a = 0; a < 2; ++a)
#pragma unroll
        for (int b = 0; b < 2; ++b)
#pragma unroll
            for (int m = 0; m < 4; ++m)
#pragma unroll
                for (int n = 0; n < 2; ++n) acc[a][b][m][n] = (f32x4){0.f, 0.f, 0.f, 0.f};
    bf16x8 At[4][2], B0[2][2], B1[2][2];
    const char* cA = (const char*)g.A + (size_t)cur.pm * tstepA + (size_t)(cur.pn >> g.a_pn_shift) * g.a_pn_bytes;
    const char* cB = (const char*)g.Bt + (size_t)cur.pn * tstepB;
    {
        PG8_STAGE(PG8_SB(0, 0), cB, voffB); PG8_STAGE(PG8_SB(0, 1), cB + hstepB, voffB); PG8_STAGE(PG8_SA(0, 0), cA, voffA); PG8_STAGE(PG8_SA(0, 1), cA + hstepA, voffA);
        if (wr == 1) PG8_BAR;
        PG8_WAIT_V(2); PG8_BAR;
        PG8_STAGE(PG8_SB(1, 0), cB + kstep, voffB); PG8_STAGE(PG8_SA(1, 0), cA + PG8_AK(1), voffA); PG8_STAGE(PG8_SB(1, 1), cB + hstepB + kstep, voffB);
        PG8_WAIT_V(6); PG8_BAR;
    }
    for (;;) {
        const bool has_next = S.next(ui + 1, nxt);
        const char* nA = has_next ? (const char*)g.A + (size_t)nxt.pm * tstepA + (size_t)(nxt.pn >> g.a_pn_shift) * g.a_pn_bytes : cA;
        const char* nB = has_next ? (const char*)g.Bt + (size_t)nxt.pn * tstepB : cB;
#pragma nounroll
        for (int t = 0; t < nt; t += 2) {
            const bool last = (t == nt - 2);
            const char* a1 = cA + PG8_AK(t + 1);
            const char* a2 = last ? nA : cA + PG8_AK(t + 2); const char* b2 = last ? nB : cB + (size_t)(t + 2) * kstep;
            const char* a3 = last ? nA + PG8_AK(1) : cA + PG8_AK(t + 3); const char* b3 = b2 + kstep;
            PG8_LDB(B0, 0, 0); PG8_LDB(B1, 0, 1); PG8_SCHED; PG8_LDA(At, 0, 0); PG8_STAGE(PG8_SA(1, 1), a1 + hstepA, voffA);
            PG8_WAIT_V(8); PG8_WAIT_L(0); PG8_BAR; PG8_MMA(0, 0, At, B0); PG8_MMA(0, 1, At, B1); PG8_BAR; PG8_SCHED;
            PG8_LDA(At, 0, 1); PG8_STAGE(PG8_SB(0, 0), b2, voffB); PG8_STAGE(PG8_SB(0, 1), b2 + hstepB, voffB); PG8_STAGE(PG8_SA(0, 0), a2, voffA);
            PG8_WAIT_V(8); PG8_WAIT_L(0); PG8_BAR; PG8_MMA(1, 0, At, B0); PG8_MMA(1, 1, At, B1); PG8_BAR; PG8_SCHED;
            PG8_LDB(B0, 1, 0); PG8_LDB(B1, 1, 1); PG8_SCHED; PG8_LDA(At, 1, 0); PG8_STAGE(PG8_SA(0, 1), a2 + hstepA, voffA);
            PG8_WAIT_V(8); PG8_WAIT_L(0); PG8_BAR; PG8_MMA(0, 0, At, B0); PG8_MMA(0, 1, At, B1); PG8_BAR; PG8_SCHED;
            PG8_LDA(At, 1, 1); PG8_STAGE(PG8_SB(1, 0), b3, voffB); PG8_STAGE(PG8_SB(1, 1), b3 + hstepB, voffB); PG8_STAGE(PG8_SA(1, 0), a3, voffA);
            PG8_WAIT_V(8); PG8_WAIT_L(0); PG8_BAR; PG8_MMA(1, 0, At, B0); PG8_MMA(1, 1, At, B1); PG8_BAR; PG8_SCHED;
        }
        if (wr == 0) PG8_BAR;
        E(acc, cur, wr, wc, fr, fq);
        if (!has_next) break;
#pragma unroll
        for (int a = 0; a < 2; ++a)
#pragma unroll
            for (int b = 0; b < 2; ++b)
#pragma unroll
                for (int m = 0; m < 4; ++m)
#pragma unroll
                    for (int n = 0; n < 2; ++n) acc[a][b][m][n] = (f32x4){0.f, 0.f, 0.f, 0.f};
        cur = nxt; cA = nA; cB = nB; ++ui;
        if (wr == 1) PG8_BAR;
    }
    PG8_WAIT_V(0);
    PG8_BAR;
#undef PG8_AK
#undef PG8_SA
#undef PG8_SB
#undef PG8_STAGE
#undef PG8_LDA
#undef PG8_LDB
#undef PG8_MMA
#undef PG8_WAIT_V
#undef PG8_WAIT_L
#undef PG8_BAR
#undef PG8_SCHED
}
}

struct Args { const float* in[31]; float* out; unsigned char* ws; };
enum { I_X = 0, I_NF1, I_WG1, I_WU1, I_WD1, I_NMIX, I_WIN, I_MCW, I_MCB, I_WQ, I_WK, I_WV, I_WGATES, I_BGATES, I_LNW, I_SKIP, I_RCW, I_RCB, I_RWA, I_RBA, I_RWX, I_RBX, I_LAM,
       I_ONM, I_ONR, I_WOUT, I_NF2, I_WG2, I_WU2, I_WD2, I_NFIN };

template <class F> __device__ __forceinline__ void tr_item(F src, int K, bf16_t* WT, float* scr, int item, int nblk, int lane) {
    const int kb = item / nblk, nb = item % nblk, k0 = 64 * kb, n0 = 32 * nb;
#pragma unroll 8
    for (int i = 0; i < 32; ++i) { const int kk = 2 * i + (lane >> 5); scr[kk * 33 + (lane & 31)] = src(k0 + kk, n0 + (lane & 31)); }
    __builtin_amdgcn_wave_barrier();
    const int c = lane & 7;
#pragma unroll
    for (int j = 0; j < 4; ++j) { const int n = (lane >> 3) + 8 * j; const float* s = scr + (8 * c) * 33 + n;
        u32x4 o; o.x = pk2(s[0 * 33], s[1 * 33]); o.y = pk2(s[2 * 33], s[3 * 33]); o.z = pk2(s[4 * 33], s[5 * 33]); o.w = pk2(s[6 * 33], s[7 * 33]);
        *(u32x4*)(WT + (size_t)(n0 + n) * K + k0 + 8 * c) = o; }
    __builtin_amdgcn_wave_barrier();
}

__device__ __forceinline__ void p0_prologue(const Args& a, unsigned char* lds) {
    const int tid = opaque_tid(), lane = tid & 63, wave = tid >> 6;
    const int gw = blockIdx.x * 8 + wave, NGW = gridDim.x * 8;
    float* scr = (float*)(lds + wave * 16384);
    unsigned char* ws = a.ws;
    constexpr int I1 = 16 * 176, I2 = 44 * 32, I3 = 16 * 128, I4 = 4 * 64, I5 = 32 * 32;
    constexpr int NIT = I1 + I2 + I3 + I4 + I5 + I1 + I2;
    for (int it = gw; it < NIT; it += NGW) {
        int r = it;
        if (r < I1) { const float* wg = a.in[I_WG1]; const float* wu = a.in[I_WU1]; const float* gn = a.in[I_NF1];
            tr_item([=](int k, int n) { const int c = (n >> 8) * 128 + (n & 127); return (((n >> 7) & 1) ? wu : wg)[(size_t)k * FF + c] * gn[k]; }, 1024, (bf16_t*)(ws + WS_WGU1), scr, r, 176, lane); continue; } r -= I1;
        if (r < I2) { const float* wd = a.in[I_WD1];
            tr_item([=](int k, int n) { return wd[(size_t)k * D + n]; }, FF, (bf16_t*)(ws + WS_WD1), scr, r, 32, lane); continue; } r -= I2;
        if (r < I3) { const float* w = a.in[I_WIN]; const float* gn = a.in[I_NMIX];
            tr_item([=](int k, int n) { return w[(size_t)k * 4096 + n] * gn[k]; }, 1024, (bf16_t*)(ws + WS_WIN), scr, r, 128, lane); continue; } r -= I3;
        if (r < I4) { const float* wa = a.in[I_RWA]; const float* wx = a.in[I_RWX];
            tr_item([=](int k, int n) { const int pn = n >> 8, blk = pn >> 1, hh = pn & 1, sel = (n >> 7) & 1, c = hh * 128 + (n & 127); return (sel ? wx : wa)[(size_t)blk * 65536 + (size_t)k * 256 + c]; }, 256, (bf16_t*)(ws + WS_WRG), scr, r, 64, lane); continue; } r -= I4;
        if (r < I5) { const float* w = a.in[I_WOUT]; const float* gm = a.in[I_ONM]; const float* gr = a.in[I_ONR];
            tr_item([=](int k, int n) { return w[(size_t)k * D + n] * (k < 1024 ? gm[k] : gr[k - 1024]); }, 2048, (bf16_t*)(ws + WS_WOUT), scr, r, 32, lane); continue; } r -= I5;
        if (r < I1) { const float* wg = a.in[I_WG2]; const float* wu = a.in[I_WU2]; const float* gn = a.in[I_NF2];
            tr_item([=](int k, int n) { const int c = (n >> 8) * 128 + (n & 127); return (((n >> 7) & 1) ? wu : wg)[(size_t)k * FF + c] * gn[k]; }, 1024, (bf16_t*)(ws + WS_WGU2), scr, r, 176, lane); continue; } r -= I1;
        { const float* wd = a.in[I_WD2];
            tr_item([=](int k, int n) { return wd[(size_t)k * D + n]; }, FF, (bf16_t*)(ws + WS_WD2), scr, r, 32, lane); }
    }
    {
        bf16_t* WG8 = (bf16_t*)(ws + WS_WG8);
        const float* wq = a.in[I_WQ]; const float* wk = a.in[I_WK]; const float* wv = a.in[I_WV]; const float* Wg = a.in[I_WGATES];
        const int gt = blockIdx.x * 512 + tid, NT = gridDim.x * 512;
        for (int e = gt; e < 256 * 2048 / 8; e += NT) {
            const int g = e / 256, k0 = (e % 256) * 8;
            float o[8];
#pragma unroll
            for (int j = 0; j < 8; ++j) {
                float v = 0.f;
                if (g < 8) { const int k = k0 + j, c = k & 1023, n = c >> 2, i = c & 3;
                    if (k < 1024) { for (int oo = 0; oo < 4; ++oo) v += wq[n * 16 + i * 4 + oo] * Wg[(size_t)(4 * n + oo) * 8 + g] + wk[n * 16 + i * 4 + oo] * Wg[(size_t)(1024 + 4 * n + oo) * 8 + g]; }
                    else { for (int oo = 0; oo < 4; ++oo) v += wv[n * 16 + i * 4 + oo] * Wg[(size_t)(2048 + 4 * n + oo) * 8 + g]; } }
                o[j] = v;
            }
            *(u32x4*)(WG8 + (size_t)g * 2048 + k0) = pack8(o);
        }
    }
    if (blockIdx.x == 0) { float* C8 = (float*)(ws + WS_C8); const float* lam = a.in[I_LAM]; for (int e = tid; e < 1024; e += 512) C8[e] = 8.0f * logsig_acc_(lam[e]); }
    {
        const float* x = a.in[I_X]; bf16_t* XB = (bf16_t*)(ws + WS_XB); float* SS = (float*)(ws + WS_SSA);
        for (int m0 = gw; m0 < T; m0 += 2 * NGW) {
            const bool two = (m0 + NGW < T);
            f32x4 v[2][4];
#pragma unroll
            for (int q = 0; q < 2; ++q) { const int m = (q == 0 || two) ? m0 + q * NGW : m0; const f32x4* xr = (const f32x4*)(x + (size_t)m * D) + lane;
#pragma unroll
                for (int j = 0; j < 4; ++j) v[q][j] = xr[64 * j]; }
#pragma unroll
            for (int q = 0; q < 2; ++q) {
                if (q == 1 && !two) break;
                const int m = m0 + q * NGW; float s = 0.f;
#pragma unroll
                for (int j = 0; j < 4; ++j) s += (v[q][j][0] * v[q][j][0] + v[q][j][1] * v[q][j][1]) + (v[q][j][2] * v[q][j][2] + v[q][j][3] * v[q][j][3]);
                s = wave_sum(s);
                u32x2* o8 = (u32x2*)(XB + (size_t)m * D) + lane;
#pragma unroll
                for (int j = 0; j < 4; ++j) { u32x2 w; w.x = pk2(v[q][j][0], v[q][j][1]); w.y = pk2(v[q][j][2], v[q][j][3]); o8[64 * j] = w; }
                if (lane < 16) SS[(size_t)m * 16 + lane] = (lane == 0) ? s : 0.f;
            }
        }
    }
}

template <bool SILU> __device__ __forceinline__ void conv_part(const bf16_t* in, bf16_t* out, const float* cw, const float* cb, int t0, int c0) {
    float w[4][8], b[8];
#pragma unroll
    for (int tap = 0; tap < 4; ++tap) { const f32x4 p = *(const f32x4*)(cw + tap * D + c0), q = *(const f32x4*)(cw + tap * D + c0 + 4); for (int j = 0; j < 4; ++j) { w[tap][j] = p[j]; w[tap][4 + j] = q[j]; } }
    { const f32x4 p = *(const f32x4*)(cb + c0), q = *(const f32x4*)(cb + c0 + 4); for (int j = 0; j < 4; ++j) { b[j] = p[j]; b[4 + j] = q[j]; } }
    float h0[8], h1[8], h2[8];
    const bool first = (t0 % SEQ) == 0;
    if (first) { for (int j = 0; j < 8; ++j) { h0[j] = 0.f; h1[j] = 0.f; h2[j] = 0.f; } }
    else {
        unpack8(*(const u32x4*)(in + (size_t)(t0 - 3) * D + c0), h0); unpack8(*(const u32x4*)(in + (size_t)(t0 - 2) * D + c0), h1); unpack8(*(const u32x4*)(in + (size_t)(t0 - 1) * D + c0), h2);
    }
    u32x4 cur[8];
#pragma unroll
    for (int i = 0; i < 8; ++i) cur[i] = *(const u32x4*)(in + (size_t)(t0 + i) * D + c0);
#pragma unroll
    for (int i = 0; i < 8; ++i) {
        float x[8], y[8]; unpack8(cur[i], x);
#pragma unroll
        for (int j = 0; j < 8; ++j) { float v = b[j] + w[0][j] * h0[j] + w[1][j] * h1[j] + w[2][j] * h2[j] + w[3][j] * x[j]; y[j] = SILU ? siluf_(v) : v; h0[j] = h1[j]; h1[j] = h2[j]; h2[j] = x[j]; }
        *(u32x4*)(out + (size_t)(t0 + i) * D + c0) = pack8(y);
    }
}
__device__ __forceinline__ void p4_conv(const Args& a) {
    unsigned char* ws = a.ws; const int tid = opaque_tid(), cgp = tid & 127, ts = tid >> 7;
    for (int u = blockIdx.x; u < T / 32; u += gridDim.x) {
        const int t0 = u * 32 + ts * 8, c0 = cgp * 8;
        conv_part<true>((const bf16_t*)(ws + WS_XM), (bf16_t*)(ws + WS_XC), a.in[I_MCW], a.in[I_MCB], t0, c0);
        conv_part<false>((const bf16_t*)(ws + WS_XR), (bf16_t*)a.out + (size_t)T * D  , a.in[I_RCW], a.in[I_RCB], t0, c0);
    }
}

__device__ __forceinline__ void p6_rg_agg(const Args& a) {
    unsigned char* ws = a.ws; const int tid = opaque_tid();
    const unsigned* LOGA = (const unsigned*)(ws + WS_XR); const unsigned* U = (const unsigned*)(ws + WS_U); float* AGG = (float*)(ws + WS_AGG);
    for (int tile = blockIdx.x; tile < 256; tile += gridDim.x) {
        const size_t row0 = (size_t)tile * 128;
        float sl0 = 0.f, sl1 = 0.f, h0 = 0.f, h1 = 0.f;
        for (int i0 = 0; i0 < 128; i0 += 16) {
            unsigned la[16], uu[16];
#pragma unroll
            for (int i = 0; i < 16; ++i) { la[i] = LOGA[(row0 + i0 + i) * 512 + tid]; uu[i] = U[(row0 + i0 + i) * 512 + tid]; }
#pragma unroll
            for (int i = 0; i < 16; ++i) { const float l0 = bflo(la[i]), l1 = bfhi(la[i]); sl0 += l0; sl1 += l1; h0 = __expf(l0) * h0 + bflo(uu[i]); h1 = __expf(l1) * h1 + bfhi(uu[i]); }
        }
        f32x4 o = {sl0, h0, sl1, h1};
        *(f32x4*)(AGG + ((size_t)tile * 1024 + 2 * tid) * 2) = o;
    }
}

template <int CTRL, int RMASK> __device__ __forceinline__ float dppf(float old, float src) {
    return __builtin_bit_cast(float, __builtin_amdgcn_update_dpp(__builtin_bit_cast(int, old), __builtin_bit_cast(int, src), CTRL, RMASK, 0xf, false));
}
__device__ __forceinline__ float readlane_f(float v, int l) { return __builtin_bit_cast(float, __builtin_amdgcn_readlane(__builtin_bit_cast(int, v), l)); }

namespace ml {
constexpr int QP = 264, SP = 72;
constexpr int O_QS = 0, O_KS = 33792, O_SS = 67584, O_VT = 76800, O_VW = 81408, O_CS = 86016, O_OSM = 102912, O_TAB = 111360, O_WTS = 113920, O_END = 126208;
}
__device__ __forceinline__ unsigned char* sraw_ptr(unsigned char* ws, int u) {
    return u < 1600 ? ws + (size_t)u * 5120 : (u < 2000 ? ws + 62 * MiB + (size_t)(u - 1600) * 5120 : ws + 12 * MiB + 512 * 1024 + (size_t)(u - 2000) * 5120);
}
__device__ __forceinline__ void p5b_sraw(const Args& a, unsigned char* lds) {
    using namespace ml;
    unsigned char* ws = a.ws;
    const int tid = opaque_tid(), lane = tid & 63, w = __builtin_amdgcn_readfirstlane(tid >> 6), fr = lane & 15, fq = lane >> 4;
    bf16_t* Qs = (bf16_t*)(lds + O_QS); bf16_t* Ks = (bf16_t*)(lds + O_KS); float* WTS = (float*)(lds + O_WTS);
    const bf16_t* XC = (const bf16_t*)(ws + WS_XC); bf16_t* QG = (bf16_t*)a.out;
    const int srow = tid >> 5, scol = (tid & 31) * 8;
    for (int g = blockIdx.x; g < 256; g += gridDim.x) {
        const int bh = g >> 4, c0 = (g & 15) * 8, b = bh >> 2, h = bh & 3;
        __syncthreads();
        for (int e = tid; e < 1024; e += 512) { const int gg = e >> 4, bb = (e >> 2) & 3, aa = e & 3; const float* wq = a.in[I_WQ] + (h * 64 + gg) * 16; const float* wk = a.in[I_WK] + (h * 64 + gg) * 16;
            float v = 0.f; for (int o = 0; o < 4; ++o) v += wq[bb * 4 + o] * wk[aa * 4 + o]; WTS[e] = v * 0.0625f; }
        __syncthreads();
        const int lg0 = (tid & 31) * 2;
        f32x4 Wq[2][4];
#pragma unroll
        for (int g2 = 0; g2 < 2; ++g2)
#pragma unroll
            for (int i = 0; i < 4; ++i) Wq[g2][i] = *(const f32x4*)(WTS + (lg0 + g2) * 16 + i * 4);
        u32x4 xn[4];
#pragma unroll
        for (int i = 0; i < 4; ++i) xn[i] = *(const u32x4*)(XC + ((size_t)b * SEQ + (size_t)c0 * 64 + srow + 16 * i) * D + h * 256 + scol);
        for (int cc = 0; cc < 8; ++cc) {
            const int c = c0 + cc; const size_t t0 = (size_t)b * SEQ + (size_t)c * 64;
            u32x4 xr[4];
#pragma unroll
            for (int i = 0; i < 4; ++i) xr[i] = xn[i];
            if (cc + 1 < 8) {
#pragma unroll
                for (int i = 0; i < 4; ++i) xn[i] = *(const u32x4*)(XC + (t0 + 64 + srow + 16 * i) * D + h * 256 + scol);
            }
#pragma unroll
            for (int i = 0; i < 4; ++i) {
                float x[8]; unpack8(xr[i], x);
                float q[8];
#pragma unroll
                for (int g2 = 0; g2 < 2; ++g2) {
                    const f32x4 qq = Wq[g2][0] * x[4 * g2] + Wq[g2][1] * x[4 * g2 + 1] + Wq[g2][2] * x[4 * g2 + 2] + Wq[g2][3] * x[4 * g2 + 3];
                    for (int j = 0; j < 4; ++j) q[4 * g2 + j] = qq[j];
                }
                const int r = srow + 16 * i; const u32x4 qp = pack8(q);
                *(u32x4*)(Qs + r * QP + scol) = qp; *(u32x4*)(Ks + r * QP + scol) = xr[i];
                *(u32x4*)(QG + (t0 + r) * D + h * 256 + scol) = qp;
            }
            __syncthreads();
            {
                unsigned char* sp = sraw_ptr(ws, bh * 128 + c);
#define S_DECODE(li, it, jt) do { if ((li) < 4) { it = 3; jt = (li); } else if ((li) < 7) { it = 2; jt = (li) - 4; } else if ((li) < 9) { it = 1; jt = (li) - 7; } else { it = 0; jt = 0; } } while (0)
#define S_EPI(li, sv) do { u32x2 wv_; wv_.x = pk2(sv[0], sv[1]); wv_.y = pk2(sv[2], sv[3]); *(u32x2*)(sp + (li) * 512 + lane * 8) = wv_; } while (0)
                int it0, jt0, it1 = 0, jt1 = 0; S_DECODE(w, it0, jt0);
                const bool two = (w < 2); if (two) S_DECODE(w + 8, it1, jt1);
                f32x4 sA = (f32x4){0.f, 0.f, 0.f, 0.f}, sB = sA, tA = sA, tB = sA;
                const bf16_t* k0p = Ks + (jt0 * 16 + fr) * QP + fq * 8; const bf16_t* q0p = Qs + (it0 * 16 + fr) * QP + fq * 8;
                const bf16_t* k1p = Ks + (jt1 * 16 + fr) * QP + fq * 8; const bf16_t* q1p = Qs + (it1 * 16 + fr) * QP + fq * 8;
#pragma unroll
                for (int ks = 0; ks < 8; ks += 2) {
                    sA = __builtin_amdgcn_mfma_f32_16x16x32_bf16(*(const bf16x8*)(k0p + ks * 32), *(const bf16x8*)(q0p + ks * 32), sA, 0, 0, 0);
                    sB = __builtin_amdgcn_mfma_f32_16x16x32_bf16(*(const bf16x8*)(k0p + ks * 32 + 32), *(const bf16x8*)(q0p + ks * 32 + 32), sB, 0, 0, 0);
                    if (two) {
                        tA = __builtin_amdgcn_mfma_f32_16x16x32_bf16(*(const bf16x8*)(k1p + ks * 32), *(const bf16x8*)(q1p + ks * 32), tA, 0, 0, 0);
                        tB = __builtin_amdgcn_mfma_f32_16x16x32_bf16(*(const bf16x8*)(k1p + ks * 32 + 32), *(const bf16x8*)(q1p + ks * 32 + 32), tB, 0, 0, 0);
                    }
                }
                const f32x4 s0 = sA + sB; S_EPI(w, s0);
                if (two) { const f32x4 s1 = tA + tB; S_EPI(w + 8, s1); }
#undef S_DECODE
#undef S_EPI
            }
            __syncthreads();
        }
    }
}

__device__ __forceinline__ void p6_mlstm(const Args& a, unsigned char* lds) {
    using namespace ml;
    unsigned char* ws = a.ws;
    const int tid = opaque_tid(), lane = tid & 63, w = __builtin_amdgcn_readfirstlane(tid >> 6), fr = lane & 15, fq = lane >> 4;
    bf16_t* Qs = (bf16_t*)(lds + O_QS); bf16_t* Ks = (bf16_t*)(lds + O_KS); bf16_t* Ss = (bf16_t*)(lds + O_SS);
    bf16_t* Vt = (bf16_t*)(lds + O_VT); bf16_t* Vw = (bf16_t*)(lds + O_VW); bf16_t* Cs = (bf16_t*)(lds + O_CS);
    float* Osm = (float*)(lds + O_OSM); float* TAB = (float*)(lds + O_TAB); float* WTS = (float*)(lds + O_WTS);
    const bf16_t* XC = (const bf16_t*)(ws + WS_XC); const bf16_t* XM = (const bf16_t*)(ws + WS_XM); const float* GATES = (const float*)(ws + WS_GATES);
    const bf16_t* QG = (const bf16_t*)a.out;
    bf16_t* HM = (bf16_t*)a.out + (size_t)T * D;
    for (int unit = blockIdx.x; unit < 256; unit += gridDim.x) {
        const int xcd = unit & 7, idx = unit >> 3, bh = xcd * 2 + (idx >> 4), vs = idx & 15, b = bh >> 2, h = bh & 3;
        __syncthreads();
        for (int e = tid; e < 64 * SP / 2; e += 512) ((unsigned*)Ss)[e] = 0u;
        for (int e = tid; e < 32 * SP / 2; e += 512) { const int row = e / (SP / 2); ((unsigned*)Vt)[e] = (row == 16) ? 0x3F803F80u : 0u; ((unsigned*)Vw)[e] = 0u; }
        for (int e = tid; e < 32 * QP / 2; e += 512) ((unsigned*)Cs)[e] = 0u;
        for (int e = tid; e < 1024; e += 512) WTS[2048 + e] = a.in[I_WV][h * 1024 + e];
        f32x4 Cacc[2][2];
#pragma unroll
        for (int i = 0; i < 2; ++i)
#pragma unroll
            for (int j = 0; j < 2; ++j) Cacc[i][j] = (f32x4){0.f, 0.f, 0.f, 0.f};
        const int srow = tid >> 5, scol = (tid & 31) * 8;
        const int vrow = tid >> 1, vhalf = tid & 1;
        const size_t tbase = (size_t)b * SEQ;
        u32x4 xr[4], qr[4], xmr = (u32x4){0u, 0u, 0u, 0u}; float gi, gf;
        u32x2 sr0 = (u32x2){0u, 0u}, sr1 = (u32x2){0u, 0u};
        {
            const size_t t0 = tbase;
#pragma unroll
            for (int i = 0; i < 4; ++i) { xr[i] = *(const u32x4*)(XC + (t0 + srow + 16 * i) * D + h * 256 + scol); qr[i] = *(const u32x4*)(QG + (t0 + srow + 16 * i) * D + h * 256 + scol); }
            if (tid < 128) xmr = *(const u32x4*)(XM + (t0 + vrow) * D + h * 256 + vs * 16 + vhalf * 8);
            gi = GATES[(t0 + lane) * 8 + h]; gf = GATES[(t0 + lane) * 8 + 4 + h];
            const unsigned char* sp = sraw_ptr(ws, bh * 128);
            sr0 = *(const u32x2*)(sp + tid * 8); if (tid < 128) sr1 = *(const u32x2*)(sp + 4096 + tid * 8);
        }
        __syncthreads();
        float decay = 0.f, m_cur = -1e30f;
        constexpr int NC = SEQ / 64;
        for (int c = -1; c < NC; ++c) {
            float* tab = TAB + (c & 1) * 320;
            if (c >= 0) {
            __syncthreads();
            {
                const int rt = w & 3, vt = w >> 2;
                f32x4 a1 = (f32x4){0.f, 0.f, 0.f, 0.f}, a2 = (f32x4){0.f, 0.f, 0.f, 0.f};
#pragma unroll
                for (int ks = 0; ks < 2; ++ks) {
                    const bf16x8 sa_ = *(const bf16x8*)(Ss + (rt * 16 + fr) * SP + ks * 32 + fq * 8);
                    const bf16x8 vb = *(const bf16x8*)(Vt + (vt * 16 + fr) * SP + ks * 32 + fq * 8);
                    a1 = __builtin_amdgcn_mfma_f32_16x16x32_bf16(sa_, vb, a1, 0, 0, 0);
                }
#pragma unroll
                for (int ks = 0; ks < 8; ++ks) {
                    const bf16x8 qa = *(const bf16x8*)(Qs + (rt * 16 + fr) * QP + ks * 32 + fq * 8);
                    const bf16x8 cb = *(const bf16x8*)(Cs + (vt * 16 + fr) * QP + ks * 32 + fq * 8);
                    a2 = __builtin_amdgcn_mfma_f32_16x16x32_bf16(qa, cb, a2, 0, 0, 0);
                }
#pragma unroll
                for (int e = 0; e < 4; ++e) { const int i = rt * 16 + fq * 4 + e; Osm[i * 33 + vt * 16 + fr] = a1[e] + tab[128 + i] * a2[e]; }
            }
            {
#pragma unroll
                for (int kl = 0; kl < 2; ++kl)
#pragma unroll
                    for (int vt = 0; vt < 2; ++vt) Cacc[kl][vt] = Cacc[kl][vt] * decay;
#pragma unroll
                for (int kl = 0; kl < 2; ++kl) {
                    const int kcol = (2 * w + kl) * 16 + fr;
#pragma unroll
                    for (int ks = 0; ks < 2; ++ks) {
                        bf16x8 ka;
#pragma unroll
                        for (int e = 0; e < 8; ++e) ka[e] = (short)Ks[(ks * 32 + fq * 8 + e) * QP + kcol];
#pragma unroll
                        for (int vt = 0; vt < 2; ++vt) {
                            const bf16x8 vb = *(const bf16x8*)(Vw + (vt * 16 + fr) * SP + ks * 32 + fq * 8);
                            Cacc[kl][vt] = __builtin_amdgcn_mfma_f32_16x16x32_bf16(ka, vb, Cacc[kl][vt], 0, 0, 0);
                        }
                    }
                }
            }
            }
            float vnx[8], decay_n = 0.f, m_nx = m_cur;
            if (c + 1 < NC) {
                if (tid < 128) {
                    float x[8]; unpack8(xmr, x);
                    const int lgv = vs * 4 + vhalf * 2;
#pragma unroll
                    for (int g2 = 0; g2 < 2; ++g2) {
                        const float* Wv = WTS + 2048 + (lgv + g2) * 16;
#pragma unroll
                        for (int o = 0; o < 4; ++o) vnx[4 * g2 + o] = Wv[0 * 4 + o] * x[4 * g2] + Wv[1 * 4 + o] * x[4 * g2 + 1] + Wv[2 * 4 + o] * x[4 * g2 + 2] + Wv[3 * 4 + o] * x[4 * g2 + 3];
                    }
                }
                float sa = gf, sc = gi;
#define SCAN_STEP(CTRL, RM) do { const float ao = dppf<CTRL, RM>(0.f, sa), co = dppf<CTRL, RM>(-INFINITY, sc); sc = fmaxf(co + sa, sc); sa = ao + sa; } while (0)
                SCAN_STEP(0x111, 0xf); SCAN_STEP(0x112, 0xf); SCAN_STEP(0x114, 0xf); SCAN_STEP(0x118, 0xf);
                SCAN_STEP(0x142, 0xa);
                SCAN_STEP(0x143, 0xc);
#undef SCAN_STEP
                const float Mi = fmaxf(m_cur + sa, sc);
                const float gtot = readlane_f(sa, 63); m_nx = readlane_f(Mi, 63);
                decay_n = __expf(gtot + m_cur - m_nx);
                if (w == 0) {
                    float* tn = TAB + ((c + 1) & 1) * 320;
                    tn[lane] = sa - Mi; tn[64 + lane] = gi - sa; tn[128 + lane] = __expf(sa + m_cur - Mi); tn[192 + lane] = __expf(-Mi); tn[256 + lane] = __expf(gtot - sa + gi - m_nx);
                }
            }
            if (c >= 0) {
            __syncthreads();
            {
#pragma unroll
                for (int kl = 0; kl < 2; ++kl)
#pragma unroll
                    for (int vt = 0; vt < 2; ++vt) {
                        u32x2 wv; wv.x = pk2(Cacc[kl][vt][0], Cacc[kl][vt][1]); wv.y = pk2(Cacc[kl][vt][2], Cacc[kl][vt][3]);
                        *(u32x2*)(Cs + (vt * 16 + fr) * QP + (2 * w + kl) * 16 + fq * 4) = wv;
                    }
                const int i = tid >> 3, vp = (tid & 7) * 2;
                const float den = Osm[i * 33 + 16], dn = fmaxf(fabsf(den), tab[192 + i]);
                const float rdn = __builtin_amdgcn_rcpf(dn); const float h0 = Osm[i * 33 + vp] * rdn, h1 = Osm[i * 33 + vp + 1] * rdn;
                *(unsigned*)(HM + ((size_t)(bh * 16 + vs) * SEQ + (size_t)c * 64 + i) * 16 + vp) = pk2(h0, h1);
            }
            }
            if (c + 1 < NC) {
#pragma unroll
                for (int i = 0; i < 4; ++i) { const int r = srow + 16 * i; *(u32x4*)(Qs + r * QP + scol) = qr[i]; *(u32x4*)(Ks + r * QP + scol) = xr[i]; }
                if (c < 0) __syncthreads();
                const float* tn = TAB + ((c + 1) & 1) * 320;
                if (tid < 128) {
                    const float wk = tn[256 + vrow];
#pragma unroll
                    for (int e = 0; e < 8; ++e) { Vt[(vhalf * 8 + e) * SP + vrow] = (bf16_t)(pk2(vnx[e], 0.f) & 0xffffu); Vw[(vhalf * 8 + e) * SP + vrow] = (bf16_t)(pk2(vnx[e] * wk, 0.f) & 0xffffu); }
                } else if (tid < 192) { Vw[16 * SP + (tid - 128)] = (bf16_t)(pk2(tn[256 + tid - 128], 0.f) & 0xffffu); }
#define SS_ITEM(li, sr) do { int it_, jt_; if ((li) < 4) { it_ = 3; jt_ = (li); } else if ((li) < 7) { it_ = 2; jt_ = (li) - 4; } else if ((li) < 9) { it_ = 1; jt_ = (li) - 7; } else { it_ = 0; jt_ = 0; } \
        const int i_ = it_ * 16 + fr, j0_ = jt_ * 16 + fq * 4; const float rf_ = tn[i_]; const f32x4 cf_ = *(const f32x4*)(tn + 64 + j0_); \
        const float sv_[4] = {bflo((sr).x), bfhi((sr).x), bflo((sr).y), bfhi((sr).y)}; float o_[4]; \
        _Pragma("unroll") for (int e = 0; e < 4; ++e) o_[e] = (j0_ + e <= i_) ? sv_[e] * __expf(rf_ + cf_[e]) : 0.f; \
        u32x2 wv_; wv_.x = pk2(o_[0], o_[1]); wv_.y = pk2(o_[2], o_[3]); *(u32x2*)(Ss + i_ * SP + j0_) = wv_; } while (0)
                SS_ITEM(w, sr0);
                if (w < 2) SS_ITEM(w + 8, sr1);
#undef SS_ITEM
                decay = decay_n; m_cur = m_nx;
                if (c + 2 < NC) {
                    const size_t t2 = tbase + (size_t)(c + 2) * 64;
#pragma unroll
                    for (int i = 0; i < 4; ++i) { xr[i] = *(const u32x4*)(XC + (t2 + srow + 16 * i) * D + h * 256 + scol); qr[i] = *(const u32x4*)(QG + (t2 + srow + 16 * i) * D + h * 256 + scol); }
                    if (tid < 128) xmr = *(const u32x4*)(XM + (t2 + vrow) * D + h * 256 + vs * 16 + vhalf * 8);
                    gi = GATES[(t2 + lane) * 8 + h]; gf = GATES[(t2 + lane) * 8 + 4 + h];
                    const unsigned char* sp = sraw_ptr(ws, bh * 128 + c + 2);
                    sr0 = *(const u32x2*)(sp + tid * 8); if (tid < 128) sr1 = *(const u32x2*)(sp + 4096 + tid * 8);
                }
            }
        }
    }
}

__device__ __forceinline__ void p7_mlstm_fin(const Args& a) {
    unsigned char* ws = a.ws; const int tid = opaque_tid(), lane = tid & 63, wave = tid >> 6;
    const int gw = blockIdx.x * 8 + wave, NGW = gridDim.x * 8;
    const bf16_t* HM = (const bf16_t*)a.out + (size_t)T * D; const bf16_t* XC = (const bf16_t*)(ws + WS_XC); bf16_t* ZM = (bf16_t*)(ws + WS_ZM);
    float lnw[16], skp[16];
#pragma unroll
    for (int j = 0; j < 4; ++j) { const f32x4 p = *(const f32x4*)(a.in[I_LNW] + lane * 16 + 4 * j), q = *(const f32x4*)(a.in[I_SKIP] + lane * 16 + 4 * j); for (int e = 0; e < 4; ++e) { lnw[4 * j + e] = p[e]; skp[4 * j + e] = q[e]; } }
    for (int m = gw; m < T; m += NGW) {
        const size_t off = (size_t)m * D + lane * 16;
        float hv[16], xc[16], z[16];
        { const size_t hoff = ((size_t)(((m / SEQ) * 4 + (lane >> 4)) * 16 + (lane & 15)) * SEQ + (size_t)(m % SEQ)) * 16;
          unpack8(*(const u32x4*)(HM + hoff), hv); unpack8(*(const u32x4*)(HM + hoff + 8), hv + 8); }
        unpack8(*(const u32x4*)(XC + off), xc); unpack8(*(const u32x4*)(XC + off + 8), xc + 8);
        unpack8(*(const u32x4*)(ZM + off), z); unpack8(*(const u32x4*)(ZM + off + 8), z + 8);
        float s = 0.f;
#pragma unroll
        for (int e = 0; e < 16; ++e) s += hv[e];
        s += __shfl_xor(s, 1); s += __shfl_xor(s, 2); s += __shfl_xor(s, 4); s += __shfl_xor(s, 8);
        const float mu = s * (1.0f / 256.0f); float q = 0.f;
#pragma unroll
        for (int e = 0; e < 16; ++e) { hv[e] -= mu; q += hv[e] * hv[e]; }
        q += __shfl_xor(q, 1); q += __shfl_xor(q, 2); q += __shfl_xor(q, 4); q += __shfl_xor(q, 8);
        const float rstd = rsqrtf(q * (1.0f / 256.0f) + EPS);
        float o[16], ss = 0.f;
#pragma unroll
        for (int e = 0; e < 16; ++e) { o[e] = (hv[e] * rstd * lnw[e] + skp[e] * xc[e]) * siluf_(z[e]); ss += o[e] * o[e]; }
        ss = wave_sum(ss);
        const float rs = rsqrtf(ss * (1.0f / 1024.0f) + EPS);
#pragma unroll
        for (int e = 0; e < 16; ++e) o[e] *= rs;
        *(u32x4*)(ZM + off) = pack8(o); *(u32x4*)(ZM + off + 8) = pack8(o + 8);
    }
}
__device__ __forceinline__ void p7_rg_fin(const Args& a, unsigned char* lds) {
    unsigned char* ws = a.ws; const int tid = opaque_tid();
    unsigned* LOGA = (unsigned*)(ws + WS_XR); const unsigned* U = (const unsigned*)(ws + WS_U); const unsigned* YR = (const unsigned*)(ws + WS_YR); const float* AGG = (const float*)(ws + WS_AGG);
    float* Ot = (float*)lds;
    constexpr int OP = 1028;
    for (int tile = blockIdx.x; tile < 256; tile += gridDim.x) {
        const int tc = tile & 63, tb = tile & ~63;
        float h0 = 0.f, h1 = 0.f;
        for (int p = 0; p < tc; ++p) { const f32x4 g = *(const f32x4*)(AGG + ((size_t)(tb + p) * 1024 + 2 * tid) * 2); h0 = __expf(g[0]) * h0 + g[1]; h1 = __expf(g[2]) * h1 + g[3]; }
        const size_t row0 = (size_t)tile * 128;
        for (int i0 = 0; i0 < 128; i0 += 16) {
            unsigned la[16], uu[16], yy[16];
#pragma unroll
            for (int i = 0; i < 16; ++i) { const size_t o = (row0 + i0 + i) * 512 + tid; la[i] = LOGA[o]; uu[i] = U[o]; yy[i] = YR[o]; }
            __syncthreads();
#pragma unroll
            for (int i = 0; i < 16; ++i) {
                h0 = __expf(bflo(la[i])) * h0 + bflo(uu[i]); h1 = __expf(bfhi(la[i])) * h1 + bfhi(uu[i]);
                Ot[i * OP + 2 * tid] = h0 * geluf_(bflo(yy[i])); Ot[i * OP + 2 * tid + 1] = h1 * geluf_(bfhi(yy[i]));
            }
            __syncthreads();
            {
                const int row = tid >> 5, sub = tid & 31;
                f32x4 v[4][2]; float ss = 0.f;
#pragma unroll
                for (int q = 0; q < 4; ++q)
#pragma unroll
                    for (int hh = 0; hh < 2; ++hh) { v[q][hh] = *(const f32x4*)(Ot + row * OP + q * 256 + sub * 8 + hh * 4); const f32x4 t = v[q][hh]; ss += (t[0] * t[0] + t[1] * t[1]) + (t[2] * t[2] + t[3] * t[3]); }
                ss += __shfl_xor(ss, 1); ss += __shfl_xor(ss, 2); ss += __shfl_xor(ss, 4); ss += __shfl_xor(ss, 8); ss += __shfl_xor(ss, 16);
                const float rs = rsqrtf(ss * (1.0f / 1024.0f) + EPS);
                bf16_t* orow = (bf16_t*)LOGA + (row0 + i0 + row) * D;
#pragma unroll
                for (int q = 0; q < 4; ++q) { const f32x4 p = v[q][0] * rs, r = v[q][1] * rs; u32x4 wv; wv.x = pk2(p[0], p[1]); wv.y = pk2(p[2], p[3]); wv.z = pk2(r[0], r[1]); wv.w = pk2(r[2], r[3]); *(u32x4*)(orow + q * 256 + sub * 8) = wv; }
            }
        }
        __syncthreads();
    }
}

__device__ __forceinline__ void p11_final(const Args& a) {
    const int tid = opaque_tid(), lane = tid & 63, wave = tid >> 6;
    const int gw = blockIdx.x * 8 + wave, NGW = gridDim.x * 8;
    const float* SS = (const float*)(a.ws + WS_SSD); const float* gn = a.in[I_NFIN]; const bf16_t* X3 = (const bf16_t*)(a.ws + WS_XB);
    f32x4 g[4];
#pragma unroll
    for (int j = 0; j < 4; ++j) g[j] = *((const f32x4*)gn + lane * 4 + j);
    for (int m0 = gw; m0 < T; m0 += 2 * NGW) {
        const bool two = (m0 + NGW < T);
        const int m1 = two ? m0 + NGW : m0;
        const size_t off0 = (size_t)m0 * D + lane * 16, off1 = (size_t)m1 * D + lane * 16;
        const u32x4 a0 = *(const u32x4*)(X3 + off0), a1 = *(const u32x4*)(X3 + off0 + 8), b0 = *(const u32x4*)(X3 + off1), b1 = *(const u32x4*)(X3 + off1 + 8);
        const float rs0 = pg8::row_scale(SS, m0), rs1 = pg8::row_scale(SS, m1);
        float x[16];
        unpack8(a0, x); unpack8(a1, x + 8);
        { f32x4* o = (f32x4*)(a.out + off0);
#pragma unroll
          for (int j = 0; j < 4; ++j) { f32x4 v = (f32x4){x[4 * j], x[4 * j + 1], x[4 * j + 2], x[4 * j + 3]}; o[j] = v * rs0 * g[j]; } }
        if (two) {
            unpack8(b0, x); unpack8(b1, x + 8);
            f32x4* o = (f32x4*)(a.out + off1);
#pragma unroll
            for (int j = 0; j < 4; ++j) { f32x4 v = (f32x4){x[4 * j], x[4 * j + 1], x[4 * j + 2], x[4 * j + 3]}; o[j] = v * rs1 * g[j]; }
        }
    }
}

#define XB_TMO      128
#define XB_XCNT(j)  (256  + 64 * (j))
#define XB_XSUB(j)  (1280 + 64 * (j))
#define XB_XGEN(j)  (2304 + 64 * (j))
#define XB_TOP      3328
#define XB_TOPGEN   3392
#define XCD_BAR_WORDS 3456
#define XB_SPIN_CAP (1u << 18)
__device__ __forceinline__ unsigned xb_ld(unsigned* p)              { return __hip_atomic_load(p, __ATOMIC_RELAXED, __HIP_MEMORY_SCOPE_AGENT); }
__device__ __forceinline__ unsigned xb_add(unsigned* p, unsigned v) { return __hip_atomic_fetch_add(p, v, __ATOMIC_RELAXED, __HIP_MEMORY_SCOPE_AGENT); }
__device__ __forceinline__ unsigned xb_xcc_id() { return (unsigned)__builtin_amdgcn_s_getreg((3 << 11) | 20) & 0xFu; }
#define XB_SPIN(cond, bar) do { unsigned _sp = 0; while (cond) { __builtin_amdgcn_s_sleep(1); \
    if ((++_sp & 255u) == 0u) { if (xb_ld(&(bar)[XB_TMO])) break; if (_sp > XB_SPIN_CAP) { atomicAdd(&(bar)[XB_TMO], 1u); break; } } } } while (0)
struct XcdBarrier { unsigned* bar; unsigned x; volatile LAS unsigned* st; };
__device__ __forceinline__ XcdBarrier xcd_barrier_post(unsigned* bar, volatile LAS unsigned* st) {
    XcdBarrier b; b.bar = bar; b.x = xb_xcc_id(); b.st = st;
    if (threadIdx.x == 0) (void)xb_add(&bar[XB_XCNT(b.x)], 1u);
    return b;
}
__device__ __forceinline__ void xcd_barrier_complete(unsigned* bar, unsigned x, unsigned& nloc, unsigned& nx) {
    const unsigned G = gridDim.x * gridDim.y * gridDim.z;
    unsigned sum, cnt, mine, sp = 0u;
    for (;;) {
        sum = 0u; cnt = 0u; mine = 0u;
#pragma unroll
        for (unsigned j = 0; j < 16; ++j) { const unsigned c = xb_ld(&bar[XB_XCNT(j)]); sum += c; cnt += (c > 0u) ? 1u : 0u; mine = (j == x) ? c : mine; }
        if (sum == G) break;
        __builtin_amdgcn_s_sleep(1);
        if ((++sp & 255u) == 0u) { if (xb_ld(&bar[XB_TMO])) break; if (sp > XB_SPIN_CAP) { atomicAdd(&bar[XB_TMO], 1u); break; } }
    }
    nloc = mine > 0u ? mine : 1u; nx = cnt > 0u ? cnt : 1u;
}
__device__ __forceinline__ void xcd_barrier(const XcdBarrier& b) {
    asm volatile("s_waitcnt vmcnt(0)" ::: "memory");
    __syncthreads();
    if (threadIdx.x == 0) {
        unsigned* bar = b.bar;
        __builtin_amdgcn_s_waitcnt(0);
        unsigned nloc = b.st[0], nx = b.st[1];
        if (nloc == 0u) { xcd_barrier_complete(bar, b.x, nloc, nx); b.st[0] = nloc; b.st[1] = nx; }
        const unsigned old = xb_add(&bar[XB_XSUB(b.x)], 1u);
        const unsigned gen = old / nloc;
        if (old + 1u == (gen + 1u) * nloc) {
            __builtin_amdgcn_fence(__ATOMIC_RELEASE, "agent");
            asm volatile("s_waitcnt vmcnt(0)" ::: "memory");
            const unsigned og = xb_add(&bar[XB_TOP], 1u);
            const unsigned tg = og / nx;
            if (og + 1u == (tg + 1u) * nx) xb_add(&bar[XB_TOPGEN], 1u);
            else XB_SPIN(xb_ld(&bar[XB_TOPGEN]) == tg, bar);
            __builtin_amdgcn_fence(__ATOMIC_ACQUIRE, "agent");
            xb_add(&bar[XB_XGEN(b.x)], 1u);
            asm volatile("s_waitcnt vmcnt(0)" ::: "memory");
        } else {
            XB_SPIN(xb_ld(&bar[XB_XGEN(b.x)]) == gen, bar);
            __builtin_amdgcn_fence(__ATOMIC_ACQUIRE, "agent");
            asm volatile("s_waitcnt vmcnt(0)" ::: "memory");
        }
    }
    __syncthreads();
}
#define GSYNC() xcd_barrier(xbar)
__global__ void __launch_bounds__(512, 2) mk_fwd(Args args) {
    extern __shared__ __attribute__((aligned(16))) unsigned char lds_raw[];
    cg::grid_group grid = cg::this_grid();
    LAS unsigned char* lds = (LAS unsigned char*)lds_raw;
    unsigned char* ws = args.ws;
    const int G = gridDim.x, bid = blockIdx.x;
    volatile LAS unsigned* xst = (volatile LAS unsigned*)(lds + (LDS_BYTES - 64));
    if (threadIdx.x == 0) { xst[0] = 0u; xst[1] = 0u; }
    __syncthreads();
    const XcdBarrier xbar = xcd_barrier_post((unsigned*)(ws + WS_BAR), xst);
    bf16_t* XB = (bf16_t*)(ws + WS_XB); bf16_t* ACT = (bf16_t*)(ws + WS_R1);
#ifndef NO_P0
    p0_prologue(args, lds_raw);
#endif
    GSYNC();
    if (gridDim.x == 0x7fffffffu) grid.sync();
#ifndef NO_P1
    { const pg8::Gemm gUp1{XB, (const bf16_t*)(ws + WS_WGU1), 1024, 1024, 1 << 30, 0, 0, 0}; pg8::StaticOrder S; S.init(T, 2 * FF, G, bid); pg8::EpiSwiGLU E{ACT, (const float*)(ws + WS_SSA)}; pg8::gemm_phase(lds, gUp1, S, E); }
#endif
    GSYNC();
#ifndef NO_P2
    { const pg8::Gemm gDn1{ACT, (const bf16_t*)(ws + WS_WD1), FF, FF, 1 << 30, 0, 0, 0}; pg8::StaticOrder S; S.init(T, D, G, bid); pg8::EpiResidB E{nullptr, XB  , XB  , nullptr, (float*)(ws + WS_SSB), 0.5f}; pg8::gemm_phase(lds, gDn1, S, E); }
#endif
    GSYNC();
#ifndef NO_P3
    { const pg8::Gemm gIn{XB, (const bf16_t*)(ws + WS_WIN), 1024, 1024, 1 << 30, 0, 0, 0}; pg8::StaticOrder S; S.init(T, 4096, G, bid); pg8::EpiProj E{(bf16_t*)(ws + WS_XM), (const float*)(ws + WS_SSB)}; pg8::gemm_phase(lds, gIn, S, E); }
#endif
    GSYNC();
#ifndef NO_P4
    p4_conv(args);
#endif
    GSYNC();
#ifndef NO_P5
    {
        const bf16_t* XCR = (const bf16_t*)args.out + (size_t)T * D;
        const pg8::Gemm gRg{XCR, (const bf16_t*)(ws + WS_WRG), 256, 1024, 1 << 30, 0, 1, 512};
        const pg8::Gemm gGt{(const bf16_t*)(ws + WS_XC), (const bf16_t*)(ws + WS_WG8), 2048, 1024, 16, (long)WS_XM - (long)WS_XC - 16 * 128, 0, 0};
        pg8::EpiGates Eg{(float*)(ws + WS_GATES), args.in[I_BGATES]};
        pg8::EpiRg Er{XCR, args.in[I_RBA], args.in[I_RBX], (const float*)(ws + WS_C8), (bf16_t*)(ws + WS_XR), (bf16_t*)(ws + WS_U)};
        if (G == 256) {
#ifndef NO_P5G
            if (bid < 128) { pg8::ListOrder S{bid, 1, 0}; pg8::gemm_phase(lds, gGt, S, Eg); }
#endif
#ifndef NO_P5R
            if (bid >= 128) { pg8::ListOrder S{(bid - 128) * 8, 8, 3}; pg8::gemm_phase(lds, gRg, S, Er); }
#endif
        } else {
#ifndef NO_P5G
            for (int u = bid; u < 128; u += G) { pg8::ListOrder S{u, 1, 0}; pg8::gemm_phase(lds, gGt, S, Eg); }
#endif
#ifndef NO_P5R
            for (int u = bid; u < 128; u += G) { pg8::ListOrder S{u * 8, 8, 3}; pg8::gemm_phase(lds, gRg, S, Er); }
#endif
        }
    }
#endif
    GSYNC();
#ifndef NO_P6A
    p6_rg_agg(args);
#endif
    p5b_sraw(args, lds_raw);
    GSYNC();
#ifndef NO_P6
    p6_mlstm(args, lds_raw);
#endif
    GSYNC();
#ifndef NO_P7A
    p7_mlstm_fin(args);
#endif
#ifndef NO_P7B
    p7_rg_fin(args, lds_raw);
#endif
    GSYNC();
#ifndef NO_P8
    { const pg8::Gemm gOut{(const bf16_t*)(ws + WS_ZM)  , (const bf16_t*)(ws + WS_WOUT), 2048, 1024, 16, (long)(64 * MiB) - 16 * 128, 0, 0}; pg8::StaticOrder S; S.init(T, D, G, bid); pg8::EpiResidB E{nullptr, XB, XB  , nullptr, (float*)(ws + WS_SSC), 1.0f}; pg8::gemm_phase(lds, gOut, S, E); }
#endif
    GSYNC();
#ifndef NO_P9
    { const pg8::Gemm gUp2{XB, (const bf16_t*)(ws + WS_WGU2), 1024, 1024, 1 << 30, 0, 0, 0}; pg8::StaticOrder S; S.init(T, 2 * FF, G, bid); pg8::EpiSwiGLU E{ACT, (const float*)(ws + WS_SSC)}; pg8::gemm_phase(lds, gUp2, S, E); }
#endif
    GSYNC();
#ifndef NO_P10
    { const pg8::Gemm gDn2{ACT, (const bf16_t*)(ws + WS_WD2), FF, FF, 1 << 30, 0, 0, 0}; pg8::StaticOrder S; S.init(T, D, G, bid); pg8::EpiResidB E{nullptr, XB, XB  , nullptr, (float*)(ws + WS_SSD), 0.5f}; pg8::gemm_phase(lds, gDn2, S, E); }
#endif
    GSYNC();
#ifndef NO_P11
    p11_final(args);
#endif
}

extern "C" void kernel_launch(void* const* d_in, const int* in_sizes, int n_in, void* d_out, int out_size, void* d_ws, size_t ws_size, hipStream_t stream) {
    static int grid = 0;
    if (grid == 0) {
        if (n_in != 31 || in_sizes[0] != T * D || out_size != T * D || ws_size < WS_END) { fprintf(stderr, "kernel_launch: unexpected shapes (n_in %d, in0 %d, out %d, ws %zu)\n", n_in, n_in > 0 ? in_sizes[0] : -1, out_size, ws_size); grid = -1; return; }
        int dev = 0, cus = 0, per_cu = 0;
        if (hipGetDevice(&dev) != hipSuccess || hipDeviceGetAttribute(&cus, hipDeviceAttributeMultiprocessorCount, dev) != hipSuccess) { grid = -1; return; }
        if (hipFuncSetAttribute((const void*)mk_fwd, hipFuncAttributeMaxDynamicSharedMemorySize, LDS_BYTES) != hipSuccess) { fprintf(stderr, "kernel_launch: hipFuncSetAttribute failed\n"); grid = -1; return; }
        if (hipOccupancyMaxActiveBlocksPerMultiprocessor(&per_cu, (const void*)mk_fwd, 512, LDS_BYTES) != hipSuccess || per_cu < 1) { fprintf(stderr, "kernel_launch: occupancy query says %d\n", per_cu); (void)hipGetLastError(); grid = -1; return; }
        grid = cus;
    }
    if (grid < 0) return;
    if (hipMemsetAsync((char*)d_ws + WS_BAR, 0, 16384, stream) != hipSuccess) { fprintf(stderr, "kernel_launch: memset of barrier words failed\n"); return; }
    Args a{};
    for (int i = 0; i < 31; ++i) a.in[i] = (const float*)d_in[i];
    a.out = (float*)d_out; a.ws = (unsigned char*)d_ws;
    void* kargs[] = {&a};
    hipError_t e = hipLaunchCooperativeKernel((const void*)mk_fwd, dim3(grid), dim3(512), kargs, LDS_BYTES, stream);
    if (e != hipSuccess) fprintf(stderr, "kernel_launch: cooperative launch failed: %s (grid %d)\n", hipGetErrorString(e), grid);
}
```

```cpp
#include <hip/hip_runtime.h>
#include <hip/hip_cooperative_groups.h>
#include <cstdio>
#include <cstdint>
namespace cg = cooperative_groups;

#define LAS __attribute__((address_space(3)))
typedef unsigned short bf16_t;
typedef short bf16x8 __attribute__((ext_vector_type(8)));
typedef float f32x4 __attribute__((ext_vector_type(4)));
typedef unsigned u32x4 __attribute__((ext_vector_type(4)));
typedef unsigned u32x2 __attribute__((ext_vector_type(2)));

constexpr int T = 32768, D = 1024, FF = 2816, SEQ = 8192, NB = 4;
constexpr float EPS = 1e-6f;
constexpr size_t MiB = 1u << 20;
constexpr size_t WS_SSA = 0, WS_SSB = 2 * MiB, WS_SSC = 4 * MiB, WS_SSD = 6 * MiB;
constexpr size_t WS_GATES = 8 * MiB;
constexpr size_t WS_AGG = 9 * MiB;
constexpr size_t WS_BAR = 14 * MiB;
constexpr size_t WS_C8 = 12 * MiB;
constexpr size_t WS_WG8 = 11 * MiB;
constexpr size_t WS_WGU1 = 16 * MiB;
constexpr size_t WS_WD1 = WS_WGU1 + 11 * MiB;
constexpr size_t WS_WIN = WS_WD1 + 11 * MiB / 2;
constexpr size_t WS_WRG = WS_WIN + 8 * MiB;
constexpr size_t WS_WOUT = WS_WRG + 1 * MiB;
constexpr size_t WS_WGU2 = WS_WOUT + 4 * MiB;
constexpr size_t WS_WD2 = WS_WGU2 + 11 * MiB;
constexpr size_t WS_XB = 64 * MiB;
constexpr size_t WS_R1 = 128 * MiB;
constexpr size_t WS_XM = WS_R1, WS_ZM = WS_R1 + 64 * MiB, WS_XR = WS_R1 + 128 * MiB, WS_YR = WS_R1 + 192 * MiB;
constexpr size_t WS_XC = 384 * MiB;
constexpr size_t WS_U = 448 * MiB;
constexpr size_t WS_END = 512 * MiB;
constexpr int LDS_BYTES = 147456;

typedef float f32x2_t __attribute__((ext_vector_type(2)));
typedef __bf16 bf16x2_t __attribute__((ext_vector_type(2)));
__device__ __forceinline__ unsigned pk2(float lo, float hi) { const f32x2_t v = {lo, hi}; const bf16x2_t b = __builtin_convertvector(v, bf16x2_t); return __builtin_bit_cast(unsigned, b); }
__device__ __forceinline__ float bflo(unsigned u) { return __uint_as_float(u << 16); }
__device__ __forceinline__ float bfhi(unsigned u) { return __uint_as_float(u & 0xffff0000u); }
__device__ __forceinline__ float bf1(bf16_t u) { return __uint_as_float(((unsigned)u) << 16); }
__device__ __forceinline__ void unpack8(const u32x4 v, float* x) { x[0] = bflo(v.x); x[1] = bfhi(v.x); x[2] = bflo(v.y); x[3] = bfhi(v.y); x[4] = bflo(v.z); x[5] = bfhi(v.z); x[6] = bflo(v.w); x[7] = bfhi(v.w); }
__device__ __forceinline__ u32x4 pack8(const float* x) { u32x4 o; o.x = pk2(x[0], x[1]); o.y = pk2(x[2], x[3]); o.z = pk2(x[4], x[5]); o.w = pk2(x[6], x[7]); return o; }
__device__ __forceinline__ float sigmoidf_(float x) { return __builtin_amdgcn_rcpf(1.0f + __expf(-x)); }
__device__ __forceinline__ float siluf_(float x) { return x * __builtin_amdgcn_rcpf(1.0f + __expf(-x)); }
__device__ __forceinline__ float logsigf_(float x) { return fminf(x, 0.f) - __logf(1.0f + __expf(-fabsf(x))); }
__device__ __forceinline__ float logsig_acc_(float x) { return fminf(x, 0.f) - log1pf(expf(-fabsf(x))); }
__device__ __forceinline__ float geluf_(float x) { const float u = 0.7978845608028654f * (x + 0.044715f * x * x * x); const float t = 1.0f - 2.0f * __builtin_amdgcn_rcpf(1.0f + __expf(2.0f * u)); return 0.5f * x * (1.0f + t); }
__device__ __forceinline__ int opaque_tid() { int t = threadIdx.x; asm volatile("" : "+v"(t)); return t; }
__device__ __forceinline__ float wave_sum(float v) {
#pragma unroll
    for (int o = 1; o < 64; o <<= 1) v += __shfl_xor(v, o);
    return v;
}

namespace pg8 {
constexpr int BM = 256, BK = 64, HALF = 128, HTB = HALF * BK * 2, STAGE_BYTES = 8 * HTB, NXCD = 8, WGM = 8;
__host__ __device__ __forceinline__ int lds_byte(int r, int c) { const int st = (r >> 4) * 2 + (c >> 5), rr = r & 15, cc = c & 31, ob = rr * 64 + cc * 2; return st * 1024 + (ob ^ (((ob >> 9) & 1) << 5)); }
__host__ __device__ __forceinline__ void stage_rc(int b, int& R, int& C) { const int st = b / 1024, sb = b % 1024, swz = sb ^ (((sb >> 9) & 1) << 5); R = (st >> 1) * 16 + swz / 64; C = (st & 1) * 32 + (swz % 64) / 2; }
__host__ __device__ __forceinline__ int perm32(int rho) { const int n = rho >> 4, i = rho & 15; return 8 * (i >> 2) + 4 * n + (i & 3); }

struct Unit { int pm, pn; };
struct Gemm { const bf16_t* A; const bf16_t* Bt; int K; int lda; int ksplit; long kdelta; int a_pn_shift; int a_pn_bytes; };

struct StaticOrder {
    int nM, nN, nwg, G, c;
    __device__ void init(int M, int N, int G_, int c_) { nM = M / BM; nN = N / BM; nwg = nM * nN; G = G_; c = c_; }
    __device__ bool next(int i, Unit& u) const {
        const long L = (long)i * G + c; if (L >= nwg) return false;
        int wgid = (int)L; { const int q = nwg / NXCD, r = nwg % NXCD, xcd = wgid % NXCD, off = wgid / NXCD; wgid = (xcd < r ? xcd * (q + 1) : r * (q + 1) + (xcd - r) * q) + off; }
        const int nig = WGM * nN, gid = wgid / nig, fm = gid * WGM, gsz = (nM - fm) < WGM ? (nM - fm) : WGM;
        u.pm = fm + ((wgid % nig) % gsz); u.pn = (wgid % nig) / gsz; return true;
    }
};
struct ListOrder {
    int first, cnt, nshift;
    __device__ bool next(int i, Unit& u) const { if (i >= cnt) return false; const int L = first + i; u.pm = L >> nshift; u.pn = L & ((1 << nshift) - 1); return true; }
};

__device__ __forceinline__ float row_scale(const float* SS, int r) {
    const f32x4* p = (const f32x4*)(SS + (size_t)r * 16);
    const f32x4 a = p[0], b = p[1], c = p[2], d = p[3];
    const float s = ((a[0] + a[1]) + (a[2] + a[3])) + ((b[0] + b[1]) + (b[2] + b[3])) + ((c[0] + c[1]) + (c[2] + c[3])) + ((d[0] + d[1]) + (d[2] + d[3]));
    return rsqrtf(s * (1.0f / 1024.0f) + EPS);
}

__device__ __forceinline__ void row_scales8(const float* SS, int row0, int fq, float (&rs)[8]) {
    f32x4 v[8];
#pragma unroll
    for (int q = 0; q < 8; ++q) v[q] = *(const f32x4*)(SS + (size_t)(row0 + (q >> 2) * HALF + (q & 3) * 16) * 16 + fq * 4);
#pragma unroll
    for (int q = 0; q < 8; ++q) { float s = (v[q][0] + v[q][1]) + (v[q][2] + v[q][3]); s += __shfl_xor(s, 16); s += __shfl_xor(s, 32); rs[q] = rsqrtf(s * (1.0f / 1024.0f) + EPS); }
}
struct EpiSwiGLU {
    bf16_t* O; const float* SS;
    __device__ __forceinline__ void operator()(const f32x4 (&acc)[2][2][4][2], const Unit& u, int wr, int wc, int fr, int fq) const {
        const int row0 = u.pm * BM + wr * 64 + fr, col0 = u.pn * HALF + wc * 32 + 8 * fq;
        float rs8[8]; row_scales8(SS, row0, fq, rs8);
#pragma unroll
        for (int ai = 0; ai < 2; ++ai)
#pragma unroll
            for (int m = 0; m < 4; ++m) {
                const int r = row0 + ai * HALF + m * 16; const float rs = rs8[ai * 4 + m];
                float o[8];
#pragma unroll
                for (int n = 0; n < 2; ++n)
#pragma unroll
                    for (int j = 0; j < 4; ++j) { const float g = acc[ai][0][m][n][j] * rs, up = acc[ai][1][m][n][j] * rs; o[n * 4 + j] = siluf_(g) * up; }
                *(u32x4*)(O + (size_t)r * FF + col0) = pack8(o);
            }
    }
};
struct EpiResid {
    const float* Xin; float* Xout; bf16_t* XBo; float* SSo; float alpha;
    __device__ __forceinline__ void operator()(const f32x4 (&acc)[2][2][4][2], const Unit& u, int wr, int wc, int fr, int fq) const {
        const int row0 = u.pm * BM + wr * 64 + fr, col0 = u.pn * BM + wc * 32 + 8 * fq;
#pragma unroll
        for (int ai = 0; ai < 2; ++ai)
#pragma unroll
            for (int m = 0; m < 4; ++m) {
                const int r = row0 + ai * HALF + m * 16; float ss = 0.f;
#pragma unroll
                for (int bj = 0; bj < 2; ++bj) {
                    const size_t off = (size_t)r * D + col0 + bj * HALF;
                    const f32x4 x0 = *(const f32x4*)(Xin + off), x1 = *(const f32x4*)(Xin + off + 4);
                    const f32x4 v0 = x0 + acc[ai][bj][m][0] * alpha, v1 = x1 + acc[ai][bj][m][1] * alpha;
                    *(f32x4*)(Xout + off) = v0; *(f32x4*)(Xout + off + 4) = v1;
                    ss += (v0[0] * v0[0] + v0[1] * v0[1]) + (v0[2] * v0[2] + v0[3] * v0[3]) + (v1[0] * v1[0] + v1[1] * v1[1]) + (v1[2] * v1[2] + v1[3] * v1[3]);
                    if (XBo) { u32x4 w; w.x = pk2(v0[0], v0[1]); w.y = pk2(v0[2], v0[3]); w.z = pk2(v1[0], v1[1]); w.w = pk2(v1[2], v1[3]); *(u32x4*)(XBo + off) = w; }
                }
                ss += __shfl_xor(ss, 16); ss += __shfl_xor(ss, 32);
                if (fq == 0) SSo[(size_t)r * 16 + u.pn * 4 + wc] = ss;
            }
    }
};
struct EpiResidB {
    const float* XinF; const bf16_t* XinB; bf16_t* O1; bf16_t* O2; float* SSo; float alpha;
    __device__ __forceinline__ void operator()(const f32x4 (&acc)[2][2][4][2], const Unit& u, int wr, int wc, int fr, int fq) const {
        const int row0 = u.pm * BM + wr * 64 + fr, col0 = u.pn * BM + wc * 32 + 8 * fq;
#pragma unroll
        for (int ai = 0; ai < 2; ++ai)
#pragma unroll
            for (int m = 0; m < 4; ++m) {
                const int r = row0 + ai * HALF + m * 16; float ss = 0.f;
#pragma unroll
                for (int bj = 0; bj < 2; ++bj) {
                    const size_t off = (size_t)r * D + col0 + bj * HALF;
                    f32x4 x0, x1;
                    if (XinF) { x0 = *(const f32x4*)(XinF + off); x1 = *(const f32x4*)(XinF + off + 4); }
                    else { const u32x4 xb = *(const u32x4*)(XinB + off); x0 = (f32x4){bflo(xb.x), bfhi(xb.x), bflo(xb.y), bfhi(xb.y)}; x1 = (f32x4){bflo(xb.z), bfhi(xb.z), bflo(xb.w), bfhi(xb.w)}; }
                    const f32x4 v0 = x0 + acc[ai][bj][m][0] * alpha, v1 = x1 + acc[ai][bj][m][1] * alpha;
                    ss += (v0[0] * v0[0] + v0[1] * v0[1]) + (v0[2] * v0[2] + v0[3] * v0[3]) + (v1[0] * v1[0] + v1[1] * v1[1]) + (v1[2] * v1[2] + v1[3] * v1[3]);
                    u32x4 w; w.x = pk2(v0[0], v0[1]); w.y = pk2(v0[2], v0[3]); w.z = pk2(v1[0], v1[1]); w.w = pk2(v1[2], v1[3]);
                    *(u32x4*)(O1 + off) = w; if (O2) *(u32x4*)(O2 + off) = w;
                }
                ss += __shfl_xor(ss, 16); ss += __shfl_xor(ss, 32);
                if (fq == 0) SSo[(size_t)r * 16 + u.pn * 4 + wc] = ss;
            }
    }
};
struct EpiProj {
    bf16_t* O; const float* SS;
    __device__ __forceinline__ void operator()(const f32x4 (&acc)[2][2][4][2], const Unit& u, int wr, int wc, int fr, int fq) const {
        bf16_t* base = O + (size_t)(u.pn >> 2) * ((size_t)T * D);
        const int row0 = u.pm * BM + wr * 64 + fr, col0 = (u.pn & 3) * BM + wc * 32 + 8 * fq;
        float rs8[8]; row_scales8(SS, row0, fq, rs8);
#pragma unroll
        for (int ai = 0; ai < 2; ++ai)
#pragma unroll
            for (int m = 0; m < 4; ++m) {
                const int r = row0 + ai * HALF + m * 16; const float rs = rs8[ai * 4 + m];
#pragma unroll
                for (int bj = 0; bj < 2; ++bj) {
                    const f32x4 v0 = acc[ai][bj][m][0] * rs, v1 = acc[ai][bj][m][1] * rs;
                    u32x4 w; w.x = pk2(v0[0], v0[1]); w.y = pk2(v0[2], v0[3]); w.z = pk2(v1[0], v1[1]); w.w = pk2(v1[2], v1[3]);
                    *(u32x4*)(base + (size_t)r * D + col0 + bj * HALF) = w;
                }
            }
    }
};
__device__ __forceinline__ float neg_expm1_(float x) {
    const float p = -x * (1.0f + x * (0.5f + x * (0.16666667f + x * (0.041666668f + x * 0.0083333338f))));
    const float e = 1.0f - __expf(x);
    return (x > -0.3f) ? p : e;
}
struct EpiRg {
    const bf16_t* XCR; const float* ba; const float* bx; const float* c8t; bf16_t* LOGA; bf16_t* U;
    __device__ __forceinline__ void operator()(const f32x4 (&acc)[2][2][4][2], const Unit& u, int wr, int wc, int fr, int fq) const {
        const int row0 = u.pm * BM + wr * 64 + fr, ch0 = (u.pn >> 1) * 256 + (u.pn & 1) * HALF + wc * 32 + 8 * fq;
#pragma unroll
        for (int n = 0; n < 2; ++n) {
            const int ch = ch0 + 4 * n;
            const f32x4 b_a = *(const f32x4*)(ba + ch), b_x = *(const f32x4*)(bx + ch), c8 = *(const f32x4*)(c8t + ch);
#pragma unroll
            for (int ai = 0; ai < 2; ++ai)
#pragma unroll
                for (int m = 0; m < 4; ++m) {
                    const int r = row0 + ai * HALF + m * 16;
                    const u32x2 xv = *(const u32x2*)(XCR + (size_t)r * D + ch);
                    const float xc[4] = {bflo(xv.x), bfhi(xv.x), bflo(xv.y), bfhi(xv.y)};
                    float la[4], uu[4];
#pragma unroll
                    for (int j = 0; j < 4; ++j) {
                        const float rg = sigmoidf_(acc[ai][0][m][n][j] + b_a[j]), ig = sigmoidf_(acc[ai][1][m][n][j] + b_x[j]);
                        la[j] = c8[j] * rg;
                        uu[j] = __builtin_amdgcn_sqrtf(fmaxf(neg_expm1_(2.0f * la[j]), 0.f)) * (ig * xc[j]);
                    }
                    u32x2 w0, w1; w0.x = pk2(la[0], la[1]); w0.y = pk2(la[2], la[3]); w1.x = pk2(uu[0], uu[1]); w1.y = pk2(uu[2], uu[3]);
                    *(u32x2*)(LOGA + (size_t)r * D + ch) = w0; *(u32x2*)(U + (size_t)r * D + ch) = w1;
                    __builtin_amdgcn_sched_barrier(0);
                }
        }
    }
};
struct EpiGates {
    float* G; const float* bg;
    __device__ __forceinline__ void operator()(const f32x4 (&acc)[2][2][4][2], const Unit& u, int wr, int wc, int fr, int fq) const {
        if (wc != 0 || fq != 0) return;
        const int row0 = u.pm * BM + wr * 64 + fr;
        const f32x4 b0 = *(const f32x4*)(bg), b1 = *(const f32x4*)(bg + 4);
#pragma unroll
        for (int ai = 0; ai < 2; ++ai)
#pragma unroll
            for (int m = 0; m < 4; ++m) {
                const int r = row0 + ai * HALF + m * 16;
                f32x4 v0 = acc[ai][0][m][0] + b0, v1 = acc[ai][0][m][1] + b1;
                for (int j = 0; j < 4; ++j) v1[j] = logsigf_(v1[j]);
                *(f32x4*)(G + (size_t)r * 8) = v0; *(f32x4*)(G + (size_t)r * 8 + 4) = v1;
            }
    }
};

template <class Epi, class Sched>
__device__ __forceinline__ void gemm_phase(LAS unsigned char* lds, const Gemm g, const Sched& S, const Epi& E) {
    const int tid = opaque_tid(), wid = __builtin_amdgcn_readfirstlane(tid >> 6), lane = tid & 63, wr = wid >> 2, wc = wid & 3, fr = lane & 15, fq = lane >> 4;
    const int K = g.K, nt = K / BK, lda = g.lda;
    unsigned voffA[2], voffB[2];
#pragma unroll
    for (int i = 0; i < 2; ++i) { int R, C; stage_rc(tid * 16 + i * 8192, R, C); const int Rb = (R & ~31) + perm32(R & 31);
        voffA[i] = (unsigned)(R * lda + C) * 2u; voffB[i] = (unsigned)(Rb * K + C) * 2u; }
    const size_t kstep = (size_t)(BK * 2);
    const size_t hstepA = (size_t)HALF * lda * 2, tstepA = 2 * hstepA;
    const size_t hstepB = (size_t)HALF * K * 2, tstepB = 2 * hstepB;
    const unsigned ldsw = (unsigned)wid * 1024u;
    const int aoff = lds_byte(wr * 64 + fr, fq * 8), boff = lds_byte(wc * 32 + fr, fq * 8);
    const int ksplit = g.ksplit; const long kdelta = g.kdelta;
#define PG8_AK(t) ((long)(t) * (long)kstep + (((t) >= ksplit) ? kdelta : 0l))
#define PG8_SA(b, h) (((b) * 2 + (h)) * HTB)
#define PG8_SB(b, h) ((4 + (b) * 2 + (h)) * HTB)
#define PG8_STAGE(bufoff, gbase, voff) do { _Pragma("unroll") for (int _i = 0; _i < 2; ++_i) \
        __builtin_amdgcn_global_load_lds((const unsigned*)((const char*)(gbase) + (voff)[_i]), (LAS unsigned*)(lds + (bufoff) + ldsw + _i * 8192), 16, 0, 0); } while (0)
#define PG8_LDA(dst, b, h) do { _Pragma("unroll") for (int m = 0; m < 4; ++m) _Pragma("unroll") for (int k = 0; k < 2; ++k) dst[m][k] = *(const LAS bf16x8*)(lds + PG8_SA(b, h) + aoff + m * 2048 + k * 1024); } while (0)
#define PG8_LDB(dst, b, h) do { _Pragma("unroll") for (int n = 0; n < 2; ++n) _Pragma("unroll") for (int k = 0; k < 2; ++k) dst[n][k] = *(const LAS bf16x8*)(lds + PG8_SB(b, h) + boff + n * 2048 + k * 1024); } while (0)
#define PG8_MMA(ai, bj, At, Bt) do { __builtin_amdgcn_s_setprio(1); _Pragma("unroll") for (int m = 0; m < 4; ++m) _Pragma("unroll") for (int n = 0; n < 2; ++n) _Pragma("unroll") for (int k = 0; k < 2; ++k) \
        acc[ai][bj][m][n] = __builtin_amdgcn_mfma_f32_16x16x32_bf16(Bt[n][k], At[m][k], acc[ai][bj][m][n], 0, 0, 0); __builtin_amdgcn_s_setprio(0); } while (0)
#define PG8_WAIT_V(n) asm volatile("s_waitcnt vmcnt(" #n ")" ::: "memory")
#define PG8_WAIT_L(n) asm volatile("s_waitcnt lgkmcnt(" #n ")" ::: "memory")
#define PG8_BAR __builtin_amdgcn_s_barrier()
#define PG8_SCHED __builtin_amdgcn_sched_barrier(0)
    Unit cur, nxt; int ui = 0;
    if (!S.next(0, cur)) return;
    f32x4 acc[2][2][4][2];
#pragma unroll
    for (int a = 0; a < 2; ++a)
#pragma unroll
        for (int b = 0; b < 2; ++b)
#pragma unroll
            for (int m = 0; m < 4; ++m)
#pragma unroll
                for (int n = 0; n < 2; ++n) acc[a][b][m][n] = (f32x4){0.f, 0.f, 0.f, 0.f};
    bf16x8 At[4][2], B0[2][2], B1[2][2];
    const char* cA = (const char*)g.A + (size_t)cur.pm * tstepA + (size_t)(cur.pn >> g.a_pn_shift) * g.a_pn_bytes;
    const char* cB = (const char*)g.Bt + (size_t)cur.pn * tstepB;
    {
        PG8_STAGE(PG8_SB(0, 0), cB, voffB); PG8_STAGE(PG8_SB(0, 1), cB + hstepB, voffB); PG8_STAGE(PG8_SA(0, 0), cA, voffA); PG8_STAGE(PG8_SA(0, 1), cA + hstepA, voffA);
        if (wr == 1) PG8_BAR;
        PG8_WAIT_V(2); PG8_BAR;
        PG8_STAGE(PG8_SB(1, 0), cB + kstep, voffB); PG8_STAGE(PG8_SA(1, 0), cA + PG8_AK(1), voffA); PG8_STAGE(PG8_SB(1, 1), cB + hstepB + kstep, voffB);
        PG8_WAIT_V(6); PG8_BAR;
    }
    for (;;) {
        const bool has_next = S.next(ui + 1, nxt);
        const char* nA = has_next ? (const char*)g.A + (size_t)nxt.pm * tstepA + (size_t)(nxt.pn >> g.a_pn_shift) * g.a_pn_bytes : cA;
        const char* nB = has_next ? (const char*)g.Bt + (size_t)nxt.pn * tstepB : cB;
#pragma nounroll
        for (int t = 0; t < nt; t += 2) {
            const bool last = (t == nt - 2);
            const char* a1 = cA + PG8_AK(t + 1);
            const char* a2 = last ? nA : cA + PG8_AK(t + 2); const char* b2 = last ? nB : cB + (size_t)(t + 2) * kstep;
            const char* a3 = last ? nA + PG8_AK(1) : cA + PG8_AK(t + 3); const char* b3 = b2 + kstep;
            PG8_LDB(B0, 0, 0); PG8_LDB(B1, 0, 1); PG8_SCHED; PG8_LDA(At, 0, 0); PG8_STAGE(PG8_SA(1, 1), a1 + hstepA, voffA);
            PG8_WAIT_V(8); PG8_WAIT_L(0); PG8_BAR; PG8_MMA(0, 0, At, B0); PG8_MMA(0, 1, At, B1); PG8_BAR; PG8_SCHED;
            PG8_LDA(At, 0, 1); PG8_STAGE(PG8_SB(0, 0), b2, voffB); PG8_STAGE(PG8_SB(0, 1), b2 + hstepB, voffB); PG8_STAGE(PG8_SA(0, 0), a2, voffA);
            PG8_WAIT_V(8); PG8_WAIT_L(0); PG8_BAR; PG8_MMA(1, 0, At, B0); PG8_MMA(1, 1, At, B1); PG8_BAR; PG8_SCHED;
            PG8_LDB(B0, 1, 0); PG8_LDB(B1, 1, 1); PG8_SCHED; PG8_LDA(At, 1, 0); PG8_STAGE(PG8_SA(0, 1), a2 + hstepA, voffA);
            PG8_WAIT_V(8); PG8_WAIT_L(0); PG8_BAR; PG8_MMA(0, 0, At, B0); PG8_MMA(0, 1, At, B1); PG8_BAR; PG8_SCHED;
            PG8_LDA(At, 1, 1); PG8_STAGE(PG8_SB(1, 0), b3, voffB); PG8_STAGE(PG8_SB(1, 1), b3 + hstepB, voffB); PG8_STAGE(PG8_SA(1, 0), a3, voffA);
            PG8_WAIT_V(8); PG8_WAIT_L(0); PG8_BAR; PG8_MMA(1, 0, At, B0); PG8_MMA(1, 1, At, B1); PG8_BAR; PG8_SCHED;
        }
        if (wr == 0) PG8_BAR;
        E(acc, cur, wr, wc, fr, fq);
        if (!has_next) break;
#pragma unroll
        for (int a = 0; a < 2; ++a)
#pragma unroll
            for (int b = 0; b < 2; ++b)
#pragma unroll
                for (int m = 0; m < 4; ++m)
#pragma unroll
                    for (int n = 0; n < 2; ++n) acc[a][b][m][n] = (f32x4){0.f, 0.f, 0.f, 0.f};
        cur = nxt; cA = nA; cB = nB; ++ui;
        if (wr == 1) PG8_BAR;
    }
    PG8_WAIT_V(0);
    PG8_BAR;
#undef PG8_AK
#undef PG8_SA
#undef PG8_SB
#undef PG8_STAGE
#undef PG8_LDA
#undef PG8_LDB
#undef PG8_MMA
#undef PG8_WAIT_V
#undef PG8_WAIT_L
#undef PG8_BAR
#undef PG8_SCHED
}
}

struct Args { const float* in[31]; float* out; unsigned char* ws; };
enum { I_X = 0, I_NF1, I_WG1, I_WU1, I_WD1, I_NMIX, I_WIN, I_MCW, I_MCB, I_WQ, I_WK, I_WV, I_WGATES, I_BGATES, I_LNW, I_SKIP, I_RCW, I_RCB, I_RWA, I_RBA, I_RWX, I_RBX, I_LAM,
       I_ONM, I_ONR, I_WOUT, I_NF2, I_WG2, I_WU2, I_WD2, I_NFIN };

template <class F> __device__ __forceinline__ void tr_item(F src, int K, bf16_t* WT, float* scr, int item, int nblk, int lane) {
    const int kb = item / nblk, nb = item % nblk, k0 = 64 * kb, n0 = 32 * nb;
#pragma unroll 8
    for (int i = 0; i < 32; ++i) { const int kk = 2 * i + (lane >> 5); scr[kk * 33 + (lane & 31)] = src(k0 + kk, n0 + (lane & 31)); }
    __builtin_amdgcn_wave_barrier();
    const int c = lane & 7;
#pragma unroll
    for (int j = 0; j < 4; ++j) { const int n = (lane >> 3) + 8 * j; const float* s = scr + (8 * c) * 33 + n;
        u32x4 o; o.x = pk2(s[0 * 33], s[1 * 33]); o.y = pk2(s[2 * 33], s[3 * 33]); o.z = pk2(s[4 * 33], s[5 * 33]); o.w = pk2(s[6 * 33], s[7 * 33]);
        *(u32x4*)(WT + (size_t)(n0 + n) * K + k0 + 8 * c) = o; }
    __builtin_amdgcn_wave_barrier();
}

__device__ __forceinline__ void p0_prologue(const Args& a, unsigned char* lds) {
    const int tid = opaque_tid(), lane = tid & 63, wave = tid >> 6;
    const int gw = blockIdx.x * 8 + wave, NGW = gridDim.x * 8;
    float* scr = (float*)(lds + wave * 16384);
    unsigned char* ws = a.ws;
    constexpr int I1 = 16 * 176, I2 = 44 * 32, I3 = 16 * 128, I4 = 4 * 64, I5 = 32 * 32;
    constexpr int NIT = I1 + I2 + I3 + I4 + I5 + I1 + I2;
    for (int it = gw; it < NIT; it += NGW) {
        int r = it;
        if (r < I1) { const float* wg = a.in[I_WG1]; const float* wu = a.in[I_WU1]; const float* gn = a.in[I_NF1];
            tr_item([=](int k, int n) { const int c = (n >> 8) * 128 + (n & 127); return (((n >> 7) & 1) ? wu : wg)[(size_t)k * FF + c] * gn[k]; }, 1024, (bf16_t*)(ws + WS_WGU1), scr, r, 176, lane); continue; } r -= I1;
        if (r < I2) { const float* wd = a.in[I_WD1];
            tr_item([=](int k, int n) { return wd[(size_t)k * D + n]; }, FF, (bf16_t*)(ws + WS_WD1), scr, r, 32, lane); continue; } r -= I2;
        if (r < I3) { const float* w = a.in[I_WIN]; const float* gn = a.in[I_NMIX];
            tr_item([=](int k, int n) { return w[(size_t)k * 4096 + n] * gn[k]; }, 1024, (bf16_t*)(ws + WS_WIN), scr, r, 128, lane); continue; } r -= I3;
        if (r < I4) { const float* wa = a.in[I_RWA]; const float* wx = a.in[I_RWX];
            tr_item([=](int k, int n) { const int pn = n >> 8, blk = pn >> 1, hh = pn & 1, sel = (n >> 7) & 1, c = hh * 128 + (n & 127); return (sel ? wx : wa)[(size_t)blk * 65536 + (size_t)k * 256 + c]; }, 256, (bf16_t*)(ws + WS_WRG), scr, r, 64, lane); continue; } r -= I4;
        if (r < I5) { const float* w = a.in[I_WOUT]; const float* gm = a.in[I_ONM]; const float* gr = a.in[I_ONR];
            tr_item([=](int k, int n) { return w[(size_t)k * D + n] * (k < 1024 ? gm[k] : gr[k - 1024]); }, 2048, (bf16_t*)(ws + WS_WOUT), scr, r, 32, lane); continue; } r -= I5;
        if (r < I1) { const float* wg = a.in[I_WG2]; const float* wu = a.in[I_WU2]; const float* gn = a.in[I_NF2];
            tr_item([=](int k, int n) { const int c = (n >> 8) * 128 + (n & 127); return (((n >> 7) & 1) ? wu : wg)[(size_t)k * FF + c] * gn[k]; }, 1024, (bf16_t*)(ws + WS_WGU2), scr, r, 176, lane); continue; } r -= I1;
        { const float* wd = a.in[I_WD2];
            tr_item([=](int k, int n) { return wd[(size_t)k * D + n]; }, FF, (bf16_t*)(ws + WS_WD2), scr, r, 32, lane); }
    }
    {
        bf16_t* WG8 = (bf16_t*)(ws + WS_WG8);
        const float* wq = a.in[I_WQ]; const float* wk = a.in[I_WK]; const float* wv = a.in[I_WV]; const float* Wg = a.in[I_WGATES];
        const int gt = blockIdx.x * 512 + tid, NT = gridDim.x * 512;
        for (int e = gt; e < 256 * 2048 / 8; e += NT) {
            const int g = e / 256, k0 = (e % 256) * 8;
            float o[8];
#pragma unroll
            for (int j = 0; j < 8; ++j) {
                float v = 0.f;
                if (g < 8) { const int k = k0 + j, c = k & 1023, n = c >> 2, i = c & 3;
                    if (k < 1024) { for (int oo = 0; oo < 4; ++oo) v += wq[n * 16 + i * 4 + oo] * Wg[(size_t)(4 * n + oo) * 8 + g] + wk[n * 16 + i * 4 + oo] * Wg[(size_t)(1024 + 4 * n + oo) * 8 + g]; }
                    else { for (int oo = 0; oo < 4; ++oo) v += wv[n * 16 + i * 4 + oo] * Wg[(size_t)(2048 + 4 * n + oo) * 8 + g]; } }
                o[j] = v;
            }
            *(u32x4*)(WG8 + (size_t)g * 2048 + k0) = pack8(o);
        }
    }
    if (blockIdx.x == 0) { float* C8 = (float*)(ws + WS_C8); const float* lam = a.in[I_LAM]; for (int e = tid; e < 1024; e += 512) C8[e] = 8.0f * logsig_acc_(lam[e]); }
    {
        const float* x = a.in[I_X]; bf16_t* XB = (bf16_t*)(ws + WS_XB); float* SS = (float*)(ws + WS_SSA);
        for (int m0 = gw; m0 < T; m0 += 2 * NGW) {
            const bool two = (m0 + NGW < T);
            f32x4 v[2][4];
#pragma unroll
            for (int q = 0; q < 2; ++q) { const int m = (q == 0 || two) ? m0 + q * NGW : m0; const f32x4* xr = (const f32x4*)(x + (size_t)m * D) + lane;
#pragma unroll
                for (int j = 0; j < 4; ++j) v[q][j] = xr[64 * j]; }
#pragma unroll
            for (int q = 0; q < 2; ++q) {
                if (q == 1 && !two) break;
                const int m = m0 + q * NGW; float s = 0.f;
#pragma unroll
                for (int j = 0; j < 4; ++j) s += (v[q][j][0] * v[q][j][0] + v[q][j][1] * v[q][j][1]) + (v[q][j][2] * v[q][j][2] + v[q][j][3] * v[q][j][3]);
                s = wave_sum(s);
                u32x2* o8 = (u32x2*)(XB + (size_t)m * D) + lane;
#pragma unroll
                for (int j = 0; j < 4; ++j) { u32x2 w; w.x = pk2(v[q][j][0], v[q][j][1]); w.y = pk2(v[q][j][2], v[q][j][3]); o8[64 * j] = w; }
                if (lane < 16) SS[(size_t)m * 16 + lane] = (lane == 0) ? s : 0.f;
            }
        }
    }
}

template <bool SILU> __device__ __forceinline__ void conv_part(const bf16_t* in, bf16_t* out, const float* cw, const float* cb, int t0, int c0) {
    float w[4][8], b[8];
#pragma unroll
    for (int tap = 0; tap < 4; ++tap) { const f32x4 p = *(const f32x4*)(cw + tap * D + c0), q = *(const f32x4*)(cw + tap * D + c0 + 4); for (int j = 0; j < 4; ++j) { w[tap][j] = p[j]; w[tap][4 + j] = q[j]; } }
    { const f32x4 p = *(const f32x4*)(cb + c0), q = *(const f32x4*)(cb + c0 + 4); for (int j = 0; j < 4; ++j) { b[j] = p[j]; b[4 + j] = q[j]; } }
    float h0[8], h1[8], h2[8];
    const bool first = (t0 % SEQ) == 0;
    if (first) { for (int j = 0; j < 8; ++j) { h0[j] = 0.f; h1[j] = 0.f; h2[j] = 0.f; } }
    else {
        unpack8(*(const u32x4*)(in + (size_t)(t0 - 3) * D + c0), h0); unpack8(*(const u32x4*)(in + (size_t)(t0 - 2) * D + c0), h1); unpack8(*(const u32x4*)(in + (size_t)(t0 - 1) * D + c0), h2);
    }
    u32x4 cur[8];
#pragma unroll
    for (int i = 0; i < 8; ++i) cur[i] = *(const u32x4*)(in + (size_t)(t0 + i) * D + c0);
#pragma unroll
    for (int i = 0; i < 8; ++i) {
        float x[8], y[8]; unpack8(cur[i], x);
#pragma unroll
        for (int j = 0; j < 8; ++j) { float v = b[j] + w[0][j] * h0[j] + w[1][j] * h1[j] + w[2][j] * h2[j] + w[3][j] * x[j]; y[j] = SILU ? siluf_(v) : v; h0[j] = h1[j]; h1[j] = h2[j]; h2[j] = x[j]; }
        *(u32x4*)(out + (size_t)(t0 + i) * D + c0) = pack8(y);
    }
}
__device__ __forceinline__ void p4_conv(const Args& a) {
    unsigned char* ws = a.ws; const int tid = opaque_tid(), cgp = tid & 127, ts = tid >> 7;
    for (int u = blockIdx.x; u < T / 32; u += gridDim.x) {
        const int t0 = u * 32 + ts * 8, c0 = cgp * 8;
        conv_part<true>((const bf16_t*)(ws + WS_XM), (bf16_t*)(ws + WS_XC), a.in[I_MCW], a.in[I_MCB], t0, c0);
        conv_part<false>((const bf16_t*)(ws + WS_XR), (bf16_t*)a.out + (size_t)T * D  , a.in[I_RCW], a.in[I_RCB], t0, c0);
    }
}

__device__ __forceinline__ void p6_rg_agg(const Args& a) {
    unsigned char* ws = a.ws; const int tid = opaque_tid();
    const unsigned* LOGA = (const unsigned*)(ws + WS_XR); const unsigned* U = (const unsigned*)(ws + WS_U); float* AGG = (float*)(ws + WS_AGG);
    for (int tile = blockIdx.x; tile < 256; tile += gridDim.x) {
        const size_t row0 = (size_t)tile * 128;
        float sl0 = 0.f, sl1 = 0.f, h0 = 0.f, h1 = 0.f;
        for (int i0 = 0; i0 < 128; i0 += 16) {
            unsigned la[16], uu[16];
#pragma unroll
            for (int i = 0; i < 16; ++i) { la[i] = LOGA[(row0 + i0 + i) * 512 + tid]; uu[i] = U[(row0 + i0 + i) * 512 + tid]; }
#pragma unroll
            for (int i = 0; i < 16; ++i) { const float l0 = bflo(la[i]), l1 = bfhi(la[i]); sl0 += l0; sl1 += l1; h0 = __expf(l0) * h0 + bflo(uu[i]); h1 = __expf(l1) * h1 + bfhi(uu[i]); }
        }
        f32x4 o = {sl0, h0, sl1, h1};
        *(f32x4*)(AGG + ((size_t)tile * 1024 + 2 * tid) * 2) = o;
    }
}

template <int CTRL, int RMASK> __device__ __forceinline__ float dppf(float old, float src) {
    return __builtin_bit_cast(float, __builtin_amdgcn_update_dpp(__builtin_bit_cast(int, old), __builtin_bit_cast(int, src), CTRL, RMASK, 0xf, false));
}
__device__ __forceinline__ float readlane_f(float v, int l) { return __builtin_bit_cast(float, __builtin_amdgcn_readlane(__builtin_bit_cast(int, v), l)); }

namespace ml {
constexpr int QP = 264, SP = 72;
constexpr int O_QS = 0, O_KS = 33792, O_SS = 67584, O_VT = 76800, O_VW = 81408, O_CS = 86016, O_OSM = 102912, O_TAB = 111360, O_WTS = 113920, O_END = 126208;
}
__device__ __forceinline__ unsigned char* sraw_ptr(unsigned char* ws, int u) {
    return u < 1600 ? ws + (size_t)u * 5120 : (u < 2000 ? ws + 62 * MiB + (size_t)(u - 1600) * 5120 : ws + 12 * MiB + 512 * 1024 + (size_t)(u - 2000) * 5120);
}
__device__ __forceinline__ void p5b_sraw(const Args& a, unsigned char* lds) {
    using namespace ml;
    unsigned char* ws = a.ws;
    const int tid = opaque_tid(), lane = tid & 63, w = __builtin_amdgcn_readfirstlane(tid >> 6), fr = lane & 15, fq = lane >> 4;
    bf16_t* Qs = (bf16_t*)(lds + O_QS); bf16_t* Ks = (bf16_t*)(lds + O_KS); float* WTS = (float*)(lds + O_WTS);
    const bf16_t* XC = (const bf16_t*)(ws + WS_XC); bf16_t* QG = (bf16_t*)a.out;
    const int srow = tid >> 5, scol = (tid & 31) * 8;
    for (int g = blockIdx.x; g < 256; g += gridDim.x) {
        const int bh = g >> 4, c0 = (g & 15) * 8, b = bh >> 2, h = bh & 3;
        __syncthreads();
        for (int e = tid; e < 1024; e += 512) { const int gg = e >> 4, bb = (e >> 2) & 3, aa = e & 3; const float* wq = a.in[I_WQ] + (h * 64 + gg) * 16; const float* wk = a.in[I_WK] + (h * 64 + gg) * 16;
            float v = 0.f; for (int o = 0; o < 4; ++o) v += wq[bb * 4 + o] * wk[aa * 4 + o]; WTS[e] = v * 0.0625f; }
        __syncthreads();
        const int lg0 = (tid & 31) * 2;
        f32x4 Wq[2][4];
#pragma unroll
        for (int g2 = 0; g2 < 2; ++g2)
#pragma unroll
            for (int i = 0; i < 4; ++i) Wq[g2][i] = *(const f32x4*)(WTS + (lg0 + g2) * 16 + i * 4);
        u32x4 xn[4];
#pragma unroll
        for (int i = 0; i < 4; ++i) xn[i] = *(const u32x4*)(XC + ((size_t)b * SEQ + (size_t)c0 * 64 + srow + 16 * i) * D + h * 256 + scol);
        for (int cc = 0; cc < 8; ++cc) {
            const int c = c0 + cc; const size_t t0 = (size_t)b * SEQ + (size_t)c * 64;
            u32x4 xr[4];
#pragma unroll
            for (int i = 0; i < 4; ++i) xr[i] = xn[i];
            if (cc + 1 < 8) {
#pragma unroll
                for (int i = 0; i < 4; ++i) xn[i] = *(const u32x4*)(XC + (t0 + 64 + srow + 16 * i) * D + h * 256 + scol);
            }
#pragma unroll
            for (int i = 0; i < 4; ++i) {
                float x[8]; unpack8(xr[i], x);
                float q[8];
#pragma unroll
                for (int g2 = 0; g2 < 2; ++g2) {
                    const f32x4 qq = Wq[g2][0] * x[4 * g2] + Wq[g2][1] * x[4 * g2 + 1] + Wq[g2][2] * x[4 * g2 + 2] + Wq[g2][3] * x[4 * g2 + 3];
                    for (int j = 0; j < 4; ++j) q[4 * g2 + j] = qq[j];
                }
                const int r = srow + 16 * i; const u32x4 qp = pack8(q);
                *(u32x4*)(Qs + r * QP + scol) = qp; *(u32x4*)(Ks + r * QP + scol) = xr[i];
                *(u32x4*)(QG + (t0 + r) * D + h * 256 + scol) = qp;
            }
            __syncthreads();
            {
                unsigned char* sp = sraw_ptr(ws, bh * 128 + c);
#define S_DECODE(li, it, jt) do { if ((li) < 4) { it = 3; jt = (li); } else if ((li) < 7) { it = 2; jt = (li) - 4; } else if ((li) < 9) { it = 1; jt = (li) - 7; } else { it = 0; jt = 0; } } while (0)
#define S_EPI(li, sv) do { u32x2 wv_; wv_.x = pk2(sv[0], sv[1]); wv_.y = pk2(sv[2], sv[3]); *(u32x2*)(sp + (li) * 512 + lane * 8) = wv_; } while (0)
                int it0, jt0, it1 = 0, jt1 = 0; S_DECODE(w, it0, jt0);
                const bool two = (w < 2); if (two) S_DECODE(w + 8, it1, jt1);
                f32x4 sA = (f32x4){0.f, 0.f, 0.f, 0.f}, sB = sA, tA = sA, tB = sA;
                const bf16_t* k0p = Ks + (jt0 * 16 + fr) * QP + fq * 8; const bf16_t* q0p = Qs + (it0 * 16 + fr) * QP + fq * 8;
                const bf16_t* k1p = Ks + (jt1 * 16 + fr) * QP + fq * 8; const bf16_t* q1p = Qs + (it1 * 16 + fr) * QP + fq * 8;
#pragma unroll
                for (int ks = 0; ks < 8; ks += 2) {
                    sA = __builtin_amdgcn_mfma_f32_16x16x32_bf16(*(const bf16x8*)(k0p + ks * 32), *(const bf16x8*)(q0p + ks * 32), sA, 0, 0, 0);
                    sB = __builtin_amdgcn_mfma_f32_16x16x32_bf16(*(const bf16x8*)(k0p + ks * 32 + 32), *(const bf16x8*)(q0p + ks * 32 + 32), sB, 0, 0, 0);
                    if (two) {
                        tA = __builtin_amdgcn_mfma_f32_16x16x32_bf16(*(const bf16x8*)(k1p + ks * 32), *(const bf16x8*)(q1p + ks * 32), tA, 0, 0, 0);
                        tB = __builtin_amdgcn_mfma_f32_16x16x32_bf16(*(const bf16x8*)(k1p + ks * 32 + 32), *(const bf16x8*)(q1p + ks * 32 + 32), tB, 0, 0, 0);
                    }
                }
                const f32x4 s0 = sA + sB; S_EPI(w, s0);
                if (two) { const f32x4 s1 = tA + tB; S_EPI(w + 8, s1); }
#undef S_DECODE
#undef S_EPI
            }
            __syncthreads();
        }
    }
}

__device__ __forceinline__ void p6_mlstm(const Args& a, unsigned char* lds) {
    using namespace ml;
    unsigned char* ws = a.ws;
    const int tid = opaque_tid(), lane = tid & 63, w = __builtin_amdgcn_readfirstlane(tid >> 6), fr = lane & 15, fq = lane >> 4;
    bf16_t* Qs = (bf16_t*)(lds + O_QS); bf16_t* Ks = (bf16_t*)(lds + O_KS); bf16_t* Ss = (bf16_t*)(lds + O_SS);
    bf16_t* Vt = (bf16_t*)(lds + O_VT); bf16_t* Vw = (bf16_t*)(lds + O_VW); bf16_t* Cs = (bf16_t*)(lds + O_CS);
    float* Osm = (float*)(lds + O_OSM); float* TAB = (float*)(lds + O_TAB); float* WTS = (float*)(lds + O_WTS);
    const bf16_t* XC = (const bf16_t*)(ws + WS_XC); const bf16_t* XM = (const bf16_t*)(ws + WS_XM); const float* GATES = (const float*)(ws + WS_GATES);
    const bf16_t* QG = (const bf16_t*)a.out;
    bf16_t* HM = (bf16_t*)a.out + (size_t)T * D;
    for (int unit = blockIdx.x; unit < 256; unit += gridDim.x) {
        const int xcd = unit & 7, idx = unit >> 3, bh = xcd * 2 + (idx >> 4), vs = idx & 15, b = bh >> 2, h = bh & 3;
        __syncthreads();
        for (int e = tid; e < 64 * SP / 2; e += 512) ((unsigned*)Ss)[e] = 0u;
        for (int e = tid; e < 32 * SP / 2; e += 512) { const int row = e / (SP / 2); ((unsigned*)Vt)[e] = (row == 16) ? 0x3F803F80u : 0u; ((unsigned*)Vw)[e] = 0u; }
        for (int e = tid; e < 32 * QP / 2; e += 512) ((unsigned*)Cs)[e] = 0u;
        for (int e = tid; e < 1024; e += 512) WTS[2048 + e] = a.in[I_WV][h * 1024 + e];
        f32x4 Cacc[2][2];
#pragma unroll
        for (int i = 0; i < 2; ++i)
#pragma unroll
            for (int j = 0; j < 2; ++j) Cacc[i][j] = (f32x4){0.f, 0.f, 0.f, 0.f};
        const int srow = tid >> 5, scol = (tid & 31) * 8;
        const int vrow = tid >> 1, vhalf = tid & 1;
        const size_t tbase = (size_t)b * SEQ;
        u32x4 xr[4], qr[4], xmr = (u32x4){0u, 0u, 0u, 0u}; float gi, gf;
        u32x2 sr0 = (u32x2){0u, 0u}, sr1 = (u32x2){0u, 0u};
        {
            const size_t t0 = tbase;
#pragma unroll
            for (int i = 0; i < 4; ++i) { xr[i] = *(const u32x4*)(XC + (t0 + srow + 16 * i) * D + h * 256 + scol); qr[i] = *(const u32x4*)(QG + (t0 + srow + 16 * i) * D + h * 256 + scol); }
            if (tid < 128) xmr = *(const u32x4*)(XM + (t0 + vrow) * D + h * 256 + vs * 16 + vhalf * 8);
            gi = GATES[(t0 + lane) * 8 + h]; gf = GATES[(t0 + lane) * 8 + 4 + h];
            const unsigned char* sp = sraw_ptr(ws, bh * 128);
            sr0 = *(const u32x2*)(sp + tid * 8); if (tid < 128) sr1 = *(const u32x2*)(sp + 4096 + tid * 8);
        }
        __syncthreads();
        float decay = 0.f, m_cur = -1e30f;
        constexpr int NC = SEQ / 64;
        for (int c = -1; c < NC; ++c) {
            float* tab = TAB + (c & 1) * 320;
            if (c >= 0) {
            __syncthreads();
            {
                const int rt = w & 3, vt = w >> 2;
                f32x4 a1 = (f32x4){0.f, 0.f, 0.f, 0.f}, a2 = (f32x4){0.f, 0.f, 0.f, 0.f};
#pragma unroll
                for (int ks = 0; ks < 2; ++ks) {
                    const bf16x8 sa_ = *(const bf16x8*)(Ss + (rt * 16 + fr) * SP + ks * 32 + fq * 8);
                    const bf16x8 vb = *(const bf16x8*)(Vt + (vt * 16 + fr) * SP + ks * 32 + fq * 8);
                    a1 = __builtin_amdgcn_mfma_f32_16x16x32_bf16(sa_, vb, a1, 0, 0, 0);
                }
#pragma unroll
                for (int ks = 0; ks < 8; ++ks) {
                    const bf16x8 qa = *(const bf16x8*)(Qs + (rt * 16 + fr) * QP + ks * 32 + fq * 8);
                    const bf16x8 cb = *(const bf16x8*)(Cs + (vt * 16 + fr) * QP + ks * 32 + fq * 8);
                    a2 = __builtin_amdgcn_mfma_f32_16x16x32_bf16(qa, cb, a2, 0, 0, 0);
                }
#pragma unroll
                for (int e = 0; e < 4; ++e) { const int i = rt * 16 + fq * 4 + e; Osm[i * 33 + vt * 16 + fr] = a1[e] + tab[128 + i] * a2[e]; }
            }
            {
#pragma unroll
                for (int kl = 0; kl < 2; ++kl)
#pragma unroll
                    for (int vt = 0; vt < 2; ++vt) Cacc[kl][vt] = Cacc[kl][vt] * decay;
#pragma unroll
                for (int kl = 0; kl < 2; ++kl) {
                    const int kcol = (2 * w + kl) * 16 + fr;
#pragma unroll
                    for (int ks = 0; ks < 2; ++ks) {
                        bf16x8 ka;
#pragma unroll
                        for (int e = 0; e < 8; ++e) ka[e] = (short)Ks[(ks * 32 + fq * 8 + e) * QP + kcol];
#pragma unroll
                        for (int vt = 0; vt < 2; ++vt) {
                            const bf16x8 vb = *(const bf16x8*)(Vw + (vt * 16 + fr) * SP + ks * 32 + fq * 8);
                            Cacc[kl][vt] = __builtin_amdgcn_mfma_f32_16x16x32_bf16(ka, vb, Cacc[kl][vt], 0, 0, 0);
                        }
                    }
                }
            }
            }
            float vnx[8], decay_n = 0.f, m_nx = m_cur;
            if (c + 1 < NC) {
                if (tid < 128) {
                    float x[8]; unpack8(xmr, x);
                    const int lgv = vs * 4 + vhalf * 2;
#pragma unroll
                    for (int g2 = 0; g2 < 2; ++g2) {
                        const float* Wv = WTS + 2048 + (lgv + g2) * 16;
#pragma unroll
                        for (int o = 0; o < 4; ++o) vnx[4 * g2 + o] = Wv[0 * 4 + o] * x[4 * g2] + Wv[1 * 4 + o] * x[4 * g2 + 1] + Wv[2 * 4 + o] * x[4 * g2 + 2] + Wv[3 * 4 + o] * x[4 * g2 + 3];
                    }
                }
                float sa = gf, sc = gi;
#define SCAN_STEP(CTRL, RM) do { const float ao = dppf<CTRL, RM>(0.f, sa), co = dppf<CTRL, RM>(-INFINITY, sc); sc = fmaxf(co + sa, sc); sa = ao + sa; } while (0)
                SCAN_STEP(0x111, 0xf); SCAN_STEP(0x112, 0xf); SCAN_STEP(0x114, 0xf); SCAN_STEP(0x118, 0xf);
                SCAN_STEP(0x142, 0xa);
                SCAN_STEP(0x143, 0xc);
#undef SCAN_STEP
                const float Mi = fmaxf(m_cur + sa, sc);
                const float gtot = readlane_f(sa, 63); m_nx = readlane_f(Mi, 63);
                decay_n = __expf(gtot + m_cur - m_nx);
                if (w == 0) {
                    float* tn = TAB + ((c + 1) & 1) * 320;
                    tn[lane] = sa - Mi; tn[64 + lane] = gi - sa; tn[128 + lane] = __expf(sa + m_cur - Mi); tn[192 + lane] = __expf(-Mi); tn[256 + lane] = __expf(gtot - sa + gi - m_nx);
                }
            }
            if (c >= 0) {
            __syncthreads();
            {
#pragma unroll
                for (int kl = 0; kl < 2; ++kl)
#pragma unroll
                    for (int vt = 0; vt < 2; ++vt) {
                        u32x2 wv; wv.x = pk2(Cacc[kl][vt][0], Cacc[kl][vt][1]); wv.y = pk2(Cacc[kl][vt][2], Cacc[kl][vt][3]);
                        *(u32x2*)(Cs + (vt * 16 + fr) * QP + (2 * w + kl) * 16 + fq * 4) = wv;
                    }
                const int i = tid >> 3, vp = (tid & 7) * 2;
                const float den = Osm[i * 33 + 16], dn = fmaxf(fabsf(den), tab[192 + i]);
                const float rdn = __builtin_amdgcn_rcpf(dn); const float h0 = Osm[i * 33 + vp] * rdn, h1 = Osm[i * 33 + vp + 1] * rdn;
                *(unsigned*)(HM + ((size_t)(bh * 16 + vs) * SEQ + (size_t)c * 64 + i) * 16 + vp) = pk2(h0, h1);
            }
            }
            if (c + 1 < NC) {
#pragma unroll
                for (int i = 0; i < 4; ++i) { const int r = srow + 16 * i; *(u32x4*)(Qs + r * QP + scol) = qr[i]; *(u32x4*)(Ks + r * QP + scol) = xr[i]; }
                if (c < 0) __syncthreads();
                const float* tn = TAB + ((c + 1) & 1) * 320;
                if (tid < 128) {
                    const float wk = tn[256 + vrow];
#pragma unroll
                    for (int e = 0; e < 8; ++e) { Vt[(vhalf * 8 + e) * SP + vrow] = (bf16_t)(pk2(vnx[e], 0.f) & 0xffffu); Vw[(vhalf * 8 + e) * SP + vrow] = (bf16_t)(pk2(vnx[e] * wk, 0.f) & 0xffffu); }
                } else if (tid < 192) { Vw[16 * SP + (tid - 128)] = (bf16_t)(pk2(tn[256 + tid - 128], 0.f) & 0xffffu); }
#define SS_ITEM(li, sr) do { int it_, jt_; if ((li) < 4) { it_ = 3; jt_ = (li); } else if ((li) < 7) { it_ = 2; jt_ = (li) - 4; } else if ((li) < 9) { it_ = 1; jt_ = (li) - 7; } else { it_ = 0; jt_ = 0; } \
        const int i_ = it_ * 16 + fr, j0_ = jt_ * 16 + fq * 4; const float rf_ = tn[i_]; const f32x4 cf_ = *(const f32x4*)(tn + 64 + j0_); \
        const float sv_[4] = {bflo((sr).x), bfhi((sr).x), bflo((sr).y), bfhi((sr).y)}; float o_[4]; \
        _Pragma("unroll") for (int e = 0; e < 4; ++e) o_[e] = (j0_ + e <= i_) ? sv_[e] * __expf(rf_ + cf_[e]) : 0.f; \
        u32x2 wv_; wv_.x = pk2(o_[0], o_[1]); wv_.y = pk2(o_[2], o_[3]); *(u32x2*)(Ss + i_ * SP + j0_) = wv_; } while (0)
                SS_ITEM(w, sr0);
                if (w < 2) SS_ITEM(w + 8, sr1);
#undef SS_ITEM
                decay = decay_n; m_cur = m_nx;
                if (c + 2 < NC) {
                    const size_t t2 = tbase + (size_t)(c + 2) * 64;
#pragma unroll
                    for (int i = 0; i < 4; ++i) { xr[i] = *(const u32x4*)(XC + (t2 + srow + 16 * i) * D + h * 256 + scol); qr[i] = *(const u32x4*)(QG + (t2 + srow + 16 * i) * D + h * 256 + scol); }
                    if (tid < 128) xmr = *(const u32x4*)(XM + (t2 + vrow) * D + h * 256 + vs * 16 + vhalf * 8);
                    gi = GATES[(t2 + lane) * 8 + h]; gf = GATES[(t2 + lane) * 8 + 4 + h];
                    const unsigned char* sp = sraw_ptr(ws, bh * 128 + c + 2);
                    sr0 = *(const u32x2*)(sp + tid * 8); if (tid < 128) sr1 = *(const u32x2*)(sp + 4096 + tid * 8);
                }
            }
        }
    }
}

__device__ __forceinline__ void p7_mlstm_fin(const Args& a) {
    unsigned char* ws = a.ws; const int tid = opaque_tid(), lane = tid & 63, wave = tid >> 6;
    const int gw = blockIdx.x * 8 + wave, NGW = gridDim.x * 8;
    const bf16_t* HM = (const bf16_t*)a.out + (size_t)T * D; const bf16_t* XC = (const bf16_t*)(ws + WS_XC); bf16_t* ZM = (bf16_t*)(ws + WS_ZM);
    float lnw[16], skp[16];
#pragma unroll
    for (int j = 0; j < 4; ++j) { const f32x4 p = *(const f32x4*)(a.in[I_LNW] + lane * 16 + 4 * j), q = *(const f32x4*)(a.in[I_SKIP] + lane * 16 + 4 * j); for (int e = 0; e < 4; ++e) { lnw[4 * j + e] = p[e]; skp[4 * j + e] = q[e]; } }
    for (int m = gw; m < T; m += NGW) {
        const size_t off = (size_t)m * D + lane * 16;
        float hv[16], xc[16], z[16];
        { const size_t hoff = ((size_t)(((m / SEQ) * 4 + (lane >> 4)) * 16 + (lane & 15)) * SEQ + (size_t)(m % SEQ)) * 16;
          unpack8(*(const u32x4*)(HM + hoff), hv); unpack8(*(const u32x4*)(HM + hoff + 8), hv + 8); }
        unpack8(*(const u32x4*)(XC + off), xc); unpack8(*(const u32x4*)(XC + off + 8), xc + 8);
        unpack8(*(const u32x4*)(ZM + off), z); unpack8(*(const u32x4*)(ZM + off + 8), z + 8);
        float s = 0.f;
#pragma unroll
        for (int e = 0; e < 16; ++e) s += hv[e];
        s += __shfl_xor(s, 1); s += __shfl_xor(s, 2); s += __shfl_xor(s, 4); s += __shfl_xor(s, 8);
        const float mu = s * (1.0f / 256.0f); float q = 0.f;
#pragma unroll
        for (int e = 0; e < 16; ++e) { hv[e] -= mu; q += hv[e] * hv[e]; }
        q += __shfl_xor(q, 1); q += __shfl_xor(q, 2); q += __shfl_xor(q, 4); q += __shfl_xor(q, 8);
        const float rstd = rsqrtf(q * (1.0f / 256.0f) + EPS);
        float o[16], ss = 0.f;
#pragma unroll
        for (int e = 0; e < 16; ++e) { o[e] = (hv[e] * rstd * lnw[e] + skp[e] * xc[e]) * siluf_(z[e]); ss += o[e] * o[e]; }
        ss = wave_sum(ss);
        const float rs = rsqrtf(ss * (1.0f / 1024.0f) + EPS);
#pragma unroll
        for (int e = 0; e < 16; ++e) o[e] *= rs;
        *(u32x4*)(ZM + off) = pack8(o); *(u32x4*)(ZM + off + 8) = pack8(o + 8);
    }
}
__device__ __forceinline__ void p7_rg_fin(const Args& a, unsigned char* lds) {
    unsigned char* ws = a.ws; const int tid = opaque_tid();
    unsigned* LOGA = (unsigned*)(ws + WS_XR); const unsigned* U = (const unsigned*)(ws + WS_U); const unsigned* YR = (const unsigned*)(ws + WS_YR); const float* AGG = (const float*)(ws + WS_AGG);
    float* Ot = (float*)lds;
    constexpr int OP = 1028;
    for (int tile = blockIdx.x; tile < 256; tile += gridDim.x) {
        const int tc = tile & 63, tb = tile & ~63;
        float h0 = 0.f, h1 = 0.f;
        for (int p0 = 0; p0 < tc; p0 += 8) {
            f32x4 g[8];
#pragma unroll
            for (int q = 0; q < 8; ++q) { const int p = (p0 + q < tc) ? p0 + q : tc - 1; g[q] = *(const f32x4*)(AGG + ((size_t)(tb + p) * 1024 + 2 * tid) * 2); }
#pragma unroll
            for (int q = 0; q < 8; ++q) if (p0 + q < tc) { h0 = __expf(g[q][0]) * h0 + g[q][1]; h1 = __expf(g[q][2]) * h1 + g[q][3]; }
        }
        const size_t row0 = (size_t)tile * 128;
        for (int i0 = 0; i0 < 128; i0 += 16) {
            unsigned la[16], uu[16], yy[16];
#pragma unroll
            for (int i = 0; i < 16; ++i) { const size_t o = (row0 + i0 + i) * 512 + tid; la[i] = LOGA[o]; uu[i] = U[o]; yy[i] = YR[o]; }
            __syncthreads();
#pragma unroll
            for (int i = 0; i < 16; ++i) {
                h0 = __expf(bflo(la[i])) * h0 + bflo(uu[i]); h1 = __expf(bfhi(la[i])) * h1 + bfhi(uu[i]);
                Ot[i * OP + 2 * tid] = h0 * geluf_(bflo(yy[i])); Ot[i * OP + 2 * tid + 1] = h1 * geluf_(bfhi(yy[i]));
            }
            __syncthreads();
            {
                const int row = tid >> 5, sub = tid & 31;
                f32x4 v[4][2]; float ss = 0.f;
#pragma unroll
                for (int q = 0; q < 4; ++q)
#pragma unroll
                    for (int hh = 0; hh < 2; ++hh) { v[q][hh] = *(const f32x4*)(Ot + row * OP + q * 256 + sub * 8 + hh * 4); const f32x4 t = v[q][hh]; ss += (t[0] * t[0] + t[1] * t[1]) + (t[2] * t[2] + t[3] * t[3]); }
                ss += __shfl_xor(ss, 1); ss += __shfl_xor(ss, 2); ss += __shfl_xor(ss, 4); ss += __shfl_xor(ss, 8); ss += __shfl_xor(ss, 16);
                const float rs = rsqrtf(ss * (1.0f / 1024.0f) + EPS);
                bf16_t* orow = (bf16_t*)LOGA + (row0 + i0 + row) * D;
#pragma unroll
                for (int q = 0; q < 4; ++q) { const f32x4 p = v[q][0] * rs, r = v[q][1] * rs; u32x4 wv; wv.x = pk2(p[0], p[1]); wv.y = pk2(p[2], p[3]); wv.z = pk2(r[0], r[1]); wv.w = pk2(r[2], r[3]); *(u32x4*)(orow + q * 256 + sub * 8) = wv; }
            }
        }
        __syncthreads();
    }
}

__device__ __forceinline__ void p11_final(const Args& a) {
    const int tid = opaque_tid(), lane = tid & 63, wave = tid >> 6;
    const int gw = blockIdx.x * 8 + wave, NGW = gridDim.x * 8;
    const float* SS = (const float*)(a.ws + WS_SSD); const float* gn = a.in[I_NFIN]; const bf16_t* X3 = (const bf16_t*)(a.ws + WS_XB);
    f32x4 g[4];
#pragma unroll
    for (int j = 0; j < 4; ++j) g[j] = *((const f32x4*)gn + lane * 4 + j);
    for (int m0 = gw; m0 < T; m0 += 2 * NGW) {
        const bool two = (m0 + NGW < T);
        const int m1 = two ? m0 + NGW : m0;
        const size_t off0 = (size_t)m0 * D + lane * 16, off1 = (size_t)m1 * D + lane * 16;
        const u32x4 a0 = *(const u32x4*)(X3 + off0), a1 = *(const u32x4*)(X3 + off0 + 8), b0 = *(const u32x4*)(X3 + off1), b1 = *(const u32x4*)(X3 + off1 + 8);
        const float rs0 = pg8::row_scale(SS, m0), rs1 = pg8::row_scale(SS, m1);
        float x[16];
        unpack8(a0, x); unpack8(a1, x + 8);
        { f32x4* o = (f32x4*)(a.out + off0);
#pragma unroll
          for (int j = 0; j < 4; ++j) { f32x4 v = (f32x4){x[4 * j], x[4 * j + 1], x[4 * j + 2], x[4 * j + 3]}; o[j] = v * rs0 * g[j]; } }
        if (two) {
            unpack8(b0, x); unpack8(b1, x + 8);
            f32x4* o = (f32x4*)(a.out + off1);
#pragma unroll
            for (int j = 0; j < 4; ++j) { f32x4 v = (f32x4){x[4 * j], x[4 * j + 1], x[4 * j + 2], x[4 * j + 3]}; o[j] = v * rs1 * g[j]; }
        }
    }
}

#define XB_TMO      128
#define XB_XCNT(j)  (256  + 64 * (j))
#define XB_XSUB(j)  (1280 + 64 * (j))
#define XB_XGEN(j)  (2304 + 64 * (j))
#define XB_TOP      3328
#define XB_TOPGEN   3392
#define XCD_BAR_WORDS 3456
#define XB_SPIN_CAP (1u << 18)
__device__ __forceinline__ unsigned xb_ld(unsigned* p)              { return __hip_atomic_load(p, __ATOMIC_RELAXED, __HIP_MEMORY_SCOPE_AGENT); }
__device__ __forceinline__ unsigned xb_add(unsigned* p, unsigned v) { return __hip_atomic_fetch_add(p, v, __ATOMIC_RELAXED, __HIP_MEMORY_SCOPE_AGENT); }
__device__ __forceinline__ unsigned xb_xcc_id() { return (unsigned)__builtin_amdgcn_s_getreg((3 << 11) | 20) & 0xFu; }
#define XB_SPIN(cond, bar) do { unsigned _sp = 0; while (cond) { __builtin_amdgcn_s_sleep(1); \
    if ((++_sp & 255u) == 0u) { if (xb_ld(&(bar)[XB_TMO])) break; if (_sp > XB_SPIN_CAP) { atomicAdd(&(bar)[XB_TMO], 1u); break; } } } } while (0)
struct XcdBarrier { unsigned* bar; unsigned x; volatile LAS unsigned* st; };
__device__ __forceinline__ XcdBarrier xcd_barrier_post(unsigned* bar, volatile LAS unsigned* st) {
    XcdBarrier b; b.bar = bar; b.x = xb_xcc_id(); b.st = st;
    if (threadIdx.x == 0) (void)xb_add(&bar[XB_XCNT(b.x)], 1u);
    return b;
}
__device__ __forceinline__ void xcd_barrier_complete(unsigned* bar, unsigned x, unsigned& nloc, unsigned& nx) {
    const unsigned G = gridDim.x * gridDim.y * gridDim.z;
    unsigned sum, cnt, mine, sp = 0u;
    for (;;) {
        sum = 0u; cnt = 0u; mine = 0u;
#pragma unroll
        for (unsigned j = 0; j < 16; ++j) { const unsigned c = xb_ld(&bar[XB_XCNT(j)]); sum += c; cnt += (c > 0u) ? 1u : 0u; mine = (j == x) ? c : mine; }
        if (sum == G) break;
        __builtin_amdgcn_s_sleep(1);
        if ((++sp & 255u) == 0u) { if (xb_ld(&bar[XB_TMO])) break; if (sp > XB_SPIN_CAP) { atomicAdd(&bar[XB_TMO], 1u); break; } }
    }
    nloc = mine > 0u ? mine : 1u; nx = cnt > 0u ? cnt : 1u;
}
__device__ __forceinline__ void xcd_barrier(const XcdBarrier& b) {
    asm volatile("s_waitcnt vmcnt(0)" ::: "memory");
    __syncthreads();
    if (threadIdx.x == 0) {
        unsigned* bar = b.bar;
        __builtin_amdgcn_s_waitcnt(0);
        unsigned nloc = b.st[0], nx = b.st[1];
        if (nloc == 0u) { xcd_barrier_complete(bar, b.x, nloc, nx); b.st[0] = nloc; b.st[1] = nx; }
        const unsigned old = xb_add(&bar[XB_XSUB(b.x)], 1u);
        const unsigned gen = old / nloc;
        if (old + 1u == (gen + 1u) * nloc) {
            __builtin_amdgcn_fence(__ATOMIC_RELEASE, "agent");
            asm volatile("s_waitcnt vmcnt(0)" ::: "memory");
            const unsigned og = xb_add(&bar[XB_TOP], 1u);
            const unsigned tg = og / nx;
            if (og + 1u == (tg + 1u) * nx) xb_add(&bar[XB_TOPGEN], 1u);
            else XB_SPIN(xb_ld(&bar[XB_TOPGEN]) == tg, bar);
            __builtin_amdgcn_fence(__ATOMIC_ACQUIRE, "agent");
            xb_add(&bar[XB_XGEN(b.x)], 1u);
            asm volatile("s_waitcnt vmcnt(0)" ::: "memory");
        } else {
            XB_SPIN(xb_ld(&bar[XB_XGEN(b.x)]) == gen, bar);
            __builtin_amdgcn_fence(__ATOMIC_ACQUIRE, "agent");
            asm volatile("s_waitcnt vmcnt(0)" ::: "memory");
        }
    }
    __syncthreads();
}
#define GSYNC() xcd_barrier(xbar)
__global__ void __launch_bounds__(512, 2) mk_fwd(Args args) {
    extern __shared__ __attribute__((aligned(16))) unsigned char lds_raw[];
    cg::grid_group grid = cg::this_grid();
    LAS unsigned char* lds = (LAS unsigned char*)lds_raw;
    unsigned char* ws = args.ws;
    const int G = gridDim.x, bid = blockIdx.x;
    volatile LAS unsigned* xst = (volatile LAS unsigned*)(lds + (LDS_BYTES - 64));
    if (threadIdx.x == 0) { xst[0] = 0u; xst[1] = 0u; }
    __syncthreads();
    const XcdBarrier xbar = xcd_barrier_post((unsigned*)(ws + WS_BAR), xst);
    bf16_t* XB = (bf16_t*)(ws + WS_XB); bf16_t* ACT = (bf16_t*)(ws + WS_R1);
#ifndef NO_P0
    p0_prologue(args, lds_raw);
#endif
    GSYNC();
    if (gridDim.x == 0x7fffffffu) grid.sync();
#ifndef NO_P1
    { const pg8::Gemm gUp1{XB, (const bf16_t*)(ws + WS_WGU1), 1024, 1024, 1 << 30, 0, 0, 0}; pg8::StaticOrder S; S.init(T, 2 * FF, G, bid); pg8::EpiSwiGLU E{ACT, (const float*)(ws + WS_SSA)}; pg8::gemm_phase(lds, gUp1, S, E); }
#endif
    GSYNC();
#ifndef NO_P2
    { const pg8::Gemm gDn1{ACT, (const bf16_t*)(ws + WS_WD1), FF, FF, 1 << 30, 0, 0, 0}; pg8::StaticOrder S; S.init(T, D, G, bid); pg8::EpiResidB E{nullptr, XB  , XB  , nullptr, (float*)(ws + WS_SSB), 0.5f}; pg8::gemm_phase(lds, gDn1, S, E); }
#endif
    GSYNC();
#ifndef NO_P3
    { const pg8::Gemm gIn{XB, (const bf16_t*)(ws + WS_WIN), 1024, 1024, 1 << 30, 0, 0, 0}; pg8::StaticOrder S; S.init(T, 4096, G, bid); pg8::EpiProj E{(bf16_t*)(ws + WS_XM), (const float*)(ws + WS_SSB)}; pg8::gemm_phase(lds, gIn, S, E); }
#endif
    GSYNC();
#ifndef NO_P4
    p4_conv(args);
#endif
    GSYNC();
#ifndef NO_P5
    {
        const bf16_t* XCR = (const bf16_t*)args.out + (size_t)T * D;
        const pg8::Gemm gRg{XCR, (const bf16_t*)(ws + WS_WRG), 256, 1024, 1 << 30, 0, 1, 512};
        const pg8::Gemm gGt{(const bf16_t*)(ws + WS_XC), (const bf16_t*)(ws + WS_WG8), 2048, 1024, 16, (long)WS_XM - (long)WS_XC - 16 * 128, 0, 0};
        pg8::EpiGates Eg{(float*)(ws + WS_GATES), args.in[I_BGATES]};
        pg8::EpiRg Er{XCR, args.in[I_RBA], args.in[I_RBX], (const float*)(ws + WS_C8), (bf16_t*)(ws + WS_XR), (bf16_t*)(ws + WS_U)};
        if (G == 256) {
#ifndef NO_P5G
            if (bid < 128) { pg8::ListOrder S{bid, 1, 0}; pg8::gemm_phase(lds, gGt, S, Eg); }
#endif
#ifndef NO_P5R
            if (bid >= 128) { pg8::ListOrder S{(bid - 128) * 8, 8, 3}; pg8::gemm_phase(lds, gRg, S, Er); }
#endif
        } else {
#ifndef NO_P5G
            for (int u = bid; u < 128; u += G) { pg8::ListOrder S{u, 1, 0}; pg8::gemm_phase(lds, gGt, S, Eg); }
#endif
#ifndef NO_P5R
            for (int u = bid; u < 128; u += G) { pg8::ListOrder S{u * 8, 8, 3}; pg8::gemm_phase(lds, gRg, S, Er); }
#endif
        }
    }
#endif
    GSYNC();
#ifndef NO_P6A
    p6_rg_agg(args);
#endif
    p5b_sraw(args, lds_raw);
    GSYNC();
#ifndef NO_P6
    p6_mlstm(args, lds_raw);
#endif
    GSYNC();
#ifndef NO_P7A
    p7_mlstm_fin(args);
#endif
#ifndef NO_P7B
    p7_rg_fin(args, lds_raw);
#endif
    GSYNC();
#ifndef NO_P8
    { const pg8::Gemm gOut{(const bf16_t*)(ws + WS_ZM)  , (const bf16_t*)(ws + WS_WOUT), 2048, 1024, 16, (long)(64 * MiB) - 16 * 128, 0, 0}; pg8::StaticOrder S; S.init(T, D, G, bid); pg8::EpiResidB E{nullptr, XB, XB  , nullptr, (float*)(ws + WS_SSC), 1.0f}; pg8::gemm_phase(lds, gOut, S, E); }
#endif
    GSYNC();
#ifndef NO_P9
    { const pg8::Gemm gUp2{XB, (const bf16_t*)(ws + WS_WGU2), 1024, 1024, 1 << 30, 0, 0, 0}; pg8::StaticOrder S; S.init(T, 2 * FF, G, bid); pg8::EpiSwiGLU E{ACT, (const float*)(ws + WS_SSC)}; pg8::gemm_phase(lds, gUp2, S, E); }
#endif
    GSYNC();
#ifndef NO_P10
    { const pg8::Gemm gDn2{ACT, (const bf16_t*)(ws + WS_WD2), FF, FF, 1 << 30, 0, 0, 0}; pg8::StaticOrder S; S.init(T, D, G, bid); pg8::EpiResidB E{nullptr, XB, XB  , nullptr, (float*)(ws + WS_SSD), 0.5f}; pg8::gemm_phase(lds, gDn2, S, E); }
#endif
    GSYNC();
#ifndef NO_P11
    p11_final(args);
#endif
}

extern "C" void kernel_launch(void* const* d_in, const int* in_sizes, int n_in, void* d_out, int out_size, void* d_ws, size_t ws_size, hipStream_t stream) {
    static int grid = 0;
    if (grid == 0) {
        if (n_in != 31 || in_sizes[0] != T * D || out_size != T * D || ws_size < WS_END) { fprintf(stderr, "kernel_launch: unexpected shapes (n_in %d, in0 %d, out %d, ws %zu)\n", n_in, n_in > 0 ? in_sizes[0] : -1, out_size, ws_size); grid = -1; return; }
        int dev = 0, cus = 0, per_cu = 0;
        if (hipGetDevice(&dev) != hipSuccess || hipDeviceGetAttribute(&cus, hipDeviceAttributeMultiprocessorCount, dev) != hipSuccess) { grid = -1; return; }
        if (hipFuncSetAttribute((const void*)mk_fwd, hipFuncAttributeMaxDynamicSharedMemorySize, LDS_BYTES) != hipSuccess) { fprintf(stderr, "kernel_launch: hipFuncSetAttribute failed\n"); grid = -1; return; }
        if (hipOccupancyMaxActiveBlocksPerMultiprocessor(&per_cu, (const void*)mk_fwd, 512, LDS_BYTES) != hipSuccess || per_cu < 1) { fprintf(stderr, "kernel_launch: occupancy query says %d\n", per_cu); (void)hipGetLastError(); grid = -1; return; }
        grid = cus;
    }
    if (grid < 0) return;
    if (hipMemsetAsync((char*)d_ws + WS_BAR, 0, 16384, stream) != hipSuccess) { fprintf(stderr, "kernel_launch: memset of barrier words failed\n"); return; }
    Args a{};
    for (int i = 0; i < 31; ++i) a.in[i] = (const float*)d_in[i];
    a.out = (float*)d_out; a.ws = (unsigned char*)d_ws;
    void* kargs[] = {&a};
    hipError_t e = hipLaunchCooperativeKernel((const void*)mk_fwd, dim3(grid), dim3(512), kargs, LDS_BYTES, stream);
    if (e != hipSuccess) fprintf(stderr, "kernel_launch: cooperative launch failed: %s (grid %d)\n", hipGetErrorString(e), grid);
}
```
